# Optimizing an MI355X kernel written in HIP

```python
import math
import jax, jax.numpy as jnp
from jax import lax
import numpy as np

D_MODEL = 4096
BATCH = 1
SEQ = 16384
DEPTH = 4

TOTAL_HEADS = 32
HEAD_DIM = D_MODEL // TOTAL_HEADS
GRID_W = 64
A_HEADS = 12
A_PATTERNS = ((128, 1), (512, 4), (2048, 16))
B_HEADS = 8
B_KV_HEADS = 2
B_HALF_WINDOW = 128
C_HEADS = 12
C_KV_HEADS = 4
Q_BLOCK = 128
ROPE_THETA = 10000.0
NUM_BUCKETS = 32
MAX_DISTANCE = 1024
EPS = 1e-6
NEG_INF = -1e30

A_W = A_HEADS * HEAD_DIM
B_W = B_HEADS * HEAD_DIM
B_KV_W = B_KV_HEADS * HEAD_DIM
C_W = C_HEADS * HEAD_DIM
C_KV_W = C_KV_HEADS * HEAD_DIM
MIX_WIDTH = A_W + B_W + C_W
SPLITS = (A_W, A_W, A_W, A_W, B_W, B_KV_W, B_KV_W, B_W, C_W, C_KV_W, C_KV_W, C_W)
IN_WIDTH = 4 * A_W + 2 * B_W + 2 * B_KV_W + 2 * C_W + 2 * C_KV_W

kernel_name = 'hybrid_dilated_window_axial_encoder'


def rms_norm(x, g):
    xf = x.astype(jnp.float32)
    y = xf * lax.rsqrt(jnp.mean(xf * xf, axis=-1, keepdims=True) + EPS)
    return (y * g.astype(jnp.float32)).astype(x.dtype)


def t5_bucket(rel):
    half_b = NUM_BUCKETS // 2
    max_exact = half_b // 2
    ret = jnp.where(rel > 0, half_b, 0)
    n = jnp.abs(rel)
    nf = jnp.maximum(n, 1).astype(jnp.float32)
    large = max_exact + (jnp.log(nf / max_exact) / math.log(MAX_DISTANCE / max_exact)
                         * (half_b - max_exact)).astype(jnp.int32)
    large = jnp.minimum(large, half_b - 1)
    return ret + jnp.where(n < max_exact, n, large)


def band_bias(table, half, dil):
    r = jnp.arange(half)[:, None]
    cix = jnp.arange(3 * half)[None, :]
    rel = (cix - half - r) * dil
    return table[t5_bucket(rel)].astype(jnp.float32).transpose(2, 0, 1)


def banded_attention(q, k, v, half, bias):
    N, L, H, Dh = q.shape
    Hkv = k.shape[2]
    G = H // Hkv
    blk = half
    nb = -(-L // blk)
    pad = nb * blk - L
    qf = jnp.pad(q.astype(jnp.float32), ((0, 0), (0, pad), (0, 0), (0, 0)))
    kf = jnp.pad(k.astype(jnp.float32), ((0, 0), (blk, blk + pad), (0, 0), (0, 0)))
    vf = jnp.pad(v.astype(jnp.float32), ((0, 0), (blk, blk + pad), (0, 0), (0, 0)))
    qb = qf.reshape(N, nb, blk, Hkv, G, Dh)
    kr = kf.reshape(N, nb + 2, blk, Hkv, Dh)
    vr = vf.reshape(N, nb + 2, blk, Hkv, Dh)
    kb = jnp.concatenate([kr[:, :-2], kr[:, 1:-1], kr[:, 2:]], axis=2)
    vb = jnp.concatenate([vr[:, :-2], vr[:, 1:-1], vr[:, 2:]], axis=2)
    s = jnp.einsum('nbqkgd,nbckd->nbkgqc', qb, kb) * (Dh ** -0.5)
    s = s + bias.reshape(Hkv, G, blk, 3 * blk)
    r = jnp.arange(blk)[:, None]
    cix = jnp.arange(3 * blk)[None, :]
    kglob = jnp.arange(nb)[:, None, None] * blk + cix[None] - blk
    valid = (jnp.abs(cix - blk - r) <= half)[None] & (kglob >= 0) & (kglob < L)
    s = jnp.where(valid[None, :, None, None], s, NEG_INF)
    m = jnp.max(s, axis=-1)
    p = jnp.exp(s - m[..., None])
    l = jnp.sum(p, axis=-1)
    acc = jnp.einsum('nbkgqc,nbckd->nbqkgd', p, vb).reshape(N, nb * blk, H, Dh)[:, :L]
    m = m.transpose(0, 1, 4, 2, 3).reshape(N, nb * blk, H)[:, :L]
    l = l.transpose(0, 1, 4, 2, 3).reshape(N, nb * blk, H)[:, :L]
    return acc, m, l


def dilated_attention(q, k, v, biases):
    B, S, H, Dh = q.shape
    accs, ms, ls = [], [], []
    for (w, d), bias in zip(A_PATTERNS, biases):
        L = S // d
        def to_res(t):
            return t.reshape(B, L, d, t.shape[2], Dh).transpose(0, 2, 1, 3, 4).reshape(B * d, L, t.shape[2], Dh)
        acc, m, l = banded_attention(to_res(q), to_res(k), to_res(v), w // (2 * d), bias)
        accs.append(acc.reshape(B, d, L, H, Dh).transpose(0, 2, 1, 3, 4).reshape(B, S, H, Dh))
        ms.append(m.reshape(B, d, L, H).transpose(0, 2, 1, 3).reshape(B, S, H))
        ls.append(l.reshape(B, d, L, H).transpose(0, 2, 1, 3).reshape(B, S, H))
    mx = jnp.maximum(jnp.maximum(ms[0], ms[1]), ms[2])
    ws = [jnp.exp(m - mx) for m in ms]
    num = accs[0] * ws[0][..., None] + accs[1] * ws[1][..., None] + accs[2] * ws[2][..., None]
    den = ls[0] * ws[0] + ls[1] * ws[1] + ls[2] * ws[2]
    return (num / den[..., None]).astype(q.dtype)


def sink_window_attention(q, k, v, bias, sink):
    acc, m, l = banded_attention(q, k, v, B_HALF_WINDOW, bias)
    sk = sink.astype(jnp.float32)
    mx = jnp.maximum(m, sk)
    scale = jnp.exp(m - mx)
    den = l * scale + jnp.exp(sk - mx)
    return (acc * (scale / den)[..., None]).astype(q.dtype)


def rope_tables(pos, dim):
    freqs = ROPE_THETA ** (-jnp.arange(0, dim, 2, dtype=jnp.float32) / dim)
    ang = pos.astype(jnp.float32)[:, None] * freqs[None, :]
    return jnp.cos(ang), jnp.sin(ang)


def rotate(x, cos, sin):
    x1, x2 = jnp.split(x, 2, axis=-1)
    cos = cos[:, None, :]
    sin = sin[:, None, :]
    return jnp.concatenate([x1 * cos - x2 * sin, x2 * cos + x1 * sin], axis=-1)


def rope2d(x, tabs):
    cr, sr, cc, sc = tabs
    xf = x.astype(jnp.float32)
    hd = HEAD_DIM // 2
    return jnp.concatenate([rotate(xf[..., :hd], cr, sr), rotate(xf[..., hd:], cc, sc)], axis=-1).astype(x.dtype)


def dense_block_attention(q, k, v):
    B, S, H, Dh = q.shape
    Hkv = k.shape[2]
    G = H // Hkv
    nq = S // Q_BLOCK
    kf = k.astype(jnp.float32)
    vf = v.astype(jnp.float32)
    qb = q.astype(jnp.float32).reshape(B, nq, Q_BLOCK, Hkv, G, Dh).transpose(1, 0, 2, 3, 4, 5)
    def one_block(qblk):
        s = jnp.einsum('bqkgd,bskd->bkgqs', qblk, kf) * (Dh ** -0.5)
        p = jax.nn.softmax(s, axis=-1)
        return jnp.einsum('bkgqs,bskd->bqkgd', p, vf)
    o = lax.map(one_block, qb)
    return o.transpose(1, 0, 2, 3, 4, 5).reshape(B, S, H, Dh).astype(q.dtype)


def split_columns(t):
    outs, start = [], 0
    for w in SPLITS:
        outs.append(t[..., start:start + w])
        start += w
    return outs


def mixer_sublayer(h, w_in, w_out, q_gain, k_gain, sink, biases_a, bias_b, tabs):
    B, S, _ = h.shape
    proj = h @ w_in
    aq, ak, av, ag, bq, bk, bv, bg, cq, ck, cv, cg = split_columns(proj)
    heads = lambda t: t.reshape(B, S, -1, HEAD_DIM)
    oa = dilated_attention(heads(aq), heads(ak), heads(av), biases_a)
    ob = sink_window_attention(heads(bq), heads(bk), heads(bv), bias_b, sink)
    qc = rope2d(rms_norm(heads(cq), q_gain), tabs)
    kc = rope2d(rms_norm(heads(ck), k_gain), tabs)
    oc = dense_block_attention(qc, kc, heads(cv))
    o = jnp.concatenate([oa.reshape(B, S, A_W) * jax.nn.silu(ag),
                         ob.reshape(B, S, B_W) * jax.nn.silu(bg),
                         oc.reshape(B, S, C_W) * jax.nn.silu(cg)], axis=-1)
    return o @ w_out


def setup_inputs(seed: int = 0) -> dict:
    key = jax.random.key(seed)
    ks = jax.random.split(key, 12)
    nrm = jax.random.normal
    f32 = jnp.float32
    x = nrm(ks[0], (BATCH, SEQ, D_MODEL), f32)
    c = nrm(ks[1], (BATCH, D_MODEL), f32)
    w_mod = nrm(ks[2], (DEPTH, D_MODEL, 3 * D_MODEL), f32) * (0.5 * D_MODEL ** -0.5)
    b_mod = nrm(ks[3], (DEPTH, 3 * D_MODEL), f32) * 0.02
    pre_norm = 1.0 + 0.05 * nrm(ks[4], (DEPTH, D_MODEL), f32)
    post_norm = 1.0 + 0.05 * nrm(ks[5], (DEPTH, D_MODEL), f32)
    w_in = nrm(ks[6], (DEPTH, D_MODEL, IN_WIDTH), f32) * (D_MODEL ** -0.5)
    w_out = nrm(ks[7], (DEPTH, MIX_WIDTH, D_MODEL), f32) * (MIX_WIDTH ** -0.5)
    q_norm = 1.0 + 0.05 * nrm(ks[8], (DEPTH, HEAD_DIM), f32)
    k_norm = 1.0 + 0.05 * nrm(ks[9], (DEPTH, HEAD_DIM), f32)
    sink = nrm(ks[10], (DEPTH, B_HEADS), f32) * 0.5
    rel_bias = nrm(ks[11], (NUM_BUCKETS, A_HEADS + B_HEADS), f32) * 0.5
    return dict(x=x, c=c, w_mod=w_mod, b_mod=b_mod, pre_norm=pre_norm, post_norm=post_norm,
                w_in=w_in, w_out=w_out, q_norm=q_norm, k_norm=k_norm, sink=sink, rel_bias=rel_bias)


def reference(x, c, w_mod, b_mod, pre_norm, post_norm, w_in, w_out, q_norm, k_norm, sink, rel_bias):
    B, S, _ = x.shape
    rows = S // GRID_W
    row = jnp.repeat(jnp.arange(rows), GRID_W)
    col = jnp.tile(jnp.arange(GRID_W), rows)
    cr, sr = rope_tables(row, HEAD_DIM // 2)
    cc, sc = rope_tables(col, HEAD_DIM // 2)
    tabs = (cr, sr, cc, sc)
    biases_a = [band_bias(rel_bias[:, :A_HEADS], w // (2 * d), d) for (w, d) in A_PATTERNS]
    bias_b = band_bias(rel_bias[:, A_HEADS:], B_HALF_WINDOW, 1)
    cs = jax.nn.silu(c)
    for i in range(DEPTH):
        mod = cs @ w_mod[i] + b_mod[i]
        shift, scale, gate = jnp.split(mod, 3, axis=-1)
        h = rms_norm(x, pre_norm[i]) * (1.0 + scale[:, None, :]) + shift[:, None, :]
        y = mixer_sublayer(h, w_in[i], w_out[i], q_norm[i], k_norm[i], sink[i], biases_a, bias_b, tabs)
        x = x + gate[:, None, :] * rms_norm(y, post_norm[i])
    return x
```

```cpp
#include <hip/hip_runtime.h>
#include <hip/hip_bf16.h>
#include <cstdio>
#include <cstdint>
#include <cmath>

namespace pg8 {
#define PG8_LAS __attribute__((address_space(3)))
typedef unsigned short bf16_t;
typedef short bf16x8 __attribute__((ext_vector_type(8)));
typedef float f32x4 __attribute__((ext_vector_type(4)));
typedef unsigned u32x4 __attribute__((ext_vector_type(4)));
constexpr int BM = 256, BK = 64, HALF = 128, HTB = HALF * BK * 2  , STAGE_BYTES = 8 * HTB, NXCD = 8, WGM = 8;

__host__ __device__ __forceinline__ int lds_byte(int r, int c) { const int st = (r >> 4) * 2 + (c >> 5), rr = r & 15, cc = c & 31, ob = rr * 64 + cc * 2; return st * 1024 + (ob ^ (((ob >> 9) & 1) << 5)); }
__host__ __device__ __forceinline__ void stage_rc(int b, int& R, int& C) { const int st = b / 1024, sb = b % 1024, swz = sb ^ (((sb >> 9) & 1) << 5); R = (st >> 1) * 16 + swz / 64; C = (st & 1) * 32 + (swz % 64) / 2; }
__host__ __device__ __forceinline__ int perm32(int rho) { const int n = rho >> 4, i = rho & 15; return 8 * (i >> 2) + 4 * n + (i & 3); }

struct Unit { int pm, pn; };
struct Gemm { const bf16_t* A; const bf16_t* Bt; int M, N, K; };

struct StaticOrder {
    int nM, nN, nwg, G, c;
    __host__ __device__ void init(int M, int N, int G_, int c_) { nM = M / BM; nN = N / BM; nwg = nM * nN; G = G_; c = c_; }
    __host__ __device__ bool next(int i, Unit& u) const {
        const long L = (long)i * G + c; if (L >= nwg) return false;
        int wgid = (int)L; { const int q = nwg / NXCD, r = nwg % NXCD, xcd = wgid % NXCD, off = wgid / NXCD; wgid = (xcd < r ? xcd * (q + 1) : r * (q + 1) + (xcd - r) * q) + off; }
        const int nig = WGM * nN, gid = wgid / nig, fm = gid * WGM, gsz = (nM - fm) < WGM ? (nM - fm) : WGM;
        u.pm = fm + ((wgid % nig) % gsz); u.pn = (wgid % nig) / gsz; return true;
    }
    __device__ __forceinline__ void a_ready(const Unit&) const {}
    __device__ __forceinline__ void done(const Unit&) const {}
};

__device__ __forceinline__ unsigned cvt_pk_bf16(float lo, float hi) { unsigned r; asm volatile("v_cvt_pk_bf16_f32 %0, %1, %2" : "=v"(r) : "v"(lo), "v"(hi)); return r; }
struct EpiStore {
    static constexpr bool PERM = true, AFTER_DRAIN = false;
    bf16_t* O; int ldc;
    __device__ __forceinline__ void operator()(const f32x4 (&acc)[2][2][4][2], const Unit& u, int wr, int wc, int fr, int fq) const {
        const int row0 = u.pm * BM + wr * 64 + fr; const int col0 = u.pn * BM + wc * 32 + 8 * fq;
#pragma unroll
        for (int ai = 0; ai < 2; ++ai)
#pragma unroll
            for (int m = 0; m < 4; ++m) { bf16_t* rowp = O + (size_t)(row0 + ai * HALF + m * 16) * ldc + col0;
#pragma unroll
                for (int bj = 0; bj < 2; ++bj) { const f32x4 v0 = acc[ai][bj][m][0], v1 = acc[ai][bj][m][1];
                    u32x4 w; w.x = cvt_pk_bf16(v0[0], v0[1]); w.y = cvt_pk_bf16(v0[2], v0[3]); w.z = cvt_pk_bf16(v1[0], v1[1]); w.w = cvt_pk_bf16(v1[2], v1[3]);
                    *(u32x4*)(rowp + bj * HALF) = w; } }
    }
    __device__ __forceinline__ void fused(f32x4 (&acc)[2][2][4][2], const Unit& u, int wr, int wc, int fr, int fq, PG8_LAS unsigned char* lds, int wid, int lane) const {}
};

template <class Epi, class Sched, bool ALIGN_EPI = false, bool SP2 = false>
__device__ __forceinline__ void gemm_phase(PG8_LAS unsigned char* lds, const Gemm g, const Sched& S, const Epi& E) {
    int tid_l = threadIdx.x; asm volatile("" : "+v"(tid_l));
    const int tid = tid_l, wid = __builtin_amdgcn_readfirstlane(tid >> 6), lane = tid & 63, wr = wid >> 2, wc = wid & 3, fr = lane & 15, fq = lane >> 4;
    const int K = g.K, nt = K / BK;
    unsigned voffA[2], voffB[2];
#pragma unroll
    for (int i = 0; i < 2; ++i) { int R, C; stage_rc(tid * 16 + i * 8192, R, C); const int Rb = Epi::PERM ? ((R & ~31) + perm32(R & 31)) : R;
        voffA[i] = (unsigned)(R * K + C) * 2u; voffB[i] = (unsigned)(Rb * K + C) * 2u; }
    const size_t kstep = (size_t)(BK * 2);
    const size_t hstep = (size_t)HALF * K * 2;
    const size_t tstep = 2 * hstep;
    const unsigned ldsw = (unsigned)wid * 1024u;
    const int aoff = lds_byte(wr * 64 + fr, fq * 8), boff = lds_byte(wc * 32 + fr, fq * 8);
#define PG8_SA(b, h) (((b) * 2 + (h)) * HTB)
#define PG8_SB(b, h) ((4 + (b) * 2 + (h)) * HTB)
#define PG8_STAGE(bufoff, gbase, voff) do { _Pragma("unroll") for (int _i = 0; _i < 2; ++_i) \
        __builtin_amdgcn_global_load_lds((const unsigned*)((const char*)(gbase) + (voff)[_i]), (PG8_LAS unsigned*)(lds + (bufoff) + ldsw + _i * 8192), 16, 0, 0); } while (0)
#define PG8_LDA(dst, b, h) do { _Pragma("unroll") for (int m = 0; m < 4; ++m) _Pragma("unroll") for (int k = 0; k < 2; ++k) dst[m][k] = *(const PG8_LAS bf16x8*)(lds + PG8_SA(b, h) + aoff + m * 2048 + k * 1024); } while (0)
#define PG8_LDB(dst, b, h) do { _Pragma("unroll") for (int n = 0; n < 2; ++n) _Pragma("unroll") for (int k = 0; k < 2; ++k) dst[n][k] = *(const PG8_LAS bf16x8*)(lds + PG8_SB(b, h) + boff + n * 2048 + k * 1024); } while (0)
#define PG8_MMA(ai, bj, At, Bt) do { __builtin_amdgcn_s_setprio(1); _Pragma("unroll") for (int m = 0; m < 4; ++m) _Pragma("unroll") for (int n = 0; n < 2; ++n) _Pragma("unroll") for (int k = 0; k < 2; ++k) \
        acc[ai][bj][m][n] = __builtin_amdgcn_mfma_f32_16x16x32_bf16(Bt[n][k], At[m][k], acc[ai][bj][m][n], 0, 0, 0); __builtin_amdgcn_s_setprio(0); } while (0)
#define PG8_WAIT_V(n) asm volatile("s_waitcnt vmcnt(" #n ")" ::: "memory")
#define PG8_WAIT_L(n) asm volatile("s_waitcnt lgkmcnt(" #n ")" ::: "memory")
#define PG8_BAR __builtin_amdgcn_s_barrier()
#define PG8_SCHED __builtin_amdgcn_sched_barrier(0)
    Unit cur, nxt; int ui = 0;
    if (!S.next(0, cur)) return;
    f32x4 acc[2][2][4][2];
#pragma unroll
    for (int a = 0; a < 2; ++a)
#pragma unroll
        for (int b = 0; b < 2; ++b)
#pragma unroll
            for (int m = 0; m < 4; ++m)
#pragma unroll
                for (int n = 0; n < 2; ++n) acc[a][b][m][n] = (f32x4){0.f, 0.f, 0.f, 0.f};
    bf16x8 At[4][2], B0[2][2], B1[2][2];
    const char* cA = (const char*)g.A + (size_t)cur.pm * tstep; const char* cB = (const char*)g.Bt + (size_t)cur.pn * tstep;
    S.a_ready(cur);
    if constexpr (SP2) {
        PG8_STAGE(PG8_SB(0, 0), cB, voffB); PG8_STAGE(PG8_SB(0, 1), cB + hstep, voffB); PG8_STAGE(PG8_SA(0, 0), cA, voffA); PG8_STAGE(PG8_SA(0, 1), cA + hstep, voffA);
        if (wr == 1) PG8_BAR;
        PG8_WAIT_V(2); PG8_BAR;
        PG8_STAGE(PG8_SB(1, 0), cB + kstep, voffB); PG8_STAGE(PG8_SA(1, 0), cA + kstep, voffA); PG8_STAGE(PG8_SB(1, 1), cB + hstep + kstep, voffB);
        PG8_WAIT_V(6); PG8_BAR;
    } else {
        PG8_STAGE(PG8_SB(0, 0), cB, voffB); PG8_STAGE(PG8_SA(0, 0), cA, voffA); PG8_STAGE(PG8_SB(0, 1), cB + hstep, voffB); PG8_STAGE(PG8_SA(0, 1), cA + hstep, voffA);
        if (wr == 1) PG8_BAR;
        PG8_WAIT_V(4); PG8_BAR;
        PG8_STAGE(PG8_SB(1, 0), cB + kstep, voffB); PG8_STAGE(PG8_SA(1, 0), cA + kstep, voffA); PG8_STAGE(PG8_SB(1, 1), cB + hstep + kstep, voffB);
        PG8_WAIT_V(6); PG8_BAR;
    }
    for (;;) {
        const bool has_next = S.next(ui + 1, nxt);
        const char* nA = has_next ? (const char*)g.A + (size_t)nxt.pm * tstep : cA; const char* nB = has_next ? (const char*)g.Bt + (size_t)nxt.pn * tstep : cB;
        for (int t = 0; t < nt; t += 2) {
            const bool last = (t == nt - 2);
            const char* a1 = cA + (size_t)(t + 1) * kstep;
            const char* a2 = last ? nA : cA + (size_t)(t + 2) * kstep; const char* b2 = last ? nB : cB + (size_t)(t + 2) * kstep;
            const char* a3 = a2 + kstep; const char* b3 = b2 + kstep;
            if (last && has_next) S.a_ready(nxt);
            if constexpr (SP2) {
            PG8_LDB(B0, 0, 0); PG8_LDB(B1, 0, 1); PG8_SCHED; PG8_LDA(At, 0, 0); PG8_STAGE(PG8_SA(1, 1), a1 + hstep, voffA);
            PG8_WAIT_V(8); PG8_WAIT_L(0); PG8_BAR; PG8_MMA(0, 0, At, B0); PG8_MMA(0, 1, At, B1); PG8_BAR; PG8_SCHED;
            PG8_LDA(At, 0, 1); PG8_STAGE(PG8_SB(0, 0), b2, voffB); PG8_STAGE(PG8_SB(0, 1), b2 + hstep, voffB); PG8_STAGE(PG8_SA(0, 0), a2, voffA);
            PG8_WAIT_V(8); PG8_WAIT_L(0); PG8_BAR; PG8_MMA(1, 0, At, B0); PG8_MMA(1, 1, At, B1); PG8_BAR; PG8_SCHED;
            PG8_LDB(B0, 1, 0); PG8_LDB(B1, 1, 1); PG8_SCHED; PG8_LDA(At, 1, 0); PG8_STAGE(PG8_SA(0, 1), a2 + hstep, voffA);
            PG8_WAIT_V(8); PG8_WAIT_L(0); PG8_BAR; PG8_MMA(0, 0, At, B0); PG8_MMA(0, 1, At, B1); PG8_BAR; PG8_SCHED;
            PG8_LDA(At, 1, 1); PG8_STAGE(PG8_SB(1, 0), b3, voffB); PG8_STAGE(PG8_SB(1, 1), b3 + hstep, voffB); PG8_STAGE(PG8_SA(1, 0), a3, voffA);
            PG8_WAIT_V(8); PG8_WAIT_L(0); PG8_BAR; PG8_MMA(1, 0, At, B0); PG8_MMA(1, 1, At, B1); PG8_BAR; PG8_SCHED;
            } else {
            PG8_LDB(B0, 0, 0); PG8_SCHED; PG8_LDA(At, 0, 0); PG8_STAGE(PG8_SA(1, 1), a1 + hstep, voffA);
            PG8_WAIT_L(8); PG8_BAR; PG8_WAIT_L(0); PG8_MMA(0, 0, At, B0); PG8_BAR; PG8_SCHED;
            PG8_LDB(B1, 0, 1); PG8_STAGE(PG8_SB(0, 0), b2, voffB);
            PG8_BAR; PG8_WAIT_L(0); PG8_MMA(0, 1, At, B1); PG8_BAR;
            PG8_LDA(At, 0, 1); PG8_STAGE(PG8_SA(0, 0), a2, voffA);
            PG8_BAR; PG8_WAIT_L(0); PG8_MMA(1, 0, At, B0); PG8_BAR; PG8_SCHED;
            PG8_STAGE(PG8_SB(0, 1), b2 + hstep, voffB);
            PG8_WAIT_V(6); PG8_BAR; PG8_MMA(1, 1, At, B1); PG8_BAR;
            PG8_LDB(B0, 1, 0); PG8_SCHED; PG8_LDA(At, 1, 0); PG8_STAGE(PG8_SA(0, 1), a2 + hstep, voffA);
            PG8_WAIT_L(8); PG8_BAR; PG8_WAIT_L(0); PG8_MMA(0, 0, At, B0); PG8_BAR; PG8_SCHED;
            PG8_LDB(B1, 1, 1); PG8_STAGE(PG8_SB(1, 0), b3, voffB);
            PG8_BAR; PG8_WAIT_L(0); PG8_MMA(0, 1, At, B1); PG8_BAR;
            PG8_LDA(At, 1, 1); PG8_STAGE(PG8_SA(1, 0), a3, voffA);
            PG8_BAR; PG8_WAIT_L(0); PG8_MMA(1, 0, At, B0); PG8_BAR; PG8_SCHED;
            PG8_STAGE(PG8_SB(1, 1), b3 + hstep, voffB);
            PG8_WAIT_V(6); PG8_BAR; PG8_MMA(1, 1, At, B1); PG8_BAR;
            }
        }
        if constexpr (ALIGN_EPI) { if (wr == 0) PG8_BAR; }
        if constexpr (!Epi::AFTER_DRAIN) { E(acc, cur, wr, wc, fr, fq); S.done(cur); }
        if (!has_next) break;
#pragma unroll
        for (int a = 0; a < 2; ++a)
#pragma unroll
            for (int b = 0; b < 2; ++b)
#pragma unroll
                for (int m = 0; m < 4; ++m)
#pragma unroll
                    for (int n = 0; n < 2; ++n) acc[a][b][m][n] = (f32x4){0.f, 0.f, 0.f, 0.f};
        cur = nxt; cA = nA; cB = nB; ++ui;
        if constexpr (ALIGN_EPI) { if (wr == 1) PG8_BAR; }
    }
    PG8_WAIT_V(0);
    if constexpr (!ALIGN_EPI) { if (wr == 0) PG8_BAR; }
    PG8_BAR;
    if constexpr (Epi::AFTER_DRAIN) { E.fused(acc, cur, wr, wc, fr, fq, lds, wid, lane); S.done(cur); }
#undef PG8_SA
#undef PG8_SB
#undef PG8_STAGE
#undef PG8_LDA
#undef PG8_LDB
#undef PG8_MMA
#undef PG8_WAIT_V
#undef PG8_WAIT_L
#undef PG8_BAR
#undef PG8_SCHED
}
}
typedef unsigned short bf16;
typedef pg8::bf16_t bf16_t;
typedef unsigned u32x2 __attribute__((ext_vector_type(2)));
constexpr int S = 16384, DM = 4096, DEPTH = 4, HD = 128, INW = 12800, NMOD = 3 * DM;
constexpr int A_H = 12, B_H = 8, C_H = 12;
constexpr int COL_AQ = 0, COL_AK = 1536, COL_AV = 3072, COL_AG = 4608, COL_BQ = 6144, COL_BK = 7168, COL_BV = 7424, COL_BG = 7680,
              COL_CQ = 8704, COL_CK = 10240, COL_CV = 10752, COL_CG = 11264;
constexpr int OCOL_A = 0, OCOL_B = 1536, OCOL_C = 2560;
constexpr float EPS = 1e-6f;
constexpr float SM_SCALE = 0.08838834764831845f;
constexpr float LOG2E = 1.4426950408889634f;
constexpr float QK_C = SM_SCALE * LOG2E;
constexpr int NWAVES = 8;

constexpr size_t MiB = 1u << 20;
constexpr size_t WS_CTL = 0, CTL_ZERO_BYTES = 1 * MiB;
constexpr size_t WS_TAB = 1 * MiB;
constexpr size_t WS_WIN = 2 * MiB;
constexpr size_t WS_WOUT = WS_WIN + 400 * MiB;
constexpr size_t WS_H = WS_WOUT + 128 * MiB;
constexpr size_t WS_PROJ = WS_H + 128 * MiB;
constexpr size_t WS_O = WS_PROJ + 400 * MiB;
constexpr size_t WS_Y = WS_O + 128 * MiB;
constexpr size_t WS_END = WS_Y + 128 * MiB;
constexpr int CW_BAR = 4096;
constexpr int CW_MOD = 65536;
static_assert((CW_MOD + DEPTH * NMOD) * 4 <= (int)CTL_ZERO_BYTES, "CTL words inside the memset region");
constexpr int TB_LUTA = 0;
constexpr int TB_LUTB = 4800;
constexpr int TB_ROPE_R = 8192;
constexpr int TB_ROPE_C = 8192 + 16384;
constexpr int RING_OFF = 0, RING_BYTES = 131072;
constexpr int LDSCTL_OFF = RING_BYTES, MISC_OFF = LDSCTL_OFF + 320;
constexpr int LDS_BYTES = 147456;

#define GAS __attribute__((address_space(1)))
#define LAS __attribute__((address_space(3)))
typedef unsigned short bf16;
typedef unsigned v4u __attribute__((ext_vector_type(4)));
typedef float f32x4 __attribute__((ext_vector_type(4)));
typedef short bf16x8 __attribute__((ext_vector_type(8)));
typedef GAS unsigned gu32;
typedef GAS unsigned long long gu64;
#define RLX_AGENT __ATOMIC_RELAXED, __HIP_MEMORY_SCOPE_AGENT
#define LDS_WAIT() asm volatile("s_waitcnt lgkmcnt(0)" ::: "memory")
#define VM_WAIT() asm volatile("s_waitcnt vmcnt(0)" ::: "memory")
__device__ __forceinline__ unsigned long long rt() { return __builtin_amdgcn_s_memrealtime(); }
__device__ __forceinline__ unsigned f2bf(float f) { unsigned u = __builtin_bit_cast(unsigned, f); return (u + 0x7fffu + ((u >> 16) & 1u)) >> 16; }
__device__ __forceinline__ unsigned pk2(float lo, float hi) { return f2bf(lo) | (f2bf(hi) << 16); }

#define XB_TMO      128
#define XB_XCNT(j)  (256  + 64 * (j))
#define XB_XSUB(j)  (1280 + 64 * (j))
#define XB_XGEN(j)  (2304 + 64 * (j))
#define XB_TOP      3328
#define XB_TOPGEN   3392
#define XCD_BAR_WORDS 3456
#define XB_SPIN_CAP (1u << 18)

__device__ __forceinline__ unsigned xb_ld(unsigned* p)              { return __hip_atomic_load(p, __ATOMIC_RELAXED, __HIP_MEMORY_SCOPE_AGENT); }
__device__ __forceinline__ unsigned xb_add(unsigned* p, unsigned v) { return __hip_atomic_fetch_add(p, v, __ATOMIC_RELAXED, __HIP_MEMORY_SCOPE_AGENT); }
__device__ __forceinline__ unsigned xb_xcc_id() { return (unsigned)__builtin_amdgcn_s_getreg((3 << 11) | 20) & 0xFu; }
#define XB_SPIN(cond, bar) do { unsigned _sp = 0; while (cond) { __builtin_amdgcn_s_sleep(1); \
    if ((++_sp & 255u) == 0u) { if (xb_ld(&(bar)[XB_TMO])) break; if (_sp > XB_SPIN_CAP) { atomicAdd(&(bar)[XB_TMO], 1u); break; } } } } while (0)

struct XcdBarrier {
    unsigned* bar; unsigned x;
    volatile LAS unsigned* st;
};

__device__ __forceinline__ XcdBarrier xcd_barrier_post(unsigned* bar, volatile LAS unsigned* st) {
    XcdBarrier b; b.bar = bar; b.x = (unsigned)__builtin_amdgcn_readfirstlane((int)xb_xcc_id()); b.st = st;
    if (threadIdx.x == 0) (void)xb_add(&bar[XB_XCNT(b.x)], 1u);
    return b;
}
__device__ __forceinline__ void xcd_barrier_complete(unsigned* bar, unsigned x, unsigned& nloc, unsigned& nx) {
    const unsigned G = gridDim.x * gridDim.y * gridDim.z;
    unsigned sum, cnt, mine, sp = 0u;
    for (;;) {
        sum = 0u; cnt = 0u; mine = 0u;
#pragma unroll
        for (unsigned j = 0; j < 16; ++j) { const unsigned c = xb_ld(&bar[XB_XCNT(j)]); sum += c; cnt += (c > 0u) ? 1u : 0u; mine = (j == x) ? c : mine; }
        if (sum == G) break;
        __builtin_amdgcn_s_sleep(1);
        if ((++sp & 255u) == 0u) { if (xb_ld(&bar[XB_TMO])) break; if (sp > XB_SPIN_CAP) { atomicAdd(&bar[XB_TMO], 1u); break; } }
    }
    nloc = mine > 0u ? mine : 1u; nx = cnt > 0u ? cnt : 1u;
}

__device__ __forceinline__ void xcd_barrier(const XcdBarrier& b) {
    asm volatile("s_waitcnt vmcnt(0)" ::: "memory");
    __syncthreads();
    if (threadIdx.x == 0) {
        unsigned* bar = b.bar; unsigned bx_ = b.x; asm volatile("" : "+s"(bar), "+s"(bx_));
        __builtin_amdgcn_s_waitcnt(0);
        unsigned nloc = b.st[0], nx = b.st[1];
        if (nloc == 0u) { xcd_barrier_complete(bar, bx_, nloc, nx); b.st[0] = nloc; b.st[1] = nx; }
        const unsigned old = xb_add(&bar[XB_XSUB(bx_)], 1u);
        const unsigned gen = old / nloc;
        if (old + 1u == (gen + 1u) * nloc) {
            __builtin_amdgcn_fence(__ATOMIC_RELEASE, "agent");
            asm volatile("s_waitcnt vmcnt(0)" ::: "memory");
            const unsigned og = xb_add(&bar[XB_TOP], 1u);
            const unsigned tg = og / nx;
            if (og + 1u == (tg + 1u) * nx) xb_add(&bar[XB_TOPGEN], 1u);
            else XB_SPIN(xb_ld(&bar[XB_TOPGEN]) == tg, bar);
            __builtin_amdgcn_fence(__ATOMIC_ACQUIRE, "agent");
            xb_add(&bar[XB_XGEN(bx_)], 1u);
            asm volatile("s_waitcnt vmcnt(0)" ::: "memory");
        } else {
            XB_SPIN(xb_ld(&bar[XB_XGEN(bx_)]) == gen, bar);
            __builtin_amdgcn_fence(__ATOMIC_ACQUIRE, "agent");
            asm volatile("s_waitcnt vmcnt(0)" ::: "memory");
        }
    }
    __syncthreads();
}
__device__ __forceinline__ float wave_sum(float v) {
#pragma unroll
    for (int o = 1; o < 64; o <<= 1) v += __shfl_xor(v, o);
    return v;
}
__device__ __forceinline__ void p0_transpose_item(const float* W, int K, int N, bf16* WT, int row_off, LAS float* scr, int item, int lane) {
    const int nblk = N / 32, kb = item / nblk, nb = item % nblk, k0 = 64 * kb, n0 = 32 * nb;
#pragma unroll 8
    for (int i = 0; i < 32; ++i) { const int kk = 2 * i + (lane >> 5); scr[kk * 33 + (lane & 31)] = W[(size_t)(k0 + kk) * N + n0 + (lane & 31)]; }
    LDS_WAIT(); asm volatile("" ::: "memory");
    const int c = lane & 7;
#pragma unroll
    for (int j = 0; j < 4; ++j) { const int n = (lane >> 3) + 8 * j; const LAS float* s = scr + (8 * c) * 33 + n;
        v4u o; o.x = pk2(s[0 * 33], s[1 * 33]); o.y = pk2(s[2 * 33], s[3 * 33]); o.z = pk2(s[4 * 33], s[5 * 33]); o.w = pk2(s[6 * 33], s[7 * 33]);
        *(GAS v4u*)(WT + (size_t)(row_off + n0 + n) * K + k0 + 8 * c) = o; }
    LDS_WAIT(); asm volatile("" ::: "memory");
}
namespace attc {
typedef unsigned short bf16;
constexpr int   D = 128, NW = 8, QBLK = 32, KVBLK = 64;
constexpr float SCALE = SM_SCALE;
constexpr float THR = 8.f;
constexpr int SDEPTH = 2;
constexpr int LDQ = INW, LDK = INW, LDO = DM;
constexpr size_t SHM_V = KVBLK * D * 2, SHM_K = KVBLK * D * 2, SHM_ATTN = 2 * SHM_V + 2 * SHM_K + NW * 64 * 4;
using bf16x8 = __attribute__((ext_vector_type(8))) short;
using s16x4  = __attribute__((ext_vector_type(4))) short;
using f32x16 = __attribute__((ext_vector_type(16))) float;
using u32x4  = __attribute__((ext_vector_type(4))) unsigned;
struct StageB { using T = bf16x8;
  __device__ static __forceinline__ T ld8(const bf16* p) { return *reinterpret_cast<const bf16x8*>(p); }
  __device__ static __forceinline__ bf16x8 tobf(T x) { return x; } };
#define KSWZ(row, colB) ((row) * 256 + ((colB) ^ (((row) & 7) << 4)))
#define SBAR() __builtin_amdgcn_sched_barrier(0)
__device__ __forceinline__ int crow(int r, int hi) { return (r & 3) + 8 * (r >> 2) + 4 * hi; }
__device__ __forceinline__ unsigned cvtpk(float lo, float hi) {
  unsigned r; asm volatile("v_cvt_pk_bf16_f32 %0, %1, %2" : "=v"(r) : "v"(lo), "v"(hi)); return r;
}
__device__ __forceinline__ void partialSM(f32x16& p0, f32x16& p1, float& m_reg, float& mn, float& alpha) {
  constexpr float C = SCALE * 1.4426950408889634f;
  float pmax = p0[0]; for (int r = 1; r < 16; ++r) pmax = fmaxf(pmax, p0[r]); for (int r = 0; r < 16; ++r) pmax = fmaxf(pmax, p1[r]);
  { auto rr = __builtin_amdgcn_permlane32_swap(__float_as_uint(pmax), __float_as_uint(pmax), false, false);
    pmax = fmaxf(__uint_as_float(rr[0]), __uint_as_float(rr[1])); }
  if (__builtin_expect(__all(pmax - m_reg <= THR / SCALE), 1)) { mn = m_reg; alpha = 1.f; }
  else { mn = fmaxf(m_reg, pmax); alpha = __builtin_amdgcn_exp2f((m_reg - mn) * C); m_reg = mn; }
  float mnC = -mn * C;
  for (int r = 0; r < 16; ++r) p0[r] = fmaf(p0[r], C, mnC); for (int r = 0; r < 16; ++r) p1[r] = fmaf(p1[r], C, mnC);
  for (int r = 0; r < 16; ++r) p0[r] = __builtin_amdgcn_exp2f(p0[r]);
}
__device__ __forceinline__ void finishSM(f32x16& p0, f32x16& p1, float alpha, float& l_reg, bf16x8& pa0, bf16x8& pa1, bf16x8& pa2, bf16x8& pa3) {
  for (int r = 0; r < 16; ++r) p1[r] = __builtin_amdgcn_exp2f(p1[r]);
  float ps = 0; for (int r = 0; r < 16; ++r) ps += p0[r]; for (int r = 0; r < 16; ++r) ps += p1[r];
  { auto rr = __builtin_amdgcn_permlane32_swap(__float_as_uint(ps), __float_as_uint(ps), false, false);
    ps = __uint_as_float(rr[0]) + __uint_as_float(rr[1]); }
  l_reg = l_reg * alpha + ps;
#define PK4(P, BASE, OUT) do { unsigned a0 = cvtpk(P[BASE + 0], P[BASE + 1]), a1 = cvtpk(P[BASE + 2], P[BASE + 3]);   \
    unsigned b0 = cvtpk(P[BASE + 4], P[BASE + 5]), b1 = cvtpk(P[BASE + 6], P[BASE + 7]);                              \
    auto r0 = __builtin_amdgcn_permlane32_swap(a0, b0, false, false); auto r1 = __builtin_amdgcn_permlane32_swap(a1, b1, false, false); \
    u32x4 w = {r0[0], r1[0], r0[1], r1[1]}; OUT = *reinterpret_cast<bf16x8*>(&w); } while (0)
  PK4(p0, 0, pa0); PK4(p0, 8, pa1); PK4(p1, 0, pa2); PK4(p1, 8, pa3);
#undef PK4
}
__device__ __forceinline__ void qkt(f32x16& p0, f32x16& p1, const bf16* Ks, const bf16x8* qr, int r32, int hi) {
  p0 = f32x16{}; p1 = f32x16{};
  for (int d0 = 0; d0 < 8; ++d0) { int cb = (d0 * 16 + hi * 8) * 2;
    bf16x8 b0 = *reinterpret_cast<const bf16x8*>((const char*)Ks + KSWZ(r32, cb));
    bf16x8 b1 = *reinterpret_cast<const bf16x8*>((const char*)Ks + KSWZ(32 + r32, cb));
    p0 = __builtin_amdgcn_mfma_f32_32x32x16_bf16(b0, qr[d0], p0, 0, 0, 0);
    p1 = __builtin_amdgcn_mfma_f32_32x32x16_bf16(b1, qr[d0], p1, 0, 0, 0); }
}
__device__ __forceinline__ int v_st(int k, int c) { const int kk = (k & ~0xC) | ((k & 4) << 1) | ((k & 8) >> 1); return ((kk >> 3) * 4 + (c >> 5)) * 512 + ((kk & 7) * 32 + (c & 31)) * 2; }
__device__ __forceinline__ int v_rd_base(int lane) { return ((lane & 3) << 3) | (((lane >> 2) & 3) << 6) | (((lane >> 4) & 1) << 5) | (((lane >> 5) & 1) << 8); }
constexpr int v_rd_off(int d0, int ks, int half) { return d0 * 512 + ks * 4096 + half * 2048; }
template <int OFF> __device__ __forceinline__ s16x4 tr_read(int vb) {
  s16x4 r; asm volatile("ds_read_b64_tr_b16 %0, %1 offset:%2" : "=&v"(r) : "v"(vb), "i"(OFF) : "memory"); return r;
}
template <int D0> __device__ __forceinline__ void pv_one(f32x16& od, int vb, bf16x8 pa0, bf16x8 pa1, bf16x8 pa2, bf16x8 pa3) {
  const s16x4 l0 = tr_read<v_rd_off(D0, 0, 0)>(vb), h0 = tr_read<v_rd_off(D0, 0, 1)>(vb), l1 = tr_read<v_rd_off(D0, 1, 0)>(vb), h1 = tr_read<v_rd_off(D0, 1, 1)>(vb);
  const s16x4 l2 = tr_read<v_rd_off(D0, 2, 0)>(vb), h2 = tr_read<v_rd_off(D0, 2, 1)>(vb), l3 = tr_read<v_rd_off(D0, 3, 0)>(vb), h3 = tr_read<v_rd_off(D0, 3, 1)>(vb);
  asm volatile("s_waitcnt lgkmcnt(0)" ::: "memory"); SBAR();
#define PK(L, H) (bf16x8){L[0], L[1], L[2], L[3], H[0], H[1], H[2], H[3]}
  od = __builtin_amdgcn_mfma_f32_32x32x16_bf16(pa0, PK(l0, h0), od, 0, 0, 0);
  od = __builtin_amdgcn_mfma_f32_32x32x16_bf16(pa1, PK(l1, h1), od, 0, 0, 0);
  od = __builtin_amdgcn_mfma_f32_32x32x16_bf16(pa2, PK(l2, h2), od, 0, 0, 0);
  od = __builtin_amdgcn_mfma_f32_32x32x16_bf16(pa3, PK(l3, h3), od, 0, 0, 0);
#undef PK
}
__device__ __forceinline__ void pv_d0(f32x16* o, int vb, bf16x8 pa0, bf16x8 pa1, bf16x8 pa2, bf16x8 pa3) {
  pv_one<0>(o[0], vb, pa0, pa1, pa2, pa3); pv_one<1>(o[1], vb, pa0, pa1, pa2, pa3); pv_one<2>(o[2], vb, pa0, pa1, pa2, pa3); pv_one<3>(o[3], vb, pa0, pa1, pa2, pa3);
}
__device__ __forceinline__ void attn_dense_body(const bf16* __restrict__ Qb, const bf16* __restrict__ Kh, const bf16* __restrict__ Vh,
                                                const bf16* __restrict__ Gb, bf16* __restrict__ Ob, int seq, char* lds) {
  using St = StageB;
  int tid_l = threadIdx.x; asm volatile("" : "+v"(tid_l));
  const int tid = tid_l, wid = __builtin_amdgcn_readfirstlane(tid >> 6), lane = tid & 63, r32 = lane & 31, hi = lane >> 5;
  bf16* V_lds = (bf16*)lds; bf16* K_lds = (bf16*)(lds + 2 * SHM_V);
  float* ws = (float*)(lds + 2 * SHM_V + 2 * SHM_K) + wid * 64; float* li_l = ws; float* al_l = ws + 32;
  float m_reg = -1e30f, l_reg = 0; f32x16 o[4] = {}; bf16x8 qr[8];
  const bf16* Qw = Qb + (long)(wid * QBLK + r32) * LDQ + hi * 8;
#pragma unroll
  for (int d0 = 0; d0 < 8; ++d0) qr[d0] = St::ld8(Qw + d0 * 16);
  const int sr = tid >> 4, sc = (tid & 15) * 8, vst0 = v_st(sr, sc), vst1 = v_st(32 + sr, sc);
  const int vb0 = (int)(uintptr_t)V_lds + v_rd_base(lane);
  struct { typename St::T vs0, vs1, ks0, ks1; } sr_[SDEPTH];
#define SLOAD(i, k0) do { sr_[i].vs0 = St::ld8(&Vh[(long)((k0) + sr) * LDK + sc]); sr_[i].vs1 = St::ld8(&Vh[(long)((k0) + 32 + sr) * LDK + sc]); \
    sr_[i].ks0 = St::ld8(&Kh[(long)((k0) + sr) * LDK + sc]); sr_[i].ks1 = St::ld8(&Kh[(long)((k0) + 32 + sr) * LDK + sc]); } while (0)
#define SWRITE(b, i) do { *(bf16x8*)((char*)V_lds + (b) * SHM_V + vst0) = St::tobf(sr_[i].vs0);          \
    *(bf16x8*)((char*)V_lds + (b) * SHM_V + vst1) = St::tobf(sr_[i].vs1); int kc = sc * 2;               \
    *(bf16x8*)((char*)K_lds + (b) * SHM_K + KSWZ(sr, kc)) = St::tobf(sr_[i].ks0);                       \
    *(bf16x8*)((char*)K_lds + (b) * SHM_K + KSWZ(32 + sr, kc)) = St::tobf(sr_[i].ks1); } while (0)
#define SWAIT() do { if constexpr (SDEPTH == 2) asm volatile("s_waitcnt vmcnt(4)" ::: "memory"); else asm volatile("s_waitcnt vmcnt(0)" ::: "memory"); } while (0)
#define RESC(a) do { if (__any((a) < 1.f)) { if (hi == 0) al_l[r32] = (a); asm volatile("s_waitcnt lgkmcnt(0)" ::: "memory"); \
    for (int d = 0; d < 4; ++d) for (int r = 0; r < 16; ++r) o[d][r] *= al_l[crow(r, hi)]; } } while (0)
  f32x16 pA0, pA1, pB0, pB1; float mnA, mnB, alA, alB; bf16x8 pa0, pa1, pa2, pa3; const int NT = seq / KVBLK;
  constexpr int SE = 0, SO = SDEPTH - 1;
  SLOAD(SE, 0); asm volatile("s_waitcnt vmcnt(0)" ::: "memory"); SWRITE(0, SE); __syncthreads();
  qkt(pA0, pA1, K_lds, qr, r32, hi); partialSM(pA0, pA1, m_reg, mnA, alA);
  SLOAD(SO, KVBLK); if constexpr (SDEPTH == 2) { if (2 < NT) SLOAD(SE, 2 * KVBLK); }
  SWAIT(); SWRITE(1, SO); __syncthreads();
  for (int j = 1; j + 1 < NT; j += 2) {
    SBAR(); qkt(pB0, pB1, (bf16*)((char*)K_lds + SHM_K), qr, r32, hi);
    finishSM(pA0, pA1, alA, l_reg, pa0, pa1, pa2, pa3); SBAR();
    SLOAD(SO, (j + SDEPTH) * KVBLK); SBAR();
    pv_d0(o, vb0, pa0, pa1, pa2, pa3); partialSM(pB0, pB1, m_reg, mnB, alB);
    __syncthreads(); SWAIT(); SWRITE(0, SE);
    RESC(alB); __syncthreads();
    SBAR(); qkt(pA0, pA1, K_lds, qr, r32, hi);
    finishSM(pB0, pB1, alB, l_reg, pa0, pa1, pa2, pa3); SBAR();
    if (SDEPTH == 1 || j + 3 < NT) SLOAD(SE, (j + 1 + SDEPTH) * KVBLK); SBAR();
    pv_d0(o, vb0 + (int)SHM_V, pa0, pa1, pa2, pa3); partialSM(pA0, pA1, m_reg, mnA, alA);
    __syncthreads(); SWAIT(); SWRITE(1, SO);
    RESC(alA); __syncthreads();
  }
  SBAR(); qkt(pB0, pB1, (bf16*)((char*)K_lds + SHM_K), qr, r32, hi);
  finishSM(pA0, pA1, alA, l_reg, pa0, pa1, pa2, pa3); SBAR();
  pv_d0(o, vb0, pa0, pa1, pa2, pa3); partialSM(pB0, pB1, m_reg, mnB, alB);
  __syncthreads(); RESC(alB);
  finishSM(pB0, pB1, alB, l_reg, pa0, pa1, pa2, pa3); SBAR();
  pv_d0(o, vb0 + (int)SHM_V, pa0, pa1, pa2, pa3);
  if (hi == 0) li_l[r32] = l_reg; asm volatile("s_waitcnt lgkmcnt(0)" ::: "memory");
  float rli[16];
#pragma unroll
  for (int r = 0; r < 16; ++r) rli[r] = __builtin_amdgcn_rcpf(li_l[crow(r, hi)]);
  const bf16* Gw = Gb + (long)(wid * QBLK) * LDQ; bf16* Ow = Ob + (long)(wid * QBLK) * LDO;
#pragma unroll
  for (int r = 0; r < 16; ++r) { const int orow = crow(r, hi); float g[4];
#pragma unroll
    for (int d0 = 0; d0 < 4; ++d0) g[d0] = __uint_as_float((unsigned)Gw[(long)orow * LDQ + d0 * 32 + r32] << 16);
#pragma unroll
    for (int d0 = 0; d0 < 4; ++d0) { const float v = o[d0][r] * rli[r] * (g[d0] / (1.f + __expf(-g[d0])));
      Ow[(long)orow * LDO + d0 * 32 + r32] = (bf16)(cvtpk(v, v) & 0xffffu); }
    if (r & 1) asm volatile("" ::: "memory"); }
  __syncthreads();
#undef SLOAD
#undef SWRITE
#undef SWAIT
#undef RESC
}
#undef KSWZ
#undef SBAR
}

__device__ __forceinline__ float bflo(unsigned w) { return __uint_as_float(w << 16); }
__device__ __forceinline__ float bfhi(unsigned w) { return __uint_as_float(w & 0xffff0000u); }
__device__ __forceinline__ float silu_f(float x) { return x / (1.f + __expf(-x)); }
__device__ __forceinline__ float wave_max(float v) {
#pragma unroll
    for (int o = 1; o < 64; o <<= 1) v = fmaxf(v, __shfl_xor(v, o));
    return v;
}
__device__ __forceinline__ int t5_bucket(int rel) {
    const int n = rel < 0 ? -rel : rel; const float nf = (float)(n > 1 ? n : 1);
    int large = 8 + (int)(logf(nf * 0.125f) / 4.852030263919617f * 8.0f); large = large < 15 ? large : 15;
    return (rel > 0 ? 16 : 0) + (n < 8 ? n : large);
}

struct Args { const float* in[12]; float* out; unsigned char* ws; };

__device__ __forceinline__ void p0_prologue(const Args& a, LAS unsigned char* lds, int tid, int lane, int wave, int vcu, int G) {
    const float* c = a.in[1]; const float* w_mod = a.in[2]; const float* w_in = a.in[6]; const float* w_out = a.in[7]; const float* rel_bias = a.in[11];
    float* mod = (float*)(a.ws + WS_CTL) + CW_MOD;
    float* tab = (float*)(a.ws + WS_TAB);
    bf16* Win_t = (bf16*)(a.ws + WS_WIN); bf16* Wout_t = (bf16*)(a.ws + WS_WOUT);
    const int gt = vcu * (NWAVES * 64) + tid, NGT = G * NWAVES * 64;
    for (int e = gt; e < A_H * 3 * 131; e += NGT) { const int idx = e % 131, hp = e / 131, p = hp % 3, h = hp / 3, kk = idx - 65;
        float v = -1e30f; if (kk >= -64 && kk <= 64) v = rel_bias[t5_bucket(kk * (1 << (2 * p))) * (A_H + B_H) + h] * LOG2E;
        tab[TB_LUTA + e] = v; }
    for (int e = gt; e < B_H * 259; e += NGT) { const int idx = e % 259, h = e / 259, kk = idx - 129;
        float v = -1e30f; if (kk >= -128 && kk <= 128) v = rel_bias[t5_bucket(kk) * (A_H + B_H) + A_H + h] * LOG2E;
        tab[TB_LUTB + e] = v; }
    for (int e = gt; e < (256 + 64) * 32; e += NGT) { const int j = e & 31, pp = e >> 5, pos = pp < 256 ? pp : pp - 256;
        const float freq = exp2f(-(float)j * 0.4152410118609203f);
        const float ang = (float)pos * freq;
        double rev = (double)ang * 0.15915494309189535; rev -= floor(rev);
        const float cs_ = __builtin_amdgcn_cosf((float)rev), sn_ = __builtin_amdgcn_sinf((float)rev);
        float* d = tab + (pp < 256 ? TB_ROPE_R : TB_ROPE_C) + (pos * 32 + j) * 2; d[0] = cs_; d[1] = sn_; }
    LAS float* cs = (LAS float*)lds;
    LAS float* red = (LAS float*)(lds + 16384);
    for (int k = tid; k < DM; k += NWAVES * 64) cs[k] = silu_f(c[k]);
    __syncthreads();
    for (int it = vcu; it < DEPTH * 48 * 4; it += G) {
        const int kq = it & 3, nc = (it >> 2) % 48, ly = it / 192, k0 = kq * 1024 + wave * 128;
        const float* W = w_mod + (size_t)ly * DM * NMOD + (size_t)k0 * NMOD + nc * 256 + lane * 4;
        f32x4 acc = (f32x4){0.f, 0.f, 0.f, 0.f};
#pragma unroll 8
        for (int k = 0; k < 128; ++k) { const f32x4 w = *(const GAS f32x4*)(W + (size_t)k * NMOD); acc += w * cs[k0 + k]; }
        *(LAS f32x4*)(red + wave * 256 + lane * 4) = acc;
        __syncthreads();
        if (tid < 256) { float s = 0.f;
#pragma unroll
            for (int w = 0; w < NWAVES; ++w) s += red[w * 256 + tid];
            __hip_atomic_fetch_add(mod + ly * NMOD + nc * 256 + tid, s, __ATOMIC_RELAXED, __HIP_MEMORY_SCOPE_AGENT); }
        __syncthreads();
    }
    LAS float* scr = (LAS float*)(lds + wave * 16384);
    const int gw = vcu * NWAVES + wave, NGW = G * NWAVES;
    constexpr int I_IN = (DM / 64) * (INW / 32), I_OUT = (DM / 64) * (DM / 32), I_L = I_IN + I_OUT;
    for (int it = gw; it < DEPTH * I_L; it += NGW) {
        const int ly = it / I_L, r = it - ly * I_L;
        if (r < I_IN) p0_transpose_item(w_in + (size_t)ly * DM * INW, DM, INW, Win_t + (size_t)ly * INW * DM, 0, scr, r, lane);
        else p0_transpose_item(w_out + (size_t)ly * DM * DM, DM, DM, Wout_t + (size_t)ly * DM * DM, 0, scr, r - I_IN, lane);
    }
}

__device__ __forceinline__ void norm_phase(const Args& a, LAS unsigned char* lds, int layer_post, int layer_pre, const float* xin, int tid, int lane, int wave, int vcu, int G) {
    asm volatile("" : "+v"(tid), "+v"(lane));
    LAS float* Gv = (LAS float*)lds; LAS float* Av = Gv + DM; LAS float* Bv = Av + DM;
    const float* mod = (const float*)(a.ws + WS_CTL) + CW_MOD;
    const float* b_mod = a.in[3]; const float* pre_g = a.in[4]; const float* post_g = a.in[5];
    for (int j = tid; j < DM; j += NWAVES * 64) {
        if (layer_post >= 0) Gv[j] = (mod[layer_post * NMOD + 2 * DM + j] + b_mod[layer_post * NMOD + 2 * DM + j]) * post_g[layer_post * DM + j];
        if (layer_pre >= 0) { Av[j] = pre_g[layer_pre * DM + j] * (1.f + mod[layer_pre * NMOD + DM + j] + b_mod[layer_pre * NMOD + DM + j]);
                              Bv[j] = mod[layer_pre * NMOD + j] + b_mod[layer_pre * NMOD + j]; }
    }
    __syncthreads();
    const bf16* Y = (const bf16*)(a.ws + WS_Y); bf16* H = (bf16*)(a.ws + WS_H); float* xout = a.out;
    const int gw = vcu * NWAVES + wave, NGW = G * NWAVES;
    for (int row = gw; row < S; row += NGW) {
        const GAS f32x4* xr = (const GAS f32x4*)(xin + (size_t)row * DM) + lane;
        f32x4 v[16];
#pragma unroll
        for (int j = 0; j < 16; ++j) v[j] = xr[64 * j];
        if (layer_post >= 0) {
            const GAS u32x2* yr = (const GAS u32x2*)(Y + (size_t)row * DM) + lane;
            u32x2 yv[16]; float ss = 0.f;
#pragma unroll
            for (int j = 0; j < 16; ++j) { yv[j] = yr[64 * j]; const float y0 = bflo(yv[j].x), y1 = bfhi(yv[j].x), y2 = bflo(yv[j].y), y3 = bfhi(yv[j].y); ss += (y0 * y0 + y1 * y1) + (y2 * y2 + y3 * y3); }
            const float ry = rsqrtf(wave_sum(ss) * (1.f / DM) + EPS);
            GAS f32x4* xo = (GAS f32x4*)(xout + (size_t)row * DM) + lane;
#pragma unroll
            for (int j = 0; j < 16; ++j) { const f32x4 g = *(const LAS f32x4*)(Gv + j * 256 + lane * 4);
                const f32x4 yf = (f32x4){bflo(yv[j].x), bfhi(yv[j].x), bflo(yv[j].y), bfhi(yv[j].y)};
                v[j] = v[j] + g * yf * ry; xo[64 * j] = v[j]; }
        }
        if (layer_pre >= 0) {
            float ss = 0.f;
#pragma unroll
            for (int j = 0; j < 16; ++j) ss += (v[j].x * v[j].x + v[j].y * v[j].y) + (v[j].z * v[j].z + v[j].w * v[j].w);
            const float rx = rsqrtf(wave_sum(ss) * (1.f / DM) + EPS);
            GAS u32x2* ho = (GAS u32x2*)(H + (size_t)row * DM) + lane;
#pragma unroll
            for (int j = 0; j < 16; ++j) { const f32x4 av = *(const LAS f32x4*)(Av + j * 256 + lane * 4), bv = *(const LAS f32x4*)(Bv + j * 256 + lane * 4);
                const f32x4 hv = v[j] * rx * av + bv; u32x2 w; w.x = pg8::cvt_pk_bf16(hv.x, hv.y); w.y = pg8::cvt_pk_bf16(hv.z, hv.w); ho[64 * j] = w; }
        }
    }
    __syncthreads();
}

__device__ __forceinline__ void prep_phase(const Args& a, int layer, int lane, int wave, int vcu, int G) {
    asm volatile("" : "+v"(lane));
    bf16* proj = (bf16*)(a.ws + WS_PROJ); const float* tab = (const float*)(a.ws + WS_TAB);
    const float* qg = a.in[8] + layer * HD; const float* kg = a.in[9] + layer * HD;
    const int l16 = lane & 15, half = l16 >> 3, jj = (l16 & 7) * 4, grp = lane >> 4;
    const f32x4 gq1 = *(const f32x4*)(qg + half * 64 + jj), gq2 = *(const f32x4*)(qg + half * 64 + 32 + jj);
    const f32x4 gk1 = *(const f32x4*)(kg + half * 64 + jj), gk2 = *(const f32x4*)(kg + half * 64 + 32 + jj);
    const int gw = vcu * NWAVES + wave, NGW = G * NWAVES;
    for (int t = gw; t < S; t += NGW) {
        const int pos = half ? (t & 63) : (t >> 6);
        const float* rt = tab + (half ? TB_ROPE_C : TB_ROPE_R) + (pos * 32 + jj) * 2;
        const f32x4 cs0 = *(const f32x4*)rt, cs1 = *(const f32x4*)(rt + 4);
        const f32x4 cv = (f32x4){cs0.x, cs0.z, cs1.x, cs1.z}, sv = (f32x4){cs0.y, cs0.w, cs1.y, cs1.w};
#pragma unroll
        for (int it = 0; it < 4; ++it) {
            const int hh = it * 4 + grp;
            bf16* p = proj + (size_t)t * INW + COL_CQ + hh * HD + half * 64 + jj;
            const u32x2 r1 = *(const u32x2*)p, r2 = *(const u32x2*)(p + 32);
            const f32x4 x1 = (f32x4){bflo(r1.x), bfhi(r1.x), bflo(r1.y), bfhi(r1.y)}, x2 = (f32x4){bflo(r2.x), bfhi(r2.x), bflo(r2.y), bfhi(r2.y)};
            float ss = (x1.x * x1.x + x1.y * x1.y) + (x1.z * x1.z + x1.w * x1.w) + (x2.x * x2.x + x2.y * x2.y) + (x2.z * x2.z + x2.w * x2.w);
            ss += __shfl_xor(ss, 1); ss += __shfl_xor(ss, 2); ss += __shfl_xor(ss, 4); ss += __shfl_xor(ss, 8);
            const float r = rsqrtf(ss * (1.f / HD) + EPS);
            const f32x4 g1 = (it == 3) ? gk1 : gq1, g2 = (it == 3) ? gk2 : gq2;
            const f32x4 y1 = x1 * r * g1, y2 = x2 * r * g2;
            const f32x4 o1 = y1 * cv - y2 * sv, o2 = y2 * cv + y1 * sv;
            u32x2 w1, w2; w1.x = pg8::cvt_pk_bf16(o1.x, o1.y); w1.y = pg8::cvt_pk_bf16(o1.z, o1.w); w2.x = pg8::cvt_pk_bf16(o2.x, o2.y); w2.y = pg8::cvt_pk_bf16(o2.z, o2.w);
            *(u32x2*)p = w1; *(u32x2*)(p + 32) = w2;
        }
    }
}

template <bool IS_B>
__device__ __forceinline__ void naive_band(const bf16* proj, bf16* o, const float* lut, float sink_l2, int t, int qcol, int kcol, int vcol, int gcol, int ocol,
                                           LAS float* sc, LAS int* jr, int lane) {
    constexpr int NS = IS_B ? 257 : 387;
    const int l16 = lane & 15, grp = lane >> 4;
    float qf[8];
    { const pg8::u32x4 qraw = *(const pg8::u32x4*)(proj + (size_t)t * INW + qcol + l16 * 8);
      qf[0] = bflo(qraw.x) * QK_C; qf[1] = bfhi(qraw.x) * QK_C; qf[2] = bflo(qraw.y) * QK_C; qf[3] = bfhi(qraw.y) * QK_C;
      qf[4] = bflo(qraw.z) * QK_C; qf[5] = bfhi(qraw.z) * QK_C; qf[6] = bflo(qraw.w) * QK_C; qf[7] = bfhi(qraw.w) * QK_C; }
    for (int s0 = 0; s0 < NS; s0 += 4) {
        const int s = s0 + grp; const bool inr = s < NS; const int ss = inr ? s : NS - 1;
        int j, li;
        if (IS_B) { j = t + ss - 128; li = ss + 1; }
        else { const int p = ss / 129, kk = ss - p * 129; j = t + (kk - 64) * (1 << (2 * p)); li = p * 131 + kk + 1; }
        const bool valid = inr && j >= 0 && j < S;
        const int jc = j < 0 ? 0 : (j > S - 1 ? S - 1 : j);
        const pg8::u32x4 kr = *(const pg8::u32x4*)(proj + (size_t)jc * INW + kcol + l16 * 8);
        float d = qf[0] * bflo(kr.x) + qf[1] * bfhi(kr.x) + qf[2] * bflo(kr.y) + qf[3] * bfhi(kr.y) + qf[4] * bflo(kr.z) + qf[5] * bfhi(kr.z) + qf[6] * bflo(kr.w) + qf[7] * bfhi(kr.w);
        d += __shfl_xor(d, 1); d += __shfl_xor(d, 2); d += __shfl_xor(d, 4); d += __shfl_xor(d, 8);
        const float sv = valid ? d + lut[li] : -1e30f;
        if (l16 == 0 && inr) { sc[s] = sv; jr[s] = jc; }
    }
    float mx = -1e30f;
    for (int s = lane; s < NS; s += 64) mx = fmaxf(mx, sc[s]);
    mx = wave_max(mx); if (IS_B) mx = fmaxf(mx, sink_l2);
    float lsum = 0.f;
    for (int s = lane; s < NS; s += 64) { const float p = exp2f(sc[s] - mx); sc[s] = p; lsum += p; }
    lsum = wave_sum(lsum); if (IS_B) lsum += exp2f(sink_l2 - mx);
    float a0 = 0.f, a1 = 0.f;
#pragma unroll 4
    for (int s = 0; s < NS; ++s) { const float p = sc[s]; const int j = jr[s];
        const unsigned v = *(const unsigned*)(proj + (size_t)j * INW + vcol + lane * 2); a0 += p * bflo(v); a1 += p * bfhi(v); }
    const unsigned g = *(const unsigned*)(proj + (size_t)t * INW + gcol + lane * 2);
    const float inv = 1.f / lsum;
    *(unsigned*)(o + (size_t)t * DM + ocol + lane * 2) = pg8::cvt_pk_bf16(a0 * inv * silu_f(bflo(g)), a1 * inv * silu_f(bfhi(g)));
}

__device__ __forceinline__ void naive_ab_phase(const Args& a, LAS unsigned char* lds, int layer, int lane, int wave, int vcu, int G) {
    asm volatile("" : "+v"(lane));
    const bf16* proj = (const bf16*)(a.ws + WS_PROJ); bf16* o = (bf16*)(a.ws + WS_O); const float* tab = (const float*)(a.ws + WS_TAB);
    const float* sink = a.in[10] + layer * B_H;
    LAS float* sc = (LAS float*)(lds + wave * 4096); LAS int* jr = (LAS int*)(lds + wave * 4096 + 2048);
    const int gw = vcu * NWAVES + wave, NGW = G * NWAVES;
    for (int t = gw; t < S; t += NGW) {
        for (int h = 0; h < A_H; ++h)
            naive_band<false>(proj, o, tab + TB_LUTA + h * 3 * 131, 0.f, t, COL_AQ + h * HD, COL_AK + h * HD, COL_AV + h * HD, COL_AG + h * HD, OCOL_A + h * HD, sc, jr, lane);
        for (int h = 0; h < B_H; ++h)
            naive_band<true>(proj, o, tab + TB_LUTB + h * 259, sink[h] * LOG2E, t, COL_BQ + h * HD, COL_BK + (h >> 2) * HD, COL_BV + (h >> 2) * HD, COL_BG + h * HD, OCOL_B + h * HD, sc, jr, lane);
    }
}

__global__ void __launch_bounds__(NWAVES * 64, 2) fwd_kernel(Args args) {
    extern __shared__ __attribute__((aligned(16))) unsigned char lds_raw[];
    LAS unsigned char* lds = (LAS unsigned char*)lds_raw;
    volatile LAS unsigned* MISC = (volatile LAS unsigned*)(lds + MISC_OFF);
    const int tid = threadIdx.x, lane = tid & 63, wave = __builtin_amdgcn_readfirstlane(tid >> 6);
    const int G = gridDim.x; const int bx = blockIdx.x; const int vcu = (G % 8 == 0) ? (bx % 8) * (G / 8) + bx / 8 : bx;
    gu32* ctl = (gu32*)(args.ws + WS_CTL);
    for (int u = tid; u < (LDS_BYTES - LDSCTL_OFF) / 4; u += NWAVES * 64) ((LAS unsigned*)(lds + LDSCTL_OFF))[u] = 0u;
    __syncthreads();
    XcdBarrier bar = xcd_barrier_post((unsigned*)(ctl + CW_BAR), MISC + 8);
    const bf16* Win_t = (const bf16*)(args.ws + WS_WIN); const bf16* Wout_t = (const bf16*)(args.ws + WS_WOUT);
    bf16* Hb = (bf16*)(args.ws + WS_H); bf16* PROJ = (bf16*)(args.ws + WS_PROJ); bf16* Ob = (bf16*)(args.ws + WS_O); bf16* Yb = (bf16*)(args.ws + WS_Y);

    p0_prologue(args, lds, tid, lane, wave, vcu, G);
    xcd_barrier(bar);
    norm_phase(args, lds, -1, 0, args.in[0], tid, lane, wave, vcu, G);
    xcd_barrier(bar);

#pragma nounroll
    for (int layer = 0; layer < DEPTH; ++layer) {
        { pg8::Gemm g{Hb, Win_t + (size_t)layer * INW * DM, S, INW, DM}; pg8::StaticOrder so; so.init(S, INW, G, bx);
          pg8::EpiStore E{PROJ, INW};
          pg8::gemm_phase<pg8::EpiStore, pg8::StaticOrder, true, true>(lds + RING_OFF, g, so, E); }
        xcd_barrier(bar);
        prep_phase(args, layer, lane, wave, vcu, G);
        xcd_barrier(bar);
        for (int i = 0;; ++i) {
            const int u = i * G + vcu; if (u >= C_H * (S / 256)) break;
            const int gq = u / 256, rem = u % 256, kv = rem / 64, qb = rem % 64, head = kv * 3 + gq;
            attc::attn_dense_body(PROJ + (size_t)(qb * 256) * INW + COL_CQ + head * HD, PROJ + COL_CK + kv * HD, PROJ + COL_CV + kv * HD,
                                  PROJ + (size_t)(qb * 256) * INW + COL_CG + head * HD, Ob + (size_t)(qb * 256) * DM + OCOL_C + head * HD, S, (char*)lds_raw + RING_OFF);
        }
        naive_ab_phase(args, lds, layer, lane, wave, vcu, G);
        xcd_barrier(bar);
        { pg8::Gemm g{Ob, Wout_t + (size_t)layer * DM * DM, S, DM, DM}; pg8::StaticOrder so; so.init(S, DM, G, bx);
          pg8::EpiStore E{Yb, DM};
          pg8::gemm_phase<pg8::EpiStore, pg8::StaticOrder, true, true>(lds + RING_OFF, g, so, E); }
        xcd_barrier(bar);
        norm_phase(args, lds, layer, layer + 1 < DEPTH ? layer + 1 : -1, layer == 0 ? args.in[0] : (const float*)args.out, tid, lane, wave, vcu, G);
        if (layer + 1 < DEPTH) xcd_barrier(bar);
    }
}

extern "C" void kernel_launch(void* const* d_in, const int* in_sizes, int n_in, void* d_out, int out_size, void* d_ws, size_t ws_size, hipStream_t stream) {
    static int grid = 0;
    if (grid == 0) {
        if (n_in != 12 || in_sizes[0] != S * DM || out_size != S * DM || ws_size < WS_END) {
            fprintf(stderr, "kernel_launch: shape mismatch: n_in %d in0 %d out %d ws %zu (need >= %zu); nothing launched\n", n_in, n_in > 0 ? in_sizes[0] : -1, out_size, ws_size, (size_t)WS_END); grid = -1; return; }
        int dev = 0, cus = 0, per_cu = 0;
        if (hipGetDevice(&dev) != hipSuccess || hipDeviceGetAttribute(&cus, hipDeviceAttributeMultiprocessorCount, dev) != hipSuccess) { fprintf(stderr, "kernel_launch: device query failed\n"); grid = -1; return; }
        if (hipFuncSetAttribute((const void*)fwd_kernel, hipFuncAttributeMaxDynamicSharedMemorySize, LDS_BYTES) != hipSuccess) { fprintf(stderr, "kernel_launch: hipFuncSetAttribute failed\n"); grid = -1; return; }
        if (hipOccupancyMaxActiveBlocksPerMultiprocessor(&per_cu, (const void*)fwd_kernel, NWAVES * 64, LDS_BYTES) != hipSuccess || per_cu < 1)
            fprintf(stderr, "kernel_launch: note: occupancy query reports %d workgroups per CU\n", per_cu);
        (void)hipGetLastError();
        grid = cus;
    }
    if (grid < 0) return;
    if (hipMemsetAsync((char*)d_ws + WS_CTL, 0, CTL_ZERO_BYTES, stream) != hipSuccess) { fprintf(stderr, "kernel_launch: memset failed\n"); return; }
    Args a{};
    for (int i = 0; i < 12; ++i) a.in[i] = (const float*)d_in[i];
    a.out = (float*)d_out; a.ws = (unsigned char*)d_ws;
    hipLaunchKernelGGL(fwd_kernel, dim3(grid), dim3(NWAVES * 64), LDS_BYTES, stream, a);
    const hipError_t le = hipPeekAtLastError();
    if (le != hipSuccess) fprintf(stderr, "kernel_launch: launch failed: %s\n", hipGetErrorName(le));
}
```

```cpp
#define ATT_F8 1
#define ATT_PP 1
#define QK_FP4 1
#include <hip/hip_runtime.h>
#include <hip/hip_bf16.h>
#include <cstdio>
#include <cstdint>
#include <cmath>

namespace pg8 {
#define PG8_LAS __attribute__((address_space(3)))
typedef unsigned short bf16_t;
typedef short bf16x8 __attribute__((ext_vector_type(8)));
typedef float f32x4 __attribute__((ext_vector_type(4)));
typedef unsigned u32x4 __attribute__((ext_vector_type(4)));
constexpr int BM = 256, BK = 64, HALF = 128, HTB = HALF * BK * 2  , STAGE_BYTES = 8 * HTB, NXCD = 8, WGM = 8;

__host__ __device__ __forceinline__ int lds_byte(int r, int c) { const int st = (r >> 4) * 2 + (c >> 5), rr = r & 15, cc = c & 31, ob = rr * 64 + cc * 2; return st * 1024 + (ob ^ (((ob >> 9) & 1) << 5)); }
__host__ __device__ __forceinline__ void stage_rc(int b, int& R, int& C) { const int st = b / 1024, sb = b % 1024, swz = sb ^ (((sb >> 9) & 1) << 5); R = (st >> 1) * 16 + swz / 64; C = (st & 1) * 32 + (swz % 64) / 2; }
__host__ __device__ __forceinline__ int perm32(int rho) { const int n = rho >> 4, i = rho & 15; return 8 * (i >> 2) + 4 * n + (i & 3); }

struct Unit { int pm, pn, hm; };
struct Gemm { const bf16_t* A; const bf16_t* Bt; int M, N, K; };

struct StaticOrder {
    int nM, nN, nwg, G, c, lim;
    __host__ __device__ void init(int M, int N, int G_, int c_) { nM = M / BM; nN = N / BM; nwg = nM * nN; G = G_; c = c_; lim = nwg; }
    __host__ __device__ void map(int wgid, Unit& u) const {
        { const int q = nwg / NXCD, r = nwg % NXCD, xcd = wgid % NXCD, off = wgid / NXCD; wgid = (xcd < r ? xcd * (q + 1) : r * (q + 1) + (xcd - r) * q) + off; }
        const int nig = WGM * nN, gid = wgid / nig, fm = gid * WGM, gsz = (nM - fm) < WGM ? (nM - fm) : WGM;
        u.pm = fm + ((wgid % nig) % gsz); u.pn = (wgid % nig) / gsz; u.hm = 0;
    }
    __host__ __device__ bool next(int i, Unit& u) const {
        const long L = (long)i * G + c; if (L >= lim) return false;
        map((int)L, u); return true;
    }
    __device__ __forceinline__ void a_ready(const Unit&) const {}
    __device__ __forceinline__ void done(const Unit&) const {}
};
struct HalfOrder {
    StaticOrder base; int first;
    __host__ __device__ bool next(int i, Unit& u) const { if (i > 0) return false; base.map(first + (base.c >> 1), u); u.hm = (base.c & 1) ? 1 : 2; return true; }
    __device__ __forceinline__ void a_ready(const Unit&) const {}
    __device__ __forceinline__ void done(const Unit&) const {}
};

__device__ __forceinline__ unsigned cvt_pk_bf16(float lo, float hi) { unsigned r; asm volatile("v_cvt_pk_bf16_f32 %0, %1, %2" : "=v"(r) : "v"(lo), "v"(hi)); return r; }
struct EpiStore {
    static constexpr bool PERM = true, AFTER_DRAIN = false;
    bf16_t* O; int ldc;
    __device__ __forceinline__ void operator()(const f32x4 (&acc)[2][2][4][2], const Unit& u, int wr, int wc, int fr, int fq) const {
        const int row0 = u.pm * BM + wr * 64 + fr; const int col0 = u.pn * BM + wc * 32 + 8 * fq;
#pragma unroll
        for (int ai = 0; ai < 2; ++ai)
#pragma unroll
            for (int m = 0; m < 4; ++m) { bf16_t* rowp = O + (size_t)(row0 + ai * HALF + m * 16) * ldc + col0;
#pragma unroll
                for (int bj = 0; bj < 2; ++bj) { if (u.hm & (1 << bj)) continue; const f32x4 v0 = acc[ai][bj][m][0], v1 = acc[ai][bj][m][1];
                    u32x4 w; w.x = cvt_pk_bf16(v0[0], v0[1]); w.y = cvt_pk_bf16(v0[2], v0[3]); w.z = cvt_pk_bf16(v1[0], v1[1]); w.w = cvt_pk_bf16(v1[2], v1[3]);
                    *(u32x4*)(rowp + bj * HALF) = w; } }
    }
    __device__ __forceinline__ void fused(f32x4 (&acc)[2][2][4][2], const Unit& u, int wr, int wc, int fr, int fq, PG8_LAS unsigned char* lds, int wid, int lane) const {}
};

template <class Epi, class Sched, bool ALIGN_EPI = false, bool SP2 = false, bool HALFU = false, bool FP8 = false>
__device__ __forceinline__ void gemm_phase(PG8_LAS unsigned char* lds, const Gemm g, const Sched& S, const Epi& E, const int wid_in, const int sclb = 127) {
    typedef int i32x4_ __attribute__((ext_vector_type(4))); typedef int i32x8_ __attribute__((ext_vector_type(8)));
    const int scl2 = 127 | (sclb << 8);
    int wid = wid_in; asm volatile("" : "+s"(wid));
    int lane_l; asm volatile("v_mbcnt_lo_u32_b32 %0, -1, 0\n\tv_mbcnt_hi_u32_b32 %0, -1, %0" : "=v"(lane_l));
    const int lane = lane_l, tid = wid * 64 + lane, wr = wid >> 2, wc = wid & 3, fr = lane & 15, fq = lane >> 4;
    const int K = g.K, nt = K / BK;
    unsigned voffA[2], voffB[2];
#pragma unroll
    for (int i = 0; i < 2; ++i) { int R, C; stage_rc(tid * 16 + i * 8192, R, C); const int Rb = Epi::PERM ? ((R & ~31) + perm32(R & 31)) : R;
        voffA[i] = (unsigned)(R * K + C) * 2u; voffB[i] = (unsigned)(Rb * K + C) * 2u; }
    const size_t kstep = (size_t)(BK * 2);
    const size_t hstep = (size_t)HALF * K * 2;
    const size_t tstep = 2 * hstep;
    const unsigned ldsw = (unsigned)wid * 1024u;
    const int aoff = lds_byte(wr * 64 + fr, fq * 8), boff = lds_byte(wc * 32 + fr, fq * 8);
#define PG8_SA(b, h) (((b) * 2 + (h)) * HTB)
#define PG8_SB(b, h) ((4 + (b) * 2 + (h)) * HTB)
#define PG8_STAGE(bufoff, gbase, voff) do { _Pragma("unroll") for (int _i = 0; _i < 2; ++_i) \
        __builtin_amdgcn_global_load_lds((const unsigned*)((const char*)(gbase) + (voff)[_i]), (PG8_LAS unsigned*)(lds + (bufoff) + ldsw + _i * 8192), 16, 0, 0); } while (0)
#define PG8_LDA(dst, b, h) do { _Pragma("unroll") for (int m = 0; m < 4; ++m) { \
        if constexpr (FP8) { const i32x4_ l_ = *(const PG8_LAS i32x4_*)(lds + PG8_SA(b, h) + aoff + m * 2048), h_ = *(const PG8_LAS i32x4_*)(lds + PG8_SA(b, h) + aoff + m * 2048 + 1024); \
                             dst##8[m] = (i32x8_){l_[0], l_[1], l_[2], l_[3], h_[0], h_[1], h_[2], h_[3]}; } \
        else { _Pragma("unroll") for (int k = 0; k < 2; ++k) dst[m][k] = *(const PG8_LAS bf16x8*)(lds + PG8_SA(b, h) + aoff + m * 2048 + k * 1024); } } } while (0)
#define PG8_LDB(dst, b, h) do { _Pragma("unroll") for (int n = 0; n < 2; ++n) { \
        if constexpr (FP8) { const i32x4_ l_ = *(const PG8_LAS i32x4_*)(lds + PG8_SB(b, h) + boff + n * 2048), h_ = *(const PG8_LAS i32x4_*)(lds + PG8_SB(b, h) + boff + n * 2048 + 1024); \
                             dst##8[n] = (i32x8_){l_[0], l_[1], l_[2], l_[3], h_[0], h_[1], h_[2], h_[3]}; } \
        else { _Pragma("unroll") for (int k = 0; k < 2; ++k) dst[n][k] = *(const PG8_LAS bf16x8*)(lds + PG8_SB(b, h) + boff + n * 2048 + k * 1024); } } } while (0)
#define PG8_MMA(ai, bj, At, Bt) do { if (HALFU && (cur.hm & (1 << (bj)))) break; __builtin_amdgcn_s_setprio(1); \
        if constexpr (FP8) { _Pragma("unroll") for (int m = 0; m < 4; ++m) _Pragma("unroll") for (int n = 0; n < 2; ++n) \
            asm volatile("v_mfma_scale_f32_16x16x128_f8f6f4 %0, %1, %2, %0, %3, %3 op_sel:[1,0,0] op_sel_hi:[0,0,0]" : "+v"(acc[ai][bj][m][n]) : "v"(Bt##8[n]), "v"(At##8[m]), "v"(scl2)); } \
        else { _Pragma("unroll") for (int m = 0; m < 4; ++m) _Pragma("unroll") for (int n = 0; n < 2; ++n) _Pragma("unroll") for (int k = 0; k < 2; ++k) \
            acc[ai][bj][m][n] = __builtin_amdgcn_mfma_f32_16x16x32_bf16(Bt[n][k], At[m][k], acc[ai][bj][m][n], 0, 0, 0); } \
        __builtin_amdgcn_s_setprio(0); } while (0)
#define PG8_WAIT_V(n) asm volatile("s_waitcnt vmcnt(" #n ")" ::: "memory")
#define PG8_WAIT_L(n) asm volatile("s_waitcnt lgkmcnt(" #n ")" ::: "memory")
#define PG8_BAR __builtin_amdgcn_s_barrier()
#define PG8_SCHED __builtin_amdgcn_sched_barrier(0)
    Unit cur, nxt; int ui = 0;
    if (!S.next(0, cur)) return;
    f32x4 acc[2][2][4][2];
#pragma unroll
    for (int a = 0; a < 2; ++a)
#pragma unroll
        for (int b = 0; b < 2; ++b)
#pragma unroll
            for (int m = 0; m < 4; ++m)
#pragma unroll
                for (int n = 0; n < 2; ++n) acc[a][b][m][n] = (f32x4){0.f, 0.f, 0.f, 0.f};
    bf16x8 At[4][2], B0[2][2], B1[2][2]; i32x8_ At8[4], B08[2], B18[2];
    const char* cA = (const char*)g.A + (size_t)cur.pm * tstep; const char* cB = (const char*)g.Bt + (size_t)cur.pn * tstep;
    S.a_ready(cur);
    if constexpr (SP2) {
        PG8_STAGE(PG8_SB(0, 0), cB, voffB); PG8_STAGE(PG8_SB(0, 1), cB + hstep, voffB); PG8_STAGE(PG8_SA(0, 0), cA, voffA); PG8_STAGE(PG8_SA(0, 1), cA + hstep, voffA);
        if (wr == 1) PG8_BAR;
        PG8_WAIT_V(2); PG8_BAR;
        PG8_STAGE(PG8_SB(1, 0), cB + kstep, voffB); PG8_STAGE(PG8_SA(1, 0), cA + kstep, voffA); PG8_STAGE(PG8_SB(1, 1), cB + hstep + kstep, voffB);
        PG8_WAIT_V(6); PG8_BAR;
    } else {
        PG8_STAGE(PG8_SB(0, 0), cB, voffB); PG8_STAGE(PG8_SA(0, 0), cA, voffA); PG8_STAGE(PG8_SB(0, 1), cB + hstep, voffB); PG8_STAGE(PG8_SA(0, 1), cA + hstep, voffA);
        if (wr == 1) PG8_BAR;
        PG8_WAIT_V(4); PG8_BAR;
        PG8_STAGE(PG8_SB(1, 0), cB + kstep, voffB); PG8_STAGE(PG8_SA(1, 0), cA + kstep, voffA); PG8_STAGE(PG8_SB(1, 1), cB + hstep + kstep, voffB);
        PG8_WAIT_V(6); PG8_BAR;
    }
    for (;;) {
        const bool has_next = S.next(ui + 1, nxt);
        const char* nA = has_next ? (const char*)g.A + (size_t)nxt.pm * tstep : cA; const char* nB = has_next ? (const char*)g.Bt + (size_t)nxt.pn * tstep : cB;
        for (int t = 0; t < nt; t += 2) {
            const bool last = (t == nt - 2);
            const char* a1 = cA + (size_t)(t + 1) * kstep;
            const char* a2 = last ? nA : cA + (size_t)(t + 2) * kstep; const char* b2 = last ? nB : cB + (size_t)(t + 2) * kstep;
            const char* a3 = a2 + kstep; const char* b3 = b2 + kstep;
            if (last && has_next) S.a_ready(nxt);
            if constexpr (SP2) {
            PG8_LDB(B0, 0, 0); PG8_LDB(B1, 0, 1); PG8_SCHED; PG8_LDA(At, 0, 0); PG8_STAGE(PG8_SA(1, 1), a1 + hstep, voffA);
            PG8_WAIT_V(8); PG8_WAIT_L(0); PG8_BAR; PG8_MMA(0, 0, At, B0); PG8_MMA(0, 1, At, B1); PG8_BAR; PG8_SCHED;
            PG8_LDA(At, 0, 1); PG8_STAGE(PG8_SB(0, 0), b2, voffB); PG8_STAGE(PG8_SB(0, 1), b2 + hstep, voffB); PG8_STAGE(PG8_SA(0, 0), a2, voffA);
            PG8_WAIT_V(8); PG8_WAIT_L(0); PG8_BAR; PG8_MMA(1, 0, At, B0); PG8_MMA(1, 1, At, B1); PG8_BAR; PG8_SCHED;
            PG8_LDB(B0, 1, 0); PG8_LDB(B1, 1, 1); PG8_SCHED; PG8_LDA(At, 1, 0); PG8_STAGE(PG8_SA(0, 1), a2 + hstep, voffA);
            PG8_WAIT_V(8); PG8_WAIT_L(0); PG8_BAR; PG8_MMA(0, 0, At, B0); PG8_MMA(0, 1, At, B1); PG8_BAR; PG8_SCHED;
            PG8_LDA(At, 1, 1); PG8_STAGE(PG8_SB(1, 0), b3, voffB); PG8_STAGE(PG8_SB(1, 1), b3 + hstep, voffB); PG8_STAGE(PG8_SA(1, 0), a3, voffA);
            PG8_WAIT_V(8); PG8_WAIT_L(0); PG8_BAR; PG8_MMA(1, 0, At, B0); PG8_MMA(1, 1, At, B1); PG8_BAR; PG8_SCHED;
            } else {
            PG8_LDB(B0, 0, 0); PG8_SCHED; PG8_LDA(At, 0, 0); PG8_STAGE(PG8_SA(1, 1), a1 + hstep, voffA);
            PG8_WAIT_L(8); PG8_BAR; PG8_WAIT_L(0); PG8_MMA(0, 0, At, B0); PG8_BAR; PG8_SCHED;
            PG8_LDB(B1, 0, 1); PG8_STAGE(PG8_SB(0, 0), b2, voffB);
            PG8_BAR; PG8_WAIT_L(0); PG8_MMA(0, 1, At, B1); PG8_BAR;
            PG8_LDA(At, 0, 1); PG8_STAGE(PG8_SA(0, 0), a2, voffA);
            PG8_BAR; PG8_WAIT_L(0); PG8_MMA(1, 0, At, B0); PG8_BAR; PG8_SCHED;
            PG8_STAGE(PG8_SB(0, 1), b2 + hstep, voffB);
            PG8_WAIT_V(6); PG8_BAR; PG8_MMA(1, 1, At, B1); PG8_BAR;
            PG8_LDB(B0, 1, 0); PG8_SCHED; PG8_LDA(At, 1, 0); PG8_STAGE(PG8_SA(0, 1), a2 + hstep, voffA);
            PG8_WAIT_L(8); PG8_BAR; PG8_WAIT_L(0); PG8_MMA(0, 0, At, B0); PG8_BAR; PG8_SCHED;
            PG8_LDB(B1, 1, 1); PG8_STAGE(PG8_SB(1, 0), b3, voffB);
            PG8_BAR; PG8_WAIT_L(0); PG8_MMA(0, 1, At, B1); PG8_BAR;
            PG8_LDA(At, 1, 1); PG8_STAGE(PG8_SA(1, 0), a3, voffA);
            PG8_BAR; PG8_WAIT_L(0); PG8_MMA(1, 0, At, B0); PG8_BAR; PG8_SCHED;
            PG8_STAGE(PG8_SB(1, 1), b3 + hstep, voffB);
            PG8_WAIT_V(6); PG8_BAR; PG8_MMA(1, 1, At, B1); PG8_BAR;
            }
        }
        if constexpr (ALIGN_EPI) { if (wr == 0) PG8_BAR; }
        if constexpr (!Epi::AFTER_DRAIN) { E(acc, cur, wr, wc, fr, fq); S.done(cur); }
        if (!has_next) break;
#pragma unroll
        for (int a = 0; a < 2; ++a)
#pragma unroll
            for (int b = 0; b < 2; ++b)
#pragma unroll
                for (int m = 0; m < 4; ++m)
#pragma unroll
                    for (int n = 0; n < 2; ++n) acc[a][b][m][n] = (f32x4){0.f, 0.f, 0.f, 0.f};
        cur = nxt; cA = nA; cB = nB; ++ui;
        if constexpr (ALIGN_EPI) { if (wr == 1) PG8_BAR; }
    }
    PG8_WAIT_V(0);
    if constexpr (!ALIGN_EPI) { if (wr == 0) PG8_BAR; }
    PG8_BAR;
    if constexpr (Epi::AFTER_DRAIN) { E.fused(acc, cur, wr, wc, fr, fq, lds, wid, lane); S.done(cur); }
#undef PG8_SA
#undef PG8_SB
#undef PG8_STAGE
#undef PG8_LDA
#undef PG8_LDB
#undef PG8_MMA
#undef PG8_WAIT_V
#undef PG8_WAIT_L
#undef PG8_BAR
#undef PG8_SCHED
}
}
typedef unsigned short bf16;
typedef pg8::bf16_t bf16_t;
typedef unsigned u32x2 __attribute__((ext_vector_type(2)));
constexpr int S = 16384, DM = 4096, DEPTH = 4, HD = 128, INW = 12800, NMOD = 3 * DM;
constexpr int A_H = 12, B_H = 8, C_H = 12;
constexpr int COL_AK = 0, COL_AV = 1536, COL_AG = 3072, COL_BQ = 4608, COL_BK = 5632, COL_BV = 5888, COL_BG = 6144, COL_CG = 7168, COL_CV = 8704,
              COL_AQ = 9216, COL_CQ = 10752, COL_CK = 12288;
__host__ __device__ constexpr int proj_col_of(int src) { return src < 1536 ? src + COL_AQ : (src < 8704 ? src - 1536 : (src < 10752 ? src + 2048 : (src < 11264 ? src - 2048 : src - 4096))); }
constexpr int OCOL_A = 0, OCOL_B = 1536, OCOL_C = 2560;
constexpr float EPS = 1e-6f;
constexpr float SM_SCALE = 0.08838834764831845f;
constexpr float LOG2E = 1.4426950408889634f;
constexpr float QK_C = SM_SCALE * LOG2E;
constexpr int NWAVES = 8;

constexpr size_t MiB = 1u << 20;
constexpr size_t WS_CTL = 0, CTL_ZERO_BYTES = 1 * MiB;
constexpr size_t WS_TAB = 1 * MiB;
constexpr size_t WS_MODP = 1 * MiB + 256 * 1024;
constexpr size_t WS_WIN = 2 * MiB;
constexpr size_t WS_WOUT = WS_WIN + 400 * MiB;
constexpr size_t WS_H = WS_WOUT + 128 * MiB;
constexpr size_t WS_PROJ = WS_H + 128 * MiB;
constexpr size_t WS_O = WS_PROJ + 400 * MiB;
constexpr size_t WS_Y = WS_O + 128 * MiB;
constexpr size_t WS_PART4 = WS_Y + 128 * MiB;
constexpr size_t WS_PART16 = WS_PART4 + 48 * MiB;
constexpr size_t WS_STAT4 = WS_PART16 + 48 * MiB;
constexpr size_t WS_STAT16 = WS_STAT4 + 2 * MiB;
constexpr size_t WS_QF8 = WS_STAT16 + 2 * MiB;
constexpr size_t WS_KF8 = WS_QF8 + 24 * MiB;
constexpr size_t WS_VTF8 = WS_KF8 + 8 * MiB;
constexpr size_t WS_H8 = WS_VTF8 + 8 * MiB;
constexpr size_t WS_W8 = WS_H8 + 64 * MiB;
constexpr size_t WS_END = WS_W8 + 64 * MiB;
constexpr int F8_COL0 = COL_AQ, F8_COLS = 3584;
constexpr int CW_AMAX = 1024;
constexpr int CW_BAR = 4096;
constexpr int LUTA_N = 2 * (64 + 28) + 1, LUTB_N = 2 * (128 + 28) + 1;
constexpr int TB_LUTA = 0;
constexpr int TB_LUTB = 6912;
constexpr int TB_ROPE_R = 12288;
constexpr int TB_ROPE_C = 12288 + 16384;
constexpr int RING_OFF = 0, RING_BYTES = 131072;
constexpr int BAND_BYTES = 8 * (8192 + 32 * 272);
constexpr int LDSCTL_OFF = BAND_BYTES, MISC_OFF = LDSCTL_OFF + 320;
constexpr int BAND_LUT_OFF = LDSCTL_OFF + 1024;
constexpr int BAND_LUT_WAVE = 2048;
constexpr int LDS_BYTES = BAND_LUT_OFF + 8 * BAND_LUT_WAVE;
__device__ __forceinline__ int fresh_lane() { int l; asm volatile("v_mbcnt_lo_u32_b32 %0, -1, 0\n\tv_mbcnt_hi_u32_b32 %0, -1, %0" : "=v"(l)); return l; }
__device__ __forceinline__ float lane_xor(float v, int mask, int lane) { return __uint_as_float((unsigned)__builtin_amdgcn_ds_bpermute((lane ^ mask) << 2, (int)__float_as_uint(v))); }
__device__ __forceinline__ float wave_sum_l(float v, int lane) {
#pragma unroll
    for (int o = 1; o < 64; o <<= 1) v += lane_xor(v, o, lane);
    return v;
}
__device__ __forceinline__ float wave_max_l(float v, int lane) {
#pragma unroll
    for (int o = 1; o < 64; o <<= 1) v = fmaxf(v, lane_xor(v, o, lane));
    return v;
}

#define GAS __attribute__((address_space(1)))
#define LAS __attribute__((address_space(3)))
typedef unsigned short bf16;
typedef unsigned v4u __attribute__((ext_vector_type(4)));
typedef float f32x4 __attribute__((ext_vector_type(4)));
typedef short bf16x8 __attribute__((ext_vector_type(8)));
typedef GAS unsigned gu32;
typedef GAS unsigned long long gu64;
#define RLX_AGENT __ATOMIC_RELAXED, __HIP_MEMORY_SCOPE_AGENT
#define LDS_WAIT() asm volatile("s_waitcnt lgkmcnt(0)" ::: "memory")
#define VM_WAIT() asm volatile("s_waitcnt vmcnt(0)" ::: "memory")
__device__ __forceinline__ unsigned long long rt() { return __builtin_amdgcn_s_memrealtime(); }
__device__ __forceinline__ unsigned f2bf(float f) { unsigned u = __builtin_bit_cast(unsigned, f); return (u + 0x7fffu + ((u >> 16) & 1u)) >> 16; }
__device__ __forceinline__ unsigned pk2(float lo, float hi) { return f2bf(lo) | (f2bf(hi) << 16); }

#define XB_TMO      128
#define XB_XCNT(j)  (256  + 64 * (j))
#define XB_XSUB(j)  (1280 + 64 * (j))
#define XB_XGEN(j)  (2304 + 64 * (j))
#define XB_TOP      3328
#define XB_TOPGEN   3392
#define XCD_BAR_WORDS 3456
#define XB_SPIN_CAP (1u << 18)

__device__ __forceinline__ unsigned xb_ld(unsigned* p)              { return __hip_atomic_load(p, __ATOMIC_RELAXED, __HIP_MEMORY_SCOPE_AGENT); }
__device__ __forceinline__ unsigned xb_add(unsigned* p, unsigned v) { return __hip_atomic_fetch_add(p, v, __ATOMIC_RELAXED, __HIP_MEMORY_SCOPE_AGENT); }
__device__ __forceinline__ unsigned xb_xcc_id() { return (unsigned)__builtin_amdgcn_s_getreg((3 << 11) | 20) & 0xFu; }
#define XB_SPIN(cond, bar) do { unsigned _sp = 0; while (cond) { __builtin_amdgcn_s_sleep(1); \
    if ((++_sp & 255u) == 0u) { if (xb_ld(&(bar)[XB_TMO])) break; if (_sp > XB_SPIN_CAP) { atomicAdd(&(bar)[XB_TMO], 1u); break; } } } } while (0)

struct XcdBarrier {
    unsigned* bar; unsigned x; unsigned w;
    volatile LAS unsigned* st;
};

__device__ __forceinline__ XcdBarrier xcd_barrier_post(unsigned* bar, volatile LAS unsigned* st, unsigned wave) {
    XcdBarrier b; b.bar = bar; b.x = (unsigned)__builtin_amdgcn_readfirstlane((int)xb_xcc_id()); b.st = st; b.w = wave;
    if (threadIdx.x == 0) (void)xb_add(&bar[XB_XCNT(b.x)], 1u);
    return b;
}
__device__ __forceinline__ void xcd_barrier_complete(unsigned* bar, unsigned x, unsigned& nloc, unsigned& nx) {
    const unsigned G = gridDim.x * gridDim.y * gridDim.z;
    unsigned sum, cnt, mine, sp = 0u;
    for (;;) {
        sum = 0u; cnt = 0u; mine = 0u;
#pragma unroll
        for (unsigned j = 0; j < 16; ++j) { const unsigned c = xb_ld(&bar[XB_XCNT(j)]); sum += c; cnt += (c > 0u) ? 1u : 0u; mine = (j == x) ? c : mine; }
        if (sum == G) break;
        __builtin_amdgcn_s_sleep(1);
        if ((++sp & 255u) == 0u) { if (xb_ld(&bar[XB_TMO])) break; if (sp > XB_SPIN_CAP) { atomicAdd(&bar[XB_TMO], 1u); break; } }
    }
    nloc = mine > 0u ? mine : 1u; nx = cnt > 0u ? cnt : 1u;
}

__device__ __forceinline__ void xcd_barrier(const XcdBarrier& b) {
    asm volatile("s_waitcnt vmcnt(0)" ::: "memory");
    __syncthreads();
    int ln_; asm volatile("v_mbcnt_lo_u32_b32 %0, -1, 0\n\tv_mbcnt_hi_u32_b32 %0, -1, %0" : "=v"(ln_));
    if (b.w == 0u && ln_ == 0) {
        unsigned* bar = b.bar; unsigned bx_ = b.x; asm volatile("" : "+s"(bar), "+s"(bx_));
        __builtin_amdgcn_s_waitcnt(0);
        unsigned nloc = b.st[0], nx = b.st[1];
        if (nloc == 0u) { xcd_barrier_complete(bar, bx_, nloc, nx); b.st[0] = nloc; b.st[1] = nx; }
        const unsigned old = xb_add(&bar[XB_XSUB(bx_)], 1u);
        const unsigned gen = old / nloc;
        if (old + 1u == (gen + 1u) * nloc) {
            __builtin_amdgcn_fence(__ATOMIC_RELEASE, "agent");
            asm volatile("s_waitcnt vmcnt(0)" ::: "memory");
            const unsigned og = xb_add(&bar[XB_TOP], 1u);
            const unsigned tg = og / nx;
            if (og + 1u == (tg + 1u) * nx) xb_add(&bar[XB_TOPGEN], 1u);
            else XB_SPIN(xb_ld(&bar[XB_TOPGEN]) == tg, bar);
            __builtin_amdgcn_fence(__ATOMIC_ACQUIRE, "agent");
            xb_add(&bar[XB_XGEN(bx_)], 1u);
            asm volatile("s_waitcnt vmcnt(0)" ::: "memory");
        } else {
            XB_SPIN(xb_ld(&bar[XB_XGEN(bx_)]) == gen, bar);
            __builtin_amdgcn_fence(__ATOMIC_ACQUIRE, "agent");
            asm volatile("s_waitcnt vmcnt(0)" ::: "memory");
        }
    }
    __syncthreads();
}
__device__ __forceinline__ float wave_sum(float v) {
#pragma unroll
    for (int o = 1; o < 64; o <<= 1) v += __shfl_xor(v, o);
    return v;
}
template <bool TRACK>
__device__ __forceinline__ void p0_transpose_item(const float* W, int K, int N, bf16* WT, int row_off, LAS float* scr, int item, int lane, float& amx) {
    const int nblk = N / 32, kb = item / nblk, nb = item % nblk, k0 = 64 * kb, n0 = 32 * nb;
#pragma unroll 8
    for (int i = 0; i < 32; ++i) { const int kk = 2 * i + (lane >> 5); const float w_ = W[(size_t)(k0 + kk) * N + n0 + (lane & 31)]; scr[kk * 33 + (lane & 31)] = w_; if (TRACK) amx = fmaxf(amx, fabsf(w_)); }
    LDS_WAIT(); asm volatile("" ::: "memory");
    const int c = lane & 7;
#pragma unroll
    for (int j = 0; j < 4; ++j) { const int n = (lane >> 3) + 8 * j; const LAS float* s = scr + (8 * c) * 33 + n;
        v4u o; o.x = pk2(s[0 * 33], s[1 * 33]); o.y = pk2(s[2 * 33], s[3 * 33]); o.z = pk2(s[4 * 33], s[5 * 33]); o.w = pk2(s[6 * 33], s[7 * 33]);
        *(GAS v4u*)(WT + (size_t)(row_off + n0 + n) * K + k0 + 8 * c) = o; }
    LDS_WAIT(); asm volatile("" ::: "memory");
}
namespace attc {
typedef unsigned short bf16;
constexpr int   D = 128, NW = 8, QBLK = 32, KVBLK = 64;
constexpr float SCALE = SM_SCALE;
constexpr float THR = 8.f;
constexpr int SDEPTH = 2;
constexpr int LDQ = INW, LDK = INW, LDO = DM;
constexpr size_t SHM_V = KVBLK * D * 2, SHM_K = KVBLK * D * 2, SHM_ATTN = 2 * SHM_V + 2 * SHM_K + NW * 64 * 4;
using bf16x8 = __attribute__((ext_vector_type(8))) short;
using s16x4  = __attribute__((ext_vector_type(4))) short;
using f32x16 = __attribute__((ext_vector_type(16))) float;
using u32x4  = __attribute__((ext_vector_type(4))) unsigned;
struct StageB { using T = bf16x8;
  __device__ static __forceinline__ T ld8(const bf16* p) { return *reinterpret_cast<const bf16x8*>(p); }
  __device__ static __forceinline__ bf16x8 tobf(T x) { return x; } };
#define KSWZ(row, colB) ((row) * 256 + ((colB) ^ (((row) & 7) << 4)))
#define SBAR() __builtin_amdgcn_sched_barrier(0)
__device__ __forceinline__ int crow(int r, int hi) { return (r & 3) + 8 * (r >> 2) + 4 * hi; }
__device__ __forceinline__ unsigned cvtpk(float lo, float hi) {
  unsigned r; asm volatile("v_cvt_pk_bf16_f32 %0, %1, %2" : "=v"(r) : "v"(lo), "v"(hi)); return r;
}
__device__ __forceinline__ void partialSM(f32x16& p0, f32x16& p1, float& m_reg, float& mn, float& alpha) {
  constexpr float C = SCALE * 1.4426950408889634f;
  float pmax = p0[0]; for (int r = 1; r < 16; ++r) pmax = fmaxf(pmax, p0[r]); for (int r = 0; r < 16; ++r) pmax = fmaxf(pmax, p1[r]);
  { auto rr = __builtin_amdgcn_permlane32_swap(__float_as_uint(pmax), __float_as_uint(pmax), false, false);
    pmax = fmaxf(__uint_as_float(rr[0]), __uint_as_float(rr[1])); }
  if (__builtin_expect(__all(pmax - m_reg <= THR / SCALE), 1)) { mn = m_reg; alpha = 1.f; }
  else { mn = fmaxf(m_reg, pmax); alpha = __builtin_amdgcn_exp2f((m_reg - mn) * C); m_reg = mn; }
  float mnC = -mn * C;
  for (int r = 0; r < 16; ++r) p0[r] = fmaf(p0[r], C, mnC); for (int r = 0; r < 16; ++r) p1[r] = fmaf(p1[r], C, mnC);
  for (int r = 0; r < 16; ++r) p0[r] = __builtin_amdgcn_exp2f(p0[r]);
}
__device__ __forceinline__ float psm_max(const f32x16& p0, const f32x16& p1) {
  float pmax = p0[0];
#pragma unroll
  for (int r = 1; r < 16; ++r) pmax = fmaxf(pmax, p0[r]);
#pragma unroll
  for (int r = 0; r < 16; ++r) pmax = fmaxf(pmax, p1[r]);
  auto rr = __builtin_amdgcn_permlane32_swap(__float_as_uint(pmax), __float_as_uint(pmax), false, false);
  return fmaxf(__uint_as_float(rr[0]), __uint_as_float(rr[1]));
}
__device__ __forceinline__ void psm_scale(f32x16& p0, f32x16& p1, float pmax, float& m_reg, float& mn, float& alpha) {
  constexpr float C = SCALE * 1.4426950408889634f;
  const bool keep = __all(pmax - m_reg <= THR / SCALE);
  mn = keep ? m_reg : fmaxf(m_reg, pmax); alpha = keep ? 1.f : __builtin_amdgcn_exp2f((m_reg - mn) * C); m_reg = mn;
  const float mnC = -mn * C;
#pragma unroll
  for (int r = 0; r < 16; ++r) p0[r] = fmaf(p0[r], C, mnC);
#pragma unroll
  for (int r = 0; r < 16; ++r) p1[r] = fmaf(p1[r], C, mnC);
}
template <int LO> __device__ __forceinline__ void psm_exp8(f32x16& p0) {
#pragma unroll
  for (int r = LO; r < LO + 8; ++r) p0[r] = __builtin_amdgcn_exp2f(p0[r]);
}
__device__ __forceinline__ void finishSM(f32x16& p0, f32x16& p1, float alpha, float& l_reg, bf16x8& pa0, bf16x8& pa1, bf16x8& pa2, bf16x8& pa3) {
  for (int r = 0; r < 16; ++r) p1[r] = __builtin_amdgcn_exp2f(p1[r]);
  float ps = 0; for (int r = 0; r < 16; ++r) ps += p0[r]; for (int r = 0; r < 16; ++r) ps += p1[r];
  { auto rr = __builtin_amdgcn_permlane32_swap(__float_as_uint(ps), __float_as_uint(ps), false, false);
    ps = __uint_as_float(rr[0]) + __uint_as_float(rr[1]); }
  l_reg = l_reg * alpha + ps;
#define PK4(P, BASE, OUT) do { unsigned a0 = cvtpk(P[BASE + 0], P[BASE + 1]), a1 = cvtpk(P[BASE + 2], P[BASE + 3]);   \
    unsigned b0 = cvtpk(P[BASE + 4], P[BASE + 5]), b1 = cvtpk(P[BASE + 6], P[BASE + 7]);                              \
    auto r0 = __builtin_amdgcn_permlane32_swap(a0, b0, false, false); auto r1 = __builtin_amdgcn_permlane32_swap(a1, b1, false, false); \
    u32x4 w = {r0[0], r1[0], r0[1], r1[1]}; OUT = *reinterpret_cast<bf16x8*>(&w); } while (0)
  PK4(p0, 0, pa0); PK4(p0, 8, pa1); PK4(p1, 0, pa2); PK4(p1, 8, pa3);
#undef PK4
}
__device__ __forceinline__ void qkt(f32x16& p0, f32x16& p1, const bf16* Ks, const bf16x8* qr, int r32, int hi) {
  p0 = f32x16{}; p1 = f32x16{};
  for (int d0 = 0; d0 < 8; ++d0) { int cb = (d0 * 16 + hi * 8) * 2;
    bf16x8 b0 = *reinterpret_cast<const bf16x8*>((const char*)Ks + KSWZ(r32, cb));
    bf16x8 b1 = *reinterpret_cast<const bf16x8*>((const char*)Ks + KSWZ(32 + r32, cb));
    p0 = __builtin_amdgcn_mfma_f32_32x32x16_bf16(b0, qr[d0], p0, 0, 0, 0);
    p1 = __builtin_amdgcn_mfma_f32_32x32x16_bf16(b1, qr[d0], p1, 0, 0, 0); }
}
__device__ __forceinline__ int v_st(int k, int c) { const int kk = (k & ~0xC) | ((k & 4) << 1) | ((k & 8) >> 1); return ((kk >> 3) * 4 + (c >> 5)) * 512 + ((kk & 7) * 32 + (c & 31)) * 2; }
__device__ __forceinline__ int v_rd_base(int lane) { return ((lane & 3) << 3) | (((lane >> 2) & 3) << 6) | (((lane >> 4) & 1) << 5) | (((lane >> 5) & 1) << 8); }
constexpr int v_rd_off(int d0, int ks, int half) { return d0 * 512 + ks * 4096 + half * 2048; }
template <int OFF> __device__ __forceinline__ s16x4 tr_read(int vb) {
  s16x4 r; asm volatile("ds_read_b64_tr_b16 %0, %1 offset:%2" : "=&v"(r) : "v"(vb), "i"(OFF) : "memory"); return r;
}
template <int D0> __device__ __forceinline__ void pv_one(f32x16& od, int vb, bf16x8 pa0, bf16x8 pa1, bf16x8 pa2, bf16x8 pa3) {
  const s16x4 l0 = tr_read<v_rd_off(D0, 0, 0)>(vb), h0 = tr_read<v_rd_off(D0, 0, 1)>(vb), l1 = tr_read<v_rd_off(D0, 1, 0)>(vb), h1 = tr_read<v_rd_off(D0, 1, 1)>(vb);
  const s16x4 l2 = tr_read<v_rd_off(D0, 2, 0)>(vb), h2 = tr_read<v_rd_off(D0, 2, 1)>(vb), l3 = tr_read<v_rd_off(D0, 3, 0)>(vb), h3 = tr_read<v_rd_off(D0, 3, 1)>(vb);
  asm volatile("s_waitcnt lgkmcnt(0)" ::: "memory"); SBAR();
#define PK(L, H) (bf16x8){L[0], L[1], L[2], L[3], H[0], H[1], H[2], H[3]}
  od = __builtin_amdgcn_mfma_f32_32x32x16_bf16(pa0, PK(l0, h0), od, 0, 0, 0);
  od = __builtin_amdgcn_mfma_f32_32x32x16_bf16(pa1, PK(l1, h1), od, 0, 0, 0);
  od = __builtin_amdgcn_mfma_f32_32x32x16_bf16(pa2, PK(l2, h2), od, 0, 0, 0);
  od = __builtin_amdgcn_mfma_f32_32x32x16_bf16(pa3, PK(l3, h3), od, 0, 0, 0);
#undef PK
}
__device__ __forceinline__ void pv_d0(f32x16* o, int vb, bf16x8 pa0, bf16x8 pa1, bf16x8 pa2, bf16x8 pa3) {
  pv_one<0>(o[0], vb, pa0, pa1, pa2, pa3); pv_one<1>(o[1], vb, pa0, pa1, pa2, pa3); pv_one<2>(o[2], vb, pa0, pa1, pa2, pa3); pv_one<3>(o[3], vb, pa0, pa1, pa2, pa3);
}
__device__ __forceinline__ void pv_psm(f32x16* o, int vb, bf16x8 pa0, bf16x8 pa1, bf16x8 pa2, bf16x8 pa3, f32x16& q0, f32x16& q1, float& m_reg, float& mn, float& alpha) {
  pv_one<0>(o[0], vb, pa0, pa1, pa2, pa3); float pmax = psm_max(q0, q1); asm volatile("" : "+v"(pmax));
  pv_one<1>(o[1], vb, pa0, pa1, pa2, pa3); psm_scale(q0, q1, pmax, m_reg, mn, alpha); asm volatile("" : "+v"(q0), "+v"(q1));
  pv_one<2>(o[2], vb, pa0, pa1, pa2, pa3); psm_exp8<0>(q0); asm volatile("" : "+v"(q0));
  pv_one<3>(o[3], vb, pa0, pa1, pa2, pa3); psm_exp8<8>(q0); asm volatile("" : "+v"(q0)); SBAR();
}

constexpr int EPI_PITCH = 528, EPI_BYTES = 32 * EPI_PITCH;
template <int QS>
__device__ __forceinline__ void epi_stage_store(const f32x16 (&o)[4], const float (&rli)[16], __attribute__((address_space(3))) unsigned char* st,
                                                const bf16* __restrict__ gbase, bf16* __restrict__ obase, int lane) {
  typedef float f32x4_t __attribute__((ext_vector_type(4)));
  asm volatile("" : "+v"(lane));
  const int r32 = lane & 31, hi = lane >> 5;
  const int rr = lane >> 4, c16 = lane & 15;
  u32x4 g[8];
#pragma unroll
  for (int i = 0; i < 8; ++i) g[i] = *reinterpret_cast<const u32x4*>(gbase + (size_t)(QS * (rr + 4 * i)) * LDQ + c16 * 8);
#pragma unroll
  for (int r = 0; r < 16; ++r) { const int row = crow(r, hi);
#pragma unroll
    for (int d0 = 0; d0 < 4; ++d0) *reinterpret_cast<__attribute__((address_space(3))) float*>(st + row * EPI_PITCH + (d0 * 32 + r32) * 4) = o[d0][r] * rli[r]; }
#pragma unroll
  for (int i = 0; i < 8; ++i) { const int row = rr + 4 * i;
    const f32x4_t a = *reinterpret_cast<const __attribute__((address_space(3))) f32x4_t*>(st + row * EPI_PITCH + c16 * 32);
    const f32x4_t b = *reinterpret_cast<const __attribute__((address_space(3))) f32x4_t*>(st + row * EPI_PITCH + c16 * 32 + 16);
    float v[8] = {a[0], a[1], a[2], a[3], b[0], b[1], b[2], b[3]};
#pragma unroll
    for (int e = 0; e < 4; ++e) { const float g0 = __uint_as_float(g[i][e] << 16), g1 = __uint_as_float(g[i][e] & 0xffff0000u);
      v[2 * e] *= g0 * __builtin_amdgcn_rcpf(1.f + __expf(-g0)); v[2 * e + 1] *= g1 * __builtin_amdgcn_rcpf(1.f + __expf(-g1)); }
    u32x4 w = {cvtpk(v[0], v[1]), cvtpk(v[2], v[3]), cvtpk(v[4], v[5]), cvtpk(v[6], v[7])};
    *reinterpret_cast<u32x4*>(obase + (size_t)(QS * row) * LDO + c16 * 8) = w; }
}

__device__ __forceinline__ void attn_dense_body(const bf16* __restrict__ Qb, const bf16* __restrict__ Kh, const bf16* __restrict__ Vh,
                                                const bf16* __restrict__ Gb, bf16* __restrict__ Ob, int seq, char* lds, const int wid) {
  using St = StageB;
  int lane_l; asm volatile("v_mbcnt_lo_u32_b32 %0, -1, 0\n\tv_mbcnt_hi_u32_b32 %0, -1, %0" : "=v"(lane_l));
  const int lane = lane_l, tid = wid * 64 + lane, r32 = lane & 31, hi = lane >> 5;
  bf16* V_lds = (bf16*)lds; bf16* K_lds = (bf16*)(lds + 2 * SHM_V);
  float* ws = (float*)(lds + 2 * SHM_V + 2 * SHM_K) + wid * 64; float* li_l = ws; float* al_l = ws + 32;
  float m_reg = -1e30f, l_reg = 0; f32x16 o[4] = {}; bf16x8 qr[8];
  const bf16* Qw = Qb + (long)(wid * QBLK + r32) * LDQ + hi * 8;
#pragma unroll
  for (int d0 = 0; d0 < 8; ++d0) qr[d0] = St::ld8(Qw + d0 * 16);
  const int sr = tid >> 4, sc = (tid & 15) * 8, vst0 = v_st(sr, sc), vst1 = v_st(32 + sr, sc);
  const int vb0 = (int)(uintptr_t)V_lds + v_rd_base(lane);
  struct { typename St::T vs0, vs1, ks0, ks1; } sr_[SDEPTH];
#define SLOAD(i, k0) do { sr_[i].vs0 = St::ld8(&Vh[(long)((k0) + sr) * LDK + sc]); sr_[i].vs1 = St::ld8(&Vh[(long)((k0) + 32 + sr) * LDK + sc]); \
    sr_[i].ks0 = St::ld8(&Kh[(long)((k0) + sr) * LDK + sc]); sr_[i].ks1 = St::ld8(&Kh[(long)((k0) + 32 + sr) * LDK + sc]); } while (0)
#define SWRITE(b, i) do { *(bf16x8*)((char*)V_lds + (b) * SHM_V + vst0) = St::tobf(sr_[i].vs0);          \
    *(bf16x8*)((char*)V_lds + (b) * SHM_V + vst1) = St::tobf(sr_[i].vs1); int kc = sc * 2;               \
    *(bf16x8*)((char*)K_lds + (b) * SHM_K + KSWZ(sr, kc)) = St::tobf(sr_[i].ks0);                       \
    *(bf16x8*)((char*)K_lds + (b) * SHM_K + KSWZ(32 + sr, kc)) = St::tobf(sr_[i].ks1); } while (0)
#define SWAIT() do { if constexpr (SDEPTH == 2) asm volatile("s_waitcnt vmcnt(4)" ::: "memory"); else asm volatile("s_waitcnt vmcnt(0)" ::: "memory"); } while (0)
#define RESC(a) do { if (__any((a) < 1.f)) { if (hi == 0) al_l[r32] = (a); asm volatile("s_waitcnt lgkmcnt(0)" ::: "memory"); \
    for (int d = 0; d < 4; ++d) for (int r = 0; r < 16; ++r) o[d][r] *= al_l[crow(r, hi)]; } } while (0)
  f32x16 pA0, pA1, pB0, pB1; float mnA, mnB, alA, alB; bf16x8 pa0, pa1, pa2, pa3; const int NT = seq / KVBLK;
#ifdef ATT_PRIO
  if (wid >= 4) __builtin_amdgcn_s_setprio(1);
#endif
  constexpr int SE = 0, SO = SDEPTH - 1;
  SLOAD(SE, 0); asm volatile("s_waitcnt vmcnt(0)" ::: "memory"); SWRITE(0, SE); __syncthreads();
  qkt(pA0, pA1, K_lds, qr, r32, hi); partialSM(pA0, pA1, m_reg, mnA, alA);
  SLOAD(SO, KVBLK); if constexpr (SDEPTH == 2) { if (2 < NT) SLOAD(SE, 2 * KVBLK); }
  SWAIT(); SWRITE(1, SO); __syncthreads();
  for (int j = 1; j + 1 < NT; j += 2) {
    SBAR(); qkt(pB0, pB1, (bf16*)((char*)K_lds + SHM_K), qr, r32, hi);
    finishSM(pA0, pA1, alA, l_reg, pa0, pa1, pa2, pa3); SBAR();
    SLOAD(SO, (j + SDEPTH) * KVBLK); SBAR();
    pv_psm(o, vb0, pa0, pa1, pa2, pa3, pB0, pB1, m_reg, mnB, alB);
    __syncthreads(); SWAIT(); SWRITE(0, SE);
    RESC(alB); __syncthreads();
    SBAR(); qkt(pA0, pA1, K_lds, qr, r32, hi);
    finishSM(pB0, pB1, alB, l_reg, pa0, pa1, pa2, pa3); SBAR();
    if (SDEPTH == 1 || j + 3 < NT) SLOAD(SE, (j + 1 + SDEPTH) * KVBLK); SBAR();
    pv_psm(o, vb0 + (int)SHM_V, pa0, pa1, pa2, pa3, pA0, pA1, m_reg, mnA, alA);
    __syncthreads(); SWAIT(); SWRITE(1, SO);
    RESC(alA); __syncthreads();
  }
  SBAR(); qkt(pB0, pB1, (bf16*)((char*)K_lds + SHM_K), qr, r32, hi);
  finishSM(pA0, pA1, alA, l_reg, pa0, pa1, pa2, pa3); SBAR();
  pv_psm(o, vb0, pa0, pa1, pa2, pa3, pB0, pB1, m_reg, mnB, alB);
  __syncthreads(); RESC(alB);
  finishSM(pB0, pB1, alB, l_reg, pa0, pa1, pa2, pa3); SBAR();
  pv_d0(o, vb0 + (int)SHM_V, pa0, pa1, pa2, pa3);
  if (hi == 0) li_l[r32] = l_reg; asm volatile("s_waitcnt lgkmcnt(0)" ::: "memory");
  float rli[16];
#pragma unroll
  for (int r = 0; r < 16; ++r) rli[r] = __builtin_amdgcn_rcpf(li_l[crow(r, hi)]);
#ifdef ATT_PRIO
  __builtin_amdgcn_s_setprio(0);
#endif
  __syncthreads();
  epi_stage_store<1>(o, rli, (__attribute__((address_space(3))) unsigned char*)(uintptr_t)(unsigned)(uintptr_t)lds + wid * EPI_BYTES, Gb + (long)(wid * QBLK) * LDQ, Ob + (long)(wid * QBLK) * LDO, lane);
  __syncthreads();
#undef SLOAD
#undef SWRITE
#undef SWAIT
#undef RESC
}
typedef int i32x8 __attribute__((ext_vector_type(8)));
typedef int i32x4 __attribute__((ext_vector_type(4)));
constexpr int KP8 = 144, VP8 = 80;
constexpr size_t SHM_K8 = 64 * KP8, SHM_V8 = 128 * VP8;
constexpr float THR8 = 3.72f, PSH8 = 5.f;
constexpr float Q8_PRESCALE = SCALE * 1.4426950408889634f * 8.f;
constexpr int LDQ8 = C_H * HD, LDK8 = 4 * HD;
#define MFMA8(A, B, Cc) __builtin_amdgcn_mfma_scale_f32_32x32x64_f8f6f4(A, B, Cc, 0, 0, 0, 0x7f7f7f7f, 0, 0x7f7f7f7f)
#define MFMA8Q(A, B, Cc) __builtin_amdgcn_mfma_scale_f32_32x32x64_f8f6f4(A, B, Cc, 0, 0, 0, 0x7f7f7f7f, 0, 0x7c7c7c7c)
typedef __attribute__((address_space(3))) const unsigned char* lcp8;
__device__ __forceinline__ i32x8 lds32(lcp8 p) {
  const i32x4 a = *reinterpret_cast<const __attribute__((address_space(3))) i32x4*>(p), b = *reinterpret_cast<const __attribute__((address_space(3))) i32x4*>(p + 16);
  return (i32x8){a[0], a[1], a[2], a[3], b[0], b[1], b[2], b[3]};
}
__device__ __forceinline__ void qkt8(f32x16& p0, f32x16& p1, lcp8 kb, const i32x8* qf, const f32x16& minit) {
  p0 = MFMA8Q(lds32(kb), qf[0], minit); p0 = MFMA8Q(lds32(kb + 64), qf[1], p0);
  p1 = MFMA8Q(lds32(kb + 32 * KP8), qf[0], minit); p1 = MFMA8Q(lds32(kb + 32 * KP8 + 64), qf[1], p1);
}
template <bool FIRST>
__device__ __forceinline__ void psm_fix8(f32x16& p0, f32x16& p1, float pmax, f32x16& minit, float& alpha) {
  alpha = 1.f;
  if (FIRST || !__all(pmax <= PSH8 + THR8)) {
    const float delta = FIRST ? pmax - PSH8 : fmaxf(pmax - PSH8, 0.f);
    if (!FIRST) alpha = __builtin_amdgcn_exp2f(-delta);
#pragma unroll
    for (int r = 0; r < 16; ++r) { p0[r] -= delta; p1[r] -= delta; minit[r] -= delta; }
  }
}
__device__ __forceinline__ void finishSM8(f32x16& p0, f32x16& p1, i32x8& pa) {
#pragma unroll
  for (int r = 0; r < 16; ++r) p1[r] = __builtin_amdgcn_exp2f(p1[r]);
  int und; asm volatile("" : "=v"(und));
#pragma unroll
  for (int w = 0; w < 4; ++w) { int t = __builtin_amdgcn_cvt_pk_fp8_f32(p0[4 * w], p0[4 * w + 1], und, false); pa[w] = __builtin_amdgcn_cvt_pk_fp8_f32(p0[4 * w + 2], p0[4 * w + 3], t, true);
                                int u = __builtin_amdgcn_cvt_pk_fp8_f32(p1[4 * w], p1[4 * w + 1], und, false); pa[4 + w] = __builtin_amdgcn_cvt_pk_fp8_f32(p1[4 * w + 2], p1[4 * w + 3], u, true); }
}
template <int LO> __device__ __forceinline__ void exp4(f32x16& p) {
#pragma unroll
  for (int r = LO; r < LO + 4; ++r) p[r] = __builtin_amdgcn_exp2f(p[r]);
}
template <int W> __device__ __forceinline__ void cvt8(const f32x16& p, int& d0, int& d1, int und) {
  int t = __builtin_amdgcn_cvt_pk_fp8_f32(p[8 * W], p[8 * W + 1], und, false); d0 = __builtin_amdgcn_cvt_pk_fp8_f32(p[8 * W + 2], p[8 * W + 3], t, true);
  int u = __builtin_amdgcn_cvt_pk_fp8_f32(p[8 * W + 4], p[8 * W + 5], und, false); d1 = __builtin_amdgcn_cvt_pk_fp8_f32(p[8 * W + 6], p[8 * W + 7], u, true);
}
__device__ __forceinline__ void qkt_fsm8(f32x16& n0, f32x16& n1, lcp8 kb, const i32x8* qf, const f32x16& minit, const f32x16& p0, f32x16& p1, i32x8& pa) {
  int und; asm volatile("" : "=v"(und));
  int a0, a1, a2, a3, a4, a5, a6, a7;
  const i32x8 k00 = lds32(kb), k10 = lds32(kb + 32 * KP8);
  cvt8<0>(p0, a0, a1, und); exp4<0>(p1); asm volatile("" : "+v"(p1), "+v"(a0), "+v"(a1)); SBAR();
  n0 = MFMA8Q(k00, qf[0], minit); const i32x8 k01 = lds32(kb + 64);
  cvt8<1>(p0, a2, a3, und); exp4<4>(p1); asm volatile("" : "+v"(p1), "+v"(a2), "+v"(a3)); SBAR();
  n1 = MFMA8Q(k10, qf[0], minit); const i32x8 k11 = lds32(kb + 32 * KP8 + 64);
  exp4<8>(p1); cvt8<0>(p1, a4, a5, und); asm volatile("" : "+v"(p1), "+v"(a4), "+v"(a5)); SBAR();
  n0 = MFMA8Q(k01, qf[1], n0);
  exp4<12>(p1); asm volatile("" : "+v"(p1)); SBAR();
  n1 = MFMA8Q(k11, qf[1], n1);
  cvt8<1>(p1, a6, a7, und); asm volatile("" : "+v"(a6), "+v"(a7)); SBAR();
  pa = (i32x8){a0, a1, a2, a3, a4, a5, a6, a7};
}
__device__ __forceinline__ void pv_psm8(f32x16* o, f32x16& ol, const i32x8 ones, lcp8 vb, const i32x8 pa, f32x16& q0, f32x16& q1, f32x16& minit, float& alpha) {
  o[0] = MFMA8(pa, lds32(vb), o[0]); float pmax = psm_max(q0, q1); asm volatile("" : "+v"(pmax));
  o[1] = MFMA8(pa, lds32(vb + 32 * VP8), o[1]); psm_fix8<false>(q0, q1, pmax, minit, alpha); asm volatile("" : "+v"(q0), "+v"(q1));
  o[2] = MFMA8(pa, lds32(vb + 64 * VP8), o[2]); psm_exp8<0>(q0); asm volatile("" : "+v"(q0));
  o[3] = MFMA8(pa, lds32(vb + 96 * VP8), o[3]); psm_exp8<8>(q0); asm volatile("" : "+v"(q0));
  ol = MFMA8(pa, ones, ol);
  SBAR();
}
__device__ __forceinline__ void pv8(f32x16* o, f32x16& ol, const i32x8 ones, lcp8 vb, const i32x8 pa) {
  o[0] = MFMA8(pa, lds32(vb), o[0]); o[1] = MFMA8(pa, lds32(vb + 32 * VP8), o[1]); o[2] = MFMA8(pa, lds32(vb + 64 * VP8), o[2]); o[3] = MFMA8(pa, lds32(vb + 96 * VP8), o[3]); ol = MFMA8(pa, ones, ol);
}
__device__ __forceinline__ void attn_f8_body(const unsigned char* __restrict__ Qb, const unsigned char* __restrict__ Kh, const unsigned char* __restrict__ Vt,
                                             const bf16* __restrict__ Gb, bf16* __restrict__ Ob, int seq, char* lds, const int wid) {
  int lane_l; asm volatile("v_mbcnt_lo_u32_b32 %0, -1, 0\n\tv_mbcnt_hi_u32_b32 %0, -1, %0" : "=v"(lane_l));
  const int lane = lane_l, tid = wid * 64 + lane, r32 = lane & 31, hi = lane >> 5;
  typedef __attribute__((address_space(3))) unsigned char* lp8;
  const lp8 V_lds = (lp8)(uintptr_t)(unsigned)(uintptr_t)lds; const lp8 K_lds = V_lds + 2 * SHM_V8;
  float* al_l = (float*)(lds + 2 * SHM_V8 + 2 * SHM_K8) + wid * 32;
  f32x16 o[4] = {}, ol = {}; i32x8 qf[2], ones; f32x16 minit;
#pragma unroll
  for (int r = 0; r < 8; ++r) ones[r] = 0x38383838;
#pragma unroll
  for (int r = 0; r < 16; ++r) minit[r] = PSH8;
  { const unsigned char* Qw = Qb + (long)(wid * QBLK + r32) * LDQ8 + hi * 32;
#pragma unroll
    for (int s = 0; s < 2; ++s) { const i32x4 a = *reinterpret_cast<const i32x4*>(Qw + 64 * s), b = *reinterpret_cast<const i32x4*>(Qw + 64 * s + 16); qf[s] = (i32x8){a[0], a[1], a[2], a[3], b[0], b[1], b[2], b[3]}; } }
  const int kr = tid >> 3, kc = (tid & 7) * 16, vd = tid >> 2, vc = (tid & 3) * 16;
  const int kst = kr * KP8 + kc, vst = vd * VP8 + vc;
  const lcp8 kb0 = K_lds + r32 * KP8 + hi * 32, vb0 = V_lds + r32 * VP8 + hi * 32;
  struct { i32x4 k, v; } sr_[2];
#define SLOAD8(i, k0) do { sr_[i].k = *reinterpret_cast<const i32x4*>(Kh + (long)((k0) + kr) * LDK8 + kc); sr_[i].v = *reinterpret_cast<const i32x4*>(Vt + (long)(k0) * HD + tid * 16); } while (0)
#define SWRITE8(b, i) do { *reinterpret_cast<__attribute__((address_space(3))) i32x4*>(K_lds + (b) * SHM_K8 + kst) = sr_[i].k; *reinterpret_cast<__attribute__((address_space(3))) i32x4*>(V_lds + (b) * SHM_V8 + vst) = sr_[i].v; } while (0)
#define SWAIT8() asm volatile("s_waitcnt vmcnt(2)" ::: "memory")
#define RESC8(a) do { if (__any((a) < 1.f)) { if (hi == 0) al_l[r32] = (a); asm volatile("s_waitcnt lgkmcnt(0)" ::: "memory"); \
    for (int r = 0; r < 16; ++r) { const float a_ = al_l[crow(r, hi)]; o[0][r] *= a_; o[1][r] *= a_; o[2][r] *= a_; o[3][r] *= a_; ol[r] *= a_; } } } while (0)
  f32x16 pA0, pA1, pB0, pB1; float alA, alB; i32x8 pa; const int NT = seq / KVBLK;
  constexpr int SE = 0, SO = 1;
  SLOAD8(SE, 0); asm volatile("s_waitcnt vmcnt(0)" ::: "memory"); SWRITE8(0, SE); __syncthreads();
  qkt8(pA0, pA1, kb0, qf, minit);
  { const float pmax = psm_max(pA0, pA1); psm_fix8<true>(pA0, pA1, pmax, minit, alA); psm_exp8<0>(pA0); psm_exp8<8>(pA0); }
  SLOAD8(SO, KVBLK); if (2 < NT) SLOAD8(SE, 2 * KVBLK);
  SWAIT8(); SWRITE8(1, SO); __syncthreads();
  for (int j = 1; j + 1 < NT; j += 2) {
    SBAR(); qkt_fsm8(pB0, pB1, kb0 + SHM_K8, qf, minit, pA0, pA1, pa);
    SLOAD8(SO, (j + 2) * KVBLK); SBAR();
    pv_psm8(o, ol, ones, vb0, pa, pB0, pB1, minit, alB);
    __syncthreads(); SWAIT8(); SWRITE8(0, SE);
    RESC8(alB); __syncthreads();
    SBAR(); qkt_fsm8(pA0, pA1, kb0, qf, minit, pB0, pB1, pa);
    SLOAD8(SE, (j + 3 < NT ? j + 3 : NT - 1) * KVBLK); SBAR();
    pv_psm8(o, ol, ones, vb0 + SHM_V8, pa, pA0, pA1, minit, alA);
    __syncthreads(); SWAIT8(); SWRITE8(1, SO);
    RESC8(alA); __syncthreads();
  }
  SBAR(); qkt_fsm8(pB0, pB1, kb0 + SHM_K8, qf, minit, pA0, pA1, pa);
  pv_psm8(o, ol, ones, vb0, pa, pB0, pB1, minit, alB);
  __syncthreads(); RESC8(alB);
  finishSM8(pB0, pB1, pa); SBAR();
  pv8(o, ol, ones, vb0 + SHM_V8, pa);
  float rli[16];
#pragma unroll
  for (int r = 0; r < 16; ++r) rli[r] = __builtin_amdgcn_rcpf(ol[r]);
  __syncthreads();
  epi_stage_store<1>(o, rli, (__attribute__((address_space(3))) unsigned char*)(uintptr_t)(unsigned)(uintptr_t)lds + wid * EPI_BYTES, Gb + (long)(wid * QBLK) * LDQ, Ob + (long)(wid * QBLK) * LDO, lane);
  __syncthreads();
#undef SLOAD8
#undef SWRITE8
#undef SWAIT8
#undef RESC8
}
#ifdef QK_FP4
constexpr int PP_KIMG = 4096, PP_TIMG = PP_KIMG + 8192, PP_KR = 0, PP_VR = 3 * PP_KIMG, PP_AL = PP_VR + 3 * 8192;
constexpr int LDQ4 = C_H * 64;
constexpr float Q4_PRESCALE = SCALE * 1.4426950408889634f * 16.f / 1.5f, K4_PRESCALE = 1.5f;
#define MFMA4Q(A, B, Cc) __builtin_amdgcn_mfma_scale_f32_32x32x64_f8f6f4(A, B, Cc, 4, 4, 0, 0x7f7f7f7f, 0, 0x7b7b7b7b)
__device__ __forceinline__ i32x8 lds1(int a0, int off) {
  const i32x4 a = *(const __attribute__((address_space(3))) i32x4*)(uintptr_t)(unsigned)(a0 + off);
  return (i32x8){a[0], a[1], a[2], a[3], 0, 0, 0, 0};
}
#else
constexpr int PP_KIMG = 8192, PP_TIMG = 16384, PP_KR = 0, PP_VR = 3 * 8192, PP_AL = 6 * 8192;
#endif
typedef __attribute__((address_space(3))) const i32x4* lq4;
__device__ __forceinline__ i32x8 lds2(int a0, int a1, int off) {
  const i32x4 a = *(lq4)(uintptr_t)(unsigned)(a0 + off), b = *(lq4)(uintptr_t)(unsigned)(a1 + off);
  return (i32x8){a[0], a[1], a[2], a[3], b[0], b[1], b[2], b[3]};
}
#ifndef PP_PADN
#define PP_PADN 7
#endif
#define PP_STR2(x) #x
#define PP_STR(x) PP_STR2(x)
#define PP_PAD() do { SBAR(); asm volatile("s_nop " PP_STR(PP_PADN)); SBAR(); } while (0)
#ifndef PP_PADQN
#define PP_PADQN 7
#endif
#define PP_PADQ() do { SBAR(); asm volatile("s_nop " PP_STR(PP_PADQN)); SBAR(); } while (0)
template <bool QK, bool PV>
__device__ __forceinline__ void pp_mseg(f32x16* o, f32x16& ol, f32x16& n0, f32x16& n1, const i32x8 pa, const i32x8 ones, const i32x8* qf, const f32x16& minit, const i32x8 vf0, const i32x8 vf1,
                                        const int k0, const int k1, const int k2, const int k3, const int v0, const int v1) {
  i32x8 k00, k10, k01, k11, vf2, vf3;
#ifdef QK_FP4
  if (QK) { k00 = lds1(k0, 0); k10 = lds1(k0, 2048); }
#else
  if (QK) { k00 = lds2(k0, k1, 0); k10 = lds2(k0, k1, 4096); }
#endif
  if (PV) { o[0] = MFMA8(pa, vf0, o[0]); vf2 = lds2(v0, v1, 4096); PP_PAD(); }
#ifdef QK_FP4
  if (QK) { k01 = lds1(k1, 0); }
#else
  if (QK) { k01 = lds2(k2, k3, 0); }
#endif
  if (PV) { o[1] = MFMA8(pa, vf1, o[1]); vf3 = lds2(v0, v1, 6144); PP_PAD(); }
#ifdef QK_FP4
  if (QK) { k11 = lds1(k1, 2048);
            n0 = MFMA4Q(k00, qf[0], minit); PP_PADQ(); n1 = MFMA4Q(k10, qf[0], minit); PP_PADQ(); n0 = MFMA4Q(k01, qf[1], n0); PP_PADQ(); n1 = MFMA4Q(k11, qf[1], n1); PP_PADQ(); }
#else
  if (QK) { k11 = lds2(k2, k3, 4096);
            n0 = MFMA8Q(k00, qf[0], minit); PP_PAD(); n1 = MFMA8Q(k10, qf[0], minit); PP_PAD(); n0 = MFMA8Q(k01, qf[1], n0); PP_PAD(); n1 = MFMA8Q(k11, qf[1], n1); PP_PAD(); }
#endif
  if (PV) { o[2] = MFMA8(pa, vf2, o[2]); PP_PAD(); o[3] = MFMA8(pa, vf3, o[3]); PP_PAD(); ol = MFMA8(pa, ones, ol); }
}
template <bool FIRST>
__device__ __forceinline__ void pp_vseg(f32x16* o, f32x16& ol, f32x16& n0, f32x16& n1, f32x16& minit, i32x8& pa, float* al_l, const int r32, const int hi) {
  asm volatile("" : "+v"(n0), "+v"(n1));
  const float pmax = psm_max(n0, n1);
  if (FIRST || !__all(pmax <= PSH8 + THR8)) {
    const float delta = FIRST ? pmax - PSH8 : fmaxf(pmax - PSH8, 0.f);
#pragma unroll
    for (int r = 0; r < 16; ++r) { n0[r] -= delta; n1[r] -= delta; minit[r] -= delta; }
    if (!FIRST) {
      const float alpha = __builtin_amdgcn_exp2f(-delta);
      if (hi == 0) al_l[r32] = alpha;
      asm volatile("s_waitcnt lgkmcnt(0)" ::: "memory");
#pragma unroll
      for (int r = 0; r < 16; ++r) { const float a_ = al_l[crow(r, hi)]; o[0][r] *= a_; o[1][r] *= a_; o[2][r] *= a_; o[3][r] *= a_; ol[r] *= a_; }
    }
  }
#pragma unroll
  for (int r = 0; r < 16; ++r) n0[r] = __builtin_amdgcn_exp2f(n0[r]);
#pragma unroll
  for (int r = 0; r < 16; ++r) n1[r] = __builtin_amdgcn_exp2f(n1[r]);
#pragma unroll
  for (int w = 0; w < 4; ++w) { int t0_, t1_; asm volatile("" : "=v"(t0_), "=v"(t1_));
    t0_ = __builtin_amdgcn_cvt_pk_fp8_f32(n0[4 * w], n0[4 * w + 1], t0_, false); pa[w] = __builtin_amdgcn_cvt_pk_fp8_f32(n0[4 * w + 2], n0[4 * w + 3], t0_, true);
    t1_ = __builtin_amdgcn_cvt_pk_fp8_f32(n1[4 * w], n1[4 * w + 1], t1_, false); pa[4 + w] = __builtin_amdgcn_cvt_pk_fp8_f32(n1[4 * w + 2], n1[4 * w + 3], t1_, true); }
  asm volatile("" : "+v"(pa));
}
__device__ __forceinline__ void attn_f8pp_body(const unsigned char* __restrict__ Qb, const unsigned char* __restrict__ KV, const bf16* __restrict__ Gb, bf16* __restrict__ Ob, int seq, char* lds, const int wid) {
  int lane_l; asm volatile("v_mbcnt_lo_u32_b32 %0, -1, 0\n\tv_mbcnt_hi_u32_b32 %0, -1, %0" : "=v"(lane_l));
  const int lane = lane_l, r32 = lane & 31, hi = lane >> 5;
  const int ldsb = (int)(unsigned)(uintptr_t)lds;
  float* al_l = (float*)(lds + PP_AL) + wid * 32;
  int grp, w4;
  { int* sid = (int*)(lds + PP_AL + 1024);
    const int mine = (int)__builtin_amdgcn_s_getreg(2308);
    if (lane == 0) sid[wid] = mine;
    __syncthreads();
    int g[8], n0c = 0;
#pragma unroll
    for (int u = 0; u < 8; ++u) { const int su = __builtin_amdgcn_readfirstlane(sid[u]); int c = 0;
#pragma unroll
      for (int t = 0; t < 8; ++t) if (t < u) c += (__builtin_amdgcn_readfirstlane(sid[t]) == su) ? 1 : 0;
      g[u] = c; n0c += (c == 0) ? 1 : 0; }
    bool ok = (n0c == 4);
#pragma unroll
    for (int u = 0; u < 8; ++u) ok = ok && (g[u] <= 1);
    int gm = 0, rk = 0;
#pragma unroll
    for (int u = 0; u < 8; ++u) { if (u == wid) gm = g[u]; }
#pragma unroll
    for (int u = 0; u < 8; ++u) { if (u < wid && g[u] == gm) ++rk; }
    grp = ok ? gm : (wid >> 2); w4 = ok ? rk : (wid & 3);
    grp = __builtin_amdgcn_readfirstlane(grp); w4 = __builtin_amdgcn_readfirstlane(w4);
    __syncthreads(); }
  f32x16 o[4] = {}, ol = {}, minit, n0, n1; i32x8 qf[2], ones, pa, vf0, vf1;
#pragma unroll
  for (int r = 0; r < 16; ++r) minit[r] = PSH8;
  { int one4 = 0x38383838; asm volatile("" : "+v"(one4));
#pragma unroll
    for (int r = 0; r < 8; ++r) ones[r] = one4; }
#pragma unroll
  for (int r = 0; r < 8; ++r) { pa[r] = 0; vf0[r] = 0; vf1[r] = 0; }
  asm volatile("" : "+v"(ones));
#ifdef QK_FP4
  const int vg = (r32 >> 2) & 3, ka = r32 * 64 + ((hi ^ vg) << 4), ka1 = ka ^ 32, ka2 = 0, ka3 = 0, va = r32 * 64 + (((2 * hi) ^ vg) << 4), va1 = va ^ 16;
#else
  const int kf = (r32 >> 1) & 7, ka = r32 * 128 + (((2 * hi) ^ kf) << 4), vg = (r32 >> 2) & 3, va = r32 * 64 + (((2 * hi) ^ vg) << 4);
  const int ka1 = ka ^ 16, ka2 = ka ^ 64, ka3 = ka ^ 80, va1 = va ^ 16;
#endif
  const int kbase = ldsb + PP_KR, vbase = ldsb + PP_VR;
#ifdef QK_FP4
  const unsigned char* gsrc = KV + (grp ? PP_KIMG + 2 * w4 * 1024 : w4 * 1024) + lane * 16;
  const int ldst = ldsb + (grp ? PP_VR + 2 * w4 * 1024 : PP_KR + w4 * 1024);
#define PP_DMA(tile, slot) do { const unsigned char* g_ = gsrc + (long)(tile) * PP_TIMG; const int d_ = ldst + (slot) * (grp ? 8192 : PP_KIMG); \
    __builtin_amdgcn_global_load_lds((const unsigned*)g_, (__attribute__((address_space(3))) unsigned*)(uintptr_t)(unsigned)d_, 16, 0, 0); \
    if (grp) __builtin_amdgcn_global_load_lds((const unsigned*)(g_ + 1024), (__attribute__((address_space(3))) unsigned*)(uintptr_t)(unsigned)(d_ + 1024), 16, 0, 0); } while (0)
#else
  const unsigned char* gsrc = KV + (grp * 8 + 2 * w4) * 1024 + lane * 16;
  const int ldst = ldsb + (grp ? PP_VR : PP_KR) + 2 * w4 * 1024;
#define PP_DMA(tile, slot) do { const unsigned char* g_ = gsrc + (long)(tile) * PP_TIMG; const int d_ = ldst + (slot) * 8192; \
    __builtin_amdgcn_global_load_lds((const unsigned*)g_, (__attribute__((address_space(3))) unsigned*)(uintptr_t)(unsigned)d_, 16, 0, 0); \
    __builtin_amdgcn_global_load_lds((const unsigned*)(g_ + 1024), (__attribute__((address_space(3))) unsigned*)(uintptr_t)(unsigned)(d_ + 1024), 16, 0, 0); } while (0)
#endif
#define PP_BAR() do { SBAR(); __builtin_amdgcn_s_barrier(); SBAR(); } while (0)
#define PP_KOFF(s_) ((s_) / (8192 / PP_KIMG))
  const int NT = seq / KVBLK;
  PP_DMA(0, 0); PP_DMA(1, 1);
#ifdef QK_FP4
  { const unsigned char* Qw = Qb + (long)(wid * QBLK + r32) * LDQ4 + hi * 16;
#pragma unroll
    for (int s = 0; s < 2; ++s) { const i32x4 a = *reinterpret_cast<const i32x4*>(Qw + 32 * s); qf[s] = (i32x8){a[0], a[1], a[2], a[3], 0, 0, 0, 0}; } }
#else
  { const unsigned char* Qw = Qb + (long)(wid * QBLK + r32) * LDQ8 + hi * 32;
#pragma unroll
    for (int s = 0; s < 2; ++s) { const i32x4 a = *reinterpret_cast<const i32x4*>(Qw + 64 * s), b = *reinterpret_cast<const i32x4*>(Qw + 64 * s + 16); qf[s] = (i32x8){a[0], a[1], a[2], a[3], b[0], b[1], b[2], b[3]}; } }
#endif
  asm volatile("s_waitcnt vmcnt(0)" ::: "memory");
  __syncthreads();
  if (grp == 1) PP_BAR();
  int sa = 0, sb = 8192, sc = 16384;
  { const int kb_ = kbase + PP_KOFF(sa); pp_mseg<true, false>(o, ol, n0, n1, pa, ones, qf, minit, vf0, vf1, kb_ + ka, kb_ + ka1, kb_ + ka2, kb_ + ka3, 0, 0); }
  asm volatile("" : "+v"(n0), "+v"(n1)); PP_BAR();
  asm volatile("s_waitcnt vmcnt(0)" ::: "memory"); PP_DMA(2, 2);
  pp_vseg<true>(o, ol, n0, n1, minit, pa, al_l, r32, hi);
  { const int vb_ = vbase + sa; vf0 = lds2(vb_ + va, vb_ + va1, 0); vf1 = lds2(vb_ + va, vb_ + va1, 2048); }
  PP_BAR();
  { const int t = sa; sa = sb; sb = sc; sc = t; }
  for (int j = 1; j < NT; ++j) {
    { const int kb_ = kbase + PP_KOFF(sa), vb_ = vbase + sc;
      pp_mseg<true, true>(o, ol, n0, n1, pa, ones, qf, minit, vf0, vf1, kb_ + ka, kb_ + ka1, kb_ + ka2, kb_ + ka3, vb_ + va, vb_ + va1); }
    asm volatile("" : "+v"(n0), "+v"(n1), "+v"(o[0]), "+v"(o[1]), "+v"(o[2]), "+v"(o[3]), "+v"(ol)); PP_BAR();
    asm volatile("s_waitcnt vmcnt(0)" ::: "memory");
    { const int tl = (j + 2 < NT) ? j + 2 : NT - 1; PP_DMA(tl, sc >> 13); }
    pp_vseg<false>(o, ol, n0, n1, minit, pa, al_l, r32, hi);
    { const int vb_ = vbase + sa; vf0 = lds2(vb_ + va, vb_ + va1, 0); vf1 = lds2(vb_ + va, vb_ + va1, 2048); }
    PP_BAR();
    { const int t = sa; sa = sb; sb = sc; sc = t; }
  }
  { const int vb_ = vbase + sc; pp_mseg<false, true>(o, ol, n0, n1, pa, ones, qf, minit, vf0, vf1, 0, 0, 0, 0, vb_ + va, vb_ + va1); }
  if (grp == 0) PP_BAR();
  asm volatile("s_waitcnt vmcnt(0)" ::: "memory");
  float rli[16];
#pragma unroll
  for (int r = 0; r < 16; ++r) rli[r] = __builtin_amdgcn_rcpf(ol[r]);
  __syncthreads();
  epi_stage_store<1>(o, rli, (__attribute__((address_space(3))) unsigned char*)(uintptr_t)(unsigned)(uintptr_t)lds + wid * EPI_BYTES, Gb + (long)(wid * QBLK) * LDQ, Ob + (long)(wid * QBLK) * LDO, lane);
  __syncthreads();
#undef PP_DMA
#undef PP_BAR
#undef PP_KOFF
}
#undef MFMA8
#undef MFMA8Q

#undef KSWZ
#undef SBAR
}

__device__ __forceinline__ float bflo(unsigned w) { return __uint_as_float(w << 16); }
__device__ __forceinline__ float bfhi(unsigned w) { return __uint_as_float(w & 0xffff0000u); }
__device__ __forceinline__ float silu_f(float x) { return x / (1.f + __expf(-x)); }
__device__ __forceinline__ float wave_max(float v) {
#pragma unroll
    for (int o = 1; o < 64; o <<= 1) v = fmaxf(v, __shfl_xor(v, o));
    return v;
}
__device__ __forceinline__ int t5_bucket(int rel) {
    const int n = rel < 0 ? -rel : rel; const float nf = (float)(n > 1 ? n : 1);
    int large = 8 + (int)(logf(nf * 0.125f) / 4.852030263919617f * 8.0f); large = large < 15 ? large : 15;
    return (rel > 0 ? 16 : 0) + (n < 8 ? n : large);
}

struct Args { const float* in[12]; float* out; unsigned char* ws; };

__device__ __forceinline__ void p0_prologue(const Args& a, LAS unsigned char* lds, int wave, int vcu, int G) {
    const int lane = fresh_lane(), tid = wave * 64 + lane;
    const float* c = a.in[1]; const float* w_mod = a.in[2]; const float* w_in = a.in[6]; const float* w_out = a.in[7]; const float* rel_bias = a.in[11];
    float* modp = (float*)(a.ws + WS_MODP);
    float* tab = (float*)(a.ws + WS_TAB);
    bf16* Win_t = (bf16*)(a.ws + WS_WIN); bf16* Wout_t = (bf16*)(a.ws + WS_WOUT);
    const int gt = vcu * (NWAVES * 64) + tid, NGT = G * NWAVES * 64;
    for (int e = gt; e < A_H * 3 * LUTA_N; e += NGT) { const int idx = e % LUTA_N, hp = e / LUTA_N, p = hp % 3, h = hp / 3, kk = idx - 92;
        float v = -1e30f; if (kk >= -64 && kk <= 64) v = rel_bias[t5_bucket(kk * (1 << (2 * p))) * (A_H + B_H) + h] * LOG2E;
        tab[TB_LUTA + e] = v; }
    for (int e = gt; e < B_H * LUTB_N; e += NGT) { const int idx = e % LUTB_N, h = e / LUTB_N, kk = idx - 156;
        float v = -1e30f; if (kk >= -128 && kk <= 128) v = rel_bias[t5_bucket(kk) * (A_H + B_H) + A_H + h] * LOG2E;
        tab[TB_LUTB + e] = v; }
    for (int e = gt; e < (256 + 64) * 32; e += NGT) { const int j = e & 31, pp = e >> 5, pos = pp < 256 ? pp : pp - 256;
        const float freq = exp2f(-(float)j * 0.4152410118609203f);
        const float ang = (float)pos * freq;
        double rev = (double)ang * 0.15915494309189535; rev -= floor(rev);
        const float cs_ = __builtin_amdgcn_cosf((float)rev), sn_ = __builtin_amdgcn_sinf((float)rev);
        float* d = tab + (pp < 256 ? TB_ROPE_R : TB_ROPE_C) + (pos * 32 + j) * 2; d[0] = cs_; d[1] = sn_; }
    LAS float* cs = (LAS float*)lds;
    LAS float* red = (LAS float*)(lds + 16384);
    for (int k = tid; k < DM; k += NWAVES * 64) cs[k] = silu_f(c[k]);
    __syncthreads();
#ifndef REP_GEMV
#define REP_GEMV 1
#endif
    for (int rep = 0; rep < REP_GEMV; ++rep)
    for (int it = vcu; it < DEPTH * 48 * 4; it += G) {
        const int kq = it & 3, nc = (it >> 2) % 48, ly = it / 192, k0 = kq * 1024 + wave * 128;
        const float* W = w_mod + (size_t)ly * DM * NMOD + (size_t)k0 * NMOD + nc * 256 + lane * 4;
        f32x4 acc = (f32x4){0.f, 0.f, 0.f, 0.f};
#pragma unroll 8
        for (int k = 0; k < 128; ++k) { const f32x4 w = *(const GAS f32x4*)(W + (size_t)k * NMOD); acc += w * cs[k0 + k]; }
        *(LAS f32x4*)(red + wave * 256 + lane * 4) = acc;
        __syncthreads();
        if (tid < 256) { float s = 0.f;
#pragma unroll
            for (int w = 0; w < NWAVES; ++w) s += red[w * 256 + tid];
            modp[(size_t)kq * DEPTH * NMOD + ly * NMOD + nc * 256 + tid] = s; }
        __syncthreads();
    }
    LAS float* scr = (LAS float*)(lds + wave * 16384);
    const int gw = vcu * NWAVES + wave, NGW = G * NWAVES;
    constexpr int I_IN = (DM / 64) * (INW / 32), I_OUT = (DM / 64) * (DM / 32), I_L = I_IN + I_OUT;
#ifndef REP_TR
#define REP_TR 1
#endif
    gu32* ctlw = (gu32*)(a.ws + WS_CTL);
    float amx = 0.f; int aly = -1;
#define AMX_FLUSH() do { if (aly >= 0) { float m_ = amx; for (int o_ = 1; o_ < 64; o_ <<= 1) m_ = fmaxf(m_, __shfl_xor(m_, o_)); \
        if (lane == 0) (void)__hip_atomic_fetch_max((unsigned*)(ctlw + CW_AMAX + 64 * aly), __builtin_bit_cast(unsigned, m_), RLX_AGENT); } } while (0)
    for (int rep = 0; rep < REP_TR; ++rep)
    for (int it = gw; it < DEPTH * I_L; it += NGW) {
        const int ly = it / I_L, r = it - ly * I_L;
        if (ly != aly) { AMX_FLUSH(); amx = 0.f; aly = ly; }
        if (r < I_IN) { const int n0 = 32 * (r % (INW / 32));
                        const int off = proj_col_of(n0) - n0;
                        if (proj_col_of(n0) >= F8_COL0) p0_transpose_item<true>(w_in + (size_t)ly * DM * INW, DM, INW, Win_t + (size_t)ly * INW * DM, off, scr, r, lane, amx);
                        else p0_transpose_item<false>(w_in + (size_t)ly * DM * INW, DM, INW, Win_t + (size_t)ly * INW * DM, off, scr, r, lane, amx); }
        else p0_transpose_item<false>(w_out + (size_t)ly * DM * DM, DM, DM, Wout_t + (size_t)ly * DM * DM, 0, scr, r - I_IN, lane, amx);
    }
    AMX_FLUSH();
#undef AMX_FLUSH
}

__device__ __forceinline__ int w8_exp(const Args& a, int layer) {
    const unsigned b = __hip_atomic_load((unsigned*)((gu32*)(a.ws + WS_CTL) + CW_AMAX + 64 * layer), RLX_AGENT);
    int e = 7 - ((int)(b >> 23) - 127); e = e > 60 ? 60 : (e < -60 ? -60 : e);
    return __builtin_amdgcn_readfirstlane(e);
}
__device__ __forceinline__ void w8_phase(const Args& a, int wave, int vcu, int G) {
    const int lane = fresh_lane();
    const bf16* Win_t = (const bf16*)(a.ws + WS_WIN); unsigned char* W8 = (unsigned char*)(a.ws + WS_W8);
    const int gw = vcu * NWAVES + wave, NGW = G * NWAVES;
    for (int row = gw; row < DEPTH * F8_COLS; row += NGW) {
        const int ly = row / F8_COLS, n = row % F8_COLS;
        const float sc = __builtin_bit_cast(float, (unsigned)(w8_exp(a, ly) + 127) << 23);
        const bf16* src = Win_t + ((size_t)ly * INW + F8_COL0 + n) * DM + lane * 8; unsigned char* dst = W8 + ((size_t)ly * F8_COLS + n) * DM + lane * 8;
        pg8::u32x4 r_[8];
#pragma unroll
        for (int j = 0; j < 8; ++j) r_[j] = *(const pg8::u32x4*)(src + j * 512);
#pragma unroll
        for (int j = 0; j < 8; ++j) {
            int lo = __builtin_amdgcn_cvt_pk_fp8_f32(bflo(r_[j].x) * sc, bfhi(r_[j].x) * sc, 0, false); lo = __builtin_amdgcn_cvt_pk_fp8_f32(bflo(r_[j].y) * sc, bfhi(r_[j].y) * sc, lo, true);
            int hi = __builtin_amdgcn_cvt_pk_fp8_f32(bflo(r_[j].z) * sc, bfhi(r_[j].z) * sc, 0, false); hi = __builtin_amdgcn_cvt_pk_fp8_f32(bflo(r_[j].w) * sc, bfhi(r_[j].w) * sc, hi, true);
            u32x2 w; w.x = (unsigned)lo; w.y = (unsigned)hi; *(u32x2*)(dst + j * 512) = w; }
    }
}

__device__ __forceinline__ void norm_phase(const Args& a, LAS unsigned char* lds, int layer_post, int layer_pre, const float* xin, int wave, int vcu, int G, bool dummy = false) {
    const int lane = fresh_lane(), tid = wave * 64 + lane;
    LAS float* Gv = (LAS float*)lds; LAS float* Av = Gv + DM; LAS float* Bv = Av + DM;
    const float* modp = (const float*)(a.ws + WS_MODP);
#define MOD4(i) (((*(const f32x4*)(modp + (i)) + *(const f32x4*)(modp + DEPTH * NMOD + (i))) + *(const f32x4*)(modp + 2 * DEPTH * NMOD + (i))) + *(const f32x4*)(modp + 3 * DEPTH * NMOD + (i)))
    const float* b_mod = a.in[3]; const float* pre_g = a.in[4]; const float* post_g = a.in[5];
#pragma unroll
    for (int hf = 0; hf < 2; ++hf) { const int j = tid * 8 + 4 * hf;
        if (layer_post >= 0) *(LAS f32x4*)(Gv + j) = (MOD4(layer_post * NMOD + 2 * DM + j) + *(const f32x4*)(b_mod + layer_post * NMOD + 2 * DM + j)) * *(const f32x4*)(post_g + layer_post * DM + j);
        if (layer_pre >= 0) { *(LAS f32x4*)(Av + j) = *(const f32x4*)(pre_g + layer_pre * DM + j) * (1.f + MOD4(layer_pre * NMOD + DM + j) + *(const f32x4*)(b_mod + layer_pre * NMOD + DM + j));
                              *(LAS f32x4*)(Bv + j) = MOD4(layer_pre * NMOD + j) + *(const f32x4*)(b_mod + layer_pre * NMOD + j); } }
#undef MOD4
    __syncthreads();
    const bf16* Y = (const bf16*)(a.ws + WS_Y); bf16* H = (bf16*)(a.ws + (dummy ? WS_END + 256 * MiB : WS_H)); float* xout = dummy ? (float*)(a.ws + WS_END) : a.out;
    const int gw = vcu * NWAVES + wave, NGW = G * NWAVES;
    for (int row = gw; row < S; row += NGW) {
        const GAS f32x4* xr = (const GAS f32x4*)(xin + (size_t)row * DM) + lane;
        f32x4 v[16];
#pragma unroll
        for (int j = 0; j < 16; ++j) v[j] = xr[64 * j];
        if (layer_post >= 0) {
            const GAS u32x2* yr = (const GAS u32x2*)(Y + (size_t)row * DM) + lane;
            u32x2 yv[16]; float ss = 0.f;
#pragma unroll
            for (int j = 0; j < 16; ++j) { yv[j] = yr[64 * j]; const float y0 = bflo(yv[j].x), y1 = bfhi(yv[j].x), y2 = bflo(yv[j].y), y3 = bfhi(yv[j].y); ss += (y0 * y0 + y1 * y1) + (y2 * y2 + y3 * y3); }
            const float ry = rsqrtf(wave_sum_l(ss, lane) * (1.f / DM) + EPS);
            GAS f32x4* xo = (GAS f32x4*)(xout + (size_t)row * DM) + lane;
#pragma unroll
            for (int j = 0; j < 16; ++j) { const f32x4 g = *(const LAS f32x4*)(Gv + j * 256 + lane * 4);
                const f32x4 yf = (f32x4){bflo(yv[j].x), bfhi(yv[j].x), bflo(yv[j].y), bfhi(yv[j].y)};
                v[j] = v[j] + g * yf * ry; xo[64 * j] = v[j]; }
        }
        if (layer_pre >= 0) {
            float ss = 0.f;
#pragma unroll
            for (int j = 0; j < 16; ++j) ss += (v[j].x * v[j].x + v[j].y * v[j].y) + (v[j].z * v[j].z + v[j].w * v[j].w);
            const float rx = rsqrtf(wave_sum_l(ss, lane) * (1.f / DM) + EPS);
            GAS u32x2* ho = (GAS u32x2*)(H + (size_t)row * DM) + lane;
            GAS int* h8o = (GAS int*)((unsigned char*)(a.ws + (dummy ? WS_END + 320 * MiB : WS_H8)) + (size_t)row * DM) + lane;
#pragma unroll
            for (int j = 0; j < 16; ++j) { const f32x4 av = *(const LAS f32x4*)(Av + j * 256 + lane * 4), bv = *(const LAS f32x4*)(Bv + j * 256 + lane * 4);
                const f32x4 hv = v[j] * rx * av + bv; u32x2 w; w.x = pg8::cvt_pk_bf16(hv.x, hv.y); w.y = pg8::cvt_pk_bf16(hv.z, hv.w); ho[64 * j] = w;
                int w8_ = __builtin_amdgcn_cvt_pk_fp8_f32(hv.x, hv.y, 0, false); w8_ = __builtin_amdgcn_cvt_pk_fp8_f32(hv.z, hv.w, w8_, true); h8o[64 * j] = w8_; }
        }
    }
    __syncthreads();
}

__device__ __forceinline__ void prep_phase(const Args& a, LAS unsigned char* lds, int layer, int wave, int vcu, int G) {
    const int lane = fresh_lane();
    bf16* proj = (bf16*)(a.ws + WS_PROJ); const float* tab = (const float*)(a.ws + WS_TAB);
    const float* qg = a.in[8] + layer * HD; const float* kg = a.in[9] + layer * HD;
    const int l16 = lane & 15, half = l16 >> 3, jj = (l16 & 7) * 4, grp = lane >> 4;
    const f32x4 gq1 = *(const f32x4*)(qg + half * 64 + jj), gq2 = *(const f32x4*)(qg + half * 64 + 32 + jj);
    const f32x4 gk1 = *(const f32x4*)(kg + half * 64 + jj), gk2 = *(const f32x4*)(kg + half * 64 + 32 + jj);
    const int gw = vcu * NWAVES + wave, NGW = G * NWAVES;
    for (int t = gw; t < S; t += NGW) {
        const int pos = half ? (t & 63) : (t >> 6);
        const float* rt = tab + (half ? TB_ROPE_C : TB_ROPE_R) + (pos * 32 + jj) * 2;
        const f32x4 cs0 = *(const f32x4*)rt, cs1 = *(const f32x4*)(rt + 4);
        const f32x4 cv = (f32x4){cs0.x, cs0.z, cs1.x, cs1.z}, sv = (f32x4){cs0.y, cs0.w, cs1.y, cs1.w};
#pragma unroll
        for (int it = 0; it < 4; ++it) {
            const int hh = it * 4 + grp;
            bf16* p = proj + (size_t)t * INW + COL_CQ + hh * HD + half * 64 + jj;
            const u32x2 r1 = *(const u32x2*)p, r2 = *(const u32x2*)(p + 32);
            const f32x4 x1 = (f32x4){bflo(r1.x), bfhi(r1.x), bflo(r1.y), bfhi(r1.y)}, x2 = (f32x4){bflo(r2.x), bfhi(r2.x), bflo(r2.y), bfhi(r2.y)};
            float ss = (x1.x * x1.x + x1.y * x1.y) + (x1.z * x1.z + x1.w * x1.w) + (x2.x * x2.x + x2.y * x2.y) + (x2.z * x2.z + x2.w * x2.w);
            ss += lane_xor(ss, 1, lane); ss += lane_xor(ss, 2, lane); ss += lane_xor(ss, 4, lane); ss += lane_xor(ss, 8, lane);
            const float r = rsqrtf(ss * (1.f / HD) + EPS);
            const f32x4 g1 = (it == 3) ? gk1 : gq1, g2 = (it == 3) ? gk2 : gq2;
            const f32x4 y1 = x1 * r * g1, y2 = x2 * r * g2;
            const f32x4 o1_ = y1 * cv - y2 * sv, o2_ = y2 * cv + y1 * sv;
#ifndef ATT_F8
            const f32x4 o1 = o1_, o2 = o2_;
#endif
#ifdef ATT_F8
#if defined(ATT_PP) && defined(QK_FP4)
            { unsigned char* d8; int d8b;
              if (it == 3) { unsigned char* rb = (unsigned char*)(a.ws + WS_KF8) + ((size_t)((hh - 12) * (S / 64) + (t >> 6))) * attc::PP_TIMG + (t & 63) * 64 + (jj >> 1);
                             const int c1 = half * 2, kg = ((t & 63) >> 2) & 3; d8 = rb + ((c1 ^ kg) << 4); d8b = (((c1 + 1) ^ kg) << 4) - ((c1 ^ kg) << 4); }
              else { d8 = (unsigned char*)(a.ws + WS_QF8) + (size_t)t * attc::LDQ4 + hh * 64 + half * 32 + (jj >> 1); d8b = 16; }
              const float qs = (it == 3) ? attc::K4_PRESCALE : attc::Q4_PRESCALE; const f32x4 o1 = o1_ * qs, o2 = o2_ * qs;
              const unsigned a0 = __builtin_amdgcn_cvt_scalef32_pk_fp4_f32(0u, o1.x, o1.y, 1.f, 0) & 0xffu, a1 = __builtin_amdgcn_cvt_scalef32_pk_fp4_f32(0u, o1.z, o1.w, 1.f, 0) & 0xffu;
              const unsigned b0 = __builtin_amdgcn_cvt_scalef32_pk_fp4_f32(0u, o2.x, o2.y, 1.f, 0) & 0xffu, b1 = __builtin_amdgcn_cvt_scalef32_pk_fp4_f32(0u, o2.z, o2.w, 1.f, 0) & 0xffu;
              *(unsigned short*)d8 = (unsigned short)(a0 | (a1 << 8)); *(unsigned short*)(d8 + d8b) = (unsigned short)(b0 | (b1 << 8)); }
#elif defined(ATT_PP)
            unsigned char* d8; int d8b;
            if (it == 3) { unsigned char* rb = (unsigned char*)(a.ws + WS_KF8) + ((size_t)((hh - 12) * (S / 64) + (t >> 6))) * attc::PP_TIMG + (t & 63) * 128 + (jj & 15);
                           const int c1 = half * 4 + (jj >> 4), kf = ((t & 63) >> 1) & 7; d8 = rb + ((c1 ^ kf) << 4); d8b = (((c1 + 2) ^ kf) << 4) - ((c1 ^ kf) << 4); }
            else { d8 = (unsigned char*)(a.ws + WS_QF8) + (size_t)t * (C_H * HD) + hh * HD + half * 64 + jj; d8b = 32; }
            {
#else
            { const int d8b = 32;
              unsigned char* d8 = (it == 3) ? (unsigned char*)(a.ws + WS_KF8) + (size_t)t * 512 + (hh - 12) * HD + half * 64 + jj
                                            : (unsigned char*)(a.ws + WS_QF8) + (size_t)t * (C_H * HD) + hh * HD + half * 64 + jj;
#endif
#if !(defined(ATT_PP) && defined(QK_FP4))
              const float qs = (it == 3) ? 1.f : attc::Q8_PRESCALE; const f32x4 o1 = o1_ * qs, o2 = o2_ * qs;
              int t1 = __builtin_amdgcn_cvt_pk_fp8_f32(o1.x, o1.y, 0, false); t1 = __builtin_amdgcn_cvt_pk_fp8_f32(o1.z, o1.w, t1, true);
              int t2 = __builtin_amdgcn_cvt_pk_fp8_f32(o2.x, o2.y, 0, false); t2 = __builtin_amdgcn_cvt_pk_fp8_f32(o2.z, o2.w, t2, true);
              *(int*)d8 = t1; *(int*)(d8 + d8b) = t2; }
#endif
#else
            u32x2 w1, w2; w1.x = pg8::cvt_pk_bf16(o1.x, o1.y); w1.y = pg8::cvt_pk_bf16(o1.z, o1.w); w2.x = pg8::cvt_pk_bf16(o2.x, o2.y); w2.y = pg8::cvt_pk_bf16(o2.z, o2.w);
            *(u32x2*)p = w1; *(u32x2*)(p + 32) = w2;
#endif
        }
    }
#ifdef ATT_F8
    { typedef attc::bf16x8 bx8; typedef attc::s16x4 sx4;
      unsigned char* VT8 = (unsigned char*)(a.ws + WS_VTF8);
      LAS unsigned char* img = lds + wave * 8192;
      const int lane2 = fresh_lane(), r32 = lane2 & 31, hi = lane2 >> 5, vrow = lane2 >> 4, vch = lane2 & 15;
      LAS unsigned char* vwr = img + (vch >> 2) * 512 + vrow * 64 + (vch & 3) * 16;
      const int vb = (int)(uintptr_t)img + attc::v_rd_base(lane2);
      for (int itv = gw; itv < 4 * (S / 32); itv += NGW) {
        const int kv = itv / (S / 32), t0 = (itv % (S / 32)) * 32;
        bx8 vs[8];
#pragma unroll
        for (int i = 0; i < 8; ++i) vs[i] = *reinterpret_cast<const bx8*>(proj + (size_t)(t0 + vrow + 4 * i) * INW + COL_CV + kv * HD + vch * 8);
#pragma unroll
        for (int i = 0; i < 8; ++i) *reinterpret_cast<LAS bx8*>(vwr + (i & 1) * 2048 + ((i >> 1) & 1) * 256 + ((i >> 2) & 1) * 4096) = vs[i];
#ifdef ATT_PP
        const int vg = (r32 >> 2) & 3, c_lo = (t0 >> 5) & 1;
        unsigned char* rowp = (unsigned char*)(a.ws + WS_KF8) + ((size_t)(kv * (S / 64) + (t0 >> 6))) * attc::PP_TIMG + attc::PP_KIMG + r32 * 64 + ((c_lo ^ vg) << 4) + 4 * hi;
        const int hi_off = (((c_lo + 2) ^ vg) << 4) - ((c_lo ^ vg) << 4);
#else
        const int hi_off = 32;
        unsigned char* rowp = VT8 + (size_t)kv * HD * S + (size_t)(t0 >> 6) * 8192 + r32 * 64 + ((t0 & 32) ? 16 : 0) + 4 * hi;
#endif
#define VTR8(D0, KS) do { const sx4 l_ = attc::tr_read<attc::v_rd_off(D0, KS, 0)>(vb), h_ = attc::tr_read<attc::v_rd_off(D0, KS, 1)>(vb); asm volatile("s_waitcnt lgkmcnt(0)" ::: "memory"); __builtin_amdgcn_sched_barrier(0); \
          int lo_ = __builtin_amdgcn_cvt_pk_fp8_f32(__uint_as_float((unsigned)(unsigned short)l_[0] << 16), __uint_as_float((unsigned)(unsigned short)l_[1] << 16), 0, false); \
          lo_ = __builtin_amdgcn_cvt_pk_fp8_f32(__uint_as_float((unsigned)(unsigned short)l_[2] << 16), __uint_as_float((unsigned)(unsigned short)l_[3] << 16), lo_, true); \
          int hi_ = __builtin_amdgcn_cvt_pk_fp8_f32(__uint_as_float((unsigned)(unsigned short)h_[0] << 16), __uint_as_float((unsigned)(unsigned short)h_[1] << 16), 0, false); \
          hi_ = __builtin_amdgcn_cvt_pk_fp8_f32(__uint_as_float((unsigned)(unsigned short)h_[2] << 16), __uint_as_float((unsigned)(unsigned short)h_[3] << 16), hi_, true); \
          unsigned char* q_ = rowp + (D0 * 32) * 64 + 8 * KS; *(int*)q_ = lo_; *(int*)(q_ + hi_off) = hi_; } while (0)
        VTR8(0, 0); VTR8(0, 1); VTR8(1, 0); VTR8(1, 1); VTR8(2, 0); VTR8(2, 1); VTR8(3, 0); VTR8(3, 1);
#undef VTR8
        asm volatile("s_waitcnt lgkmcnt(0)" ::: "memory");
      } }
#endif
}

template <bool IS_B>
__device__ __forceinline__ void naive_band(const bf16* proj, bf16* o, const float* lut, float sink_l2, int t, int qcol, int kcol, int vcol, int gcol, int ocol,
                                           LAS float* sc, LAS int* jr, int lane) {
    constexpr int NS = IS_B ? 257 : 387;
    const int l16 = lane & 15, grp = lane >> 4;
    float qf[8];
    { const pg8::u32x4 qraw = *(const pg8::u32x4*)(proj + (size_t)t * INW + qcol + l16 * 8);
      qf[0] = bflo(qraw.x) * QK_C; qf[1] = bfhi(qraw.x) * QK_C; qf[2] = bflo(qraw.y) * QK_C; qf[3] = bfhi(qraw.y) * QK_C;
      qf[4] = bflo(qraw.z) * QK_C; qf[5] = bfhi(qraw.z) * QK_C; qf[6] = bflo(qraw.w) * QK_C; qf[7] = bfhi(qraw.w) * QK_C; }
    for (int s0 = 0; s0 < NS; s0 += 4) {
        const int s = s0 + grp; const bool inr = s < NS; const int ss = inr ? s : NS - 1;
        int j, li;
        if (IS_B) { j = t + ss - 128; li = ss + 28; }
        else { const int p = ss / 129, kk = ss - p * 129; j = t + (kk - 64) * (1 << (2 * p)); li = p * LUTA_N + kk + 28; }
        const bool valid = inr && j >= 0 && j < S;
        const int jc = j < 0 ? 0 : (j > S - 1 ? S - 1 : j);
        const pg8::u32x4 kr = *(const pg8::u32x4*)(proj + (size_t)jc * INW + kcol + l16 * 8);
        float d = qf[0] * bflo(kr.x) + qf[1] * bfhi(kr.x) + qf[2] * bflo(kr.y) + qf[3] * bfhi(kr.y) + qf[4] * bflo(kr.z) + qf[5] * bfhi(kr.z) + qf[6] * bflo(kr.w) + qf[7] * bfhi(kr.w);
        d += lane_xor(d, 1, lane); d += lane_xor(d, 2, lane); d += lane_xor(d, 4, lane); d += lane_xor(d, 8, lane);
        const float sv = valid ? d + lut[li] : -1e30f;
        if (l16 == 0 && inr) { sc[s] = sv; jr[s] = jc; }
    }
    float mx = -1e30f;
    for (int s = lane; s < NS; s += 64) mx = fmaxf(mx, sc[s]);
    mx = wave_max_l(mx, lane); if (IS_B) mx = fmaxf(mx, sink_l2);
    float lsum = 0.f;
    for (int s = lane; s < NS; s += 64) { const float p = exp2f(sc[s] - mx); sc[s] = p; lsum += p; }
    lsum = wave_sum_l(lsum, lane); if (IS_B) lsum += exp2f(sink_l2 - mx);
    float a0 = 0.f, a1 = 0.f;
#pragma unroll 4
    for (int s = 0; s < NS; ++s) { const float p = sc[s]; const int j = jr[s];
        const unsigned v = *(const unsigned*)(proj + (size_t)j * INW + vcol + lane * 2); a0 += p * bflo(v); a1 += p * bfhi(v); }
    const unsigned g = *(const unsigned*)(proj + (size_t)t * INW + gcol + lane * 2);
    const float inv = 1.f / lsum;
    *(unsigned*)(o + (size_t)t * DM + ocol + lane * 2) = pg8::cvt_pk_bf16(a0 * inv * silu_f(bflo(g)), a1 * inv * silu_f(bfhi(g)));
}

__device__ __forceinline__ void naive_ab_phase(const Args& a, LAS unsigned char* lds, int layer, int wave, int vcu, int G) {
    const int lane = fresh_lane();
    const bf16* proj = (const bf16*)(a.ws + WS_PROJ); bf16* o = (bf16*)(a.ws + WS_O); const float* tab = (const float*)(a.ws + WS_TAB);
    const float* sink = a.in[10] + layer * B_H;
    LAS float* sc = (LAS float*)(lds + wave * 4096); LAS int* jr = (LAS int*)(lds + wave * 4096 + 2048);
    const int gw = vcu * NWAVES + wave, NGW = G * NWAVES;
    for (int t = gw; t < S; t += NGW) {
        for (int h = 0; h < A_H; ++h)
            naive_band<false>(proj, o, tab + TB_LUTA + h * 3 * LUTA_N, 0.f, t, COL_AQ + h * HD, COL_AK + h * HD, COL_AV + h * HD, COL_AG + h * HD, OCOL_A + h * HD, sc, jr, lane);
        for (int h = 0; h < B_H; ++h)
            naive_band<true>(proj, o, tab + TB_LUTB + h * LUTB_N, sink[h] * LOG2E, t, COL_BQ + h * HD, COL_BK + (h >> 2) * HD, COL_BV + (h >> 2) * HD, COL_BG + h * HD, OCOL_B + h * HD, sc, jr, lane);
    }
}

namespace band {
using attc::bf16x8; using attc::s16x4; using attc::f32x16; using attc::u32x4; using attc::crow; using attc::cvtpk; using attc::v_rd_base; using attc::v_rd_off; using attc::tr_read;
constexpr float THR2 = 8.f;
constexpr int KPITCH = 272;
constexpr int WAVE_LDS = 8192 + 32 * KPITCH;
static_assert(WAVE_LDS >= attc::EPI_BYTES, "O stage fits the per-wave region");
enum Mode { P16 = 0, P4 = 1, P1 = 2, MB = 3 };
constexpr int A_ROW = A_H * HD;
template <int D0> __device__ __forceinline__ void pv32(f32x16& od, int vb, bf16x8 pa0, bf16x8 pa1) {
  const s16x4 l0 = tr_read<v_rd_off(D0, 0, 0)>(vb), h0 = tr_read<v_rd_off(D0, 0, 1)>(vb), l1 = tr_read<v_rd_off(D0, 1, 0)>(vb), h1 = tr_read<v_rd_off(D0, 1, 1)>(vb);
  asm volatile("s_waitcnt lgkmcnt(0)" ::: "memory"); __builtin_amdgcn_sched_barrier(0);
#define PK(L, H) (bf16x8){L[0], L[1], L[2], L[3], H[0], H[1], H[2], H[3]}
  od = __builtin_amdgcn_mfma_f32_32x32x16_bf16(pa0, PK(l0, h0), od, 0, 0, 0);
  od = __builtin_amdgcn_mfma_f32_32x32x16_bf16(pa1, PK(l1, h1), od, 0, 0, 0);
#undef PK
}
__device__ __forceinline__ void epi_stage(const f32x16 (&o)[4], const float (&rli)[16], LAS unsigned char* st, int lane) {
  asm volatile("" : "+v"(lane));
  const int r32 = lane & 31, hi = lane >> 5;
#pragma unroll
  for (int r = 0; r < 16; ++r) { const int row = crow(r, hi);
#pragma unroll
    for (int d0 = 0; d0 < 4; ++d0) *reinterpret_cast<LAS float*>(st + row * attc::EPI_PITCH + (d0 * 32 + r32) * 4) = o[d0][r] * rli[r]; }
}
template <int QS>
__device__ __forceinline__ void epi_partial_out(LAS unsigned char* st, bf16* __restrict__ dst, int lane) {
  typedef float f32x4_t __attribute__((ext_vector_type(4)));
  asm volatile("" : "+v"(lane));
  const int rr = lane >> 4, c16 = lane & 15;
#pragma unroll
  for (int i = 0; i < 8; ++i) { const int row = rr + 4 * i;
    const f32x4_t a = *reinterpret_cast<const LAS f32x4_t*>(st + row * attc::EPI_PITCH + c16 * 32);
    const f32x4_t b = *reinterpret_cast<const LAS f32x4_t*>(st + row * attc::EPI_PITCH + c16 * 32 + 16);
    u32x4 w = {cvtpk(a[0], a[1]), cvtpk(a[2], a[3]), cvtpk(b[0], b[1]), cvtpk(b[2], b[3])};
    *reinterpret_cast<u32x4*>(dst + (size_t)(QS * row) * A_ROW + c16 * 8) = w; }
}
__device__ __forceinline__ void epi_gate_out(LAS unsigned char* st, const u32x4 (&g)[8], bf16* __restrict__ obase, int lane) {
  typedef float f32x4_t __attribute__((ext_vector_type(4)));
  asm volatile("" : "+v"(lane));
  const int rr = lane >> 4, c16 = lane & 15;
#pragma unroll
  for (int i = 0; i < 8; ++i) { const int row = rr + 4 * i;
    const f32x4_t a = *reinterpret_cast<const LAS f32x4_t*>(st + row * attc::EPI_PITCH + c16 * 32);
    const f32x4_t b = *reinterpret_cast<const LAS f32x4_t*>(st + row * attc::EPI_PITCH + c16 * 32 + 16);
    float v[8] = {a[0], a[1], a[2], a[3], b[0], b[1], b[2], b[3]};
#pragma unroll
    for (int e = 0; e < 4; ++e) { const float g0 = __uint_as_float(g[i][e] << 16), g1 = __uint_as_float(g[i][e] & 0xffff0000u);
      v[2 * e] *= g0 * __builtin_amdgcn_rcpf(1.f + __expf(-g0)); v[2 * e + 1] *= g1 * __builtin_amdgcn_rcpf(1.f + __expf(-g1)); }
    u32x4 w = {cvtpk(v[0], v[1]), cvtpk(v[2], v[3]), cvtpk(v[4], v[5]), cvtpk(v[6], v[7])};
    *reinterpret_cast<u32x4*>(obase + (size_t)row * DM + c16 * 8) = w; }
}
__device__ __forceinline__ void epi_merge(LAS unsigned char* st, const LAS float* cw, const bf16* __restrict__ p4, const bf16* __restrict__ p16,
                                          const bf16* __restrict__ gbase, bf16* __restrict__ obase, int lane) {
  typedef float f32x4_t __attribute__((ext_vector_type(4)));
  asm volatile("" : "+v"(lane));
  const int rr = lane >> 4, c16 = lane & 15;
#pragma unroll
  for (int hf = 0; hf < 2; ++hf) {
    u32x4 g[4], x4[4], x16[4];
#pragma unroll
    for (int i = 0; i < 4; ++i) { const int row = rr + 4 * (4 * hf + i);
      g[i] = *reinterpret_cast<const u32x4*>(gbase + (size_t)row * INW + c16 * 8);
      x4[i] = *reinterpret_cast<const u32x4*>(p4 + (size_t)row * A_ROW + c16 * 8); x16[i] = *reinterpret_cast<const u32x4*>(p16 + (size_t)row * A_ROW + c16 * 8); }
#pragma unroll
    for (int i = 0; i < 4; ++i) { const int row = rr + 4 * (4 * hf + i);
      const f32x4_t a = *reinterpret_cast<const LAS f32x4_t*>(st + row * attc::EPI_PITCH + c16 * 32);
      const f32x4_t b = *reinterpret_cast<const LAS f32x4_t*>(st + row * attc::EPI_PITCH + c16 * 32 + 16);
      const float w4 = cw[row], w16 = cw[32 + row];
      float v[8] = {a[0], a[1], a[2], a[3], b[0], b[1], b[2], b[3]};
#pragma unroll
      for (int e = 0; e < 4; ++e) { const float g0 = __uint_as_float(g[i][e] << 16), g1 = __uint_as_float(g[i][e] & 0xffff0000u);
        v[2 * e]     = (v[2 * e]     + w4 * __uint_as_float(x4[i][e] << 16)         + w16 * __uint_as_float(x16[i][e] << 16))         * (g0 * __builtin_amdgcn_rcpf(1.f + __expf(-g0)));
        v[2 * e + 1] = (v[2 * e + 1] + w4 * __uint_as_float(x4[i][e] & 0xffff0000u) + w16 * __uint_as_float(x16[i][e] & 0xffff0000u)) * (g1 * __builtin_amdgcn_rcpf(1.f + __expf(-g1))); }
      u32x4 w = {cvtpk(v[0], v[1]), cvtpk(v[2], v[3]), cvtpk(v[4], v[5]), cvtpk(v[6], v[7])};
      *reinterpret_cast<u32x4*>(obase + (size_t)row * DM + c16 * 8) = w; }
    asm volatile("" ::: "memory"); }
}
struct Part { bf16* p4; bf16* p16; float* s4; float* s16; };
struct Next { bool has; int q0, qcol, kcol, vcol; };
template <int MODE>
__device__ __forceinline__ void wave_tile(const bf16* __restrict__ proj, bf16* __restrict__ obuf, const Part& part, int h, int q0, int qcol, int kcol, int vcol, int gcol, int ocol,
                                          float m_init, float l_init, LAS unsigned char* vlds, LAS float* xch, LAS float* lut, const float* __restrict__ lut_g, int lane,
                                          bf16x8 (&qr)[8], bf16x8 (&ks8)[8], bf16x8 (&vs)[8], bool pre, const Next nx) {
  constexpr int KS = MODE == P16 ? 16 : (MODE == P4 ? 4 : 1), W = MODE == MB ? 128 : 64, NTT = MODE == MB ? 9 : 5;
  const int r32 = lane & 31, hi = lane >> 5, vrow = lane >> 4, vch = lane & 15;
#define BAND_QLOAD(q0_, qcol_) do { const bf16* qp = proj + (size_t)((q0_) + KS * r32) * INW + (qcol_) + hi * 8; \
    _Pragma("unroll") for (int d0 = 0; d0 < 8; ++d0) qr[d0] = *reinterpret_cast<const bf16x8*>(qp + d0 * 16); } while (0)
  if (!pre) BAND_QLOAD(q0, qcol);
  f32x16 o[4] = {}; float m_reg = m_init, l_reg = l_init;
  const int vb = (int)(uintptr_t)vlds + v_rd_base(lane);
  LAS unsigned char* klds = vlds + 8192;
  LAS unsigned char* vwr = vlds + (vch >> 2) * 512 + vrow * 64 + (vch & 3) * 16;
  LAS unsigned char* kwr = klds + vrow * KPITCH + vch * 16;
  const LAS unsigned char* krd = klds + r32 * KPITCH + hi * 16;
#define BAND_ISSUE(kt_, kcol, vcol) do { _Pragma("unroll") for (int i = 0; i < 8; ++i) { int tv = (kt_) + KS * (vrow + 4 * i); tv = tv < 0 ? 0 : (tv > S - 1 ? S - 1 : tv); \
        const bf16* rp = proj + (size_t)tv * INW + vch * 8; ks8[i] = *reinterpret_cast<const bf16x8*>(rp + kcol); vs[i] = *reinterpret_cast<const bf16x8*>(rp + vcol); } } while (0)
  int kt = q0 - W * KS;
  if (!pre) BAND_ISSUE(kt, kcol, vcol);
  { constexpr int LN = MODE == MB ? LUTB_N : LUTA_N, LK = (LN + 63) / 64; float lv[LK];
#pragma unroll
    for (int k = 0; k < LK; ++k) { const int e = lane + 64 * k; lv[k] = lut_g[e < LN ? e : LN - 1]; }
#pragma unroll
    for (int k = 0; k < LK; ++k) { const int e = lane + 64 * k; if (e < LN) lut[e] = lv[k]; } }
#pragma nounroll
  for (int tt = 0; tt < NTT; ++tt) {
#pragma unroll
    for (int i = 0; i < 8; ++i) { *reinterpret_cast<LAS bf16x8*>(vwr + (i & 1) * 2048 + ((i >> 1) & 1) * 256 + ((i >> 2) & 1) * 4096) = vs[i];
                                  *reinterpret_cast<LAS bf16x8*>(kwr + i * 4 * KPITCH) = ks8[i]; }
    f32x16 p0 = {};
#pragma unroll
    for (int d0 = 0; d0 < 8; ++d0) { const bf16x8 kfr = *reinterpret_cast<const LAS bf16x8*>(krd + d0 * 32);
      p0 = __builtin_amdgcn_mfma_f32_32x32x16_bf16(kfr, qr[d0], p0, 0, 0, 0); }
    const int c_kt = kt; kt += 32 * KS;
    if (tt + 1 < NTT) BAND_ISSUE(kt, kcol, vcol);
    float tv[16];
    { int dl = -W + 32 * tt + 4 * hi - r32; dl = dl < -(W + 28) ? -(W + 28) : (dl > W + 1 ? W + 1 : dl);
      const LAS float* lp = lut + (dl + (W + 28));
#pragma unroll
      for (int r = 0; r < 16; ++r) tv[r] = fmaf(p0[r], QK_C, lp[(r & 3) + 8 * (r >> 2)]); }
    if (c_kt < 0 || c_kt + 31 * KS > S - 1) {
#pragma unroll
      for (int r = 0; r < 16; ++r) { const int tok = c_kt + KS * crow(r, hi); if (tok < 0 || tok > S - 1) tv[r] = -1e30f; } }
    float pmax = tv[0];
#pragma unroll
    for (int r = 1; r < 16; ++r) pmax = fmaxf(pmax, tv[r]);
    { auto rr = __builtin_amdgcn_permlane32_swap(__float_as_uint(pmax), __float_as_uint(pmax), false, false); pmax = fmaxf(__uint_as_float(rr[0]), __uint_as_float(rr[1])); }
    float alpha = 1.f;
    if (!__all(pmax - m_reg <= THR2)) { const float mn = fmaxf(m_reg, pmax); alpha = __builtin_amdgcn_exp2f(m_reg - mn); m_reg = mn; }
    float ps = 0.f;
#pragma unroll
    for (int r = 0; r < 16; ++r) { tv[r] = __builtin_amdgcn_exp2f(tv[r] - m_reg); ps += tv[r]; }
    { auto rr = __builtin_amdgcn_permlane32_swap(__float_as_uint(ps), __float_as_uint(ps), false, false); ps = __uint_as_float(rr[0]) + __uint_as_float(rr[1]); }
    l_reg = l_reg * alpha + ps;
    bf16x8 pa0, pa1;
#define PK4(P, BASE, OUT) do { unsigned a0 = cvtpk(P[BASE + 0], P[BASE + 1]), a1 = cvtpk(P[BASE + 2], P[BASE + 3]);   \
    unsigned b0 = cvtpk(P[BASE + 4], P[BASE + 5]), b1 = cvtpk(P[BASE + 6], P[BASE + 7]);                              \
    auto r0 = __builtin_amdgcn_permlane32_swap(a0, b0, false, false); auto r1 = __builtin_amdgcn_permlane32_swap(a1, b1, false, false); \
    u32x4 w = {r0[0], r1[0], r0[1], r1[1]}; OUT = *reinterpret_cast<bf16x8*>(&w); } while (0)
    PK4(tv, 0, pa0); PK4(tv, 8, pa1);
#undef PK4
    if (__any(alpha < 1.f)) { if (hi == 0) xch[r32] = alpha; asm volatile("s_waitcnt lgkmcnt(0)" ::: "memory");
#pragma unroll
      for (int d = 0; d < 4; ++d)
#pragma unroll
        for (int r = 0; r < 16; ++r) o[d][r] *= xch[crow(r, hi)]; }
    pv32<0>(o[0], vb, pa0, pa1); pv32<1>(o[1], vb, pa0, pa1); pv32<2>(o[2], vb, pa0, pa1); pv32<3>(o[3], vb, pa0, pa1);
  }
  float f = __builtin_amdgcn_rcpf(l_reg);
  if (MODE == P16 || MODE == P4) {
    if (hi == 0) { float* sp = (MODE == P16 ? part.s16 : part.s4) + ((size_t)(q0 + KS * r32) * A_H + h) * 2; sp[0] = m_reg; sp[1] = l_reg; } }
  if (MODE == P1) {
    const size_t si = ((size_t)(q0 + r32) * A_H + h) * 2;
    const float m4 = part.s4[si], l4 = part.s4[si + 1], m16 = part.s16[si], l16 = part.s16[si + 1];
    const float M = fmaxf(m_reg, fmaxf(m4, m16));
    const float e1 = __builtin_amdgcn_exp2f(m_reg - M), e4 = l4 * __builtin_amdgcn_exp2f(m4 - M), e16 = l16 * __builtin_amdgcn_exp2f(m16 - M);
    const float rden = __builtin_amdgcn_rcpf(l_reg * e1 + e4 + e16);
    f = e1 * rden;
    if (hi == 0) { xch[64 + r32] = e4 * rden; xch[96 + r32] = e16 * rden; } }
  if (hi == 0) xch[32 + r32] = f; asm volatile("s_waitcnt lgkmcnt(0)" ::: "memory");
  float rli[16];
#pragma unroll
  for (int r = 0; r < 16; ++r) rli[r] = xch[32 + crow(r, hi)];
  u32x4 gpre[8];
  if (MODE == MB) {
    int vr2 = vrow; asm volatile("" : "+v"(vr2));
    const bf16* gb = proj + (size_t)q0 * INW + gcol + vch * 8;
#pragma unroll
    for (int i = 0; i < 8; ++i) gpre[i] = *reinterpret_cast<const u32x4*>(gb + (size_t)(vr2 + 4 * i) * INW); }
  epi_stage(o, rli, vlds, lane);
  if (nx.has) { BAND_QLOAD(nx.q0, nx.qcol); BAND_ISSUE(nx.q0 - W * KS, nx.kcol, nx.vcol); }
  if (MODE == P16) epi_partial_out<KS>(vlds, part.p16 + (size_t)q0 * A_ROW + h * HD, lane);
  else if (MODE == P4) epi_partial_out<KS>(vlds, part.p4 + (size_t)q0 * A_ROW + h * HD, lane);
  else if (MODE == P1) epi_merge(vlds, xch + 64, part.p4 + (size_t)q0 * A_ROW + h * HD, part.p16 + (size_t)q0 * A_ROW + h * HD, proj + (size_t)q0 * INW + gcol, obuf + (size_t)q0 * DM + ocol, lane);
  else epi_gate_out(vlds, gpre, obuf + (size_t)q0 * DM + ocol, lane);
#undef BAND_ISSUE
#undef BAND_QLOAD
}
}

__device__ __forceinline__ void band_phase(const Args& a, LAS unsigned char* lds, int layer, int pass, int wave, int vcu, int G) {
    const int lane = fresh_lane();
    const bf16* proj = (const bf16*)(a.ws + WS_PROJ); bf16* o = (bf16*)(a.ws + WS_O); const float* tab = (const float*)(a.ws + WS_TAB);
    band::Part part; part.p4 = (bf16*)(a.ws + WS_PART4); part.p16 = (bf16*)(a.ws + WS_PART16); part.s4 = (float*)(a.ws + WS_STAT4); part.s16 = (float*)(a.ws + WS_STAT16);
    LAS unsigned char* vlds = lds + wave * band::WAVE_LDS; LAS float* xch = (LAS float*)(lds + BAND_LUT_OFF + wave * BAND_LUT_WAVE); LAS float* lut = xch + 128;
    typedef band::bf16x8 bf16x8;
    if (pass == 0) {
        { bool pre = false; bf16x8 qr[8], ks8[8], vs[8];
          for (int ua = vcu; ua < A_H * 64; ua += G) {
            const int h = ua / 64, rem = ua % 64, u = rem >> 1, r = (rem & 1) * 8 + wave;
            const int un = ua + G; band::Next nx; nx.has = un < A_H * 64; { const int h2 = un / 64, rem2 = un % 64; nx.q0 = 512 * (rem2 >> 1) + (rem2 & 1) * 8 + wave; nx.qcol = COL_AQ + h2 * HD; nx.kcol = COL_AK + h2 * HD; nx.vcol = COL_AV + h2 * HD; }
            const float* lut_g = tab + TB_LUTA + (h * 3 + 2) * LUTA_N;
            band::wave_tile<band::P16>(proj, o, part, h, 512 * u + r, COL_AQ + h * HD, COL_AK + h * HD, COL_AV + h * HD, COL_AG + h * HD, OCOL_A + h * HD, -1e20f, 0.f, vlds, xch, lut, lut_g, lane, qr, ks8, vs, pre, nx);
            pre = nx.has; } }
        { bool pre = false; bf16x8 qr[8], ks8[8], vs[8];
          for (int ua = vcu; ua < A_H * 64; ua += G) {
            const int h = ua / 64, b = ua % 64;
            const int un = ua + G; band::Next nx; nx.has = un < A_H * 64; { const int h2 = un / 64, b2 = un % 64; nx.q0 = 256 * b2 + 128 * (wave >> 2) + (wave & 3); nx.qcol = COL_AQ + h2 * HD; nx.kcol = COL_AK + h2 * HD; nx.vcol = COL_AV + h2 * HD; }
            const float* lut_g = tab + TB_LUTA + (h * 3 + 1) * LUTA_N;
            band::wave_tile<band::P4>(proj, o, part, h, 256 * b + 128 * (wave >> 2) + (wave & 3), COL_AQ + h * HD, COL_AK + h * HD, COL_AV + h * HD, COL_AG + h * HD, OCOL_A + h * HD, -1e20f, 0.f, vlds, xch, lut, lut_g, lane, qr, ks8, vs, pre, nx);
            pre = nx.has; } }
        const float* sink = a.in[10] + layer * B_H;
        { bool pre = false; bf16x8 qr[8], ks8[8], vs[8];
          for (int ub = vcu; ub < B_H * 64; ub += G) {
            const int kv = ub / 256, rem = ub % 256, qblk = rem >> 2, h = kv * 4 + (rem & 3);
            const int un = ub + G; band::Next nx; nx.has = un < B_H * 64; { const int kv2 = un / 256, rem2 = un % 256, h2 = kv2 * 4 + (rem2 & 3); nx.q0 = (rem2 >> 2) * 256 + wave * 32; nx.qcol = COL_BQ + h2 * HD; nx.kcol = COL_BK + kv2 * HD; nx.vcol = COL_BV + kv2 * HD; }
            const float* lut_g = tab + TB_LUTB + h * LUTB_N;
            band::wave_tile<band::MB>(proj, o, part, h, qblk * 256 + wave * 32, COL_BQ + h * HD, COL_BK + kv * HD, COL_BV + kv * HD, COL_BG + h * HD, OCOL_B + h * HD, sink[h] * LOG2E, 1.f, vlds, xch, lut, lut_g, lane, qr, ks8, vs, pre, nx);
            pre = nx.has; } }
    } else {
        band::Next nx; nx.has = false; nx.q0 = 0; nx.qcol = 0; nx.kcol = 0; nx.vcol = 0;
        for (int ua = vcu; ua < A_H * 64; ua += G) {
            bf16x8 qr[8], ks8[8], vs[8];
            const int h = ua / 64, b = ua % 64;
            const float* lut_g = tab + TB_LUTA + (h * 3 + 0) * LUTA_N;
            band::wave_tile<band::P1>(proj, o, part, h, 256 * b + 32 * wave, COL_AQ + h * HD, COL_AK + h * HD, COL_AV + h * HD, COL_AG + h * HD, OCOL_A + h * HD, -1e20f, 0.f, vlds, xch, lut, lut_g, lane, qr, ks8, vs, false, nx);
        }
    }
}

__global__ void __launch_bounds__(NWAVES * 64, 2) fwd_kernel(Args args) {
    extern __shared__ __attribute__((aligned(16))) unsigned char lds_raw[];
    LAS unsigned char* lds = (LAS unsigned char*)lds_raw;
    volatile LAS unsigned* MISC = (volatile LAS unsigned*)(lds + MISC_OFF);
    const int wave = __builtin_amdgcn_readfirstlane((int)threadIdx.x >> 6);
    const int G = gridDim.x; const int bx = blockIdx.x; const int vcu = (G % 8 == 0) ? (bx % 8) * (G / 8) + bx / 8 : bx;
    gu32* ctl = (gu32*)(args.ws + WS_CTL);
    for (int u = threadIdx.x; u < (LDS_BYTES - LDSCTL_OFF) / 4; u += NWAVES * 64) ((LAS unsigned*)(lds + LDSCTL_OFF))[u] = 0u;
    __syncthreads();
    XcdBarrier bar = xcd_barrier_post((unsigned*)(ctl + CW_BAR), MISC + 8, (unsigned)wave);
    const bf16* Win_t = (const bf16*)(args.ws + WS_WIN); const bf16* Wout_t = (const bf16*)(args.ws + WS_WOUT);
    bf16* Hb = (bf16*)(args.ws + WS_H); bf16* PROJ = (bf16*)(args.ws + WS_PROJ); bf16* Ob = (bf16*)(args.ws + WS_O); bf16* Yb = (bf16*)(args.ws + WS_Y);

    p0_prologue(args, lds, wave, vcu, G);
    xcd_barrier(bar);
    norm_phase(args, lds, -1, 0, args.in[0], wave, vcu, G);
    w8_phase(args, wave, vcu, G);
    xcd_barrier(bar);

#pragma nounroll
    for (int layer = 0; layer < DEPTH; ++layer) {
#ifndef REP_G1
#define REP_G1 1
#endif
        for (int rep = 0; rep < REP_G1; ++rep)
        {
          pg8::Gemm g{Hb, Win_t + (size_t)layer * INW * DM, S, F8_COL0, DM}; pg8::StaticOrder so; so.init(S, F8_COL0, G, bx);
          pg8::EpiStore E{PROJ, INW};
          const int whole = (so.nwg / G) * G, rest = so.nwg - whole; const bool halves = (2 * rest == G);
          if (halves) so.lim = whole;
          pg8::gemm_phase<pg8::EpiStore, pg8::StaticOrder, true, true>(lds + RING_OFF, g, so, E, wave);
          if (halves) { pg8::HalfOrder ho; ho.base = so; ho.first = whole;
              pg8::gemm_phase<pg8::EpiStore, pg8::HalfOrder, true, true, true>(lds + RING_OFF, g, ho, E, wave); }
          pg8::Gemm g8{(const pg8::bf16_t*)(args.ws + WS_H8), (const pg8::bf16_t*)(args.ws + WS_W8 + (size_t)layer * F8_COLS * DM), S, F8_COLS, DM / 2}; pg8::StaticOrder s8; s8.init(S, F8_COLS, G, bx);
          pg8::EpiStore E8{PROJ + F8_COL0, INW};
          const int sclb = 127 - w8_exp(args, layer);
          const int whole8 = (s8.nwg / G) * G, rest8 = s8.nwg - whole8; const bool halves8 = (2 * rest8 == G);
          if (halves8) s8.lim = whole8;
          pg8::gemm_phase<pg8::EpiStore, pg8::StaticOrder, true, true, false, true>(lds + RING_OFF, g8, s8, E8, wave, sclb);
          if (halves8) { pg8::HalfOrder h8; h8.base = s8; h8.first = whole8;
              pg8::gemm_phase<pg8::EpiStore, pg8::HalfOrder, true, true, true, true>(lds + RING_OFF, g8, h8, E8, wave, sclb); } }
        xcd_barrier(bar);
        prep_phase(args, lds, layer, wave, vcu, G);
        __syncthreads();
        band_phase(args, lds, layer, 0, wave, vcu, G);
        xcd_barrier(bar);
#ifndef REP_C
#define REP_C 1
#endif
        for (int rep = 0; rep < REP_C; ++rep)
        for (int i = 0;; ++i) {
            const int u = i * G + vcu; if (u >= C_H * (S / 256)) break;
            const int gq = u / 256, rem = u % 256, kv = rem / 64, qb = rem % 64, head = kv * 3 + gq;
#if defined(ATT_PP)
#ifdef QK_FP4
            attc::attn_f8pp_body((const unsigned char*)(args.ws + WS_QF8) + (size_t)(qb * 256) * attc::LDQ4 + head * 64,
#else
            attc::attn_f8pp_body((const unsigned char*)(args.ws + WS_QF8) + (size_t)(qb * 256) * (C_H * HD) + head * HD,
#endif
 (const unsigned char*)(args.ws + WS_KF8) + (size_t)kv * (S / 64) * attc::PP_TIMG,
                                 PROJ + (size_t)(qb * 256) * INW + COL_CG + head * HD, Ob + (size_t)(qb * 256) * DM + OCOL_C + head * HD, S, (char*)lds_raw + RING_OFF, wave);
#elif defined(ATT_F8)
            attc::attn_f8_body((const unsigned char*)(args.ws + WS_QF8) + (size_t)(qb * 256) * (C_H * HD) + head * HD, (const unsigned char*)(args.ws + WS_KF8) + kv * HD,
                               (const unsigned char*)(args.ws + WS_VTF8) + (size_t)kv * HD * S,
                               PROJ + (size_t)(qb * 256) * INW + COL_CG + head * HD, Ob + (size_t)(qb * 256) * DM + OCOL_C + head * HD, S, (char*)lds_raw + RING_OFF, wave);
#else
            attc::attn_dense_body(PROJ + (size_t)(qb * 256) * INW + COL_CQ + head * HD, PROJ + COL_CK + kv * HD, PROJ + COL_CV + kv * HD,
                                  PROJ + (size_t)(qb * 256) * INW + COL_CG + head * HD, Ob + (size_t)(qb * 256) * DM + OCOL_C + head * HD, S, (char*)lds_raw + RING_OFF, wave);
#endif
        }
        band_phase(args, lds, layer, 1, wave, vcu, G);
        xcd_barrier(bar);
#ifndef REP_G2
#define REP_G2 1
#endif
        for (int rep = 0; rep < REP_G2; ++rep)
        { pg8::Gemm g{Ob, Wout_t + (size_t)layer * DM * DM, S, DM, DM}; pg8::StaticOrder so; so.init(S, DM, G, bx);
          pg8::EpiStore E{Yb, DM};
          pg8::gemm_phase<pg8::EpiStore, pg8::StaticOrder, true, true>(lds + RING_OFF, g, so, E, wave); }
        xcd_barrier(bar);
#ifdef REP_NORM
        norm_phase(args, lds, layer, layer + 1 < DEPTH ? layer + 1 : -1, layer == 0 ? args.in[0] : (const float*)args.out, wave, vcu, G, true);
#endif
        norm_phase(args, lds, layer, layer + 1 < DEPTH ? layer + 1 : -1, layer == 0 ? args.in[0] : (const float*)args.out, wave, vcu, G);
        if (layer + 1 < DEPTH) xcd_barrier(bar);
    }
}

extern "C" void kernel_launch(void* const* d_in, const int* in_sizes, int n_in, void* d_out, int out_size, void* d_ws, size_t ws_size, hipStream_t stream) {
    static int grid = 0;
    if (grid == 0) {
        if (n_in != 12 || in_sizes[0] != S * DM || out_size != S * DM || ws_size < WS_END) {
            fprintf(stderr, "kernel_launch: shape mismatch: n_in %d in0 %d out %d ws %zu (need >= %zu); nothing launched\n", n_in, n_in > 0 ? in_sizes[0] : -1, out_size, ws_size, (size_t)WS_END); grid = -1; return; }
        int dev = 0, cus = 0, per_cu = 0;
        if (hipGetDevice(&dev) != hipSuccess || hipDeviceGetAttribute(&cus, hipDeviceAttributeMultiprocessorCount, dev) != hipSuccess) { fprintf(stderr, "kernel_launch: device query failed\n"); grid = -1; return; }
        if (hipFuncSetAttribute((const void*)fwd_kernel, hipFuncAttributeMaxDynamicSharedMemorySize, LDS_BYTES) != hipSuccess) { fprintf(stderr, "kernel_launch: hipFuncSetAttribute failed\n"); grid = -1; return; }
        if (hipOccupancyMaxActiveBlocksPerMultiprocessor(&per_cu, (const void*)fwd_kernel, NWAVES * 64, LDS_BYTES) != hipSuccess || per_cu < 1)
            fprintf(stderr, "kernel_launch: note: occupancy query reports %d workgroups per CU\n", per_cu);
        (void)hipGetLastError();
        grid = cus;
    }
    if (grid < 0) return;
    if (hipMemsetAsync((char*)d_ws + WS_CTL, 0, CTL_ZERO_BYTES, stream) != hipSuccess) { fprintf(stderr, "kernel_launch: memset failed\n"); return; }
    Args a{};
    for (int i = 0; i < 12; ++i) a.in[i] = (const float*)d_in[i];
    a.out = (float*)d_out; a.ws = (unsigned char*)d_ws;
    hipLaunchKernelGGL(fwd_kernel, dim3(grid), dim3(NWAVES * 64), LDS_BYTES, stream, a);
    const hipError_t le = hipPeekAtLastError();
    if (le != hipSuccess) fprintf(stderr, "kernel_launch: launch failed: %s\n", hipGetErrorName(le));
}
```

```cpp
#define ATT_F8 1
#define ATT_PP 1
#define QK_FP4 1
#include <hip/hip_runtime.h>
#include <hip/hip_bf16.h>
#include <cstdio>
#include <cstdint>
#include <cmath>

namespace pg8 {
#define PG8_LAS __attribute__((address_space(3)))
typedef unsigned short bf16_t;
typedef short bf16x8 __attribute__((ext_vector_type(8)));
typedef float f32x4 __attribute__((ext_vector_type(4)));
typedef unsigned u32x4 __attribute__((ext_vector_type(4)));
constexpr int BM = 256, BK = 64, HALF = 128, HTB = HALF * BK * 2  , STAGE_BYTES = 8 * HTB, NXCD = 8, WGM = 8;

__host__ __device__ __forceinline__ int lds_byte(int r, int c) { const int st = (r >> 4) * 2 + (c >> 5), rr = r & 15, cc = c & 31, ob = rr * 64 + cc * 2; return st * 1024 + (ob ^ (((ob >> 9) & 1) << 5)); }
__host__ __device__ __forceinline__ void stage_rc(int b, int& R, int& C) { const int st = b / 1024, sb = b % 1024, swz = sb ^ (((sb >> 9) & 1) << 5); R = (st >> 1) * 16 + swz / 64; C = (st & 1) * 32 + (swz % 64) / 2; }
__host__ __device__ __forceinline__ int perm32(int rho) { const int n = rho >> 4, i = rho & 15; return 8 * (i >> 2) + 4 * n + (i & 3); }

struct Unit { int pm, pn, hm; };
struct Gemm { const bf16_t* A; const bf16_t* Bt; int M, N, K; };

struct StaticOrder {
    int nM, nN, nwg, G, c, lim;
    __host__ __device__ void init(int M, int N, int G_, int c_) { nM = M / BM; nN = N / BM; nwg = nM * nN; G = G_; c = c_; lim = nwg; }
    __host__ __device__ void map(int wgid, Unit& u) const {
        { const int q = nwg / NXCD, r = nwg % NXCD, xcd = wgid % NXCD, off = wgid / NXCD; wgid = (xcd < r ? xcd * (q + 1) : r * (q + 1) + (xcd - r) * q) + off; }
        const int nig = WGM * nN, gid = wgid / nig, fm = gid * WGM, gsz = (nM - fm) < WGM ? (nM - fm) : WGM;
        u.pm = fm + ((wgid % nig) % gsz); u.pn = (wgid % nig) / gsz; u.hm = 0;
    }
    __host__ __device__ bool next(int i, Unit& u) const {
        const long L = (long)i * G + c; if (L >= lim) return false;
        map((int)L, u); return true;
    }
    __device__ __forceinline__ void a_ready(const Unit&) const {}
    __device__ __forceinline__ void done(const Unit&) const {}
};
struct HalfOrder {
    StaticOrder base; int first;
    __host__ __device__ bool next(int i, Unit& u) const { if (i > 0) return false; base.map(first + (base.c >> 1), u); u.hm = (base.c & 1) ? 1 : 2; return true; }
    __device__ __forceinline__ void a_ready(const Unit&) const {}
    __device__ __forceinline__ void done(const Unit&) const {}
};

__device__ __forceinline__ unsigned cvt_pk_bf16(float lo, float hi) { unsigned r; asm volatile("v_cvt_pk_bf16_f32 %0, %1, %2" : "=v"(r) : "v"(lo), "v"(hi)); return r; }
struct EpiStore {
    static constexpr bool PERM = true, AFTER_DRAIN = false;
    bf16_t* O; int ldc;
    __device__ __forceinline__ void operator()(const f32x4 (&acc)[2][2][4][2], const Unit& u, int wr, int wc, int fr, int fq) const {
        const int row0 = u.pm * BM + wr * 64 + fr; const int col0 = u.pn * BM + wc * 32 + 8 * fq;
#pragma unroll
        for (int ai = 0; ai < 2; ++ai)
#pragma unroll
            for (int m = 0; m < 4; ++m) { bf16_t* rowp = O + (size_t)(row0 + ai * HALF + m * 16) * ldc + col0;
#pragma unroll
                for (int bj = 0; bj < 2; ++bj) { if (u.hm & (1 << bj)) continue; const f32x4 v0 = acc[ai][bj][m][0], v1 = acc[ai][bj][m][1];
                    u32x4 w; w.x = cvt_pk_bf16(v0[0], v0[1]); w.y = cvt_pk_bf16(v0[2], v0[3]); w.z = cvt_pk_bf16(v1[0], v1[1]); w.w = cvt_pk_bf16(v1[2], v1[3]);
                    *(u32x4*)(rowp + bj * HALF) = w; } }
    }
    __device__ __forceinline__ void fused(f32x4 (&acc)[2][2][4][2], const Unit& u, int wr, int wc, int fr, int fq, PG8_LAS unsigned char* lds, int wid, int lane) const {}
};

struct EpiStoreT {
    static constexpr bool PERM = true, AFTER_DRAIN = false;
    bf16_t* O; size_t tstride;
    __device__ __forceinline__ void operator()(const f32x4 (&acc)[2][2][4][2], const Unit& u, int wr, int wc, int fr, int fq) const {
        const int row0 = u.pm * BM + wr * 64 + fr; bf16_t* Ot = O + (size_t)u.pn * tstride + wc * 32 + 8 * fq;
#pragma unroll
        for (int ai = 0; ai < 2; ++ai)
#pragma unroll
            for (int m = 0; m < 4; ++m) { bf16_t* rowp = Ot + (size_t)(row0 + ai * HALF + m * 16) * BM;
#pragma unroll
                for (int bj = 0; bj < 2; ++bj) { if (u.hm & (1 << bj)) continue; const f32x4 v0 = acc[ai][bj][m][0], v1 = acc[ai][bj][m][1];
                    u32x4 w; w.x = cvt_pk_bf16(v0[0], v0[1]); w.y = cvt_pk_bf16(v0[2], v0[3]); w.z = cvt_pk_bf16(v1[0], v1[1]); w.w = cvt_pk_bf16(v1[2], v1[3]);
                    *(u32x4*)(rowp + bj * HALF) = w; } }
    }
    __device__ __forceinline__ void fused(f32x4 (&acc)[2][2][4][2], const Unit& u, int wr, int wc, int fr, int fq, PG8_LAS unsigned char* lds, int wid, int lane) const {}
};

template <class Epi, class Sched, bool ALIGN_EPI = false, bool SP2 = false, bool HALFU = false, bool FP8 = false>
__device__ __forceinline__ void gemm_phase(PG8_LAS unsigned char* lds, const Gemm g, const Sched& S, const Epi& E, const int wid_in, const int sclb = 127) {
    typedef int i32x4_ __attribute__((ext_vector_type(4))); typedef int i32x8_ __attribute__((ext_vector_type(8)));
    const int scl2 = 127 | (sclb << 8);
    int wid = wid_in; asm volatile("" : "+s"(wid));
    int lane_l; asm volatile("v_mbcnt_lo_u32_b32 %0, -1, 0\n\tv_mbcnt_hi_u32_b32 %0, -1, %0" : "=v"(lane_l));
    const int lane = lane_l, tid = wid * 64 + lane, wr = wid >> 2, wc = wid & 3, fr = lane & 15, fq = lane >> 4;
    const int K = g.K, nt = K / BK;
    unsigned voffA[2], voffB[2];
#pragma unroll
    for (int i = 0; i < 2; ++i) { int R, C; stage_rc(tid * 16 + i * 8192, R, C); const int Rb = Epi::PERM ? ((R & ~31) + perm32(R & 31)) : R;
        voffA[i] = (unsigned)(R * K + C) * 2u; voffB[i] = (unsigned)(Rb * K + C) * 2u; }
    const size_t kstep = (size_t)(BK * 2);
    const size_t hstep = (size_t)HALF * K * 2;
    const size_t tstep = 2 * hstep;
    const unsigned ldsw = (unsigned)wid * 1024u;
    const int aoff = lds_byte(wr * 64 + fr, fq * 8), boff = lds_byte(wc * 32 + fr, fq * 8);
#define PG8_SA(b, h) (((b) * 2 + (h)) * HTB)
#define PG8_SB(b, h) ((4 + (b) * 2 + (h)) * HTB)
#define PG8_STAGE(bufoff, gbase, voff) do { _Pragma("unroll") for (int _i = 0; _i < 2; ++_i) \
        __builtin_amdgcn_global_load_lds((const unsigned*)((const char*)(gbase) + (voff)[_i]), (PG8_LAS unsigned*)(lds + (bufoff) + ldsw + _i * 8192), 16, 0, 0); } while (0)
#define PG8_LDA(dst, b, h) do { _Pragma("unroll") for (int m = 0; m < 4; ++m) { \
        if constexpr (FP8) { const i32x4_ l_ = *(const PG8_LAS i32x4_*)(lds + PG8_SA(b, h) + aoff + m * 2048), h_ = *(const PG8_LAS i32x4_*)(lds + PG8_SA(b, h) + aoff + m * 2048 + 1024); \
                             dst##8[m] = (i32x8_){l_[0], l_[1], l_[2], l_[3], h_[0], h_[1], h_[2], h_[3]}; } \
        else { _Pragma("unroll") for (int k = 0; k < 2; ++k) dst[m][k] = *(const PG8_LAS bf16x8*)(lds + PG8_SA(b, h) + aoff + m * 2048 + k * 1024); } } } while (0)
#define PG8_LDB(dst, b, h) do { _Pragma("unroll") for (int n = 0; n < 2; ++n) { \
        if constexpr (FP8) { const i32x4_ l_ = *(const PG8_LAS i32x4_*)(lds + PG8_SB(b, h) + boff + n * 2048), h_ = *(const PG8_LAS i32x4_*)(lds + PG8_SB(b, h) + boff + n * 2048 + 1024); \
                             dst##8[n] = (i32x8_){l_[0], l_[1], l_[2], l_[3], h_[0], h_[1], h_[2], h_[3]}; } \
        else { _Pragma("unroll") for (int k = 0; k < 2; ++k) dst[n][k] = *(const PG8_LAS bf16x8*)(lds + PG8_SB(b, h) + boff + n * 2048 + k * 1024); } } } while (0)
#define PG8_MMA(ai, bj, At, Bt) do { if (HALFU && (cur.hm & (1 << (bj)))) break; __builtin_amdgcn_s_setprio(1); \
        if constexpr (FP8) { _Pragma("unroll") for (int m = 0; m < 4; ++m) _Pragma("unroll") for (int n = 0; n < 2; ++n) \
            asm volatile("v_mfma_scale_f32_16x16x128_f8f6f4 %0, %1, %2, %0, %3, %3 op_sel:[1,0,0] op_sel_hi:[0,0,0]" : "+v"(acc[ai][bj][m][n]) : "v"(Bt##8[n]), "v"(At##8[m]), "v"(scl2)); } \
        else { _Pragma("unroll") for (int m = 0; m < 4; ++m) _Pragma("unroll") for (int n = 0; n < 2; ++n) _Pragma("unroll") for (int k = 0; k < 2; ++k) \
            acc[ai][bj][m][n] = __builtin_amdgcn_mfma_f32_16x16x32_bf16(Bt[n][k], At[m][k], acc[ai][bj][m][n], 0, 0, 0); } \
        __builtin_amdgcn_s_setprio(0); } while (0)
#define PG8_WAIT_V(n) asm volatile("s_waitcnt vmcnt(" #n ")" ::: "memory")
#define PG8_WAIT_L(n) asm volatile("s_waitcnt lgkmcnt(" #n ")" ::: "memory")
#define PG8_BAR __builtin_amdgcn_s_barrier()
#define PG8_SCHED __builtin_amdgcn_sched_barrier(0)
    Unit cur, nxt; int ui = 0;
    if (!S.next(0, cur)) return;
    f32x4 acc[2][2][4][2];
#pragma unroll
    for (int a = 0; a < 2; ++a)
#pragma unroll
        for (int b = 0; b < 2; ++b)
#pragma unroll
            for (int m = 0; m < 4; ++m)
#pragma unroll
                for (int n = 0; n < 2; ++n) acc[a][b][m][n] = (f32x4){0.f, 0.f, 0.f, 0.f};
    bf16x8 At[4][2], B0[2][2], B1[2][2]; i32x8_ At8[4], B08[2], B18[2];
    const char* cA = (const char*)g.A + (size_t)cur.pm * tstep; const char* cB = (const char*)g.Bt + (size_t)cur.pn * tstep;
    S.a_ready(cur);
    if constexpr (SP2) {
        PG8_STAGE(PG8_SB(0, 0), cB, voffB); PG8_STAGE(PG8_SB(0, 1), cB + hstep, voffB); PG8_STAGE(PG8_SA(0, 0), cA, voffA); PG8_STAGE(PG8_SA(0, 1), cA + hstep, voffA);
        if (wr == 1) PG8_BAR;
        PG8_WAIT_V(2); PG8_BAR;
        PG8_STAGE(PG8_SB(1, 0), cB + kstep, voffB); PG8_STAGE(PG8_SA(1, 0), cA + kstep, voffA); PG8_STAGE(PG8_SB(1, 1), cB + hstep + kstep, voffB);
        PG8_WAIT_V(6); PG8_BAR;
    } else {
        PG8_STAGE(PG8_SB(0, 0), cB, voffB); PG8_STAGE(PG8_SA(0, 0), cA, voffA); PG8_STAGE(PG8_SB(0, 1), cB + hstep, voffB); PG8_STAGE(PG8_SA(0, 1), cA + hstep, voffA);
        if (wr == 1) PG8_BAR;
        PG8_WAIT_V(4); PG8_BAR;
        PG8_STAGE(PG8_SB(1, 0), cB + kstep, voffB); PG8_STAGE(PG8_SA(1, 0), cA + kstep, voffA); PG8_STAGE(PG8_SB(1, 1), cB + hstep + kstep, voffB);
        PG8_WAIT_V(6); PG8_BAR;
    }
    for (;;) {
        const bool has_next = S.next(ui + 1, nxt);
        const char* nA = has_next ? (const char*)g.A + (size_t)nxt.pm * tstep : cA; const char* nB = has_next ? (const char*)g.Bt + (size_t)nxt.pn * tstep : cB;
        for (int t = 0; t < nt; t += 2) {
            const bool last = (t == nt - 2);
            const char* a1 = cA + (size_t)(t + 1) * kstep;
            const char* a2 = last ? nA : cA + (size_t)(t + 2) * kstep; const char* b2 = last ? nB : cB + (size_t)(t + 2) * kstep;
            const char* a3 = a2 + kstep; const char* b3 = b2 + kstep;
            if (last && has_next) S.a_ready(nxt);
            if constexpr (SP2) {
            PG8_LDB(B0, 0, 0); PG8_LDB(B1, 0, 1); PG8_SCHED; PG8_LDA(At, 0, 0); PG8_STAGE(PG8_SA(1, 1), a1 + hstep, voffA);
            PG8_WAIT_V(8); PG8_WAIT_L(0); PG8_BAR; PG8_MMA(0, 0, At, B0); PG8_MMA(0, 1, At, B1); PG8_BAR; PG8_SCHED;
            PG8_LDA(At, 0, 1); PG8_STAGE(PG8_SB(0, 0), b2, voffB); PG8_STAGE(PG8_SB(0, 1), b2 + hstep, voffB); PG8_STAGE(PG8_SA(0, 0), a2, voffA);
            PG8_WAIT_V(8); PG8_WAIT_L(0); PG8_BAR; PG8_MMA(1, 0, At, B0); PG8_MMA(1, 1, At, B1); PG8_BAR; PG8_SCHED;
            PG8_LDB(B0, 1, 0); PG8_LDB(B1, 1, 1); PG8_SCHED; PG8_LDA(At, 1, 0); PG8_STAGE(PG8_SA(0, 1), a2 + hstep, voffA);
            PG8_WAIT_V(8); PG8_WAIT_L(0); PG8_BAR; PG8_MMA(0, 0, At, B0); PG8_MMA(0, 1, At, B1); PG8_BAR; PG8_SCHED;
            PG8_LDA(At, 1, 1); PG8_STAGE(PG8_SB(1, 0), b3, voffB); PG8_STAGE(PG8_SB(1, 1), b3 + hstep, voffB); PG8_STAGE(PG8_SA(1, 0), a3, voffA);
            PG8_WAIT_V(8); PG8_WAIT_L(0); PG8_BAR; PG8_MMA(1, 0, At, B0); PG8_MMA(1, 1, At, B1); PG8_BAR; PG8_SCHED;
            } else {
            PG8_LDB(B0, 0, 0); PG8_SCHED; PG8_LDA(At, 0, 0); PG8_STAGE(PG8_SA(1, 1), a1 + hstep, voffA);
            PG8_WAIT_L(8); PG8_BAR; PG8_WAIT_L(0); PG8_MMA(0, 0, At, B0); PG8_BAR; PG8_SCHED;
            PG8_LDB(B1, 0, 1); PG8_STAGE(PG8_SB(0, 0), b2, voffB);
            PG8_BAR; PG8_WAIT_L(0); PG8_MMA(0, 1, At, B1); PG8_BAR;
            PG8_LDA(At, 0, 1); PG8_STAGE(PG8_SA(0, 0), a2, voffA);
            PG8_BAR; PG8_WAIT_L(0); PG8_MMA(1, 0, At, B0); PG8_BAR; PG8_SCHED;
            PG8_STAGE(PG8_SB(0, 1), b2 + hstep, voffB);
            PG8_WAIT_V(6); PG8_BAR; PG8_MMA(1, 1, At, B1); PG8_BAR;
            PG8_LDB(B0, 1, 0); PG8_SCHED; PG8_LDA(At, 1, 0); PG8_STAGE(PG8_SA(0, 1), a2 + hstep, voffA);
            PG8_WAIT_L(8); PG8_BAR; PG8_WAIT_L(0); PG8_MMA(0, 0, At, B0); PG8_BAR; PG8_SCHED;
            PG8_LDB(B1, 1, 1); PG8_STAGE(PG8_SB(1, 0), b3, voffB);
            PG8_BAR; PG8_WAIT_L(0); PG8_MMA(0, 1, At, B1); PG8_BAR;
            PG8_LDA(At, 1, 1); PG8_STAGE(PG8_SA(1, 0), a3, voffA);
            PG8_BAR; PG8_WAIT_L(0); PG8_MMA(1, 0, At, B0); PG8_BAR; PG8_SCHED;
            PG8_STAGE(PG8_SB(1, 1), b3 + hstep, voffB);
            PG8_WAIT_V(6); PG8_BAR; PG8_MMA(1, 1, At, B1); PG8_BAR;
            }
        }
        if constexpr (ALIGN_EPI) { if (wr == 0) PG8_BAR; }
        if constexpr (!Epi::AFTER_DRAIN) { E(acc, cur, wr, wc, fr, fq); S.done(cur); }
        if (!has_next) break;
#pragma unroll
        for (int a = 0; a < 2; ++a)
#pragma unroll
            for (int b = 0; b < 2; ++b)
#pragma unroll
                for (int m = 0; m < 4; ++m)
#pragma unroll
                    for (int n = 0; n < 2; ++n) acc[a][b][m][n] = (f32x4){0.f, 0.f, 0.f, 0.f};
        cur = nxt; cA = nA; cB = nB; ++ui;
        if constexpr (ALIGN_EPI) { if (wr == 1) PG8_BAR; }
    }
    PG8_WAIT_V(0);
    if constexpr (!ALIGN_EPI) { if (wr == 0) PG8_BAR; }
    PG8_BAR;
    if constexpr (Epi::AFTER_DRAIN) { E.fused(acc, cur, wr, wc, fr, fq, lds, wid, lane); S.done(cur); }
#undef PG8_SA
#undef PG8_SB
#undef PG8_STAGE
#undef PG8_LDA
#undef PG8_LDB
#undef PG8_MMA
#undef PG8_WAIT_V
#undef PG8_WAIT_L
#undef PG8_BAR
#undef PG8_SCHED
}
}
typedef unsigned short bf16;
typedef pg8::bf16_t bf16_t;
typedef unsigned u32x2 __attribute__((ext_vector_type(2)));
constexpr int S = 16384, DM = 4096, DEPTH = 4, HD = 128, INW = 12800, NMOD = 3 * DM;
constexpr int A_H = 12, B_H = 8, C_H = 12;
constexpr int COL_AK = 0, COL_AV = 1536, COL_AG = 3072, COL_BQ = 4608, COL_BK = 5632, COL_BV = 5888, COL_BG = 6144, COL_CG = 7168, COL_CV = 8704,
              COL_AQ = 9216, COL_CQ = 10752, COL_CK = 12288;
__host__ __device__ constexpr int proj_col_of(int src) { return src < 1536 ? src + COL_AQ : (src < 8704 ? src - 1536 : (src < 10752 ? src + 2048 : (src < 11264 ? src - 2048 : src - 4096))); }
constexpr int PLD = 256;
__host__ __device__ constexpr int PC(int col) { return (col >> 8) * (S * 256) + (col & 255); }
constexpr int OCOL_A = 0, OCOL_B = 1536, OCOL_C = 2560;
constexpr float EPS = 1e-6f;
constexpr float SM_SCALE = 0.08838834764831845f;
constexpr float LOG2E = 1.4426950408889634f;
constexpr float QK_C = SM_SCALE * LOG2E;
constexpr int NWAVES = 8;

constexpr size_t MiB = 1u << 20;
constexpr size_t WS_CTL = 0, CTL_ZERO_BYTES = 1 * MiB;
constexpr size_t WS_TAB = 1 * MiB;
constexpr size_t WS_MODP = 1 * MiB + 256 * 1024;
constexpr size_t WS_WIN = 2 * MiB;
constexpr size_t WS_WOUT = WS_WIN + 400 * MiB;
constexpr size_t WS_H = WS_WOUT + 128 * MiB;
constexpr size_t WS_PROJ = WS_H + 128 * MiB;
constexpr size_t WS_O = WS_PROJ + 400 * MiB;
constexpr size_t WS_Y = WS_O + 128 * MiB;
constexpr size_t WS_PART4 = WS_Y + 128 * MiB;
constexpr size_t WS_PART16 = WS_PART4 + 48 * MiB;
constexpr size_t WS_STAT4 = WS_PART16 + 48 * MiB;
constexpr size_t WS_STAT16 = WS_STAT4 + 2 * MiB;
constexpr size_t WS_QF8 = WS_STAT16 + 2 * MiB;
constexpr size_t WS_KF8 = WS_QF8 + 24 * MiB;
constexpr size_t WS_VTF8 = WS_KF8 + 8 * MiB;
constexpr size_t WS_H8 = WS_VTF8 + 8 * MiB;
constexpr size_t WS_W8 = WS_H8 + 64 * MiB;
constexpr size_t WS_END = WS_W8 + 64 * MiB;
constexpr int F8_COL0 = COL_AQ, F8_COLS = 3584;
constexpr int CW_AMAX = 1024;
constexpr int CW_BAR = 4096;
constexpr int LUTA_N = 2 * (64 + 28) + 1, LUTB_N = 2 * (128 + 28) + 1;
constexpr int TB_LUTA = 0;
constexpr int TB_LUTB = 6912;
constexpr int TB_ROPE_R = 12288;
constexpr int TB_ROPE_C = 12288 + 16384;
constexpr int RING_OFF = 0, RING_BYTES = 131072;
constexpr int BAND_BYTES = 8 * (8192 + 32 * 272);
constexpr int LDSCTL_OFF = BAND_BYTES, MISC_OFF = LDSCTL_OFF + 320;
constexpr int BAND_LUT_OFF = LDSCTL_OFF + 1024;
constexpr int BAND_LUT_WAVE = 2048;
constexpr int LDS_BYTES = BAND_LUT_OFF + 8 * BAND_LUT_WAVE;
__device__ __forceinline__ int fresh_lane() { int l; asm volatile("v_mbcnt_lo_u32_b32 %0, -1, 0\n\tv_mbcnt_hi_u32_b32 %0, -1, %0" : "=v"(l)); return l; }
__device__ __forceinline__ float lane_xor(float v, int mask, int lane) { return __uint_as_float((unsigned)__builtin_amdgcn_ds_bpermute((lane ^ mask) << 2, (int)__float_as_uint(v))); }
__device__ __forceinline__ float wave_sum_l(float v, int lane) {
#pragma unroll
    for (int o = 1; o < 64; o <<= 1) v += lane_xor(v, o, lane);
    return v;
}
__device__ __forceinline__ float wave_max_l(float v, int lane) {
#pragma unroll
    for (int o = 1; o < 64; o <<= 1) v = fmaxf(v, lane_xor(v, o, lane));
    return v;
}

#define GAS __attribute__((address_space(1)))
#define LAS __attribute__((address_space(3)))
typedef unsigned short bf16;
typedef unsigned v4u __attribute__((ext_vector_type(4)));
typedef float f32x4 __attribute__((ext_vector_type(4)));
typedef short bf16x8 __attribute__((ext_vector_type(8)));
typedef GAS unsigned gu32;
typedef GAS unsigned long long gu64;
#define RLX_AGENT __ATOMIC_RELAXED, __HIP_MEMORY_SCOPE_AGENT
#define LDS_WAIT() asm volatile("s_waitcnt lgkmcnt(0)" ::: "memory")
#define VM_WAIT() asm volatile("s_waitcnt vmcnt(0)" ::: "memory")
__device__ __forceinline__ unsigned long long rt() { return __builtin_amdgcn_s_memrealtime(); }
__device__ __forceinline__ unsigned f2bf(float f) { unsigned u = __builtin_bit_cast(unsigned, f); return (u + 0x7fffu + ((u >> 16) & 1u)) >> 16; }
__device__ __forceinline__ unsigned pk2(float lo, float hi) { return f2bf(lo) | (f2bf(hi) << 16); }

#define XB_TMO      128
#define XB_XCNT(j)  (256  + 64 * (j))
#define XB_XSUB(j)  (1280 + 64 * (j))
#define XB_XGEN(j)  (2304 + 64 * (j))
#define XB_TOP      3328
#define XB_TOPGEN   3392
#define XCD_BAR_WORDS 3456
#define XB_SPIN_CAP (1u << 18)

__device__ __forceinline__ unsigned xb_ld(unsigned* p)              { return __hip_atomic_load(p, __ATOMIC_RELAXED, __HIP_MEMORY_SCOPE_AGENT); }
__device__ __forceinline__ unsigned xb_add(unsigned* p, unsigned v) { return __hip_atomic_fetch_add(p, v, __ATOMIC_RELAXED, __HIP_MEMORY_SCOPE_AGENT); }
__device__ __forceinline__ unsigned xb_xcc_id() { return (unsigned)__builtin_amdgcn_s_getreg((3 << 11) | 20) & 0xFu; }
#define XB_SPIN(cond, bar) do { unsigned _sp = 0; while (cond) { __builtin_amdgcn_s_sleep(1); \
    if ((++_sp & 255u) == 0u) { if (xb_ld(&(bar)[XB_TMO])) break; if (_sp > XB_SPIN_CAP) { atomicAdd(&(bar)[XB_TMO], 1u); break; } } } } while (0)

struct XcdBarrier {
    unsigned* bar; unsigned x; unsigned w;
    volatile LAS unsigned* st;
};

__device__ __forceinline__ XcdBarrier xcd_barrier_post(unsigned* bar, volatile LAS unsigned* st, unsigned wave) {
    XcdBarrier b; b.bar = bar; b.x = (unsigned)__builtin_amdgcn_readfirstlane((int)xb_xcc_id()); b.st = st; b.w = wave;
    if (threadIdx.x == 0) (void)xb_add(&bar[XB_XCNT(b.x)], 1u);
    return b;
}
__device__ __forceinline__ void xcd_barrier_complete(unsigned* bar, unsigned x, unsigned& nloc, unsigned& nx) {
    const unsigned G = gridDim.x * gridDim.y * gridDim.z;
    unsigned sum, cnt, mine, sp = 0u;
    for (;;) {
        sum = 0u; cnt = 0u; mine = 0u;
#pragma unroll
        for (unsigned j = 0; j < 16; ++j) { const unsigned c = xb_ld(&bar[XB_XCNT(j)]); sum += c; cnt += (c > 0u) ? 1u : 0u; mine = (j == x) ? c : mine; }
        if (sum == G) break;
        __builtin_amdgcn_s_sleep(1);
        if ((++sp & 255u) == 0u) { if (xb_ld(&bar[XB_TMO])) break; if (sp > XB_SPIN_CAP) { atomicAdd(&bar[XB_TMO], 1u); break; } }
    }
    nloc = mine > 0u ? mine : 1u; nx = cnt > 0u ? cnt : 1u;
}

__device__ __forceinline__ void xcd_barrier(const XcdBarrier& b) {
    asm volatile("s_waitcnt vmcnt(0)" ::: "memory");
    __syncthreads();
    int ln_; asm volatile("v_mbcnt_lo_u32_b32 %0, -1, 0\n\tv_mbcnt_hi_u32_b32 %0, -1, %0" : "=v"(ln_));
    if (b.w == 0u && ln_ == 0) {
        unsigned* bar = b.bar; unsigned bx_ = b.x; asm volatile("" : "+s"(bar), "+s"(bx_));
        __builtin_amdgcn_s_waitcnt(0);
        unsigned nloc = b.st[0], nx = b.st[1];
        if (nloc == 0u) { xcd_barrier_complete(bar, bx_, nloc, nx); b.st[0] = nloc; b.st[1] = nx; }
        const unsigned old = xb_add(&bar[XB_XSUB(bx_)], 1u);
        const unsigned gen = old / nloc;
        if (old + 1u == (gen + 1u) * nloc) {
            __builtin_amdgcn_fence(__ATOMIC_RELEASE, "agent");
            asm volatile("s_waitcnt vmcnt(0)" ::: "memory");
            const unsigned og = xb_add(&bar[XB_TOP], 1u);
            const unsigned tg = og / nx;
            if (og + 1u == (tg + 1u) * nx) xb_add(&bar[XB_TOPGEN], 1u);
            else XB_SPIN(xb_ld(&bar[XB_TOPGEN]) == tg, bar);
            __builtin_amdgcn_fence(__ATOMIC_ACQUIRE, "agent");
            xb_add(&bar[XB_XGEN(bx_)], 1u);
            asm volatile("s_waitcnt vmcnt(0)" ::: "memory");
        } else {
            XB_SPIN(xb_ld(&bar[XB_XGEN(bx_)]) == gen, bar);
            __builtin_amdgcn_fence(__ATOMIC_ACQUIRE, "agent");
            asm volatile("s_waitcnt vmcnt(0)" ::: "memory");
        }
    }
    __syncthreads();
}
__device__ __forceinline__ float wave_sum(float v) {
#pragma unroll
    for (int o = 1; o < 64; o <<= 1) v += __shfl_xor(v, o);
    return v;
}
template <bool TRACK>
__device__ __forceinline__ void p0_transpose_item(const float* W, int K, int N, bf16* WT, int row_off, LAS float* scr, int item, int lane, float& amx) {
    const int nblk = N / 32, kb = item / nblk, nb = item % nblk, k0 = 64 * kb, n0 = 32 * nb;
#pragma unroll 8
    for (int i = 0; i < 32; ++i) { const int kk = 2 * i + (lane >> 5); const float w_ = W[(size_t)(k0 + kk) * N + n0 + (lane & 31)]; scr[kk * 33 + (lane & 31)] = w_; if (TRACK) amx = fmaxf(amx, fabsf(w_)); }
    LDS_WAIT(); asm volatile("" ::: "memory");
    const int c = lane & 7;
#pragma unroll
    for (int j = 0; j < 4; ++j) { const int n = (lane >> 3) + 8 * j; const LAS float* s = scr + (8 * c) * 33 + n;
        v4u o; o.x = pk2(s[0 * 33], s[1 * 33]); o.y = pk2(s[2 * 33], s[3 * 33]); o.z = pk2(s[4 * 33], s[5 * 33]); o.w = pk2(s[6 * 33], s[7 * 33]);
        *(GAS v4u*)(WT + (size_t)(row_off + n0 + n) * K + k0 + 8 * c) = o; }
    LDS_WAIT(); asm volatile("" ::: "memory");
}
namespace attc {
typedef unsigned short bf16;
constexpr int   D = 128, NW = 8, QBLK = 32, KVBLK = 64;
constexpr float SCALE = SM_SCALE;
constexpr float THR = 8.f;
constexpr int SDEPTH = 2;
constexpr int LDQ = PLD, LDK = INW, LDO = DM;
constexpr size_t SHM_V = KVBLK * D * 2, SHM_K = KVBLK * D * 2, SHM_ATTN = 2 * SHM_V + 2 * SHM_K + NW * 64 * 4;
using bf16x8 = __attribute__((ext_vector_type(8))) short;
using s16x4  = __attribute__((ext_vector_type(4))) short;
using f32x16 = __attribute__((ext_vector_type(16))) float;
using u32x4  = __attribute__((ext_vector_type(4))) unsigned;
struct StageB { using T = bf16x8;
  __device__ static __forceinline__ T ld8(const bf16* p) { return *reinterpret_cast<const bf16x8*>(p); }
  __device__ static __forceinline__ bf16x8 tobf(T x) { return x; } };
#define KSWZ(row, colB) ((row) * 256 + ((colB) ^ (((row) & 7) << 4)))
#define SBAR() __builtin_amdgcn_sched_barrier(0)
__device__ __forceinline__ int crow(int r, int hi) { return (r & 3) + 8 * (r >> 2) + 4 * hi; }
__device__ __forceinline__ unsigned cvtpk(float lo, float hi) {
  unsigned r; asm volatile("v_cvt_pk_bf16_f32 %0, %1, %2" : "=v"(r) : "v"(lo), "v"(hi)); return r;
}
__device__ __forceinline__ void partialSM(f32x16& p0, f32x16& p1, float& m_reg, float& mn, float& alpha) {
  constexpr float C = SCALE * 1.4426950408889634f;
  float pmax = p0[0]; for (int r = 1; r < 16; ++r) pmax = fmaxf(pmax, p0[r]); for (int r = 0; r < 16; ++r) pmax = fmaxf(pmax, p1[r]);
  { auto rr = __builtin_amdgcn_permlane32_swap(__float_as_uint(pmax), __float_as_uint(pmax), false, false);
    pmax = fmaxf(__uint_as_float(rr[0]), __uint_as_float(rr[1])); }
  if (__builtin_expect(__all(pmax - m_reg <= THR / SCALE), 1)) { mn = m_reg; alpha = 1.f; }
  else { mn = fmaxf(m_reg, pmax); alpha = __builtin_amdgcn_exp2f((m_reg - mn) * C); m_reg = mn; }
  float mnC = -mn * C;
  for (int r = 0; r < 16; ++r) p0[r] = fmaf(p0[r], C, mnC); for (int r = 0; r < 16; ++r) p1[r] = fmaf(p1[r], C, mnC);
  for (int r = 0; r < 16; ++r) p0[r] = __builtin_amdgcn_exp2f(p0[r]);
}
__device__ __forceinline__ float psm_max(const f32x16& p0, const f32x16& p1) {
  float pmax = p0[0];
#pragma unroll
  for (int r = 1; r < 16; ++r) pmax = fmaxf(pmax, p0[r]);
#pragma unroll
  for (int r = 0; r < 16; ++r) pmax = fmaxf(pmax, p1[r]);
  auto rr = __builtin_amdgcn_permlane32_swap(__float_as_uint(pmax), __float_as_uint(pmax), false, false);
  return fmaxf(__uint_as_float(rr[0]), __uint_as_float(rr[1]));
}
__device__ __forceinline__ void psm_scale(f32x16& p0, f32x16& p1, float pmax, float& m_reg, float& mn, float& alpha) {
  constexpr float C = SCALE * 1.4426950408889634f;
  const bool keep = __all(pmax - m_reg <= THR / SCALE);
  mn = keep ? m_reg : fmaxf(m_reg, pmax); alpha = keep ? 1.f : __builtin_amdgcn_exp2f((m_reg - mn) * C); m_reg = mn;
  const float mnC = -mn * C;
#pragma unroll
  for (int r = 0; r < 16; ++r) p0[r] = fmaf(p0[r], C, mnC);
#pragma unroll
  for (int r = 0; r < 16; ++r) p1[r] = fmaf(p1[r], C, mnC);
}
template <int LO> __device__ __forceinline__ void psm_exp8(f32x16& p0) {
#pragma unroll
  for (int r = LO; r < LO + 8; ++r) p0[r] = __builtin_amdgcn_exp2f(p0[r]);
}
__device__ __forceinline__ void finishSM(f32x16& p0, f32x16& p1, float alpha, float& l_reg, bf16x8& pa0, bf16x8& pa1, bf16x8& pa2, bf16x8& pa3) {
  for (int r = 0; r < 16; ++r) p1[r] = __builtin_amdgcn_exp2f(p1[r]);
  float ps = 0; for (int r = 0; r < 16; ++r) ps += p0[r]; for (int r = 0; r < 16; ++r) ps += p1[r];
  { auto rr = __builtin_amdgcn_permlane32_swap(__float_as_uint(ps), __float_as_uint(ps), false, false);
    ps = __uint_as_float(rr[0]) + __uint_as_float(rr[1]); }
  l_reg = l_reg * alpha + ps;
#define PK4(P, BASE, OUT) do { unsigned a0 = cvtpk(P[BASE + 0], P[BASE + 1]), a1 = cvtpk(P[BASE + 2], P[BASE + 3]);   \
    unsigned b0 = cvtpk(P[BASE + 4], P[BASE + 5]), b1 = cvtpk(P[BASE + 6], P[BASE + 7]);                              \
    auto r0 = __builtin_amdgcn_permlane32_swap(a0, b0, false, false); auto r1 = __builtin_amdgcn_permlane32_swap(a1, b1, false, false); \
    u32x4 w = {r0[0], r1[0], r0[1], r1[1]}; OUT = *reinterpret_cast<bf16x8*>(&w); } while (0)
  PK4(p0, 0, pa0); PK4(p0, 8, pa1); PK4(p1, 0, pa2); PK4(p1, 8, pa3);
#undef PK4
}
__device__ __forceinline__ void qkt(f32x16& p0, f32x16& p1, const bf16* Ks, const bf16x8* qr, int r32, int hi) {
  p0 = f32x16{}; p1 = f32x16{};
  for (int d0 = 0; d0 < 8; ++d0) { int cb = (d0 * 16 + hi * 8) * 2;
    bf16x8 b0 = *reinterpret_cast<const bf16x8*>((const char*)Ks + KSWZ(r32, cb));
    bf16x8 b1 = *reinterpret_cast<const bf16x8*>((const char*)Ks + KSWZ(32 + r32, cb));
    p0 = __builtin_amdgcn_mfma_f32_32x32x16_bf16(b0, qr[d0], p0, 0, 0, 0);
    p1 = __builtin_amdgcn_mfma_f32_32x32x16_bf16(b1, qr[d0], p1, 0, 0, 0); }
}
__device__ __forceinline__ int v_st(int k, int c) { const int kk = (k & ~0xC) | ((k & 4) << 1) | ((k & 8) >> 1); return ((kk >> 3) * 4 + (c >> 5)) * 512 + ((kk & 7) * 32 + (c & 31)) * 2; }
__device__ __forceinline__ int v_rd_base(int lane) { return ((lane & 3) << 3) | (((lane >> 2) & 3) << 6) | (((lane >> 4) & 1) << 5) | (((lane >> 5) & 1) << 8); }
constexpr int v_rd_off(int d0, int ks, int half) { return d0 * 512 + ks * 4096 + half * 2048; }
template <int OFF> __device__ __forceinline__ s16x4 tr_read(int vb) {
  s16x4 r; asm volatile("ds_read_b64_tr_b16 %0, %1 offset:%2" : "=&v"(r) : "v"(vb), "i"(OFF) : "memory"); return r;
}
template <int D0> __device__ __forceinline__ void pv_one(f32x16& od, int vb, bf16x8 pa0, bf16x8 pa1, bf16x8 pa2, bf16x8 pa3) {
  const s16x4 l0 = tr_read<v_rd_off(D0, 0, 0)>(vb), h0 = tr_read<v_rd_off(D0, 0, 1)>(vb), l1 = tr_read<v_rd_off(D0, 1, 0)>(vb), h1 = tr_read<v_rd_off(D0, 1, 1)>(vb);
  const s16x4 l2 = tr_read<v_rd_off(D0, 2, 0)>(vb), h2 = tr_read<v_rd_off(D0, 2, 1)>(vb), l3 = tr_read<v_rd_off(D0, 3, 0)>(vb), h3 = tr_read<v_rd_off(D0, 3, 1)>(vb);
  asm volatile("s_waitcnt lgkmcnt(0)" ::: "memory"); SBAR();
#define PK(L, H) (bf16x8){L[0], L[1], L[2], L[3], H[0], H[1], H[2], H[3]}
  od = __builtin_amdgcn_mfma_f32_32x32x16_bf16(pa0, PK(l0, h0), od, 0, 0, 0);
  od = __builtin_amdgcn_mfma_f32_32x32x16_bf16(pa1, PK(l1, h1), od, 0, 0, 0);
  od = __builtin_amdgcn_mfma_f32_32x32x16_bf16(pa2, PK(l2, h2), od, 0, 0, 0);
  od = __builtin_amdgcn_mfma_f32_32x32x16_bf16(pa3, PK(l3, h3), od, 0, 0, 0);
#undef PK
}
__device__ __forceinline__ void pv_d0(f32x16* o, int vb, bf16x8 pa0, bf16x8 pa1, bf16x8 pa2, bf16x8 pa3) {
  pv_one<0>(o[0], vb, pa0, pa1, pa2, pa3); pv_one<1>(o[1], vb, pa0, pa1, pa2, pa3); pv_one<2>(o[2], vb, pa0, pa1, pa2, pa3); pv_one<3>(o[3], vb, pa0, pa1, pa2, pa3);
}
__device__ __forceinline__ void pv_psm(f32x16* o, int vb, bf16x8 pa0, bf16x8 pa1, bf16x8 pa2, bf16x8 pa3, f32x16& q0, f32x16& q1, float& m_reg, float& mn, float& alpha) {
  pv_one<0>(o[0], vb, pa0, pa1, pa2, pa3); float pmax = psm_max(q0, q1); asm volatile("" : "+v"(pmax));
  pv_one<1>(o[1], vb, pa0, pa1, pa2, pa3); psm_scale(q0, q1, pmax, m_reg, mn, alpha); asm volatile("" : "+v"(q0), "+v"(q1));
  pv_one<2>(o[2], vb, pa0, pa1, pa2, pa3); psm_exp8<0>(q0); asm volatile("" : "+v"(q0));
  pv_one<3>(o[3], vb, pa0, pa1, pa2, pa3); psm_exp8<8>(q0); asm volatile("" : "+v"(q0)); SBAR();
}

constexpr int EPI_PITCH = 528, EPI_BYTES = 32 * EPI_PITCH;
template <int QS>
__device__ __forceinline__ void epi_stage_store(const f32x16 (&o)[4], const float (&rli)[16], __attribute__((address_space(3))) unsigned char* st,
                                                const bf16* __restrict__ gbase, bf16* __restrict__ obase, int lane) {
  typedef float f32x4_t __attribute__((ext_vector_type(4)));
  asm volatile("" : "+v"(lane));
  const int r32 = lane & 31, hi = lane >> 5;
  const int rr = lane >> 4, c16 = lane & 15;
  u32x4 g[8];
#pragma unroll
  for (int i = 0; i < 8; ++i) g[i] = *reinterpret_cast<const u32x4*>(gbase + (size_t)(QS * (rr + 4 * i)) * LDQ + c16 * 8);
#pragma unroll
  for (int r = 0; r < 16; ++r) { const int row = crow(r, hi);
#pragma unroll
    for (int d0 = 0; d0 < 4; ++d0) *reinterpret_cast<__attribute__((address_space(3))) float*>(st + row * EPI_PITCH + (d0 * 32 + r32) * 4) = o[d0][r] * rli[r]; }
#pragma unroll
  for (int i = 0; i < 8; ++i) { const int row = rr + 4 * i;
    const f32x4_t a = *reinterpret_cast<const __attribute__((address_space(3))) f32x4_t*>(st + row * EPI_PITCH + c16 * 32);
    const f32x4_t b = *reinterpret_cast<const __attribute__((address_space(3))) f32x4_t*>(st + row * EPI_PITCH + c16 * 32 + 16);
    float v[8] = {a[0], a[1], a[2], a[3], b[0], b[1], b[2], b[3]};
#pragma unroll
    for (int e = 0; e < 4; ++e) { const float g0 = __uint_as_float(g[i][e] << 16), g1 = __uint_as_float(g[i][e] & 0xffff0000u);
      v[2 * e] *= g0 * __builtin_amdgcn_rcpf(1.f + __expf(-g0)); v[2 * e + 1] *= g1 * __builtin_amdgcn_rcpf(1.f + __expf(-g1)); }
    u32x4 w = {cvtpk(v[0], v[1]), cvtpk(v[2], v[3]), cvtpk(v[4], v[5]), cvtpk(v[6], v[7])};
    *reinterpret_cast<u32x4*>(obase + (size_t)(QS * row) * LDO + c16 * 8) = w; }
}

__device__ __forceinline__ void attn_dense_body(const bf16* __restrict__ Qb, const bf16* __restrict__ Kh, const bf16* __restrict__ Vh,
                                                const bf16* __restrict__ Gb, bf16* __restrict__ Ob, int seq, char* lds, const int wid) {
  using St = StageB;
  int lane_l; asm volatile("v_mbcnt_lo_u32_b32 %0, -1, 0\n\tv_mbcnt_hi_u32_b32 %0, -1, %0" : "=v"(lane_l));
  const int lane = lane_l, tid = wid * 64 + lane, r32 = lane & 31, hi = lane >> 5;
  bf16* V_lds = (bf16*)lds; bf16* K_lds = (bf16*)(lds + 2 * SHM_V);
  float* ws = (float*)(lds + 2 * SHM_V + 2 * SHM_K) + wid * 64; float* li_l = ws; float* al_l = ws + 32;
  float m_reg = -1e30f, l_reg = 0; f32x16 o[4] = {}; bf16x8 qr[8];
  const bf16* Qw = Qb + (long)(wid * QBLK + r32) * LDQ + hi * 8;
#pragma unroll
  for (int d0 = 0; d0 < 8; ++d0) qr[d0] = St::ld8(Qw + d0 * 16);
  const int sr = tid >> 4, sc = (tid & 15) * 8, vst0 = v_st(sr, sc), vst1 = v_st(32 + sr, sc);
  const int vb0 = (int)(uintptr_t)V_lds + v_rd_base(lane);
  struct { typename St::T vs0, vs1, ks0, ks1; } sr_[SDEPTH];
#define SLOAD(i, k0) do { sr_[i].vs0 = St::ld8(&Vh[(long)((k0) + sr) * LDK + sc]); sr_[i].vs1 = St::ld8(&Vh[(long)((k0) + 32 + sr) * LDK + sc]); \
    sr_[i].ks0 = St::ld8(&Kh[(long)((k0) + sr) * LDK + sc]); sr_[i].ks1 = St::ld8(&Kh[(long)((k0) + 32 + sr) * LDK + sc]); } while (0)
#define SWRITE(b, i) do { *(bf16x8*)((char*)V_lds + (b) * SHM_V + vst0) = St::tobf(sr_[i].vs0);          \
    *(bf16x8*)((char*)V_lds + (b) * SHM_V + vst1) = St::tobf(sr_[i].vs1); int kc = sc * 2;               \
    *(bf16x8*)((char*)K_lds + (b) * SHM_K + KSWZ(sr, kc)) = St::tobf(sr_[i].ks0);                       \
    *(bf16x8*)((char*)K_lds + (b) * SHM_K + KSWZ(32 + sr, kc)) = St::tobf(sr_[i].ks1); } while (0)
#define SWAIT() do { if constexpr (SDEPTH == 2) asm volatile("s_waitcnt vmcnt(4)" ::: "memory"); else asm volatile("s_waitcnt vmcnt(0)" ::: "memory"); } while (0)
#define RESC(a) do { if (__any((a) < 1.f)) { if (hi == 0) al_l[r32] = (a); asm volatile("s_waitcnt lgkmcnt(0)" ::: "memory"); \
    for (int d = 0; d < 4; ++d) for (int r = 0; r < 16; ++r) o[d][r] *= al_l[crow(r, hi)]; } } while (0)
  f32x16 pA0, pA1, pB0, pB1; float mnA, mnB, alA, alB; bf16x8 pa0, pa1, pa2, pa3; const int NT = seq / KVBLK;
#ifdef ATT_PRIO
  if (wid >= 4) __builtin_amdgcn_s_setprio(1);
#endif
  constexpr int SE = 0, SO = SDEPTH - 1;
  SLOAD(SE, 0); asm volatile("s_waitcnt vmcnt(0)" ::: "memory"); SWRITE(0, SE); __syncthreads();
  qkt(pA0, pA1, K_lds, qr, r32, hi); partialSM(pA0, pA1, m_reg, mnA, alA);
  SLOAD(SO, KVBLK); if constexpr (SDEPTH == 2) { if (2 < NT) SLOAD(SE, 2 * KVBLK); }
  SWAIT(); SWRITE(1, SO); __syncthreads();
  for (int j = 1; j + 1 < NT; j += 2) {
    SBAR(); qkt(pB0, pB1, (bf16*)((char*)K_lds + SHM_K), qr, r32, hi);
    finishSM(pA0, pA1, alA, l_reg, pa0, pa1, pa2, pa3); SBAR();
    SLOAD(SO, (j + SDEPTH) * KVBLK); SBAR();
    pv_psm(o, vb0, pa0, pa1, pa2, pa3, pB0, pB1, m_reg, mnB, alB);
    __syncthreads(); SWAIT(); SWRITE(0, SE);
    RESC(alB); __syncthreads();
    SBAR(); qkt(pA0, pA1, K_lds, qr, r32, hi);
    finishSM(pB0, pB1, alB, l_reg, pa0, pa1, pa2, pa3); SBAR();
    if (SDEPTH == 1 || j + 3 < NT) SLOAD(SE, (j + 1 + SDEPTH) * KVBLK); SBAR();
    pv_psm(o, vb0 + (int)SHM_V, pa0, pa1, pa2, pa3, pA0, pA1, m_reg, mnA, alA);
    __syncthreads(); SWAIT(); SWRITE(1, SO);
    RESC(alA); __syncthreads();
  }
  SBAR(); qkt(pB0, pB1, (bf16*)((char*)K_lds + SHM_K), qr, r32, hi);
  finishSM(pA0, pA1, alA, l_reg, pa0, pa1, pa2, pa3); SBAR();
  pv_psm(o, vb0, pa0, pa1, pa2, pa3, pB0, pB1, m_reg, mnB, alB);
  __syncthreads(); RESC(alB);
  finishSM(pB0, pB1, alB, l_reg, pa0, pa1, pa2, pa3); SBAR();
  pv_d0(o, vb0 + (int)SHM_V, pa0, pa1, pa2, pa3);
  if (hi == 0) li_l[r32] = l_reg; asm volatile("s_waitcnt lgkmcnt(0)" ::: "memory");
  float rli[16];
#pragma unroll
  for (int r = 0; r < 16; ++r) rli[r] = __builtin_amdgcn_rcpf(li_l[crow(r, hi)]);
#ifdef ATT_PRIO
  __builtin_amdgcn_s_setprio(0);
#endif
  __syncthreads();
  epi_stage_store<1>(o, rli, (__attribute__((address_space(3))) unsigned char*)(uintptr_t)(unsigned)(uintptr_t)lds + wid * EPI_BYTES, Gb + (long)(wid * QBLK) * LDQ, Ob + (long)(wid * QBLK) * LDO, lane);
  __syncthreads();
#undef SLOAD
#undef SWRITE
#undef SWAIT
#undef RESC
}
typedef int i32x8 __attribute__((ext_vector_type(8)));
typedef int i32x4 __attribute__((ext_vector_type(4)));
constexpr int KP8 = 144, VP8 = 80;
constexpr size_t SHM_K8 = 64 * KP8, SHM_V8 = 128 * VP8;
constexpr float THR8 = 3.72f, PSH8 = 5.f;
constexpr float Q8_PRESCALE = SCALE * 1.4426950408889634f * 8.f;
constexpr int LDQ8 = C_H * HD, LDK8 = 4 * HD;
#define MFMA8(A, B, Cc) __builtin_amdgcn_mfma_scale_f32_32x32x64_f8f6f4(A, B, Cc, 0, 0, 0, 0x7f7f7f7f, 0, 0x7f7f7f7f)
#define MFMA8Q(A, B, Cc) __builtin_amdgcn_mfma_scale_f32_32x32x64_f8f6f4(A, B, Cc, 0, 0, 0, 0x7f7f7f7f, 0, 0x7c7c7c7c)
typedef __attribute__((address_space(3))) const unsigned char* lcp8;
__device__ __forceinline__ i32x8 lds32(lcp8 p) {
  const i32x4 a = *reinterpret_cast<const __attribute__((address_space(3))) i32x4*>(p), b = *reinterpret_cast<const __attribute__((address_space(3))) i32x4*>(p + 16);
  return (i32x8){a[0], a[1], a[2], a[3], b[0], b[1], b[2], b[3]};
}
__device__ __forceinline__ void qkt8(f32x16& p0, f32x16& p1, lcp8 kb, const i32x8* qf, const f32x16& minit) {
  p0 = MFMA8Q(lds32(kb), qf[0], minit); p0 = MFMA8Q(lds32(kb + 64), qf[1], p0);
  p1 = MFMA8Q(lds32(kb + 32 * KP8), qf[0], minit); p1 = MFMA8Q(lds32(kb + 32 * KP8 + 64), qf[1], p1);
}
template <bool FIRST>
__device__ __forceinline__ void psm_fix8(f32x16& p0, f32x16& p1, float pmax, f32x16& minit, float& alpha) {
  alpha = 1.f;
  if (FIRST || !__all(pmax <= PSH8 + THR8)) {
    const float delta = FIRST ? pmax - PSH8 : fmaxf(pmax - PSH8, 0.f);
    if (!FIRST) alpha = __builtin_amdgcn_exp2f(-delta);
#pragma unroll
    for (int r = 0; r < 16; ++r) { p0[r] -= delta; p1[r] -= delta; minit[r] -= delta; }
  }
}
__device__ __forceinline__ void finishSM8(f32x16& p0, f32x16& p1, i32x8& pa) {
#pragma unroll
  for (int r = 0; r < 16; ++r) p1[r] = __builtin_amdgcn_exp2f(p1[r]);
  int und; asm volatile("" : "=v"(und));
#pragma unroll
  for (int w = 0; w < 4; ++w) { int t = __builtin_amdgcn_cvt_pk_fp8_f32(p0[4 * w], p0[4 * w + 1], und, false); pa[w] = __builtin_amdgcn_cvt_pk_fp8_f32(p0[4 * w + 2], p0[4 * w + 3], t, true);
                                int u = __builtin_amdgcn_cvt_pk_fp8_f32(p1[4 * w], p1[4 * w + 1], und, false); pa[4 + w] = __builtin_amdgcn_cvt_pk_fp8_f32(p1[4 * w + 2], p1[4 * w + 3], u, true); }
}
template <int LO> __device__ __forceinline__ void exp4(f32x16& p) {
#pragma unroll
  for (int r = LO; r < LO + 4; ++r) p[r] = __builtin_amdgcn_exp2f(p[r]);
}
template <int W> __device__ __forceinline__ void cvt8(const f32x16& p, int& d0, int& d1, int und) {
  int t = __builtin_amdgcn_cvt_pk_fp8_f32(p[8 * W], p[8 * W + 1], und, false); d0 = __builtin_amdgcn_cvt_pk_fp8_f32(p[8 * W + 2], p[8 * W + 3], t, true);
  int u = __builtin_amdgcn_cvt_pk_fp8_f32(p[8 * W + 4], p[8 * W + 5], und, false); d1 = __builtin_amdgcn_cvt_pk_fp8_f32(p[8 * W + 6], p[8 * W + 7], u, true);
}
__device__ __forceinline__ void qkt_fsm8(f32x16& n0, f32x16& n1, lcp8 kb, const i32x8* qf, const f32x16& minit, const f32x16& p0, f32x16& p1, i32x8& pa) {
  int und; asm volatile("" : "=v"(und));
  int a0, a1, a2, a3, a4, a5, a6, a7;
  const i32x8 k00 = lds32(kb), k10 = lds32(kb + 32 * KP8);
  cvt8<0>(p0, a0, a1, und); exp4<0>(p1); asm volatile("" : "+v"(p1), "+v"(a0), "+v"(a1)); SBAR();
  n0 = MFMA8Q(k00, qf[0], minit); const i32x8 k01 = lds32(kb + 64);
  cvt8<1>(p0, a2, a3, und); exp4<4>(p1); asm volatile("" : "+v"(p1), "+v"(a2), "+v"(a3)); SBAR();
  n1 = MFMA8Q(k10, qf[0], minit); const i32x8 k11 = lds32(kb + 32 * KP8 + 64);
  exp4<8>(p1); cvt8<0>(p1, a4, a5, und); asm volatile("" : "+v"(p1), "+v"(a4), "+v"(a5)); SBAR();
  n0 = MFMA8Q(k01, qf[1], n0);
  exp4<12>(p1); asm volatile("" : "+v"(p1)); SBAR();
  n1 = MFMA8Q(k11, qf[1], n1);
  cvt8<1>(p1, a6, a7, und); asm volatile("" : "+v"(a6), "+v"(a7)); SBAR();
  pa = (i32x8){a0, a1, a2, a3, a4, a5, a6, a7};
}
__device__ __forceinline__ void pv_psm8(f32x16* o, f32x16& ol, const i32x8 ones, lcp8 vb, const i32x8 pa, f32x16& q0, f32x16& q1, f32x16& minit, float& alpha) {
  o[0] = MFMA8(pa, lds32(vb), o[0]); float pmax = psm_max(q0, q1); asm volatile("" : "+v"(pmax));
  o[1] = MFMA8(pa, lds32(vb + 32 * VP8), o[1]); psm_fix8<false>(q0, q1, pmax, minit, alpha); asm volatile("" : "+v"(q0), "+v"(q1));
  o[2] = MFMA8(pa, lds32(vb + 64 * VP8), o[2]); psm_exp8<0>(q0); asm volatile("" : "+v"(q0));
  o[3] = MFMA8(pa, lds32(vb + 96 * VP8), o[3]); psm_exp8<8>(q0); asm volatile("" : "+v"(q0));
  ol = MFMA8(pa, ones, ol);
  SBAR();
}
__device__ __forceinline__ void pv8(f32x16* o, f32x16& ol, const i32x8 ones, lcp8 vb, const i32x8 pa) {
  o[0] = MFMA8(pa, lds32(vb), o[0]); o[1] = MFMA8(pa, lds32(vb + 32 * VP8), o[1]); o[2] = MFMA8(pa, lds32(vb + 64 * VP8), o[2]); o[3] = MFMA8(pa, lds32(vb + 96 * VP8), o[3]); ol = MFMA8(pa, ones, ol);
}
__device__ __forceinline__ void attn_f8_body(const unsigned char* __restrict__ Qb, const unsigned char* __restrict__ Kh, const unsigned char* __restrict__ Vt,
                                             const bf16* __restrict__ Gb, bf16* __restrict__ Ob, int seq, char* lds, const int wid) {
  int lane_l; asm volatile("v_mbcnt_lo_u32_b32 %0, -1, 0\n\tv_mbcnt_hi_u32_b32 %0, -1, %0" : "=v"(lane_l));
  const int lane = lane_l, tid = wid * 64 + lane, r32 = lane & 31, hi = lane >> 5;
  typedef __attribute__((address_space(3))) unsigned char* lp8;
  const lp8 V_lds = (lp8)(uintptr_t)(unsigned)(uintptr_t)lds; const lp8 K_lds = V_lds + 2 * SHM_V8;
  float* al_l = (float*)(lds + 2 * SHM_V8 + 2 * SHM_K8) + wid * 32;
  f32x16 o[4] = {}, ol = {}; i32x8 qf[2], ones; f32x16 minit;
#pragma unroll
  for (int r = 0; r < 8; ++r) ones[r] = 0x38383838;
#pragma unroll
  for (int r = 0; r < 16; ++r) minit[r] = PSH8;
  { const unsigned char* Qw = Qb + (long)(wid * QBLK + r32) * LDQ8 + hi * 32;
#pragma unroll
    for (int s = 0; s < 2; ++s) { const i32x4 a = *reinterpret_cast<const i32x4*>(Qw + 64 * s), b = *reinterpret_cast<const i32x4*>(Qw + 64 * s + 16); qf[s] = (i32x8){a[0], a[1], a[2], a[3], b[0], b[1], b[2], b[3]}; } }
  const int kr = tid >> 3, kc = (tid & 7) * 16, vd = tid >> 2, vc = (tid & 3) * 16;
  const int kst = kr * KP8 + kc, vst = vd * VP8 + vc;
  const lcp8 kb0 = K_lds + r32 * KP8 + hi * 32, vb0 = V_lds + r32 * VP8 + hi * 32;
  struct { i32x4 k, v; } sr_[2];
#define SLOAD8(i, k0) do { sr_[i].k = *reinterpret_cast<const i32x4*>(Kh + (long)((k0) + kr) * LDK8 + kc); sr_[i].v = *reinterpret_cast<const i32x4*>(Vt + (long)(k0) * HD + tid * 16); } while (0)
#define SWRITE8(b, i) do { *reinterpret_cast<__attribute__((address_space(3))) i32x4*>(K_lds + (b) * SHM_K8 + kst) = sr_[i].k; *reinterpret_cast<__attribute__((address_space(3))) i32x4*>(V_lds + (b) * SHM_V8 + vst) = sr_[i].v; } while (0)
#define SWAIT8() asm volatile("s_waitcnt vmcnt(2)" ::: "memory")
#define RESC8(a) do { if (__any((a) < 1.f)) { if (hi == 0) al_l[r32] = (a); asm volatile("s_waitcnt lgkmcnt(0)" ::: "memory"); \
    for (int r = 0; r < 16; ++r) { const float a_ = al_l[crow(r, hi)]; o[0][r] *= a_; o[1][r] *= a_; o[2][r] *= a_; o[3][r] *= a_; ol[r] *= a_; } } } while (0)
  f32x16 pA0, pA1, pB0, pB1; float alA, alB; i32x8 pa; const int NT = seq / KVBLK;
  constexpr int SE = 0, SO = 1;
  SLOAD8(SE, 0); asm volatile("s_waitcnt vmcnt(0)" ::: "memory"); SWRITE8(0, SE); __syncthreads();
  qkt8(pA0, pA1, kb0, qf, minit);
  { const float pmax = psm_max(pA0, pA1); psm_fix8<true>(pA0, pA1, pmax, minit, alA); psm_exp8<0>(pA0); psm_exp8<8>(pA0); }
  SLOAD8(SO, KVBLK); if (2 < NT) SLOAD8(SE, 2 * KVBLK);
  SWAIT8(); SWRITE8(1, SO); __syncthreads();
  for (int j = 1; j + 1 < NT; j += 2) {
    SBAR(); qkt_fsm8(pB0, pB1, kb0 + SHM_K8, qf, minit, pA0, pA1, pa);
    SLOAD8(SO, (j + 2) * KVBLK); SBAR();
    pv_psm8(o, ol, ones, vb0, pa, pB0, pB1, minit, alB);
    __syncthreads(); SWAIT8(); SWRITE8(0, SE);
    RESC8(alB); __syncthreads();
    SBAR(); qkt_fsm8(pA0, pA1, kb0, qf, minit, pB0, pB1, pa);
    SLOAD8(SE, (j + 3 < NT ? j + 3 : NT - 1) * KVBLK); SBAR();
    pv_psm8(o, ol, ones, vb0 + SHM_V8, pa, pA0, pA1, minit, alA);
    __syncthreads(); SWAIT8(); SWRITE8(1, SO);
    RESC8(alA); __syncthreads();
  }
  SBAR(); qkt_fsm8(pB0, pB1, kb0 + SHM_K8, qf, minit, pA0, pA1, pa);
  pv_psm8(o, ol, ones, vb0, pa, pB0, pB1, minit, alB);
  __syncthreads(); RESC8(alB);
  finishSM8(pB0, pB1, pa); SBAR();
  pv8(o, ol, ones, vb0 + SHM_V8, pa);
  float rli[16];
#pragma unroll
  for (int r = 0; r < 16; ++r) rli[r] = __builtin_amdgcn_rcpf(ol[r]);
  __syncthreads();
  epi_stage_store<1>(o, rli, (__attribute__((address_space(3))) unsigned char*)(uintptr_t)(unsigned)(uintptr_t)lds + wid * EPI_BYTES, Gb + (long)(wid * QBLK) * LDQ, Ob + (long)(wid * QBLK) * LDO, lane);
  __syncthreads();
#undef SLOAD8
#undef SWRITE8
#undef SWAIT8
#undef RESC8
}
#ifdef QK_FP4
constexpr int PP_KIMG = 4096, PP_TIMG = PP_KIMG + 8192, PP_KR = 0, PP_VR = 3 * PP_KIMG, PP_AL = PP_VR + 3 * 8192;
constexpr int LDQ4 = C_H * 64;
constexpr float Q4_PRESCALE = SCALE * 1.4426950408889634f * 16.f / 1.5f, K4_PRESCALE = 1.5f;
#define MFMA4Q(A, B, Cc) __builtin_amdgcn_mfma_scale_f32_32x32x64_f8f6f4(A, B, Cc, 4, 4, 0, 0x7f7f7f7f, 0, 0x7b7b7b7b)
__device__ __forceinline__ i32x8 lds1(int a0, int off) {
  const i32x4 a = *(const __attribute__((address_space(3))) i32x4*)(uintptr_t)(unsigned)(a0 + off);
  return (i32x8){a[0], a[1], a[2], a[3], 0, 0, 0, 0};
}
#else
constexpr int PP_KIMG = 8192, PP_TIMG = 16384, PP_KR = 0, PP_VR = 3 * 8192, PP_AL = 6 * 8192;
#endif
typedef __attribute__((address_space(3))) const i32x4* lq4;
__device__ __forceinline__ i32x8 lds2(int a0, int a1, int off) {
  const i32x4 a = *(lq4)(uintptr_t)(unsigned)(a0 + off), b = *(lq4)(uintptr_t)(unsigned)(a1 + off);
  return (i32x8){a[0], a[1], a[2], a[3], b[0], b[1], b[2], b[3]};
}
#ifndef PP_PADN
#define PP_PADN 7
#endif
#define PP_STR2(x) #x
#define PP_STR(x) PP_STR2(x)
#define PP_PAD() do { SBAR(); asm volatile("s_nop " PP_STR(PP_PADN)); SBAR(); } while (0)
#ifndef PP_PADQN
#define PP_PADQN 7
#endif
#define PP_PADQ() do { SBAR(); asm volatile("s_nop " PP_STR(PP_PADQN)); SBAR(); } while (0)
template <bool QK, bool PV>
__device__ __forceinline__ void pp_mseg(f32x16* o, f32x16& ol, f32x16& n0, f32x16& n1, const i32x8 pa, const i32x8 ones, const i32x8* qf, const f32x16& minit, const i32x8 vf0, const i32x8 vf1,
                                        const int k0, const int k1, const int k2, const int k3, const int v0, const int v1) {
  i32x8 k00, k10, k01, k11, vf2, vf3;
#ifdef QK_FP4
  if (QK) { k00 = lds1(k0, 0); k10 = lds1(k0, 2048); }
#else
  if (QK) { k00 = lds2(k0, k1, 0); k10 = lds2(k0, k1, 4096); }
#endif
  if (PV) { o[0] = MFMA8(pa, vf0, o[0]); vf2 = lds2(v0, v1, 4096); PP_PAD(); }
#ifdef QK_FP4
  if (QK) { k01 = lds1(k1, 0); }
#else
  if (QK) { k01 = lds2(k2, k3, 0); }
#endif
  if (PV) { o[1] = MFMA8(pa, vf1, o[1]); vf3 = lds2(v0, v1, 6144); PP_PAD(); }
#ifdef QK_FP4
  if (QK) { k11 = lds1(k1, 2048);
            n0 = MFMA4Q(k00, qf[0], minit); PP_PADQ(); n1 = MFMA4Q(k10, qf[0], minit); PP_PADQ(); n0 = MFMA4Q(k01, qf[1], n0); PP_PADQ(); n1 = MFMA4Q(k11, qf[1], n1); PP_PADQ(); }
#else
  if (QK) { k11 = lds2(k2, k3, 4096);
            n0 = MFMA8Q(k00, qf[0], minit); PP_PAD(); n1 = MFMA8Q(k10, qf[0], minit); PP_PAD(); n0 = MFMA8Q(k01, qf[1], n0); PP_PAD(); n1 = MFMA8Q(k11, qf[1], n1); PP_PAD(); }
#endif
  if (PV) { o[2] = MFMA8(pa, vf2, o[2]); PP_PAD(); o[3] = MFMA8(pa, vf3, o[3]); PP_PAD(); ol = MFMA8(pa, ones, ol); }
}
template <bool FIRST>
__device__ __forceinline__ void pp_vseg(f32x16* o, f32x16& ol, f32x16& n0, f32x16& n1, f32x16& minit, i32x8& pa, float* al_l, const int r32, const int hi) {
  asm volatile("" : "+v"(n0), "+v"(n1));
  const float pmax = psm_max(n0, n1);
  if (FIRST || !__all(pmax <= PSH8 + THR8)) {
    const float delta = FIRST ? pmax - PSH8 : fmaxf(pmax - PSH8, 0.f);
#pragma unroll
    for (int r = 0; r < 16; ++r) { n0[r] -= delta; n1[r] -= delta; minit[r] -= delta; }
    if (!FIRST) {
      const float alpha = __builtin_amdgcn_exp2f(-delta);
      if (hi == 0) al_l[r32] = alpha;
      asm volatile("s_waitcnt lgkmcnt(0)" ::: "memory");
#pragma unroll
      for (int r = 0; r < 16; ++r) { const float a_ = al_l[crow(r, hi)]; o[0][r] *= a_; o[1][r] *= a_; o[2][r] *= a_; o[3][r] *= a_; ol[r] *= a_; }
    }
  }
#pragma unroll
  for (int r = 0; r < 16; ++r) n0[r] = __builtin_amdgcn_exp2f(n0[r]);
#pragma unroll
  for (int r = 0; r < 16; ++r) n1[r] = __builtin_amdgcn_exp2f(n1[r]);
#pragma unroll
  for (int w = 0; w < 4; ++w) { int t0_, t1_; asm volatile("" : "=v"(t0_), "=v"(t1_));
    t0_ = __builtin_amdgcn_cvt_pk_fp8_f32(n0[4 * w], n0[4 * w + 1], t0_, false); pa[w] = __builtin_amdgcn_cvt_pk_fp8_f32(n0[4 * w + 2], n0[4 * w + 3], t0_, true);
    t1_ = __builtin_amdgcn_cvt_pk_fp8_f32(n1[4 * w], n1[4 * w + 1], t1_, false); pa[4 + w] = __builtin_amdgcn_cvt_pk_fp8_f32(n1[4 * w + 2], n1[4 * w + 3], t1_, true); }
  asm volatile("" : "+v"(pa));
}
__device__ __forceinline__ void attn_f8pp_body(const unsigned char* __restrict__ Qb, const unsigned char* __restrict__ KV, const bf16* __restrict__ Gb, bf16* __restrict__ Ob, int seq, char* lds, const int wid) {
  int lane_l; asm volatile("v_mbcnt_lo_u32_b32 %0, -1, 0\n\tv_mbcnt_hi_u32_b32 %0, -1, %0" : "=v"(lane_l));
  const int lane = lane_l, r32 = lane & 31, hi = lane >> 5;
  const int ldsb = (int)(unsigned)(uintptr_t)lds;
  float* al_l = (float*)(lds + PP_AL) + wid * 32;
  int grp, w4;
  { int* sid = (int*)(lds + PP_AL + 1024);
    const int mine = (int)__builtin_amdgcn_s_getreg(2308);
    if (lane == 0) sid[wid] = mine;
    __syncthreads();
    int g[8], n0c = 0;
#pragma unroll
    for (int u = 0; u < 8; ++u) { const int su = __builtin_amdgcn_readfirstlane(sid[u]); int c = 0;
#pragma unroll
      for (int t = 0; t < 8; ++t) if (t < u) c += (__builtin_amdgcn_readfirstlane(sid[t]) == su) ? 1 : 0;
      g[u] = c; n0c += (c == 0) ? 1 : 0; }
    bool ok = (n0c == 4);
#pragma unroll
    for (int u = 0; u < 8; ++u) ok = ok && (g[u] <= 1);
    int gm = 0, rk = 0;
#pragma unroll
    for (int u = 0; u < 8; ++u) { if (u == wid) gm = g[u]; }
#pragma unroll
    for (int u = 0; u < 8; ++u) { if (u < wid && g[u] == gm) ++rk; }
    grp = ok ? gm : (wid >> 2); w4 = ok ? rk : (wid & 3);
    grp = __builtin_amdgcn_readfirstlane(grp); w4 = __builtin_amdgcn_readfirstlane(w4);
    __syncthreads(); }
  f32x16 o[4] = {}, ol = {}, minit, n0, n1; i32x8 qf[2], ones, pa, vf0, vf1;
#pragma unroll
  for (int r = 0; r < 16; ++r) minit[r] = PSH8;
  { int one4 = 0x38383838; asm volatile("" : "+v"(one4));
#pragma unroll
    for (int r = 0; r < 8; ++r) ones[r] = one4; }
#pragma unroll
  for (int r = 0; r < 8; ++r) { pa[r] = 0; vf0[r] = 0; vf1[r] = 0; }
  asm volatile("" : "+v"(ones));
#ifdef QK_FP4
  const int vg = (r32 >> 2) & 3, ka = r32 * 64 + ((hi ^ vg) << 4), ka1 = ka ^ 32, ka2 = 0, ka3 = 0, va = r32 * 64 + (((2 * hi) ^ vg) << 4), va1 = va ^ 16;
#else
  const int kf = (r32 >> 1) & 7, ka = r32 * 128 + (((2 * hi) ^ kf) << 4), vg = (r32 >> 2) & 3, va = r32 * 64 + (((2 * hi) ^ vg) << 4);
  const int ka1 = ka ^ 16, ka2 = ka ^ 64, ka3 = ka ^ 80, va1 = va ^ 16;
#endif
  const int kbase = ldsb + PP_KR, vbase = ldsb + PP_VR;
#ifdef QK_FP4
  const unsigned char* gsrc = KV + (grp ? PP_KIMG + 2 * w4 * 1024 : w4 * 1024) + lane * 16;
  const int ldst = ldsb + (grp ? PP_VR + 2 * w4 * 1024 : PP_KR + w4 * 1024);
#define PP_DMA(tile, slot) do { const unsigned char* g_ = gsrc + (long)(tile) * PP_TIMG; const int d_ = ldst + (slot) * (grp ? 8192 : PP_KIMG); \
    __builtin_amdgcn_global_load_lds((const unsigned*)g_, (__attribute__((address_space(3))) unsigned*)(uintptr_t)(unsigned)d_, 16, 0, 0); \
    if (grp) __builtin_amdgcn_global_load_lds((const unsigned*)(g_ + 1024), (__attribute__((address_space(3))) unsigned*)(uintptr_t)(unsigned)(d_ + 1024), 16, 0, 0); } while (0)
#else
  const unsigned char* gsrc = KV + (grp * 8 + 2 * w4) * 1024 + lane * 16;
  const int ldst = ldsb + (grp ? PP_VR : PP_KR) + 2 * w4 * 1024;
#define PP_DMA(tile, slot) do { const unsigned char* g_ = gsrc + (long)(tile) * PP_TIMG; const int d_ = ldst + (slot) * 8192; \
    __builtin_amdgcn_global_load_lds((const unsigned*)g_, (__attribute__((address_space(3))) unsigned*)(uintptr_t)(unsigned)d_, 16, 0, 0); \
    __builtin_amdgcn_global_load_lds((const unsigned*)(g_ + 1024), (__attribute__((address_space(3))) unsigned*)(uintptr_t)(unsigned)(d_ + 1024), 16, 0, 0); } while (0)
#endif
#define PP_BAR() do { SBAR(); __builtin_amdgcn_s_barrier(); SBAR(); } while (0)
#define PP_KOFF(s_) ((s_) / (8192 / PP_KIMG))
  const int NT = seq / KVBLK;
  PP_DMA(0, 0); PP_DMA(1, 1);
#ifdef QK_FP4
  { const unsigned char* Qw = Qb + (long)(wid * QBLK + r32) * LDQ4 + hi * 16;
#pragma unroll
    for (int s = 0; s < 2; ++s) { const i32x4 a = *reinterpret_cast<const i32x4*>(Qw + 32 * s); qf[s] = (i32x8){a[0], a[1], a[2], a[3], 0, 0, 0, 0}; } }
#else
  { const unsigned char* Qw = Qb + (long)(wid * QBLK + r32) * LDQ8 + hi * 32;
#pragma unroll
    for (int s = 0; s < 2; ++s) { const i32x4 a = *reinterpret_cast<const i32x4*>(Qw + 64 * s), b = *reinterpret_cast<const i32x4*>(Qw + 64 * s + 16); qf[s] = (i32x8){a[0], a[1], a[2], a[3], b[0], b[1], b[2], b[3]}; } }
#endif
  asm volatile("s_waitcnt vmcnt(0)" ::: "memory");
  __syncthreads();
  if (grp == 1) PP_BAR();
  int sa = 0, sb = 8192, sc = 16384;
  { const int kb_ = kbase + PP_KOFF(sa); pp_mseg<true, false>(o, ol, n0, n1, pa, ones, qf, minit, vf0, vf1, kb_ + ka, kb_ + ka1, kb_ + ka2, kb_ + ka3, 0, 0); }
  asm volatile("" : "+v"(n0), "+v"(n1)); PP_BAR();
  asm volatile("s_waitcnt vmcnt(0)" ::: "memory"); PP_DMA(2, 2);
  pp_vseg<true>(o, ol, n0, n1, minit, pa, al_l, r32, hi);
  { const int vb_ = vbase + sa; vf0 = lds2(vb_ + va, vb_ + va1, 0); vf1 = lds2(vb_ + va, vb_ + va1, 2048); }
  PP_BAR();
  { const int t = sa; sa = sb; sb = sc; sc = t; }
  for (int j = 1; j < NT; ++j) {
    { const int kb_ = kbase + PP_KOFF(sa), vb_ = vbase + sc;
      pp_mseg<true, true>(o, ol, n0, n1, pa, ones, qf, minit, vf0, vf1, kb_ + ka, kb_ + ka1, kb_ + ka2, kb_ + ka3, vb_ + va, vb_ + va1); }
    asm volatile("" : "+v"(n0), "+v"(n1), "+v"(o[0]), "+v"(o[1]), "+v"(o[2]), "+v"(o[3]), "+v"(ol)); PP_BAR();
    asm volatile("s_waitcnt vmcnt(0)" ::: "memory");
    { const int tl = (j + 2 < NT) ? j + 2 : NT - 1; PP_DMA(tl, sc >> 13); }
    pp_vseg<false>(o, ol, n0, n1, minit, pa, al_l, r32, hi);
    { const int vb_ = vbase + sa; vf0 = lds2(vb_ + va, vb_ + va1, 0); vf1 = lds2(vb_ + va, vb_ + va1, 2048); }
    PP_BAR();
    { const int t = sa; sa = sb; sb = sc; sc = t; }
  }
  { const int vb_ = vbase + sc; pp_mseg<false, true>(o, ol, n0, n1, pa, ones, qf, minit, vf0, vf1, 0, 0, 0, 0, vb_ + va, vb_ + va1); }
  if (grp == 0) PP_BAR();
  asm volatile("s_waitcnt vmcnt(0)" ::: "memory");
  float rli[16];
#pragma unroll
  for (int r = 0; r < 16; ++r) rli[r] = __builtin_amdgcn_rcpf(ol[r]);
  __syncthreads();
  epi_stage_store<1>(o, rli, (__attribute__((address_space(3))) unsigned char*)(uintptr_t)(unsigned)(uintptr_t)lds + wid * EPI_BYTES, Gb + (long)(wid * QBLK) * LDQ, Ob + (long)(wid * QBLK) * LDO, lane);
  __syncthreads();
#undef PP_DMA
#undef PP_BAR
#undef PP_KOFF
}
#undef MFMA8
#undef MFMA8Q

#undef KSWZ
#undef SBAR
}

__device__ __forceinline__ float bflo(unsigned w) { return __uint_as_float(w << 16); }
__device__ __forceinline__ float bfhi(unsigned w) { return __uint_as_float(w & 0xffff0000u); }
__device__ __forceinline__ float silu_f(float x) { return x / (1.f + __expf(-x)); }
__device__ __forceinline__ float wave_max(float v) {
#pragma unroll
    for (int o = 1; o < 64; o <<= 1) v = fmaxf(v, __shfl_xor(v, o));
    return v;
}
__device__ __forceinline__ int t5_bucket(int rel) {
    const int n = rel < 0 ? -rel : rel; const float nf = (float)(n > 1 ? n : 1);
    int large = 8 + (int)(logf(nf * 0.125f) / 4.852030263919617f * 8.0f); large = large < 15 ? large : 15;
    return (rel > 0 ? 16 : 0) + (n < 8 ? n : large);
}

struct Args { const float* in[12]; float* out; unsigned char* ws; };

__device__ __forceinline__ void p0_prologue(const Args& a, LAS unsigned char* lds, int wave, int vcu, int G) {
    const int lane = fresh_lane(), tid = wave * 64 + lane;
    const float* c = a.in[1]; const float* w_mod = a.in[2]; const float* w_in = a.in[6]; const float* w_out = a.in[7]; const float* rel_bias = a.in[11];
    float* modp = (float*)(a.ws + WS_MODP);
    float* tab = (float*)(a.ws + WS_TAB);
    bf16* Win_t = (bf16*)(a.ws + WS_WIN); bf16* Wout_t = (bf16*)(a.ws + WS_WOUT);
    const int gt = vcu * (NWAVES * 64) + tid, NGT = G * NWAVES * 64;
    for (int e = gt; e < A_H * 3 * LUTA_N; e += NGT) { const int idx = e % LUTA_N, hp = e / LUTA_N, p = hp % 3, h = hp / 3, kk = idx - 92;
        float v = -1e30f; if (kk >= -64 && kk <= 64) v = rel_bias[t5_bucket(kk * (1 << (2 * p))) * (A_H + B_H) + h] * LOG2E;
        tab[TB_LUTA + e] = v; }
    for (int e = gt; e < B_H * LUTB_N; e += NGT) { const int idx = e % LUTB_N, h = e / LUTB_N, kk = idx - 156;
        float v = -1e30f; if (kk >= -128 && kk <= 128) v = rel_bias[t5_bucket(kk) * (A_H + B_H) + A_H + h] * LOG2E;
        tab[TB_LUTB + e] = v; }
    for (int e = gt; e < (256 + 64) * 32; e += NGT) { const int j = e & 31, pp = e >> 5, pos = pp < 256 ? pp : pp - 256;
        const float freq = exp2f(-(float)j * 0.4152410118609203f);
        const float ang = (float)pos * freq;
        double rev = (double)ang * 0.15915494309189535; rev -= floor(rev);
        const float cs_ = __builtin_amdgcn_cosf((float)rev), sn_ = __builtin_amdgcn_sinf((float)rev);
        float* d = tab + (pp < 256 ? TB_ROPE_R : TB_ROPE_C) + (pos * 32 + j) * 2; d[0] = cs_; d[1] = sn_; }
    LAS float* cs = (LAS float*)lds;
    LAS float* red = (LAS float*)(lds + 16384);
    for (int k = tid; k < DM; k += NWAVES * 64) cs[k] = silu_f(c[k]);
    __syncthreads();
#ifndef REP_GEMV
#define REP_GEMV 1
#endif
    for (int rep = 0; rep < REP_GEMV; ++rep)
    for (int it = vcu; it < DEPTH * 48 * 4; it += G) {
        const int kq = it & 3, nc = (it >> 2) % 48, ly = it / 192, k0 = kq * 1024 + wave * 128;
        const float* W = w_mod + (size_t)ly * DM * NMOD + (size_t)k0 * NMOD + nc * 256 + lane * 4;
        f32x4 acc = (f32x4){0.f, 0.f, 0.f, 0.f};
#pragma unroll 8
        for (int k = 0; k < 128; ++k) { const f32x4 w = *(const GAS f32x4*)(W + (size_t)k * NMOD); acc += w * cs[k0 + k]; }
        *(LAS f32x4*)(red + wave * 256 + lane * 4) = acc;
        __syncthreads();
        if (tid < 256) { float s = 0.f;
#pragma unroll
            for (int w = 0; w < NWAVES; ++w) s += red[w * 256 + tid];
            modp[(size_t)kq * DEPTH * NMOD + ly * NMOD + nc * 256 + tid] = s; }
        __syncthreads();
    }
    LAS float* scr = (LAS float*)(lds + wave * 16384);
    const int gw = vcu * NWAVES + wave, NGW = G * NWAVES;
    constexpr int I_IN = (DM / 64) * (INW / 32), I_OUT = (DM / 64) * (DM / 32), I_L = I_IN + I_OUT;
#ifndef REP_TR
#define REP_TR 1
#endif
    gu32* ctlw = (gu32*)(a.ws + WS_CTL);
    float amx = 0.f; int aly = -1;
#define AMX_FLUSH() do { if (aly >= 0) { float m_ = amx; for (int o_ = 1; o_ < 64; o_ <<= 1) m_ = fmaxf(m_, __shfl_xor(m_, o_)); \
        if (lane == 0) (void)__hip_atomic_fetch_max((unsigned*)(ctlw + CW_AMAX + 64 * aly), __builtin_bit_cast(unsigned, m_), RLX_AGENT); } } while (0)
    for (int rep = 0; rep < REP_TR; ++rep)
    for (int it = gw; it < DEPTH * I_L; it += NGW) {
        const int ly = it / I_L, r = it - ly * I_L;
        if (ly != aly) { AMX_FLUSH(); amx = 0.f; aly = ly; }
        if (r < I_IN) { const int n0 = 32 * (r % (INW / 32));
                        const int off = proj_col_of(n0) - n0;
                        if (proj_col_of(n0) >= F8_COL0) p0_transpose_item<true>(w_in + (size_t)ly * DM * INW, DM, INW, Win_t + (size_t)ly * INW * DM, off, scr, r, lane, amx);
                        else p0_transpose_item<false>(w_in + (size_t)ly * DM * INW, DM, INW, Win_t + (size_t)ly * INW * DM, off, scr, r, lane, amx); }
        else p0_transpose_item<false>(w_out + (size_t)ly * DM * DM, DM, DM, Wout_t + (size_t)ly * DM * DM, 0, scr, r - I_IN, lane, amx);
    }
    AMX_FLUSH();
#undef AMX_FLUSH
}

__device__ __forceinline__ int w8_exp(const Args& a, int layer) {
    const unsigned b = __hip_atomic_load((unsigned*)((gu32*)(a.ws + WS_CTL) + CW_AMAX + 64 * layer), RLX_AGENT);
    int e = 7 - ((int)(b >> 23) - 127); e = e > 60 ? 60 : (e < -60 ? -60 : e);
    return __builtin_amdgcn_readfirstlane(e);
}
__device__ __forceinline__ void w8_phase(const Args& a, int wave, int vcu, int G) {
    const int lane = fresh_lane();
    const bf16* Win_t = (const bf16*)(a.ws + WS_WIN); unsigned char* W8 = (unsigned char*)(a.ws + WS_W8);
    const int gw = vcu * NWAVES + wave, NGW = G * NWAVES;
    for (int row = gw; row < DEPTH * F8_COLS; row += NGW) {
        const int ly = row / F8_COLS, n = row % F8_COLS;
        const float sc = __builtin_bit_cast(float, (unsigned)(w8_exp(a, ly) + 127) << 23);
        const bf16* src = Win_t + ((size_t)ly * INW + F8_COL0 + n) * DM + lane * 8; unsigned char* dst = W8 + ((size_t)ly * F8_COLS + n) * DM + lane * 8;
        pg8::u32x4 r_[8];
#pragma unroll
        for (int j = 0; j < 8; ++j) r_[j] = *(const pg8::u32x4*)(src + j * 512);
#pragma unroll
        for (int j = 0; j < 8; ++j) {
            int lo = __builtin_amdgcn_cvt_pk_fp8_f32(bflo(r_[j].x) * sc, bfhi(r_[j].x) * sc, 0, false); lo = __builtin_amdgcn_cvt_pk_fp8_f32(bflo(r_[j].y) * sc, bfhi(r_[j].y) * sc, lo, true);
            int hi = __builtin_amdgcn_cvt_pk_fp8_f32(bflo(r_[j].z) * sc, bfhi(r_[j].z) * sc, 0, false); hi = __builtin_amdgcn_cvt_pk_fp8_f32(bflo(r_[j].w) * sc, bfhi(r_[j].w) * sc, hi, true);
            u32x2 w; w.x = (unsigned)lo; w.y = (unsigned)hi; *(u32x2*)(dst + j * 512) = w; }
    }
}

__device__ __forceinline__ void norm_phase(const Args& a, LAS unsigned char* lds, int layer_post, int layer_pre, const float* xin, int wave, int vcu, int G, bool dummy = false) {
    const int lane = fresh_lane(), tid = wave * 64 + lane;
    LAS float* Gv = (LAS float*)lds; LAS float* Av = Gv + DM; LAS float* Bv = Av + DM;
    const float* modp = (const float*)(a.ws + WS_MODP);
#define MOD4(i) (((*(const f32x4*)(modp + (i)) + *(const f32x4*)(modp + DEPTH * NMOD + (i))) + *(const f32x4*)(modp + 2 * DEPTH * NMOD + (i))) + *(const f32x4*)(modp + 3 * DEPTH * NMOD + (i)))
    const float* b_mod = a.in[3]; const float* pre_g = a.in[4]; const float* post_g = a.in[5];
#pragma unroll
    for (int hf = 0; hf < 2; ++hf) { const int j = tid * 8 + 4 * hf;
        if (layer_post >= 0) *(LAS f32x4*)(Gv + j) = (MOD4(layer_post * NMOD + 2 * DM + j) + *(const f32x4*)(b_mod + layer_post * NMOD + 2 * DM + j)) * *(const f32x4*)(post_g + layer_post * DM + j);
        if (layer_pre >= 0) { *(LAS f32x4*)(Av + j) = *(const f32x4*)(pre_g + layer_pre * DM + j) * (1.f + MOD4(layer_pre * NMOD + DM + j) + *(const f32x4*)(b_mod + layer_pre * NMOD + DM + j));
                              *(LAS f32x4*)(Bv + j) = MOD4(layer_pre * NMOD + j) + *(const f32x4*)(b_mod + layer_pre * NMOD + j); } }
#undef MOD4
    __syncthreads();
    const bf16* Y = (const bf16*)(a.ws + WS_Y); bf16* H = (bf16*)(a.ws + (dummy ? WS_END + 256 * MiB : WS_H)); float* xout = dummy ? (float*)(a.ws + WS_END) : a.out;
    const int gw = vcu * NWAVES + wave, NGW = G * NWAVES;
    for (int row = gw; row < S; row += NGW) {
        const GAS f32x4* xr = (const GAS f32x4*)(xin + (size_t)row * DM) + lane;
        f32x4 v[16];
#pragma unroll
        for (int j = 0; j < 16; ++j) v[j] = xr[64 * j];
        if (layer_post >= 0) {
            const GAS u32x2* yr = (const GAS u32x2*)(Y + (size_t)row * DM) + lane;
            u32x2 yv[16]; float ss = 0.f;
#pragma unroll
            for (int j = 0; j < 16; ++j) { yv[j] = yr[64 * j]; const float y0 = bflo(yv[j].x), y1 = bfhi(yv[j].x), y2 = bflo(yv[j].y), y3 = bfhi(yv[j].y); ss += (y0 * y0 + y1 * y1) + (y2 * y2 + y3 * y3); }
            const float ry = rsqrtf(wave_sum_l(ss, lane) * (1.f / DM) + EPS);
            GAS f32x4* xo = (GAS f32x4*)(xout + (size_t)row * DM) + lane;
#pragma unroll
            for (int j = 0; j < 16; ++j) { const f32x4 g = *(const LAS f32x4*)(Gv + j * 256 + lane * 4);
                const f32x4 yf = (f32x4){bflo(yv[j].x), bfhi(yv[j].x), bflo(yv[j].y), bfhi(yv[j].y)};
                v[j] = v[j] + g * yf * ry; xo[64 * j] = v[j]; }
        }
        if (layer_pre >= 0) {
            float ss = 0.f;
#pragma unroll
            for (int j = 0; j < 16; ++j) ss += (v[j].x * v[j].x + v[j].y * v[j].y) + (v[j].z * v[j].z + v[j].w * v[j].w);
            const float rx = rsqrtf(wave_sum_l(ss, lane) * (1.f / DM) + EPS);
            GAS u32x2* ho = (GAS u32x2*)(H + (size_t)row * DM) + lane;
            GAS int* h8o = (GAS int*)((unsigned char*)(a.ws + (dummy ? WS_END + 320 * MiB : WS_H8)) + (size_t)row * DM) + lane;
#pragma unroll
            for (int j = 0; j < 16; ++j) { const f32x4 av = *(const LAS f32x4*)(Av + j * 256 + lane * 4), bv = *(const LAS f32x4*)(Bv + j * 256 + lane * 4);
                const f32x4 hv = v[j] * rx * av + bv; u32x2 w; w.x = pg8::cvt_pk_bf16(hv.x, hv.y); w.y = pg8::cvt_pk_bf16(hv.z, hv.w); ho[64 * j] = w;
                int w8_ = __builtin_amdgcn_cvt_pk_fp8_f32(hv.x, hv.y, 0, false); w8_ = __builtin_amdgcn_cvt_pk_fp8_f32(hv.z, hv.w, w8_, true); h8o[64 * j] = w8_; }
        }
    }
    __syncthreads();
}

__device__ __forceinline__ void prep_phase(const Args& a, LAS unsigned char* lds, int layer, int wave, int vcu, int G) {
    const int lane = fresh_lane();
    bf16* proj = (bf16*)(a.ws + WS_PROJ); const float* tab = (const float*)(a.ws + WS_TAB);
    const float* qg = a.in[8] + layer * HD; const float* kg = a.in[9] + layer * HD;
    const int l16 = lane & 15, half = l16 >> 3, jj = (l16 & 7) * 4, grp = lane >> 4;
    const f32x4 gq1 = *(const f32x4*)(qg + half * 64 + jj), gq2 = *(const f32x4*)(qg + half * 64 + 32 + jj);
    const f32x4 gk1 = *(const f32x4*)(kg + half * 64 + jj), gk2 = *(const f32x4*)(kg + half * 64 + 32 + jj);
    const int gw = vcu * NWAVES + wave, NGW = G * NWAVES;
    for (int t = gw; t < S; t += NGW) {
        const int pos = half ? (t & 63) : (t >> 6);
        const float* rt = tab + (half ? TB_ROPE_C : TB_ROPE_R) + (pos * 32 + jj) * 2;
        const f32x4 cs0 = *(const f32x4*)rt, cs1 = *(const f32x4*)(rt + 4);
        const f32x4 cv = (f32x4){cs0.x, cs0.z, cs1.x, cs1.z}, sv = (f32x4){cs0.y, cs0.w, cs1.y, cs1.w};
#pragma unroll
        for (int it = 0; it < 4; ++it) {
            const int hh = it * 4 + grp;
            bf16* p = proj + (size_t)t * PLD + PC(COL_CQ + hh * HD) + half * 64 + jj;
            const u32x2 r1 = *(const u32x2*)p, r2 = *(const u32x2*)(p + 32);
            const f32x4 x1 = (f32x4){bflo(r1.x), bfhi(r1.x), bflo(r1.y), bfhi(r1.y)}, x2 = (f32x4){bflo(r2.x), bfhi(r2.x), bflo(r2.y), bfhi(r2.y)};
            float ss = (x1.x * x1.x + x1.y * x1.y) + (x1.z * x1.z + x1.w * x1.w) + (x2.x * x2.x + x2.y * x2.y) + (x2.z * x2.z + x2.w * x2.w);
            ss += lane_xor(ss, 1, lane); ss += lane_xor(ss, 2, lane); ss += lane_xor(ss, 4, lane); ss += lane_xor(ss, 8, lane);
            const float r = rsqrtf(ss * (1.f / HD) + EPS);
            const f32x4 g1 = (it == 3) ? gk1 : gq1, g2 = (it == 3) ? gk2 : gq2;
            const f32x4 y1 = x1 * r * g1, y2 = x2 * r * g2;
            const f32x4 o1_ = y1 * cv - y2 * sv, o2_ = y2 * cv + y1 * sv;
#ifndef ATT_F8
            const f32x4 o1 = o1_, o2 = o2_;
#endif
#ifdef ATT_F8
#if defined(ATT_PP) && defined(QK_FP4)
            { unsigned char* d8; int d8b;
              if (it == 3) { unsigned char* rb = (unsigned char*)(a.ws + WS_KF8) + ((size_t)((hh - 12) * (S / 64) + (t >> 6))) * attc::PP_TIMG + (t & 63) * 64 + (jj >> 1);
                             const int c1 = half * 2, kg = ((t & 63) >> 2) & 3; d8 = rb + ((c1 ^ kg) << 4); d8b = (((c1 + 1) ^ kg) << 4) - ((c1 ^ kg) << 4); }
              else { d8 = (unsigned char*)(a.ws + WS_QF8) + (size_t)t * attc::LDQ4 + hh * 64 + half * 32 + (jj >> 1); d8b = 16; }
              const float qs = (it == 3) ? attc::K4_PRESCALE : attc::Q4_PRESCALE; const f32x4 o1 = o1_ * qs, o2 = o2_ * qs;
              const unsigned a0 = __builtin_amdgcn_cvt_scalef32_pk_fp4_f32(0u, o1.x, o1.y, 1.f, 0) & 0xffu, a1 = __builtin_amdgcn_cvt_scalef32_pk_fp4_f32(0u, o1.z, o1.w, 1.f, 0) & 0xffu;
              const unsigned b0 = __builtin_amdgcn_cvt_scalef32_pk_fp4_f32(0u, o2.x, o2.y, 1.f, 0) & 0xffu, b1 = __builtin_amdgcn_cvt_scalef32_pk_fp4_f32(0u, o2.z, o2.w, 1.f, 0) & 0xffu;
              *(unsigned short*)d8 = (unsigned short)(a0 | (a1 << 8)); *(unsigned short*)(d8 + d8b) = (unsigned short)(b0 | (b1 << 8)); }
#elif defined(ATT_PP)
            unsigned char* d8; int d8b;
            if (it == 3) { unsigned char* rb = (unsigned char*)(a.ws + WS_KF8) + ((size_t)((hh - 12) * (S / 64) + (t >> 6))) * attc::PP_TIMG + (t & 63) * 128 + (jj & 15);
                           const int c1 = half * 4 + (jj >> 4), kf = ((t & 63) >> 1) & 7; d8 = rb + ((c1 ^ kf) << 4); d8b = (((c1 + 2) ^ kf) << 4) - ((c1 ^ kf) << 4); }
            else { d8 = (unsigned char*)(a.ws + WS_QF8) + (size_t)t * (C_H * HD) + hh * HD + half * 64 + jj; d8b = 32; }
            {
#else
            { const int d8b = 32;
              unsigned char* d8 = (it == 3) ? (unsigned char*)(a.ws + WS_KF8) + (size_t)t * 512 + (hh - 12) * HD + half * 64 + jj
                                            : (unsigned char*)(a.ws + WS_QF8) + (size_t)t * (C_H * HD) + hh * HD + half * 64 + jj;
#endif
#if !(defined(ATT_PP) && defined(QK_FP4))
              const float qs = (it == 3) ? 1.f : attc::Q8_PRESCALE; const f32x4 o1 = o1_ * qs, o2 = o2_ * qs;
              int t1 = __builtin_amdgcn_cvt_pk_fp8_f32(o1.x, o1.y, 0, false); t1 = __builtin_amdgcn_cvt_pk_fp8_f32(o1.z, o1.w, t1, true);
              int t2 = __builtin_amdgcn_cvt_pk_fp8_f32(o2.x, o2.y, 0, false); t2 = __builtin_amdgcn_cvt_pk_fp8_f32(o2.z, o2.w, t2, true);
              *(int*)d8 = t1; *(int*)(d8 + d8b) = t2; }
#endif
#else
            u32x2 w1, w2; w1.x = pg8::cvt_pk_bf16(o1.x, o1.y); w1.y = pg8::cvt_pk_bf16(o1.z, o1.w); w2.x = pg8::cvt_pk_bf16(o2.x, o2.y); w2.y = pg8::cvt_pk_bf16(o2.z, o2.w);
            *(u32x2*)p = w1; *(u32x2*)(p + 32) = w2;
#endif
        }
    }
#ifdef ATT_F8
    { typedef attc::bf16x8 bx8; typedef attc::s16x4 sx4;
      unsigned char* VT8 = (unsigned char*)(a.ws + WS_VTF8);
      LAS unsigned char* img = lds + wave * 8192;
      const int lane2 = fresh_lane(), r32 = lane2 & 31, hi = lane2 >> 5, vrow = lane2 >> 4, vch = lane2 & 15;
      LAS unsigned char* vwr = img + (vch >> 2) * 512 + vrow * 64 + (vch & 3) * 16;
      const int vb = (int)(uintptr_t)img + attc::v_rd_base(lane2);
      for (int itv = gw; itv < 4 * (S / 32); itv += NGW) {
        const int kv = itv / (S / 32), t0 = (itv % (S / 32)) * 32;
        bx8 vs[8];
#pragma unroll
        for (int i = 0; i < 8; ++i) vs[i] = *reinterpret_cast<const bx8*>(proj + (size_t)(t0 + vrow + 4 * i) * PLD + PC(COL_CV + kv * HD) + vch * 8);
#pragma unroll
        for (int i = 0; i < 8; ++i) *reinterpret_cast<LAS bx8*>(vwr + (i & 1) * 2048 + ((i >> 1) & 1) * 256 + ((i >> 2) & 1) * 4096) = vs[i];
#ifdef ATT_PP
        const int vg = (r32 >> 2) & 3, c_lo = (t0 >> 5) & 1;
        unsigned char* rowp = (unsigned char*)(a.ws + WS_KF8) + ((size_t)(kv * (S / 64) + (t0 >> 6))) * attc::PP_TIMG + attc::PP_KIMG + r32 * 64 + ((c_lo ^ vg) << 4) + 4 * hi;
        const int hi_off = (((c_lo + 2) ^ vg) << 4) - ((c_lo ^ vg) << 4);
#else
        const int hi_off = 32;
        unsigned char* rowp = VT8 + (size_t)kv * HD * S + (size_t)(t0 >> 6) * 8192 + r32 * 64 + ((t0 & 32) ? 16 : 0) + 4 * hi;
#endif
#define VTR8(D0, KS) do { const sx4 l_ = attc::tr_read<attc::v_rd_off(D0, KS, 0)>(vb), h_ = attc::tr_read<attc::v_rd_off(D0, KS, 1)>(vb); asm volatile("s_waitcnt lgkmcnt(0)" ::: "memory"); __builtin_amdgcn_sched_barrier(0); \
          int lo_ = __builtin_amdgcn_cvt_pk_fp8_f32(__uint_as_float((unsigned)(unsigned short)l_[0] << 16), __uint_as_float((unsigned)(unsigned short)l_[1] << 16), 0, false); \
          lo_ = __builtin_amdgcn_cvt_pk_fp8_f32(__uint_as_float((unsigned)(unsigned short)l_[2] << 16), __uint_as_float((unsigned)(unsigned short)l_[3] << 16), lo_, true); \
          int hi_ = __builtin_amdgcn_cvt_pk_fp8_f32(__uint_as_float((unsigned)(unsigned short)h_[0] << 16), __uint_as_float((unsigned)(unsigned short)h_[1] << 16), 0, false); \
          hi_ = __builtin_amdgcn_cvt_pk_fp8_f32(__uint_as_float((unsigned)(unsigned short)h_[2] << 16), __uint_as_float((unsigned)(unsigned short)h_[3] << 16), hi_, true); \
          unsigned char* q_ = rowp + (D0 * 32) * 64 + 8 * KS; *(int*)q_ = lo_; *(int*)(q_ + hi_off) = hi_; } while (0)
        VTR8(0, 0); VTR8(0, 1); VTR8(1, 0); VTR8(1, 1); VTR8(2, 0); VTR8(2, 1); VTR8(3, 0); VTR8(3, 1);
#undef VTR8
        asm volatile("s_waitcnt lgkmcnt(0)" ::: "memory");
      } }
#endif
}

template <bool IS_B>
__device__ __forceinline__ void naive_band(const bf16* proj, bf16* o, const float* lut, float sink_l2, int t, int qcol, int kcol, int vcol, int gcol, int ocol,
                                           LAS float* sc, LAS int* jr, int lane) {
    constexpr int NS = IS_B ? 257 : 387;
    const int l16 = lane & 15, grp = lane >> 4;
    float qf[8];
    { const pg8::u32x4 qraw = *(const pg8::u32x4*)(proj + (size_t)t * INW + qcol + l16 * 8);
      qf[0] = bflo(qraw.x) * QK_C; qf[1] = bfhi(qraw.x) * QK_C; qf[2] = bflo(qraw.y) * QK_C; qf[3] = bfhi(qraw.y) * QK_C;
      qf[4] = bflo(qraw.z) * QK_C; qf[5] = bfhi(qraw.z) * QK_C; qf[6] = bflo(qraw.w) * QK_C; qf[7] = bfhi(qraw.w) * QK_C; }
    for (int s0 = 0; s0 < NS; s0 += 4) {
        const int s = s0 + grp; const bool inr = s < NS; const int ss = inr ? s : NS - 1;
        int j, li;
        if (IS_B) { j = t + ss - 128; li = ss + 28; }
        else { const int p = ss / 129, kk = ss - p * 129; j = t + (kk - 64) * (1 << (2 * p)); li = p * LUTA_N + kk + 28; }
        const bool valid = inr && j >= 0 && j < S;
        const int jc = j < 0 ? 0 : (j > S - 1 ? S - 1 : j);
        const pg8::u32x4 kr = *(const pg8::u32x4*)(proj + (size_t)jc * INW + kcol + l16 * 8);
        float d = qf[0] * bflo(kr.x) + qf[1] * bfhi(kr.x) + qf[2] * bflo(kr.y) + qf[3] * bfhi(kr.y) + qf[4] * bflo(kr.z) + qf[5] * bfhi(kr.z) + qf[6] * bflo(kr.w) + qf[7] * bfhi(kr.w);
        d += lane_xor(d, 1, lane); d += lane_xor(d, 2, lane); d += lane_xor(d, 4, lane); d += lane_xor(d, 8, lane);
        const float sv = valid ? d + lut[li] : -1e30f;
        if (l16 == 0 && inr) { sc[s] = sv; jr[s] = jc; }
    }
    float mx = -1e30f;
    for (int s = lane; s < NS; s += 64) mx = fmaxf(mx, sc[s]);
    mx = wave_max_l(mx, lane); if (IS_B) mx = fmaxf(mx, sink_l2);
    float lsum = 0.f;
    for (int s = lane; s < NS; s += 64) { const float p = exp2f(sc[s] - mx); sc[s] = p; lsum += p; }
    lsum = wave_sum_l(lsum, lane); if (IS_B) lsum += exp2f(sink_l2 - mx);
    float a0 = 0.f, a1 = 0.f;
#pragma unroll 4
    for (int s = 0; s < NS; ++s) { const float p = sc[s]; const int j = jr[s];
        const unsigned v = *(const unsigned*)(proj + (size_t)j * INW + vcol + lane * 2); a0 += p * bflo(v); a1 += p * bfhi(v); }
    const unsigned g = *(const unsigned*)(proj + (size_t)t * INW + gcol + lane * 2);
    const float inv = 1.f / lsum;
    *(unsigned*)(o + (size_t)t * DM + ocol + lane * 2) = pg8::cvt_pk_bf16(a0 * inv * silu_f(bflo(g)), a1 * inv * silu_f(bfhi(g)));
}

__device__ __forceinline__ void naive_ab_phase(const Args& a, LAS unsigned char* lds, int layer, int wave, int vcu, int G) {
    const int lane = fresh_lane();
    const bf16* proj = (const bf16*)(a.ws + WS_PROJ); bf16* o = (bf16*)(a.ws + WS_O); const float* tab = (const float*)(a.ws + WS_TAB);
    const float* sink = a.in[10] + layer * B_H;
    LAS float* sc = (LAS float*)(lds + wave * 4096); LAS int* jr = (LAS int*)(lds + wave * 4096 + 2048);
    const int gw = vcu * NWAVES + wave, NGW = G * NWAVES;
    for (int t = gw; t < S; t += NGW) {
        for (int h = 0; h < A_H; ++h)
            naive_band<false>(proj, o, tab + TB_LUTA + h * 3 * LUTA_N, 0.f, t, COL_AQ + h * HD, COL_AK + h * HD, COL_AV + h * HD, COL_AG + h * HD, OCOL_A + h * HD, sc, jr, lane);
        for (int h = 0; h < B_H; ++h)
            naive_band<true>(proj, o, tab + TB_LUTB + h * LUTB_N, sink[h] * LOG2E, t, COL_BQ + h * HD, COL_BK + (h >> 2) * HD, COL_BV + (h >> 2) * HD, COL_BG + h * HD, OCOL_B + h * HD, sc, jr, lane);
    }
}

namespace band {
using attc::bf16x8; using attc::s16x4; using attc::f32x16; using attc::u32x4; using attc::crow; using attc::cvtpk; using attc::v_rd_base; using attc::v_rd_off; using attc::tr_read;
constexpr float THR2 = 8.f;
constexpr int KPITCH = 272;
constexpr int WAVE_LDS = 8192 + 32 * KPITCH;
static_assert(WAVE_LDS >= attc::EPI_BYTES, "O stage fits the per-wave region");
enum Mode { P16 = 0, P4 = 1, P1 = 2, MB = 3 };
constexpr int A_ROW = A_H * HD;
template <int D0> __device__ __forceinline__ void pv32(f32x16& od, int vb, bf16x8 pa0, bf16x8 pa1) {
  const s16x4 l0 = tr_read<v_rd_off(D0, 0, 0)>(vb), h0 = tr_read<v_rd_off(D0, 0, 1)>(vb), l1 = tr_read<v_rd_off(D0, 1, 0)>(vb), h1 = tr_read<v_rd_off(D0, 1, 1)>(vb);
  asm volatile("s_waitcnt lgkmcnt(0)" ::: "memory"); __builtin_amdgcn_sched_barrier(0);
#define PK(L, H) (bf16x8){L[0], L[1], L[2], L[3], H[0], H[1], H[2], H[3]}
  od = __builtin_amdgcn_mfma_f32_32x32x16_bf16(pa0, PK(l0, h0), od, 0, 0, 0);
  od = __builtin_amdgcn_mfma_f32_32x32x16_bf16(pa1, PK(l1, h1), od, 0, 0, 0);
#undef PK
}
__device__ __forceinline__ void epi_stage(const f32x16 (&o)[4], const float (&rli)[16], LAS unsigned char* st, int lane) {
  asm volatile("" : "+v"(lane));
  const int r32 = lane & 31, hi = lane >> 5;
#pragma unroll
  for (int r = 0; r < 16; ++r) { const int row = crow(r, hi);
#pragma unroll
    for (int d0 = 0; d0 < 4; ++d0) *reinterpret_cast<LAS float*>(st + row * attc::EPI_PITCH + (d0 * 32 + r32) * 4) = o[d0][r] * rli[r]; }
}
template <int QS>
__device__ __forceinline__ void epi_partial_out(LAS unsigned char* st, bf16* __restrict__ dst, int lane) {
  typedef float f32x4_t __attribute__((ext_vector_type(4)));
  asm volatile("" : "+v"(lane));
  const int rr = lane >> 4, c16 = lane & 15;
#pragma unroll
  for (int i = 0; i < 8; ++i) { const int row = rr + 4 * i;
    const f32x4_t a = *reinterpret_cast<const LAS f32x4_t*>(st + row * attc::EPI_PITCH + c16 * 32);
    const f32x4_t b = *reinterpret_cast<const LAS f32x4_t*>(st + row * attc::EPI_PITCH + c16 * 32 + 16);
    u32x4 w = {cvtpk(a[0], a[1]), cvtpk(a[2], a[3]), cvtpk(b[0], b[1]), cvtpk(b[2], b[3])};
    *reinterpret_cast<u32x4*>(dst + (size_t)(QS * row) * A_ROW + c16 * 8) = w; }
}
__device__ __forceinline__ void epi_gate_out(LAS unsigned char* st, const u32x4 (&g)[8], bf16* __restrict__ obase, int lane) {
  typedef float f32x4_t __attribute__((ext_vector_type(4)));
  asm volatile("" : "+v"(lane));
  const int rr = lane >> 4, c16 = lane & 15;
#pragma unroll
  for (int i = 0; i < 8; ++i) { const int row = rr + 4 * i;
    const f32x4_t a = *reinterpret_cast<const LAS f32x4_t*>(st + row * attc::EPI_PITCH + c16 * 32);
    const f32x4_t b = *reinterpret_cast<const LAS f32x4_t*>(st + row * attc::EPI_PITCH + c16 * 32 + 16);
    float v[8] = {a[0], a[1], a[2], a[3], b[0], b[1], b[2], b[3]};
#pragma unroll
    for (int e = 0; e < 4; ++e) { const float g0 = __uint_as_float(g[i][e] << 16), g1 = __uint_as_float(g[i][e] & 0xffff0000u);
      v[2 * e] *= g0 * __builtin_amdgcn_rcpf(1.f + __expf(-g0)); v[2 * e + 1] *= g1 * __builtin_amdgcn_rcpf(1.f + __expf(-g1)); }
    u32x4 w = {cvtpk(v[0], v[1]), cvtpk(v[2], v[3]), cvtpk(v[4], v[5]), cvtpk(v[6], v[7])};
    *reinterpret_cast<u32x4*>(obase + (size_t)row * DM + c16 * 8) = w; }
}
__device__ __forceinline__ void epi_merge(LAS unsigned char* st, const LAS float* cw, const bf16* __restrict__ p4, const bf16* __restrict__ p16,
                                          const bf16* __restrict__ gbase, bf16* __restrict__ obase, int lane) {
  typedef float f32x4_t __attribute__((ext_vector_type(4)));
  asm volatile("" : "+v"(lane));
  const int rr = lane >> 4, c16 = lane & 15;
#pragma unroll
  for (int hf = 0; hf < 2; ++hf) {
    u32x4 g[4], x4[4], x16[4];
#pragma unroll
    for (int i = 0; i < 4; ++i) { const int row = rr + 4 * (4 * hf + i);
      g[i] = *reinterpret_cast<const u32x4*>(gbase + (size_t)row * PLD + c16 * 8);
      x4[i] = *reinterpret_cast<const u32x4*>(p4 + (size_t)row * A_ROW + c16 * 8); x16[i] = *reinterpret_cast<const u32x4*>(p16 + (size_t)row * A_ROW + c16 * 8); }
#pragma unroll
    for (int i = 0; i < 4; ++i) { const int row = rr + 4 * (4 * hf + i);
      const f32x4_t a = *reinterpret_cast<const LAS f32x4_t*>(st + row * attc::EPI_PITCH + c16 * 32);
      const f32x4_t b = *reinterpret_cast<const LAS f32x4_t*>(st + row * attc::EPI_PITCH + c16 * 32 + 16);
      const float w4 = cw[row], w16 = cw[32 + row];
      float v[8] = {a[0], a[1], a[2], a[3], b[0], b[1], b[2], b[3]};
#pragma unroll
      for (int e = 0; e < 4; ++e) { const float g0 = __uint_as_float(g[i][e] << 16), g1 = __uint_as_float(g[i][e] & 0xffff0000u);
        v[2 * e]     = (v[2 * e]     + w4 * __uint_as_float(x4[i][e] << 16)         + w16 * __uint_as_float(x16[i][e] << 16))         * (g0 * __builtin_amdgcn_rcpf(1.f + __expf(-g0)));
        v[2 * e + 1] = (v[2 * e + 1] + w4 * __uint_as_float(x4[i][e] & 0xffff0000u) + w16 * __uint_as_float(x16[i][e] & 0xffff0000u)) * (g1 * __builtin_amdgcn_rcpf(1.f + __expf(-g1))); }
      u32x4 w = {cvtpk(v[0], v[1]), cvtpk(v[2], v[3]), cvtpk(v[4], v[5]), cvtpk(v[6], v[7])};
      *reinterpret_cast<u32x4*>(obase + (size_t)row * DM + c16 * 8) = w; }
    asm volatile("" ::: "memory"); }
}
struct Part { bf16* p4; bf16* p16; float* s4; float* s16; };
struct Next { bool has; int q0, qcol, kcol, vcol; };
template <int MODE>
__device__ __forceinline__ void wave_tile(const bf16* __restrict__ proj, bf16* __restrict__ obuf, const Part& part, int h, int q0, int qcol, int kcol, int vcol, int gcol, int ocol,
                                          float m_init, float l_init, LAS unsigned char* vlds, LAS float* xch, LAS float* lut, const float* __restrict__ lut_g, int lane,
                                          bf16x8 (&qr)[8], bf16x8 (&ks8)[8], bf16x8 (&vs)[8], bool pre, const Next nx) {
  constexpr int KS = MODE == P16 ? 16 : (MODE == P4 ? 4 : 1), W = MODE == MB ? 128 : 64, NTT = MODE == MB ? 9 : 5;
  const int r32 = lane & 31, hi = lane >> 5, vrow = lane >> 4, vch = lane & 15;
#define BAND_QLOAD(q0_, qcol_) do { const bf16* qp = proj + (size_t)((q0_) + KS * r32) * PLD + (qcol_) + hi * 8; \
    _Pragma("unroll") for (int d0 = 0; d0 < 8; ++d0) qr[d0] = *reinterpret_cast<const bf16x8*>(qp + d0 * 16); } while (0)
  if (!pre) BAND_QLOAD(q0, qcol);
  f32x16 o[4] = {}; float m_reg = m_init, l_reg = l_init;
  const int vb = (int)(uintptr_t)vlds + v_rd_base(lane);
  LAS unsigned char* klds = vlds + 8192;
  LAS unsigned char* vwr = vlds + (vch >> 2) * 512 + vrow * 64 + (vch & 3) * 16;
  LAS unsigned char* kwr = klds + vrow * KPITCH + vch * 16;
  const LAS unsigned char* krd = klds + r32 * KPITCH + hi * 16;
#define BAND_ISSUE(kt_, kcol, vcol) do { _Pragma("unroll") for (int i = 0; i < 8; ++i) { int tv = (kt_) + KS * (vrow + 4 * i); tv = tv < 0 ? 0 : (tv > S - 1 ? S - 1 : tv); \
        const bf16* rp = proj + (size_t)tv * PLD + vch * 8; ks8[i] = *reinterpret_cast<const bf16x8*>(rp + kcol); vs[i] = *reinterpret_cast<const bf16x8*>(rp + vcol); } } while (0)
  int kt = q0 - W * KS;
  if (!pre) BAND_ISSUE(kt, kcol, vcol);
  { constexpr int LN = MODE == MB ? LUTB_N : LUTA_N, LK = (LN + 63) / 64; float lv[LK];
#pragma unroll
    for (int k = 0; k < LK; ++k) { const int e = lane + 64 * k; lv[k] = lut_g[e < LN ? e : LN - 1]; }
#pragma unroll
    for (int k = 0; k < LK; ++k) { const int e = lane + 64 * k; if (e < LN) lut[e] = lv[k]; } }
#pragma nounroll
  for (int tt = 0; tt < NTT; ++tt) {
#pragma unroll
    for (int i = 0; i < 8; ++i) { *reinterpret_cast<LAS bf16x8*>(vwr + (i & 1) * 2048 + ((i >> 1) & 1) * 256 + ((i >> 2) & 1) * 4096) = vs[i];
                                  *reinterpret_cast<LAS bf16x8*>(kwr + i * 4 * KPITCH) = ks8[i]; }
    f32x16 p0 = {};
#pragma unroll
    for (int d0 = 0; d0 < 8; ++d0) { const bf16x8 kfr = *reinterpret_cast<const LAS bf16x8*>(krd + d0 * 32);
      p0 = __builtin_amdgcn_mfma_f32_32x32x16_bf16(kfr, qr[d0], p0, 0, 0, 0); }
    const int c_kt = kt; kt += 32 * KS;
    if (tt + 1 < NTT) BAND_ISSUE(kt, kcol, vcol);
    float tv[16];
    { int dl = -W + 32 * tt + 4 * hi - r32; dl = dl < -(W + 28) ? -(W + 28) : (dl > W + 1 ? W + 1 : dl);
      const LAS float* lp = lut + (dl + (W + 28));
#pragma unroll
      for (int r = 0; r < 16; ++r) tv[r] = fmaf(p0[r], QK_C, lp[(r & 3) + 8 * (r >> 2)]); }
    if (c_kt < 0 || c_kt + 31 * KS > S - 1) {
#pragma unroll
      for (int r = 0; r < 16; ++r) { const int tok = c_kt + KS * crow(r, hi); if (tok < 0 || tok > S - 1) tv[r] = -1e30f; } }
    float pmax = tv[0];
#pragma unroll
    for (int r = 1; r < 16; ++r) pmax = fmaxf(pmax, tv[r]);
    { auto rr = __builtin_amdgcn_permlane32_swap(__float_as_uint(pmax), __float_as_uint(pmax), false, false); pmax = fmaxf(__uint_as_float(rr[0]), __uint_as_float(rr[1])); }
    float alpha = 1.f;
    if (!__all(pmax - m_reg <= THR2)) { const float mn = fmaxf(m_reg, pmax); alpha = __builtin_amdgcn_exp2f(m_reg - mn); m_reg = mn; }
    float ps = 0.f;
#pragma unroll
    for (int r = 0; r < 16; ++r) { tv[r] = __builtin_amdgcn_exp2f(tv[r] - m_reg); ps += tv[r]; }
    { auto rr = __builtin_amdgcn_permlane32_swap(__float_as_uint(ps), __float_as_uint(ps), false, false); ps = __uint_as_float(rr[0]) + __uint_as_float(rr[1]); }
    l_reg = l_reg * alpha + ps;
    bf16x8 pa0, pa1;
#define PK4(P, BASE, OUT) do { unsigned a0 = cvtpk(P[BASE + 0], P[BASE + 1]), a1 = cvtpk(P[BASE + 2], P[BASE + 3]);   \
    unsigned b0 = cvtpk(P[BASE + 4], P[BASE + 5]), b1 = cvtpk(P[BASE + 6], P[BASE + 7]);                              \
    auto r0 = __builtin_amdgcn_permlane32_swap(a0, b0, false, false); auto r1 = __builtin_amdgcn_permlane32_swap(a1, b1, false, false); \
    u32x4 w = {r0[0], r1[0], r0[1], r1[1]}; OUT = *reinterpret_cast<bf16x8*>(&w); } while (0)
    PK4(tv, 0, pa0); PK4(tv, 8, pa1);
#undef PK4
    if (__any(alpha < 1.f)) { if (hi == 0) xch[r32] = alpha; asm volatile("s_waitcnt lgkmcnt(0)" ::: "memory");
#pragma unroll
      for (int d = 0; d < 4; ++d)
#pragma unroll
        for (int r = 0; r < 16; ++r) o[d][r] *= xch[crow(r, hi)]; }
    pv32<0>(o[0], vb, pa0, pa1); pv32<1>(o[1], vb, pa0, pa1); pv32<2>(o[2], vb, pa0, pa1); pv32<3>(o[3], vb, pa0, pa1);
  }
  float f = __builtin_amdgcn_rcpf(l_reg);
  if (MODE == P16 || MODE == P4) {
    if (hi == 0) { float* sp = (MODE == P16 ? part.s16 : part.s4) + ((size_t)(q0 + KS * r32) * A_H + h) * 2; sp[0] = m_reg; sp[1] = l_reg; } }
  if (MODE == P1) {
    const size_t si = ((size_t)(q0 + r32) * A_H + h) * 2;
    const float m4 = part.s4[si], l4 = part.s4[si + 1], m16 = part.s16[si], l16 = part.s16[si + 1];
    const float M = fmaxf(m_reg, fmaxf(m4, m16));
    const float e1 = __builtin_amdgcn_exp2f(m_reg - M), e4 = l4 * __builtin_amdgcn_exp2f(m4 - M), e16 = l16 * __builtin_amdgcn_exp2f(m16 - M);
    const float rden = __builtin_amdgcn_rcpf(l_reg * e1 + e4 + e16);
    f = e1 * rden;
    if (hi == 0) { xch[64 + r32] = e4 * rden; xch[96 + r32] = e16 * rden; } }
  if (hi == 0) xch[32 + r32] = f; asm volatile("s_waitcnt lgkmcnt(0)" ::: "memory");
  float rli[16];
#pragma unroll
  for (int r = 0; r < 16; ++r) rli[r] = xch[32 + crow(r, hi)];
  u32x4 gpre[8];
  if (MODE == MB) {
    int vr2 = vrow; asm volatile("" : "+v"(vr2));
    const bf16* gb = proj + (size_t)q0 * PLD + gcol + vch * 8;
#pragma unroll
    for (int i = 0; i < 8; ++i) gpre[i] = *reinterpret_cast<const u32x4*>(gb + (size_t)(vr2 + 4 * i) * PLD); }
  epi_stage(o, rli, vlds, lane);
  if (nx.has) { BAND_QLOAD(nx.q0, nx.qcol); BAND_ISSUE(nx.q0 - W * KS, nx.kcol, nx.vcol); }
  if (MODE == P16) epi_partial_out<KS>(vlds, part.p16 + (size_t)q0 * A_ROW + h * HD, lane);
  else if (MODE == P4) epi_partial_out<KS>(vlds, part.p4 + (size_t)q0 * A_ROW + h * HD, lane);
  else if (MODE == P1) epi_merge(vlds, xch + 64, part.p4 + (size_t)q0 * A_ROW + h * HD, part.p16 + (size_t)q0 * A_ROW + h * HD, proj + (size_t)q0 * PLD + gcol, obuf + (size_t)q0 * DM + ocol, lane);
  else epi_gate_out(vlds, gpre, obuf + (size_t)q0 * DM + ocol, lane);
#undef BAND_ISSUE
#undef BAND_QLOAD
}
}

__device__ __forceinline__ void band_phase(const Args& a, LAS unsigned char* lds, int layer, int pass, int wave, int vcu, int G) {
    const int lane = fresh_lane();
    const bf16* proj = (const bf16*)(a.ws + WS_PROJ); bf16* o = (bf16*)(a.ws + WS_O); const float* tab = (const float*)(a.ws + WS_TAB);
    band::Part part; part.p4 = (bf16*)(a.ws + WS_PART4); part.p16 = (bf16*)(a.ws + WS_PART16); part.s4 = (float*)(a.ws + WS_STAT4); part.s16 = (float*)(a.ws + WS_STAT16);
    LAS unsigned char* vlds = lds + wave * band::WAVE_LDS; LAS float* xch = (LAS float*)(lds + BAND_LUT_OFF + wave * BAND_LUT_WAVE); LAS float* lut = xch + 128;
    typedef band::bf16x8 bf16x8;
    if (pass == 0) {
        { bool pre = false; bf16x8 qr[8], ks8[8], vs[8];
          for (int ua = vcu; ua < A_H * 64; ua += G) {
            const int h = ua / 64, rem = ua % 64, u = rem >> 1, r = (rem & 1) * 8 + wave;
            const int un = ua + G; band::Next nx; nx.has = un < A_H * 64; { const int h2 = un / 64, rem2 = un % 64; nx.q0 = 512 * (rem2 >> 1) + (rem2 & 1) * 8 + wave; nx.qcol = PC(COL_AQ + h2 * HD); nx.kcol = PC(COL_AK + h2 * HD); nx.vcol = PC(COL_AV + h2 * HD); }
            const float* lut_g = tab + TB_LUTA + (h * 3 + 2) * LUTA_N;
            band::wave_tile<band::P16>(proj, o, part, h, 512 * u + r, PC(COL_AQ + h * HD), PC(COL_AK + h * HD), PC(COL_AV + h * HD), PC(COL_AG + h * HD), OCOL_A + h * HD, -1e20f, 0.f, vlds, xch, lut, lut_g, lane, qr, ks8, vs, pre, nx);
            pre = nx.has; } }
        { bool pre = false; bf16x8 qr[8], ks8[8], vs[8];
          for (int ua = vcu; ua < A_H * 64; ua += G) {
            const int h = ua / 64, b = ua % 64;
            const int un = ua + G; band::Next nx; nx.has = un < A_H * 64; { const int h2 = un / 64, b2 = un % 64; nx.q0 = 256 * b2 + 128 * (wave >> 2) + (wave & 3); nx.qcol = PC(COL_AQ + h2 * HD); nx.kcol = PC(COL_AK + h2 * HD); nx.vcol = PC(COL_AV + h2 * HD); }
            const float* lut_g = tab + TB_LUTA + (h * 3 + 1) * LUTA_N;
            band::wave_tile<band::P4>(proj, o, part, h, 256 * b + 128 * (wave >> 2) + (wave & 3), PC(COL_AQ + h * HD), PC(COL_AK + h * HD), PC(COL_AV + h * HD), PC(COL_AG + h * HD), OCOL_A + h * HD, -1e20f, 0.f, vlds, xch, lut, lut_g, lane, qr, ks8, vs, pre, nx);
            pre = nx.has; } }
        const float* sink = a.in[10] + layer * B_H;
        { bool pre = false; bf16x8 qr[8], ks8[8], vs[8];
          for (int ub = vcu; ub < B_H * 64; ub += G) {
            const int kv = ub / 256, rem = ub % 256, qblk = rem >> 2, h = kv * 4 + (rem & 3);
            const int un = ub + G; band::Next nx; nx.has = un < B_H * 64; { const int kv2 = un / 256, rem2 = un % 256, h2 = kv2 * 4 + (rem2 & 3); nx.q0 = (rem2 >> 2) * 256 + wave * 32; nx.qcol = PC(COL_BQ + h2 * HD); nx.kcol = PC(COL_BK + kv2 * HD); nx.vcol = PC(COL_BV + kv2 * HD); }
            const float* lut_g = tab + TB_LUTB + h * LUTB_N;
            band::wave_tile<band::MB>(proj, o, part, h, qblk * 256 + wave * 32, PC(COL_BQ + h * HD), PC(COL_BK + kv * HD), PC(COL_BV + kv * HD), PC(COL_BG + h * HD), OCOL_B + h * HD, sink[h] * LOG2E, 1.f, vlds, xch, lut, lut_g, lane, qr, ks8, vs, pre, nx);
            pre = nx.has; } }
    } else {
        band::Next nx; nx.has = false; nx.q0 = 0; nx.qcol = 0; nx.kcol = 0; nx.vcol = 0;
        for (int ua = vcu; ua < A_H * 64; ua += G) {
            bf16x8 qr[8], ks8[8], vs[8];
            const int h = ua / 64, b = ua % 64;
            const float* lut_g = tab + TB_LUTA + (h * 3 + 0) * LUTA_N;
            band::wave_tile<band::P1>(proj, o, part, h, 256 * b + 32 * wave, PC(COL_AQ + h * HD), PC(COL_AK + h * HD), PC(COL_AV + h * HD), PC(COL_AG + h * HD), OCOL_A + h * HD, -1e20f, 0.f, vlds, xch, lut, lut_g, lane, qr, ks8, vs, false, nx);
        }
    }
}

__global__ void __launch_bounds__(NWAVES * 64, 2) fwd_kernel(Args args) {
    extern __shared__ __attribute__((aligned(16))) unsigned char lds_raw[];
    LAS unsigned char* lds = (LAS unsigned char*)lds_raw;
    volatile LAS unsigned* MISC = (volatile LAS unsigned*)(lds + MISC_OFF);
    const int wave = __builtin_amdgcn_readfirstlane((int)threadIdx.x >> 6);
    const int G = gridDim.x; const int bx = blockIdx.x; const int vcu = (G % 8 == 0) ? (bx % 8) * (G / 8) + bx / 8 : bx;
    gu32* ctl = (gu32*)(args.ws + WS_CTL);
    for (int u = threadIdx.x; u < (LDS_BYTES - LDSCTL_OFF) / 4; u += NWAVES * 64) ((LAS unsigned*)(lds + LDSCTL_OFF))[u] = 0u;
    __syncthreads();
    XcdBarrier bar = xcd_barrier_post((unsigned*)(ctl + CW_BAR), MISC + 8, (unsigned)wave);
    const bf16* Win_t = (const bf16*)(args.ws + WS_WIN); const bf16* Wout_t = (const bf16*)(args.ws + WS_WOUT);
    bf16* Hb = (bf16*)(args.ws + WS_H); bf16* PROJ = (bf16*)(args.ws + WS_PROJ); bf16* Ob = (bf16*)(args.ws + WS_O); bf16* Yb = (bf16*)(args.ws + WS_Y);

    p0_prologue(args, lds, wave, vcu, G);
    xcd_barrier(bar);
    norm_phase(args, lds, -1, 0, args.in[0], wave, vcu, G);
    w8_phase(args, wave, vcu, G);
    xcd_barrier(bar);

#pragma nounroll
    for (int layer = 0; layer < DEPTH; ++layer) {
#ifndef REP_G1
#define REP_G1 1
#endif
        for (int rep = 0; rep < REP_G1; ++rep)
        {
          pg8::Gemm g{Hb, Win_t + (size_t)layer * INW * DM, S, F8_COL0, DM}; pg8::StaticOrder so; so.init(S, F8_COL0, G, bx);
          pg8::EpiStoreT E{PROJ, (size_t)S * 256};
          const int whole = (so.nwg / G) * G, rest = so.nwg - whole; const bool halves = (2 * rest == G);
          if (halves) so.lim = whole;
          pg8::gemm_phase<pg8::EpiStoreT, pg8::StaticOrder, true, true>(lds + RING_OFF, g, so, E, wave);
          if (halves) { pg8::HalfOrder ho; ho.base = so; ho.first = whole;
              pg8::gemm_phase<pg8::EpiStoreT, pg8::HalfOrder, true, true, true>(lds + RING_OFF, g, ho, E, wave); }
          pg8::Gemm g8{(const pg8::bf16_t*)(args.ws + WS_H8), (const pg8::bf16_t*)(args.ws + WS_W8 + (size_t)layer * F8_COLS * DM), S, F8_COLS, DM / 2}; pg8::StaticOrder s8; s8.init(S, F8_COLS, G, bx);
          pg8::EpiStoreT E8{PROJ + (size_t)(F8_COL0 / 256) * S * 256, (size_t)S * 256};
          const int sclb = 127 - w8_exp(args, layer);
          const int whole8 = (s8.nwg / G) * G, rest8 = s8.nwg - whole8; const bool halves8 = (2 * rest8 == G);
          if (halves8) s8.lim = whole8;
          pg8::gemm_phase<pg8::EpiStoreT, pg8::StaticOrder, true, true, false, true>(lds + RING_OFF, g8, s8, E8, wave, sclb);
          if (halves8) { pg8::HalfOrder h8; h8.base = s8; h8.first = whole8;
              pg8::gemm_phase<pg8::EpiStoreT, pg8::HalfOrder, true, true, true, true>(lds + RING_OFF, g8, h8, E8, wave, sclb); } }
        xcd_barrier(bar);
        prep_phase(args, lds, layer, wave, vcu, G);
        __syncthreads();
        band_phase(args, lds, layer, 0, wave, vcu, G);
        xcd_barrier(bar);
#ifndef REP_C
#define REP_C 1
#endif
        for (int rep = 0; rep < REP_C; ++rep)
        for (int i = 0;; ++i) {
            const int u = i * G + vcu; if (u >= C_H * (S / 256)) break;
            const int gq = u / 256, rem = u % 256, kv = rem / 64, qb = rem % 64, head = kv * 3 + gq;
#if defined(ATT_PP)
#ifdef QK_FP4
            attc::attn_f8pp_body((const unsigned char*)(args.ws + WS_QF8) + (size_t)(qb * 256) * attc::LDQ4 + head * 64,
#else
            attc::attn_f8pp_body((const unsigned char*)(args.ws + WS_QF8) + (size_t)(qb * 256) * (C_H * HD) + head * HD,
#endif
 (const unsigned char*)(args.ws + WS_KF8) + (size_t)kv * (S / 64) * attc::PP_TIMG,
                                 PROJ + (size_t)(qb * 256) * PLD + PC(COL_CG + head * HD), Ob + (size_t)(qb * 256) * DM + OCOL_C + head * HD, S, (char*)lds_raw + RING_OFF, wave);
#elif defined(ATT_F8)
            attc::attn_f8_body((const unsigned char*)(args.ws + WS_QF8) + (size_t)(qb * 256) * (C_H * HD) + head * HD, (const unsigned char*)(args.ws + WS_KF8) + kv * HD,
                               (const unsigned char*)(args.ws + WS_VTF8) + (size_t)kv * HD * S,
                               PROJ + (size_t)(qb * 256) * PLD + PC(COL_CG + head * HD), Ob + (size_t)(qb * 256) * DM + OCOL_C + head * HD, S, (char*)lds_raw + RING_OFF, wave);
#else
            attc::attn_dense_body(PROJ + (size_t)(qb * 256) * INW + COL_CQ + head * HD, PROJ + COL_CK + kv * HD, PROJ + COL_CV + kv * HD,
                                  PROJ + (size_t)(qb * 256) * PLD + PC(COL_CG + head * HD), Ob + (size_t)(qb * 256) * DM + OCOL_C + head * HD, S, (char*)lds_raw + RING_OFF, wave);
#endif
        }
        band_phase(args, lds, layer, 1, wave, vcu, G);
        xcd_barrier(bar);
#ifndef REP_G2
#define REP_G2 1
#endif
        for (int rep = 0; rep < REP_G2; ++rep)
        { pg8::Gemm g{Ob, Wout_t + (size_t)layer * DM * DM, S, DM, DM}; pg8::StaticOrder so; so.init(S, DM, G, bx);
          pg8::EpiStore E{Yb, DM};
          pg8::gemm_phase<pg8::EpiStore, pg8::StaticOrder, true, true>(lds + RING_OFF, g, so, E, wave); }
        xcd_barrier(bar);
#ifdef REP_NORM
        norm_phase(args, lds, layer, layer + 1 < DEPTH ? layer + 1 : -1, layer == 0 ? args.in[0] : (const float*)args.out, wave, vcu, G, true);
#endif
        norm_phase(args, lds, layer, layer + 1 < DEPTH ? layer + 1 : -1, layer == 0 ? args.in[0] : (const float*)args.out, wave, vcu, G);
        if (layer + 1 < DEPTH) xcd_barrier(bar);
    }
}

extern "C" void kernel_launch(void* const* d_in, const int* in_sizes, int n_in, void* d_out, int out_size, void* d_ws, size_t ws_size, hipStream_t stream) {
    static int grid = 0;
    if (grid == 0) {
        if (n_in != 12 || in_sizes[0] != S * DM || out_size != S * DM || ws_size < WS_END) {
            fprintf(stderr, "kernel_launch: shape mismatch: n_in %d in0 %d out %d ws %zu (need >= %zu); nothing launched\n", n_in, n_in > 0 ? in_sizes[0] : -1, out_size, ws_size, (size_t)WS_END); grid = -1; return; }
        int dev = 0, cus = 0, per_cu = 0;
        if (hipGetDevice(&dev) != hipSuccess || hipDeviceGetAttribute(&cus, hipDeviceAttributeMultiprocessorCount, dev) != hipSuccess) { fprintf(stderr, "kernel_launch: device query failed\n"); grid = -1; return; }
        if (hipFuncSetAttribute((const void*)fwd_kernel, hipFuncAttributeMaxDynamicSharedMemorySize, LDS_BYTES) != hipSuccess) { fprintf(stderr, "kernel_launch: hipFuncSetAttribute failed\n"); grid = -1; return; }
        if (hipOccupancyMaxActiveBlocksPerMultiprocessor(&per_cu, (const void*)fwd_kernel, NWAVES * 64, LDS_BYTES) != hipSuccess || per_cu < 1)
            fprintf(stderr, "kernel_launch: note: occupancy query reports %d workgroups per CU\n", per_cu);
        (void)hipGetLastError();
        grid = cus;
    }
    if (grid < 0) return;
    if (hipMemsetAsync((char*)d_ws + WS_CTL, 0, CTL_ZERO_BYTES, stream) != hipSuccess) { fprintf(stderr, "kernel_launch: memset failed\n"); return; }
    Args a{};
    for (int i = 0; i < 12; ++i) a.in[i] = (const float*)d_in[i];
    a.out = (float*)d_out; a.ws = (unsigned char*)d_ws;
    hipLaunchKernelGGL(fwd_kernel, dim3(grid), dim3(NWAVES * 64), LDS_BYTES, stream, a);
    const hipError_t le = hipPeekAtLastError();
    if (le != hipSuccess) fprintf(stderr, "kernel_launch: launch failed: %s\n", hipGetErrorName(le));
}
```

```cpp
#define ATT_F8 1
#define ATT_PP 1
#define QK_FP4 1
#include <hip/hip_runtime.h>
#include <hip/hip_bf16.h>
#include <cstdio>
#include <cstdint>
#include <cmath>

namespace pg8 {
#define PG8_LAS __attribute__((address_space(3)))
typedef unsigned short bf16_t;
typedef short bf16x8 __attribute__((ext_vector_type(8)));
typedef float f32x4 __attribute__((ext_vector_type(4)));
typedef unsigned u32x4 __attribute__((ext_vector_type(4)));
constexpr int BM = 256, BK = 64, HALF = 128, HTB = HALF * BK * 2  , STAGE_BYTES = 8 * HTB, NXCD = 8, WGM = 8;

__host__ __device__ __forceinline__ int lds_byte(int r, int c) { const int st = (r >> 4) * 2 + (c >> 5), rr = r & 15, cc = c & 31, ob = rr * 64 + cc * 2; return st * 1024 + (ob ^ (((ob >> 9) & 1) << 5)); }
__host__ __device__ __forceinline__ void stage_rc(int b, int& R, int& C) { const int st = b / 1024, sb = b % 1024, swz = sb ^ (((sb >> 9) & 1) << 5); R = (st >> 1) * 16 + swz / 64; C = (st & 1) * 32 + (swz % 64) / 2; }
__host__ __device__ __forceinline__ int perm32(int rho) { const int n = rho >> 4, i = rho & 15; return 8 * (i >> 2) + 4 * n + (i & 3); }

struct Unit { int pm, pn, hm; };
struct Gemm { const bf16_t* A; const bf16_t* Bt; int M, N, K; };

struct StaticOrder {
    int nM, nN, nwg, G, c, lim;
    __host__ __device__ void init(int M, int N, int G_, int c_) { nM = M / BM; nN = N / BM; nwg = nM * nN; G = G_; c = c_; lim = nwg; }
    __host__ __device__ void map(int wgid, Unit& u) const {
        { const int q = nwg / NXCD, r = nwg % NXCD, xcd = wgid % NXCD, off = wgid / NXCD; wgid = (xcd < r ? xcd * (q + 1) : r * (q + 1) + (xcd - r) * q) + off; }
        const int nig = WGM * nN, gid = wgid / nig, fm = gid * WGM, gsz = (nM - fm) < WGM ? (nM - fm) : WGM;
        u.pm = fm + ((wgid % nig) % gsz); u.pn = (wgid % nig) / gsz; u.hm = 0;
    }
    __host__ __device__ bool next(int i, Unit& u) const {
        const long L = (long)i * G + c; if (L >= lim) return false;
        map((int)L, u); return true;
    }
    __device__ __forceinline__ void a_ready(const Unit&) const {}
    __device__ __forceinline__ void done(const Unit&) const {}
};
struct HalfOrder {
    StaticOrder base; int first;
    __host__ __device__ bool next(int i, Unit& u) const { if (i > 0) return false; base.map(first + (base.c >> 1), u); u.hm = (base.c & 1) ? 1 : 2; return true; }
    __device__ __forceinline__ void a_ready(const Unit&) const {}
    __device__ __forceinline__ void done(const Unit&) const {}
};

__device__ __forceinline__ unsigned cvt_pk_bf16(float lo, float hi) { unsigned r; asm volatile("v_cvt_pk_bf16_f32 %0, %1, %2" : "=v"(r) : "v"(lo), "v"(hi)); return r; }
struct EpiStore {
    static constexpr bool PERM = true, AFTER_DRAIN = false;
    bf16_t* O; int ldc;
    __device__ __forceinline__ void operator()(const f32x4 (&acc)[2][2][4][2], const Unit& u, int wr, int wc, int fr, int fq) const {
        const int row0 = u.pm * BM + wr * 64 + fr; const int col0 = u.pn * BM + wc * 32 + 8 * fq;
#pragma unroll
        for (int ai = 0; ai < 2; ++ai)
#pragma unroll
            for (int m = 0; m < 4; ++m) { bf16_t* rowp = O + (size_t)(row0 + ai * HALF + m * 16) * ldc + col0;
#pragma unroll
                for (int bj = 0; bj < 2; ++bj) { if (u.hm & (1 << bj)) continue; const f32x4 v0 = acc[ai][bj][m][0], v1 = acc[ai][bj][m][1];
                    u32x4 w; w.x = cvt_pk_bf16(v0[0], v0[1]); w.y = cvt_pk_bf16(v0[2], v0[3]); w.z = cvt_pk_bf16(v1[0], v1[1]); w.w = cvt_pk_bf16(v1[2], v1[3]);
                    *(u32x4*)(rowp + bj * HALF) = w; } }
    }
    __device__ __forceinline__ void fused(f32x4 (&acc)[2][2][4][2], const Unit& u, int wr, int wc, int fr, int fq, PG8_LAS unsigned char* lds, int wid, int lane) const {}
};

struct EpiStoreT {
    static constexpr bool PERM = true, AFTER_DRAIN = false;
    bf16_t* O; size_t tstride;
    __device__ __forceinline__ void operator()(const f32x4 (&acc)[2][2][4][2], const Unit& u, int wr, int wc, int fr, int fq) const {
        const int row0 = u.pm * BM + wr * 64 + fr; bf16_t* Ot = O + (size_t)u.pn * tstride + wc * 32 + 8 * fq;
#pragma unroll
        for (int ai = 0; ai < 2; ++ai)
#pragma unroll
            for (int m = 0; m < 4; ++m) { bf16_t* rowp = Ot + (size_t)(row0 + ai * HALF + m * 16) * BM;
#pragma unroll
                for (int bj = 0; bj < 2; ++bj) { if (u.hm & (1 << bj)) continue; const f32x4 v0 = acc[ai][bj][m][0], v1 = acc[ai][bj][m][1];
                    u32x4 w; w.x = cvt_pk_bf16(v0[0], v0[1]); w.y = cvt_pk_bf16(v0[2], v0[3]); w.z = cvt_pk_bf16(v1[0], v1[1]); w.w = cvt_pk_bf16(v1[2], v1[3]);
                    *(u32x4*)(rowp + bj * HALF) = w; } }
    }
    __device__ __forceinline__ void fused(f32x4 (&acc)[2][2][4][2], const Unit& u, int wr, int wc, int fr, int fq, PG8_LAS unsigned char* lds, int wid, int lane) const {}
};

template <class Epi, class Sched, bool ALIGN_EPI = false, bool SP2 = false, bool HALFU = false, bool FP8 = false>
__device__ __forceinline__ void gemm_phase(PG8_LAS unsigned char* lds, const Gemm g, const Sched& S, const Epi& E, const int wid_in, const int sclb = 127) {
    typedef int i32x4_ __attribute__((ext_vector_type(4))); typedef int i32x8_ __attribute__((ext_vector_type(8)));
    const int scl2 = 127 | (sclb << 8);
    int wid = wid_in; asm volatile("" : "+s"(wid));
    int lane_l; asm volatile("v_mbcnt_lo_u32_b32 %0, -1, 0\n\tv_mbcnt_hi_u32_b32 %0, -1, %0" : "=v"(lane_l));
    const int lane = lane_l, tid = wid * 64 + lane, wr = wid >> 2, wc = wid & 3, fr = lane & 15, fq = lane >> 4;
    const int K = g.K, nt = K / BK;
    unsigned voffA[2], voffB[2];
#pragma unroll
    for (int i = 0; i < 2; ++i) { int R, C; stage_rc(tid * 16 + i * 8192, R, C); const int Rb = Epi::PERM ? ((R & ~31) + perm32(R & 31)) : R;
        voffA[i] = (unsigned)(R * K + C) * 2u; voffB[i] = (unsigned)(Rb * K + C) * 2u; }
    const size_t kstep = (size_t)(BK * 2);
    const size_t hstep = (size_t)HALF * K * 2;
    const size_t tstep = 2 * hstep;
    const unsigned ldsw = (unsigned)wid * 1024u;
    const int aoff = lds_byte(wr * 64 + fr, fq * 8), boff = lds_byte(wc * 32 + fr, fq * 8);
#define PG8_SA(b, h) (((b) * 2 + (h)) * HTB)
#define PG8_SB(b, h) ((4 + (b) * 2 + (h)) * HTB)
#define PG8_STAGE(bufoff, gbase, voff) do { _Pragma("unroll") for (int _i = 0; _i < 2; ++_i) \
        __builtin_amdgcn_global_load_lds((const unsigned*)((const char*)(gbase) + (voff)[_i]), (PG8_LAS unsigned*)(lds + (bufoff) + ldsw + _i * 8192), 16, 0, 0); } while (0)
#define PG8_LDA(dst, b, h) do { _Pragma("unroll") for (int m = 0; m < 4; ++m) { \
        if constexpr (FP8) { const i32x4_ l_ = *(const PG8_LAS i32x4_*)(lds + PG8_SA(b, h) + aoff + m * 2048), h_ = *(const PG8_LAS i32x4_*)(lds + PG8_SA(b, h) + aoff + m * 2048 + 1024); \
                             dst##8[m] = (i32x8_){l_[0], l_[1], l_[2], l_[3], h_[0], h_[1], h_[2], h_[3]}; } \
        else { _Pragma("unroll") for (int k = 0; k < 2; ++k) dst[m][k] = *(const PG8_LAS bf16x8*)(lds + PG8_SA(b, h) + aoff + m * 2048 + k * 1024); } } } while (0)
#define PG8_LDB(dst, b, h) do { _Pragma("unroll") for (int n = 0; n < 2; ++n) { \
        if constexpr (FP8) { const i32x4_ l_ = *(const PG8_LAS i32x4_*)(lds + PG8_SB(b, h) + boff + n * 2048), h_ = *(const PG8_LAS i32x4_*)(lds + PG8_SB(b, h) + boff + n * 2048 + 1024); \
                             dst##8[n] = (i32x8_){l_[0], l_[1], l_[2], l_[3], h_[0], h_[1], h_[2], h_[3]}; } \
        else { _Pragma("unroll") for (int k = 0; k < 2; ++k) dst[n][k] = *(const PG8_LAS bf16x8*)(lds + PG8_SB(b, h) + boff + n * 2048 + k * 1024); } } } while (0)
#define PG8_MMA(ai, bj, At, Bt) do { if (HALFU && (cur.hm & (1 << (bj)))) break; __builtin_amdgcn_s_setprio(1); \
        if constexpr (FP8) { _Pragma("unroll") for (int m = 0; m < 4; ++m) _Pragma("unroll") for (int n = 0; n < 2; ++n) \
            asm volatile("v_mfma_scale_f32_16x16x128_f8f6f4 %0, %1, %2, %0, %3, %3 op_sel:[1,0,0] op_sel_hi:[0,0,0]" : "+v"(acc[ai][bj][m][n]) : "v"(Bt##8[n]), "v"(At##8[m]), "v"(scl2)); } \
        else { _Pragma("unroll") for (int m = 0; m < 4; ++m) _Pragma("unroll") for (int n = 0; n < 2; ++n) _Pragma("unroll") for (int k = 0; k < 2; ++k) \
            acc[ai][bj][m][n] = __builtin_amdgcn_mfma_f32_16x16x32_bf16(Bt[n][k], At[m][k], acc[ai][bj][m][n], 0, 0, 0); } \
        __builtin_amdgcn_s_setprio(0); } while (0)
#define PG8_WAIT_V(n) asm volatile("s_waitcnt vmcnt(" #n ")" ::: "memory")
#define PG8_WAIT_L(n) asm volatile("s_waitcnt lgkmcnt(" #n ")" ::: "memory")
#define PG8_BAR __builtin_amdgcn_s_barrier()
#define PG8_SCHED __builtin_amdgcn_sched_barrier(0)
    Unit cur, nxt; int ui = 0;
    if (!S.next(0, cur)) return;
    f32x4 acc[2][2][4][2];
#pragma unroll
    for (int a = 0; a < 2; ++a)
#pragma unroll
        for (int b = 0; b < 2; ++b)
#pragma unroll
            for (int m = 0; m < 4; ++m)
#pragma unroll
                for (int n = 0; n < 2; ++n) acc[a][b][m][n] = (f32x4){0.f, 0.f, 0.f, 0.f};
    bf16x8 At[4][2], B0[2][2], B1[2][2]; i32x8_ At8[4], B08[2], B18[2];
    const char* cA = (const char*)g.A + (size_t)cur.pm * tstep; const char* cB = (const char*)g.Bt + (size_t)cur.pn * tstep;
    S.a_ready(cur);
    if constexpr (SP2) {
        PG8_STAGE(PG8_SB(0, 0), cB, voffB); PG8_STAGE(PG8_SB(0, 1), cB + hstep, voffB); PG8_STAGE(PG8_SA(0, 0), cA, voffA); PG8_STAGE(PG8_SA(0, 1), cA + hstep, voffA);
        if (wr == 1) PG8_BAR;
        PG8_WAIT_V(2); PG8_BAR;
        PG8_STAGE(PG8_SB(1, 0), cB + kstep, voffB); PG8_STAGE(PG8_SA(1, 0), cA + kstep, voffA); PG8_STAGE(PG8_SB(1, 1), cB + hstep + kstep, voffB);
        PG8_WAIT_V(6); PG8_BAR;
    } else {
        PG8_STAGE(PG8_SB(0, 0), cB, voffB); PG8_STAGE(PG8_SA(0, 0), cA, voffA); PG8_STAGE(PG8_SB(0, 1), cB + hstep, voffB); PG8_STAGE(PG8_SA(0, 1), cA + hstep, voffA);
        if (wr == 1) PG8_BAR;
        PG8_WAIT_V(4); PG8_BAR;
        PG8_STAGE(PG8_SB(1, 0), cB + kstep, voffB); PG8_STAGE(PG8_SA(1, 0), cA + kstep, voffA); PG8_STAGE(PG8_SB(1, 1), cB + hstep + kstep, voffB);
        PG8_WAIT_V(6); PG8_BAR;
    }
    for (;;) {
        const bool has_next = S.next(ui + 1, nxt);
        const char* nA = has_next ? (const char*)g.A + (size_t)nxt.pm * tstep : cA; const char* nB = has_next ? (const char*)g.Bt + (size_t)nxt.pn * tstep : cB;
        for (int t = 0; t < nt; t += 2) {
            const bool last = (t == nt - 2);
            const char* a1 = cA + (size_t)(t + 1) * kstep;
            const char* a2 = last ? nA : cA + (size_t)(t + 2) * kstep; const char* b2 = last ? nB : cB + (size_t)(t + 2) * kstep;
            const char* a3 = a2 + kstep; const char* b3 = b2 + kstep;
            if (last && has_next) S.a_ready(nxt);
            if constexpr (SP2) {
            PG8_LDB(B0, 0, 0); PG8_LDB(B1, 0, 1); PG8_SCHED; PG8_LDA(At, 0, 0); PG8_STAGE(PG8_SA(1, 1), a1 + hstep, voffA);
            PG8_WAIT_V(8); PG8_WAIT_L(0); PG8_BAR; PG8_MMA(0, 0, At, B0); PG8_MMA(0, 1, At, B1); PG8_BAR; PG8_SCHED;
            PG8_LDA(At, 0, 1); PG8_STAGE(PG8_SB(0, 0), b2, voffB); PG8_STAGE(PG8_SB(0, 1), b2 + hstep, voffB); PG8_STAGE(PG8_SA(0, 0), a2, voffA);
            PG8_WAIT_V(8); PG8_WAIT_L(0); PG8_BAR; PG8_MMA(1, 0, At, B0); PG8_MMA(1, 1, At, B1); PG8_BAR; PG8_SCHED;
            PG8_LDB(B0, 1, 0); PG8_LDB(B1, 1, 1); PG8_SCHED; PG8_LDA(At, 1, 0); PG8_STAGE(PG8_SA(0, 1), a2 + hstep, voffA);
            PG8_WAIT_V(8); PG8_WAIT_L(0); PG8_BAR; PG8_MMA(0, 0, At, B0); PG8_MMA(0, 1, At, B1); PG8_BAR; PG8_SCHED;
            PG8_LDA(At, 1, 1); PG8_STAGE(PG8_SB(1, 0), b3, voffB); PG8_STAGE(PG8_SB(1, 1), b3 + hstep, voffB); PG8_STAGE(PG8_SA(1, 0), a3, voffA);
            PG8_WAIT_V(8); PG8_WAIT_L(0); PG8_BAR; PG8_MMA(1, 0, At, B0); PG8_MMA(1, 1, At, B1); PG8_BAR; PG8_SCHED;
            } else {
            PG8_LDB(B0, 0, 0); PG8_SCHED; PG8_LDA(At, 0, 0); PG8_STAGE(PG8_SA(1, 1), a1 + hstep, voffA);
            PG8_WAIT_L(8); PG8_BAR; PG8_WAIT_L(0); PG8_MMA(0, 0, At, B0); PG8_BAR; PG8_SCHED;
            PG8_LDB(B1, 0, 1); PG8_STAGE(PG8_SB(0, 0), b2, voffB);
            PG8_BAR; PG8_WAIT_L(0); PG8_MMA(0, 1, At, B1); PG8_BAR;
            PG8_LDA(At, 0, 1); PG8_STAGE(PG8_SA(0, 0), a2, voffA);
            PG8_BAR; PG8_WAIT_L(0); PG8_MMA(1, 0, At, B0); PG8_BAR; PG8_SCHED;
            PG8_STAGE(PG8_SB(0, 1), b2 + hstep, voffB);
            PG8_WAIT_V(6); PG8_BAR; PG8_MMA(1, 1, At, B1); PG8_BAR;
            PG8_LDB(B0, 1, 0); PG8_SCHED; PG8_LDA(At, 1, 0); PG8_STAGE(PG8_SA(0, 1), a2 + hstep, voffA);
            PG8_WAIT_L(8); PG8_BAR; PG8_WAIT_L(0); PG8_MMA(0, 0, At, B0); PG8_BAR; PG8_SCHED;
            PG8_LDB(B1, 1, 1); PG8_STAGE(PG8_SB(1, 0), b3, voffB);
            PG8_BAR; PG8_WAIT_L(0); PG8_MMA(0, 1, At, B1); PG8_BAR;
            PG8_LDA(At, 1, 1); PG8_STAGE(PG8_SA(1, 0), a3, voffA);
            PG8_BAR; PG8_WAIT_L(0); PG8_MMA(1, 0, At, B0); PG8_BAR; PG8_SCHED;
            PG8_STAGE(PG8_SB(1, 1), b3 + hstep, voffB);
            PG8_WAIT_V(6); PG8_BAR; PG8_MMA(1, 1, At, B1); PG8_BAR;
            }
        }
        if constexpr (ALIGN_EPI) { if (wr == 0) PG8_BAR; }
        if constexpr (!Epi::AFTER_DRAIN) { E(acc, cur, wr, wc, fr, fq); S.done(cur); }
        if (!has_next) break;
#pragma unroll
        for (int a = 0; a < 2; ++a)
#pragma unroll
            for (int b = 0; b < 2; ++b)
#pragma unroll
                for (int m = 0; m < 4; ++m)
#pragma unroll
                    for (int n = 0; n < 2; ++n) acc[a][b][m][n] = (f32x4){0.f, 0.f, 0.f, 0.f};
        cur = nxt; cA = nA; cB = nB; ++ui;
        if constexpr (ALIGN_EPI) { if (wr == 1) PG8_BAR; }
    }
    PG8_WAIT_V(0);
    if constexpr (!ALIGN_EPI) { if (wr == 0) PG8_BAR; }
    PG8_BAR;
    if constexpr (Epi::AFTER_DRAIN) { E.fused(acc, cur, wr, wc, fr, fq, lds, wid, lane); S.done(cur); }
#undef PG8_SA
#undef PG8_SB
#undef PG8_STAGE
#undef PG8_LDA
#undef PG8_LDB
#undef PG8_MMA
#undef PG8_WAIT_V
#undef PG8_WAIT_L
#undef PG8_BAR
#undef PG8_SCHED
}
}
typedef unsigned short bf16;
typedef pg8::bf16_t bf16_t;
typedef unsigned u32x2 __attribute__((ext_vector_type(2)));
constexpr int S = 16384, DM = 4096, DEPTH = 4, HD = 128, INW = 12800, NMOD = 3 * DM;
constexpr int A_H = 12, B_H = 8, C_H = 12;
constexpr int COL_AK = 0, COL_AV = 1536, COL_AG = 3072, COL_BQ = 4608, COL_BK = 5632, COL_BV = 5888, COL_BG = 6144, COL_CG = 7168, COL_CV = 8704,
              COL_AQ = 9216, COL_CQ = 10752, COL_CK = 12288;
__host__ __device__ constexpr int proj_col_of(int src) { return src < 1536 ? src + COL_AQ : (src < 8704 ? src - 1536 : (src < 10752 ? src + 2048 : (src < 11264 ? src - 2048 : src - 4096))); }
constexpr int PLD = 256;
__host__ __device__ constexpr int PC(int col) { return (col >> 8) * (S * 256) + (col & 255); }
constexpr int OCOL_A = 0, OCOL_B = 1536, OCOL_C = 2560;
constexpr float EPS = 1e-6f;
constexpr float SM_SCALE = 0.08838834764831845f;
constexpr float LOG2E = 1.4426950408889634f;
constexpr float QK_C = SM_SCALE * LOG2E;
constexpr int NWAVES = 8;

constexpr size_t MiB = 1u << 20;
constexpr size_t WS_CTL = 0, CTL_ZERO_BYTES = 1 * MiB;
constexpr size_t WS_TAB = 1 * MiB;
constexpr size_t WS_MODP = 1 * MiB + 256 * 1024;
constexpr size_t WS_WIN = 2 * MiB;
constexpr size_t WS_WOUT = WS_WIN + 400 * MiB;
constexpr size_t WS_H = WS_WOUT + 128 * MiB;
constexpr size_t WS_PROJ = WS_H + 128 * MiB;
constexpr size_t WS_O = WS_PROJ + 400 * MiB;
constexpr size_t WS_Y = WS_O + 128 * MiB;
constexpr size_t WS_PART4 = WS_Y + 128 * MiB;
constexpr size_t WS_PART16 = WS_PART4 + 48 * MiB;
constexpr size_t WS_STAT4 = WS_PART16 + 48 * MiB;
constexpr size_t WS_STAT16 = WS_STAT4 + 2 * MiB;
constexpr size_t WS_QF8 = WS_STAT16 + 2 * MiB;
constexpr size_t WS_KF8 = WS_QF8 + 24 * MiB;
constexpr size_t WS_VTF8 = WS_KF8 + 8 * MiB;
constexpr size_t WS_H8 = WS_VTF8 + 8 * MiB;
constexpr size_t WS_W8 = WS_H8 + 64 * MiB;
constexpr size_t WS_END = WS_W8 + 64 * MiB;
constexpr int F8_COL0 = COL_AQ, F8_COLS = 3584;
constexpr int CW_AMAX = 1024;
constexpr int CW_BAR = 4096;
constexpr int LUTA_N = 2 * (64 + 28) + 1, LUTB_N = 2 * (128 + 28) + 1;
constexpr int TB_LUTA = 0;
constexpr int TB_LUTB = 6912;
constexpr int TB_ROPE_R = 12288;
constexpr int TB_ROPE_C = 12288 + 16384;
constexpr int RING_OFF = 0, RING_BYTES = 131072;
constexpr int BAND_BYTES = 8 * (8192 + 32 * 272);
constexpr int LDSCTL_OFF = BAND_BYTES, MISC_OFF = LDSCTL_OFF + 320;
constexpr int BAND_LUT_OFF = LDSCTL_OFF + 1024;
constexpr int BAND_LUT_WAVE = 2048;
constexpr int LDS_BYTES = BAND_LUT_OFF + 8 * BAND_LUT_WAVE;
__device__ __forceinline__ int fresh_lane() { int l; asm volatile("v_mbcnt_lo_u32_b32 %0, -1, 0\n\tv_mbcnt_hi_u32_b32 %0, -1, %0" : "=v"(l)); return l; }
__device__ __forceinline__ float lane_xor(float v, int mask, int lane) { return __uint_as_float((unsigned)__builtin_amdgcn_ds_bpermute((lane ^ mask) << 2, (int)__float_as_uint(v))); }
__device__ __forceinline__ float wave_sum_l(float v, int lane) {
#pragma unroll
    for (int o = 1; o < 64; o <<= 1) v += lane_xor(v, o, lane);
    return v;
}
__device__ __forceinline__ float wave_max_l(float v, int lane) {
#pragma unroll
    for (int o = 1; o < 64; o <<= 1) v = fmaxf(v, lane_xor(v, o, lane));
    return v;
}

#define GAS __attribute__((address_space(1)))
#define LAS __attribute__((address_space(3)))
typedef unsigned short bf16;
typedef unsigned v4u __attribute__((ext_vector_type(4)));
typedef float f32x4 __attribute__((ext_vector_type(4)));
typedef short bf16x8 __attribute__((ext_vector_type(8)));
typedef GAS unsigned gu32;
typedef GAS unsigned long long gu64;
#define RLX_AGENT __ATOMIC_RELAXED, __HIP_MEMORY_SCOPE_AGENT
#define LDS_WAIT() asm volatile("s_waitcnt lgkmcnt(0)" ::: "memory")
#define VM_WAIT() asm volatile("s_waitcnt vmcnt(0)" ::: "memory")
__device__ __forceinline__ unsigned long long rt() { return __builtin_amdgcn_s_memrealtime(); }
__device__ __forceinline__ unsigned f2bf(float f) { unsigned u = __builtin_bit_cast(unsigned, f); return (u + 0x7fffu + ((u >> 16) & 1u)) >> 16; }
__device__ __forceinline__ unsigned pk2(float lo, float hi) { return f2bf(lo) | (f2bf(hi) << 16); }

#define XB_TMO      128
#define XB_XCNT(j)  (256  + 64 * (j))
#define XB_XSUB(j)  (1280 + 64 * (j))
#define XB_XGEN(j)  (2304 + 64 * (j))
#define XB_TOP      3328
#define XB_TOPGEN   3392
#define XCD_BAR_WORDS 3456
#define XB_SPIN_CAP (1u << 18)

__device__ __forceinline__ unsigned xb_ld(unsigned* p)              { return __hip_atomic_load(p, __ATOMIC_RELAXED, __HIP_MEMORY_SCOPE_AGENT); }
__device__ __forceinline__ unsigned xb_add(unsigned* p, unsigned v) { return __hip_atomic_fetch_add(p, v, __ATOMIC_RELAXED, __HIP_MEMORY_SCOPE_AGENT); }
__device__ __forceinline__ unsigned xb_xcc_id() { return (unsigned)__builtin_amdgcn_s_getreg((3 << 11) | 20) & 0xFu; }
#define XB_SPIN(cond, bar) do { unsigned _sp = 0; while (cond) { __builtin_amdgcn_s_sleep(1); \
    if ((++_sp & 255u) == 0u) { if (xb_ld(&(bar)[XB_TMO])) break; if (_sp > XB_SPIN_CAP) { atomicAdd(&(bar)[XB_TMO], 1u); break; } } } } while (0)

struct XcdBarrier {
    unsigned* bar; unsigned x; unsigned w;
    volatile LAS unsigned* st;
};

__device__ __forceinline__ XcdBarrier xcd_barrier_post(unsigned* bar, volatile LAS unsigned* st, unsigned wave) {
    XcdBarrier b; b.bar = bar; b.x = (unsigned)__builtin_amdgcn_readfirstlane((int)xb_xcc_id()); b.st = st; b.w = wave;
    if (threadIdx.x == 0) (void)xb_add(&bar[XB_XCNT(b.x)], 1u);
    return b;
}
__device__ __forceinline__ void xcd_barrier_complete(unsigned* bar, unsigned x, unsigned& nloc, unsigned& nx) {
    const unsigned G = gridDim.x * gridDim.y * gridDim.z;
    unsigned sum, cnt, mine, sp = 0u;
    for (;;) {
        sum = 0u; cnt = 0u; mine = 0u;
#pragma unroll
        for (unsigned j = 0; j < 16; ++j) { const unsigned c = xb_ld(&bar[XB_XCNT(j)]); sum += c; cnt += (c > 0u) ? 1u : 0u; mine = (j == x) ? c : mine; }
        if (sum == G) break;
        __builtin_amdgcn_s_sleep(1);
        if ((++sp & 255u) == 0u) { if (xb_ld(&bar[XB_TMO])) break; if (sp > XB_SPIN_CAP) { atomicAdd(&bar[XB_TMO], 1u); break; } }
    }
    nloc = mine > 0u ? mine : 1u; nx = cnt > 0u ? cnt : 1u;
}

__device__ __forceinline__ void xcd_barrier(const XcdBarrier& b) {
    asm volatile("s_waitcnt vmcnt(0)" ::: "memory");
    __syncthreads();
    int ln_; asm volatile("v_mbcnt_lo_u32_b32 %0, -1, 0\n\tv_mbcnt_hi_u32_b32 %0, -1, %0" : "=v"(ln_));
    if (b.w == 0u && ln_ == 0) {
        unsigned* bar = b.bar; unsigned bx_ = b.x; asm volatile("" : "+s"(bar), "+s"(bx_));
        __builtin_amdgcn_s_waitcnt(0);
        unsigned nloc = b.st[0], nx = b.st[1];
        if (nloc == 0u) { xcd_barrier_complete(bar, bx_, nloc, nx); b.st[0] = nloc; b.st[1] = nx; }
        const unsigned old = xb_add(&bar[XB_XSUB(bx_)], 1u);
        const unsigned gen = old / nloc;
        if (old + 1u == (gen + 1u) * nloc) {
            __builtin_amdgcn_fence(__ATOMIC_RELEASE, "agent");
            asm volatile("s_waitcnt vmcnt(0)" ::: "memory");
            const unsigned og = xb_add(&bar[XB_TOP], 1u);
            const unsigned tg = og / nx;
            if (og + 1u == (tg + 1u) * nx) xb_add(&bar[XB_TOPGEN], 1u);
            else XB_SPIN(xb_ld(&bar[XB_TOPGEN]) == tg, bar);
            __builtin_amdgcn_fence(__ATOMIC_ACQUIRE, "agent");
            xb_add(&bar[XB_XGEN(bx_)], 1u);
            asm volatile("s_waitcnt vmcnt(0)" ::: "memory");
        } else {
            XB_SPIN(xb_ld(&bar[XB_XGEN(bx_)]) == gen, bar);
            __builtin_amdgcn_fence(__ATOMIC_ACQUIRE, "agent");
            asm volatile("s_waitcnt vmcnt(0)" ::: "memory");
        }
    }
    __syncthreads();
}
__device__ __forceinline__ float wave_sum(float v) {
#pragma unroll
    for (int o = 1; o < 64; o <<= 1) v += __shfl_xor(v, o);
    return v;
}
template <bool TRACK>
__device__ __forceinline__ void p0_transpose_item(const float* W, int K, int N, bf16* WT, int row_off, LAS float* scr, int item, int lane, float& amx) {
    const int nblk = N / 32, kb = item / nblk, nb = item % nblk, k0 = 64 * kb, n0 = 32 * nb;
#pragma unroll 8
    for (int i = 0; i < 32; ++i) { const int kk = 2 * i + (lane >> 5); const float w_ = W[(size_t)(k0 + kk) * N + n0 + (lane & 31)]; scr[kk * 33 + (lane & 31)] = w_; if (TRACK) amx = fmaxf(amx, fabsf(w_)); }
    LDS_WAIT(); asm volatile("" ::: "memory");
    const int c = lane & 7;
#pragma unroll
    for (int j = 0; j < 4; ++j) { const int n = (lane >> 3) + 8 * j; const LAS float* s = scr + (8 * c) * 33 + n;
        v4u o; o.x = pk2(s[0 * 33], s[1 * 33]); o.y = pk2(s[2 * 33], s[3 * 33]); o.z = pk2(s[4 * 33], s[5 * 33]); o.w = pk2(s[6 * 33], s[7 * 33]);
        *(GAS v4u*)(WT + (size_t)(row_off + n0 + n) * K + k0 + 8 * c) = o; }
    LDS_WAIT(); asm volatile("" ::: "memory");
}
namespace attc {
typedef unsigned short bf16;
constexpr int   D = 128, NW = 8, QBLK = 32, KVBLK = 64;
constexpr float SCALE = SM_SCALE;
constexpr float THR = 8.f;
constexpr int SDEPTH = 2;
constexpr int LDQ = PLD, LDK = INW, LDO = DM;
constexpr size_t SHM_V = KVBLK * D * 2, SHM_K = KVBLK * D * 2, SHM_ATTN = 2 * SHM_V + 2 * SHM_K + NW * 64 * 4;
using bf16x8 = __attribute__((ext_vector_type(8))) short;
using s16x4  = __attribute__((ext_vector_type(4))) short;
using f32x16 = __attribute__((ext_vector_type(16))) float;
using u32x4  = __attribute__((ext_vector_type(4))) unsigned;
struct StageB { using T = bf16x8;
  __device__ static __forceinline__ T ld8(const bf16* p) { return *reinterpret_cast<const bf16x8*>(p); }
  __device__ static __forceinline__ bf16x8 tobf(T x) { return x; } };
#define KSWZ(row, colB) ((row) * 256 + ((colB) ^ (((row) & 7) << 4)))
#define SBAR() __builtin_amdgcn_sched_barrier(0)
__device__ __forceinline__ int crow(int r, int hi) { return (r & 3) + 8 * (r >> 2) + 4 * hi; }
__device__ __forceinline__ unsigned cvtpk(float lo, float hi) {
  unsigned r; asm volatile("v_cvt_pk_bf16_f32 %0, %1, %2" : "=v"(r) : "v"(lo), "v"(hi)); return r;
}
__device__ __forceinline__ void partialSM(f32x16& p0, f32x16& p1, float& m_reg, float& mn, float& alpha) {
  constexpr float C = SCALE * 1.4426950408889634f;
  float pmax = p0[0]; for (int r = 1; r < 16; ++r) pmax = fmaxf(pmax, p0[r]); for (int r = 0; r < 16; ++r) pmax = fmaxf(pmax, p1[r]);
  { auto rr = __builtin_amdgcn_permlane32_swap(__float_as_uint(pmax), __float_as_uint(pmax), false, false);
    pmax = fmaxf(__uint_as_float(rr[0]), __uint_as_float(rr[1])); }
  if (__builtin_expect(__all(pmax - m_reg <= THR / SCALE), 1)) { mn = m_reg; alpha = 1.f; }
  else { mn = fmaxf(m_reg, pmax); alpha = __builtin_amdgcn_exp2f((m_reg - mn) * C); m_reg = mn; }
  float mnC = -mn * C;
  for (int r = 0; r < 16; ++r) p0[r] = fmaf(p0[r], C, mnC); for (int r = 0; r < 16; ++r) p1[r] = fmaf(p1[r], C, mnC);
  for (int r = 0; r < 16; ++r) p0[r] = __builtin_amdgcn_exp2f(p0[r]);
}
__device__ __forceinline__ float psm_max(const f32x16& p0, const f32x16& p1) {
  float pmax = p0[0];
#pragma unroll
  for (int r = 1; r < 16; ++r) pmax = fmaxf(pmax, p0[r]);
#pragma unroll
  for (int r = 0; r < 16; ++r) pmax = fmaxf(pmax, p1[r]);
  auto rr = __builtin_amdgcn_permlane32_swap(__float_as_uint(pmax), __float_as_uint(pmax), false, false);
  return fmaxf(__uint_as_float(rr[0]), __uint_as_float(rr[1]));
}
__device__ __forceinline__ void psm_scale(f32x16& p0, f32x16& p1, float pmax, float& m_reg, float& mn, float& alpha) {
  constexpr float C = SCALE * 1.4426950408889634f;
  const bool keep = __all(pmax - m_reg <= THR / SCALE);
  mn = keep ? m_reg : fmaxf(m_reg, pmax); alpha = keep ? 1.f : __builtin_amdgcn_exp2f((m_reg - mn) * C); m_reg = mn;
  const float mnC = -mn * C;
#pragma unroll
  for (int r = 0; r < 16; ++r) p0[r] = fmaf(p0[r], C, mnC);
#pragma unroll
  for (int r = 0; r < 16; ++r) p1[r] = fmaf(p1[r], C, mnC);
}
template <int LO> __device__ __forceinline__ void psm_exp8(f32x16& p0) {
#pragma unroll
  for (int r = LO; r < LO + 8; ++r) p0[r] = __builtin_amdgcn_exp2f(p0[r]);
}
__device__ __forceinline__ void finishSM(f32x16& p0, f32x16& p1, float alpha, float& l_reg, bf16x8& pa0, bf16x8& pa1, bf16x8& pa2, bf16x8& pa3) {
  for (int r = 0; r < 16; ++r) p1[r] = __builtin_amdgcn_exp2f(p1[r]);
  float ps = 0; for (int r = 0; r < 16; ++r) ps += p0[r]; for (int r = 0; r < 16; ++r) ps += p1[r];
  { auto rr = __builtin_amdgcn_permlane32_swap(__float_as_uint(ps), __float_as_uint(ps), false, false);
    ps = __uint_as_float(rr[0]) + __uint_as_float(rr[1]); }
  l_reg = l_reg * alpha + ps;
#define PK4(P, BASE, OUT) do { unsigned a0 = cvtpk(P[BASE + 0], P[BASE + 1]), a1 = cvtpk(P[BASE + 2], P[BASE + 3]);   \
    unsigned b0 = cvtpk(P[BASE + 4], P[BASE + 5]), b1 = cvtpk(P[BASE + 6], P[BASE + 7]);                              \
    auto r0 = __builtin_amdgcn_permlane32_swap(a0, b0, false, false); auto r1 = __builtin_amdgcn_permlane32_swap(a1, b1, false, false); \
    u32x4 w = {r0[0], r1[0], r0[1], r1[1]}; OUT = *reinterpret_cast<bf16x8*>(&w); } while (0)
  PK4(p0, 0, pa0); PK4(p0, 8, pa1); PK4(p1, 0, pa2); PK4(p1, 8, pa3);
#undef PK4
}
__device__ __forceinline__ void qkt(f32x16& p0, f32x16& p1, const bf16* Ks, const bf16x8* qr, int r32, int hi) {
  p0 = f32x16{}; p1 = f32x16{};
  for (int d0 = 0; d0 < 8; ++d0) { int cb = (d0 * 16 + hi * 8) * 2;
    bf16x8 b0 = *reinterpret_cast<const bf16x8*>((const char*)Ks + KSWZ(r32, cb));
    bf16x8 b1 = *reinterpret_cast<const bf16x8*>((const char*)Ks + KSWZ(32 + r32, cb));
    p0 = __builtin_amdgcn_mfma_f32_32x32x16_bf16(b0, qr[d0], p0, 0, 0, 0);
    p1 = __builtin_amdgcn_mfma_f32_32x32x16_bf16(b1, qr[d0], p1, 0, 0, 0); }
}
__device__ __forceinline__ int v_st(int k, int c) { const int kk = (k & ~0xC) | ((k & 4) << 1) | ((k & 8) >> 1); return ((kk >> 3) * 4 + (c >> 5)) * 512 + ((kk & 7) * 32 + (c & 31)) * 2; }
__device__ __forceinline__ int v_rd_base(int lane) { return ((lane & 3) << 3) | (((lane >> 2) & 3) << 6) | (((lane >> 4) & 1) << 5) | (((lane >> 5) & 1) << 8); }
constexpr int v_rd_off(int d0, int ks, int half) { return d0 * 512 + ks * 4096 + half * 2048; }
template <int OFF> __device__ __forceinline__ s16x4 tr_read(int vb) {
  s16x4 r; asm volatile("ds_read_b64_tr_b16 %0, %1 offset:%2" : "=&v"(r) : "v"(vb), "i"(OFF) : "memory"); return r;
}
template <int D0> __device__ __forceinline__ void pv_one(f32x16& od, int vb, bf16x8 pa0, bf16x8 pa1, bf16x8 pa2, bf16x8 pa3) {
  const s16x4 l0 = tr_read<v_rd_off(D0, 0, 0)>(vb), h0 = tr_read<v_rd_off(D0, 0, 1)>(vb), l1 = tr_read<v_rd_off(D0, 1, 0)>(vb), h1 = tr_read<v_rd_off(D0, 1, 1)>(vb);
  const s16x4 l2 = tr_read<v_rd_off(D0, 2, 0)>(vb), h2 = tr_read<v_rd_off(D0, 2, 1)>(vb), l3 = tr_read<v_rd_off(D0, 3, 0)>(vb), h3 = tr_read<v_rd_off(D0, 3, 1)>(vb);
  asm volatile("s_waitcnt lgkmcnt(0)" ::: "memory"); SBAR();
#define PK(L, H) (bf16x8){L[0], L[1], L[2], L[3], H[0], H[1], H[2], H[3]}
  od = __builtin_amdgcn_mfma_f32_32x32x16_bf16(pa0, PK(l0, h0), od, 0, 0, 0);
  od = __builtin_amdgcn_mfma_f32_32x32x16_bf16(pa1, PK(l1, h1), od, 0, 0, 0);
  od = __builtin_amdgcn_mfma_f32_32x32x16_bf16(pa2, PK(l2, h2), od, 0, 0, 0);
  od = __builtin_amdgcn_mfma_f32_32x32x16_bf16(pa3, PK(l3, h3), od, 0, 0, 0);
#undef PK
}
__device__ __forceinline__ void pv_d0(f32x16* o, int vb, bf16x8 pa0, bf16x8 pa1, bf16x8 pa2, bf16x8 pa3) {
  pv_one<0>(o[0], vb, pa0, pa1, pa2, pa3); pv_one<1>(o[1], vb, pa0, pa1, pa2, pa3); pv_one<2>(o[2], vb, pa0, pa1, pa2, pa3); pv_one<3>(o[3], vb, pa0, pa1, pa2, pa3);
}
__device__ __forceinline__ void pv_psm(f32x16* o, int vb, bf16x8 pa0, bf16x8 pa1, bf16x8 pa2, bf16x8 pa3, f32x16& q0, f32x16& q1, float& m_reg, float& mn, float& alpha) {
  pv_one<0>(o[0], vb, pa0, pa1, pa2, pa3); float pmax = psm_max(q0, q1); asm volatile("" : "+v"(pmax));
  pv_one<1>(o[1], vb, pa0, pa1, pa2, pa3); psm_scale(q0, q1, pmax, m_reg, mn, alpha); asm volatile("" : "+v"(q0), "+v"(q1));
  pv_one<2>(o[2], vb, pa0, pa1, pa2, pa3); psm_exp8<0>(q0); asm volatile("" : "+v"(q0));
  pv_one<3>(o[3], vb, pa0, pa1, pa2, pa3); psm_exp8<8>(q0); asm volatile("" : "+v"(q0)); SBAR();
}

constexpr int EPI_PITCH = 528, EPI_BYTES = 32 * EPI_PITCH;
template <int QS>
__device__ __forceinline__ void epi_stage_store(const f32x16 (&o)[4], const float (&rli)[16], __attribute__((address_space(3))) unsigned char* st,
                                                const bf16* __restrict__ gbase, bf16* __restrict__ obase, int lane) {
  typedef float f32x4_t __attribute__((ext_vector_type(4)));
  asm volatile("" : "+v"(lane));
  const int r32 = lane & 31, hi = lane >> 5;
  const int rr = lane >> 4, c16 = lane & 15;
  u32x4 g[8];
#pragma unroll
  for (int i = 0; i < 8; ++i) g[i] = *reinterpret_cast<const u32x4*>(gbase + (size_t)(QS * (rr + 4 * i)) * LDQ + c16 * 8);
#pragma unroll
  for (int r = 0; r < 16; ++r) { const int row = crow(r, hi);
#pragma unroll
    for (int d0 = 0; d0 < 4; ++d0) *reinterpret_cast<__attribute__((address_space(3))) float*>(st + row * EPI_PITCH + (d0 * 32 + r32) * 4) = o[d0][r] * rli[r]; }
#pragma unroll
  for (int i = 0; i < 8; ++i) { const int row = rr + 4 * i;
    const f32x4_t a = *reinterpret_cast<const __attribute__((address_space(3))) f32x4_t*>(st + row * EPI_PITCH + c16 * 32);
    const f32x4_t b = *reinterpret_cast<const __attribute__((address_space(3))) f32x4_t*>(st + row * EPI_PITCH + c16 * 32 + 16);
    float v[8] = {a[0], a[1], a[2], a[3], b[0], b[1], b[2], b[3]};
#pragma unroll
    for (int e = 0; e < 4; ++e) { const float g0 = __uint_as_float(g[i][e] << 16), g1 = __uint_as_float(g[i][e] & 0xffff0000u);
      v[2 * e] *= g0 * __builtin_amdgcn_rcpf(1.f + __expf(-g0)); v[2 * e + 1] *= g1 * __builtin_amdgcn_rcpf(1.f + __expf(-g1)); }
    u32x4 w = {cvtpk(v[0], v[1]), cvtpk(v[2], v[3]), cvtpk(v[4], v[5]), cvtpk(v[6], v[7])};
    *reinterpret_cast<u32x4*>(obase + (size_t)(QS * row) * LDO + c16 * 8) = w; }
}

__device__ __forceinline__ void attn_dense_body(const bf16* __restrict__ Qb, const bf16* __restrict__ Kh, const bf16* __restrict__ Vh,
                                                const bf16* __restrict__ Gb, bf16* __restrict__ Ob, int seq, char* lds, const int wid) {
  using St = StageB;
  int lane_l; asm volatile("v_mbcnt_lo_u32_b32 %0, -1, 0\n\tv_mbcnt_hi_u32_b32 %0, -1, %0" : "=v"(lane_l));
  const int lane = lane_l, tid = wid * 64 + lane, r32 = lane & 31, hi = lane >> 5;
  bf16* V_lds = (bf16*)lds; bf16* K_lds = (bf16*)(lds + 2 * SHM_V);
  float* ws = (float*)(lds + 2 * SHM_V + 2 * SHM_K) + wid * 64; float* li_l = ws; float* al_l = ws + 32;
  float m_reg = -1e30f, l_reg = 0; f32x16 o[4] = {}; bf16x8 qr[8];
  const bf16* Qw = Qb + (long)(wid * QBLK + r32) * LDQ + hi * 8;
#pragma unroll
  for (int d0 = 0; d0 < 8; ++d0) qr[d0] = St::ld8(Qw + d0 * 16);
  const int sr = tid >> 4, sc = (tid & 15) * 8, vst0 = v_st(sr, sc), vst1 = v_st(32 + sr, sc);
  const int vb0 = (int)(uintptr_t)V_lds + v_rd_base(lane);
  struct { typename St::T vs0, vs1, ks0, ks1; } sr_[SDEPTH];
#define SLOAD(i, k0) do { sr_[i].vs0 = St::ld8(&Vh[(long)((k0) + sr) * LDK + sc]); sr_[i].vs1 = St::ld8(&Vh[(long)((k0) + 32 + sr) * LDK + sc]); \
    sr_[i].ks0 = St::ld8(&Kh[(long)((k0) + sr) * LDK + sc]); sr_[i].ks1 = St::ld8(&Kh[(long)((k0) + 32 + sr) * LDK + sc]); } while (0)
#define SWRITE(b, i) do { *(bf16x8*)((char*)V_lds + (b) * SHM_V + vst0) = St::tobf(sr_[i].vs0);          \
    *(bf16x8*)((char*)V_lds + (b) * SHM_V + vst1) = St::tobf(sr_[i].vs1); int kc = sc * 2;               \
    *(bf16x8*)((char*)K_lds + (b) * SHM_K + KSWZ(sr, kc)) = St::tobf(sr_[i].ks0);                       \
    *(bf16x8*)((char*)K_lds + (b) * SHM_K + KSWZ(32 + sr, kc)) = St::tobf(sr_[i].ks1); } while (0)
#define SWAIT() do { if constexpr (SDEPTH == 2) asm volatile("s_waitcnt vmcnt(4)" ::: "memory"); else asm volatile("s_waitcnt vmcnt(0)" ::: "memory"); } while (0)
#define RESC(a) do { if (__any((a) < 1.f)) { if (hi == 0) al_l[r32] = (a); asm volatile("s_waitcnt lgkmcnt(0)" ::: "memory"); \
    for (int d = 0; d < 4; ++d) for (int r = 0; r < 16; ++r) o[d][r] *= al_l[crow(r, hi)]; } } while (0)
  f32x16 pA0, pA1, pB0, pB1; float mnA, mnB, alA, alB; bf16x8 pa0, pa1, pa2, pa3; const int NT = seq / KVBLK;
#ifdef ATT_PRIO
  if (wid >= 4) __builtin_amdgcn_s_setprio(1);
#endif
  constexpr int SE = 0, SO = SDEPTH - 1;
  SLOAD(SE, 0); asm volatile("s_waitcnt vmcnt(0)" ::: "memory"); SWRITE(0, SE); __syncthreads();
  qkt(pA0, pA1, K_lds, qr, r32, hi); partialSM(pA0, pA1, m_reg, mnA, alA);
  SLOAD(SO, KVBLK); if constexpr (SDEPTH == 2) { if (2 < NT) SLOAD(SE, 2 * KVBLK); }
  SWAIT(); SWRITE(1, SO); __syncthreads();
  for (int j = 1; j + 1 < NT; j += 2) {
    SBAR(); qkt(pB0, pB1, (bf16*)((char*)K_lds + SHM_K), qr, r32, hi);
    finishSM(pA0, pA1, alA, l_reg, pa0, pa1, pa2, pa3); SBAR();
    SLOAD(SO, (j + SDEPTH) * KVBLK); SBAR();
    pv_psm(o, vb0, pa0, pa1, pa2, pa3, pB0, pB1, m_reg, mnB, alB);
    __syncthreads(); SWAIT(); SWRITE(0, SE);
    RESC(alB); __syncthreads();
    SBAR(); qkt(pA0, pA1, K_lds, qr, r32, hi);
    finishSM(pB0, pB1, alB, l_reg, pa0, pa1, pa2, pa3); SBAR();
    if (SDEPTH == 1 || j + 3 < NT) SLOAD(SE, (j + 1 + SDEPTH) * KVBLK); SBAR();
    pv_psm(o, vb0 + (int)SHM_V, pa0, pa1, pa2, pa3, pA0, pA1, m_reg, mnA, alA);
    __syncthreads(); SWAIT(); SWRITE(1, SO);
    RESC(alA); __syncthreads();
  }
  SBAR(); qkt(pB0, pB1, (bf16*)((char*)K_lds + SHM_K), qr, r32, hi);
  finishSM(pA0, pA1, alA, l_reg, pa0, pa1, pa2, pa3); SBAR();
  pv_psm(o, vb0, pa0, pa1, pa2, pa3, pB0, pB1, m_reg, mnB, alB);
  __syncthreads(); RESC(alB);
  finishSM(pB0, pB1, alB, l_reg, pa0, pa1, pa2, pa3); SBAR();
  pv_d0(o, vb0 + (int)SHM_V, pa0, pa1, pa2, pa3);
  if (hi == 0) li_l[r32] = l_reg; asm volatile("s_waitcnt lgkmcnt(0)" ::: "memory");
  float rli[16];
#pragma unroll
  for (int r = 0; r < 16; ++r) rli[r] = __builtin_amdgcn_rcpf(li_l[crow(r, hi)]);
#ifdef ATT_PRIO
  __builtin_amdgcn_s_setprio(0);
#endif
  __syncthreads();
  epi_stage_store<1>(o, rli, (__attribute__((address_space(3))) unsigned char*)(uintptr_t)(unsigned)(uintptr_t)lds + wid * EPI_BYTES, Gb + (long)(wid * QBLK) * LDQ, Ob + (long)(wid * QBLK) * LDO, lane);
  __syncthreads();
#undef SLOAD
#undef SWRITE
#undef SWAIT
#undef RESC
}
typedef int i32x8 __attribute__((ext_vector_type(8)));
typedef int i32x4 __attribute__((ext_vector_type(4)));
constexpr int KP8 = 144, VP8 = 80;
constexpr size_t SHM_K8 = 64 * KP8, SHM_V8 = 128 * VP8;
constexpr float THR8 = 3.72f, PSH8 = 5.f;
constexpr float Q8_PRESCALE = SCALE * 1.4426950408889634f * 8.f;
constexpr int LDQ8 = C_H * HD, LDK8 = 4 * HD;
#define MFMA8(A, B, Cc) __builtin_amdgcn_mfma_scale_f32_32x32x64_f8f6f4(A, B, Cc, 0, 0, 0, 0x7f7f7f7f, 0, 0x7f7f7f7f)
#define MFMA8Q(A, B, Cc) __builtin_amdgcn_mfma_scale_f32_32x32x64_f8f6f4(A, B, Cc, 0, 0, 0, 0x7f7f7f7f, 0, 0x7c7c7c7c)
typedef __attribute__((address_space(3))) const unsigned char* lcp8;
__device__ __forceinline__ i32x8 lds32(lcp8 p) {
  const i32x4 a = *reinterpret_cast<const __attribute__((address_space(3))) i32x4*>(p), b = *reinterpret_cast<const __attribute__((address_space(3))) i32x4*>(p + 16);
  return (i32x8){a[0], a[1], a[2], a[3], b[0], b[1], b[2], b[3]};
}
__device__ __forceinline__ void qkt8(f32x16& p0, f32x16& p1, lcp8 kb, const i32x8* qf, const f32x16& minit) {
  p0 = MFMA8Q(lds32(kb), qf[0], minit); p0 = MFMA8Q(lds32(kb + 64), qf[1], p0);
  p1 = MFMA8Q(lds32(kb + 32 * KP8), qf[0], minit); p1 = MFMA8Q(lds32(kb + 32 * KP8 + 64), qf[1], p1);
}
template <bool FIRST>
__device__ __forceinline__ void psm_fix8(f32x16& p0, f32x16& p1, float pmax, f32x16& minit, float& alpha) {
  alpha = 1.f;
  if (FIRST || !__all(pmax <= PSH8 + THR8)) {
    const float delta = FIRST ? pmax - PSH8 : fmaxf(pmax - PSH8, 0.f);
    if (!FIRST) alpha = __builtin_amdgcn_exp2f(-delta);
#pragma unroll
    for (int r = 0; r < 16; ++r) { p0[r] -= delta; p1[r] -= delta; minit[r] -= delta; }
  }
}
__device__ __forceinline__ void finishSM8(f32x16& p0, f32x16& p1, i32x8& pa) {
#pragma unroll
  for (int r = 0; r < 16; ++r) p1[r] = __builtin_amdgcn_exp2f(p1[r]);
  int und; asm volatile("" : "=v"(und));
#pragma unroll
  for (int w = 0; w < 4; ++w) { int t = __builtin_amdgcn_cvt_pk_fp8_f32(p0[4 * w], p0[4 * w + 1], und, false); pa[w] = __builtin_amdgcn_cvt_pk_fp8_f32(p0[4 * w + 2], p0[4 * w + 3], t, true);
                                int u = __builtin_amdgcn_cvt_pk_fp8_f32(p1[4 * w], p1[4 * w + 1], und, false); pa[4 + w] = __builtin_amdgcn_cvt_pk_fp8_f32(p1[4 * w + 2], p1[4 * w + 3], u, true); }
}
template <int LO> __device__ __forceinline__ void exp4(f32x16& p) {
#pragma unroll
  for (int r = LO; r < LO + 4; ++r) p[r] = __builtin_amdgcn_exp2f(p[r]);
}
template <int W> __device__ __forceinline__ void cvt8(const f32x16& p, int& d0, int& d1, int und) {
  int t = __builtin_amdgcn_cvt_pk_fp8_f32(p[8 * W], p[8 * W + 1], und, false); d0 = __builtin_amdgcn_cvt_pk_fp8_f32(p[8 * W + 2], p[8 * W + 3], t, true);
  int u = __builtin_amdgcn_cvt_pk_fp8_f32(p[8 * W + 4], p[8 * W + 5], und, false); d1 = __builtin_amdgcn_cvt_pk_fp8_f32(p[8 * W + 6], p[8 * W + 7], u, true);
}
__device__ __forceinline__ void qkt_fsm8(f32x16& n0, f32x16& n1, lcp8 kb, const i32x8* qf, const f32x16& minit, const f32x16& p0, f32x16& p1, i32x8& pa) {
  int und; asm volatile("" : "=v"(und));
  int a0, a1, a2, a3, a4, a5, a6, a7;
  const i32x8 k00 = lds32(kb), k10 = lds32(kb + 32 * KP8);
  cvt8<0>(p0, a0, a1, und); exp4<0>(p1); asm volatile("" : "+v"(p1), "+v"(a0), "+v"(a1)); SBAR();
  n0 = MFMA8Q(k00, qf[0], minit); const i32x8 k01 = lds32(kb + 64);
  cvt8<1>(p0, a2, a3, und); exp4<4>(p1); asm volatile("" : "+v"(p1), "+v"(a2), "+v"(a3)); SBAR();
  n1 = MFMA8Q(k10, qf[0], minit); const i32x8 k11 = lds32(kb + 32 * KP8 + 64);
  exp4<8>(p1); cvt8<0>(p1, a4, a5, und); asm volatile("" : "+v"(p1), "+v"(a4), "+v"(a5)); SBAR();
  n0 = MFMA8Q(k01, qf[1], n0);
  exp4<12>(p1); asm volatile("" : "+v"(p1)); SBAR();
  n1 = MFMA8Q(k11, qf[1], n1);
  cvt8<1>(p1, a6, a7, und); asm volatile("" : "+v"(a6), "+v"(a7)); SBAR();
  pa = (i32x8){a0, a1, a2, a3, a4, a5, a6, a7};
}
__device__ __forceinline__ void pv_psm8(f32x16* o, f32x16& ol, const i32x8 ones, lcp8 vb, const i32x8 pa, f32x16& q0, f32x16& q1, f32x16& minit, float& alpha) {
  o[0] = MFMA8(pa, lds32(vb), o[0]); float pmax = psm_max(q0, q1); asm volatile("" : "+v"(pmax));
  o[1] = MFMA8(pa, lds32(vb + 32 * VP8), o[1]); psm_fix8<false>(q0, q1, pmax, minit, alpha); asm volatile("" : "+v"(q0), "+v"(q1));
  o[2] = MFMA8(pa, lds32(vb + 64 * VP8), o[2]); psm_exp8<0>(q0); asm volatile("" : "+v"(q0));
  o[3] = MFMA8(pa, lds32(vb + 96 * VP8), o[3]); psm_exp8<8>(q0); asm volatile("" : "+v"(q0));
  ol = MFMA8(pa, ones, ol);
  SBAR();
}
__device__ __forceinline__ void pv8(f32x16* o, f32x16& ol, const i32x8 ones, lcp8 vb, const i32x8 pa) {
  o[0] = MFMA8(pa, lds32(vb), o[0]); o[1] = MFMA8(pa, lds32(vb + 32 * VP8), o[1]); o[2] = MFMA8(pa, lds32(vb + 64 * VP8), o[2]); o[3] = MFMA8(pa, lds32(vb + 96 * VP8), o[3]); ol = MFMA8(pa, ones, ol);
}
__device__ __forceinline__ void attn_f8_body(const unsigned char* __restrict__ Qb, const unsigned char* __restrict__ Kh, const unsigned char* __restrict__ Vt,
                                             const bf16* __restrict__ Gb, bf16* __restrict__ Ob, int seq, char* lds, const int wid) {
  int lane_l; asm volatile("v_mbcnt_lo_u32_b32 %0, -1, 0\n\tv_mbcnt_hi_u32_b32 %0, -1, %0" : "=v"(lane_l));
  const int lane = lane_l, tid = wid * 64 + lane, r32 = lane & 31, hi = lane >> 5;
  typedef __attribute__((address_space(3))) unsigned char* lp8;
  const lp8 V_lds = (lp8)(uintptr_t)(unsigned)(uintptr_t)lds; const lp8 K_lds = V_lds + 2 * SHM_V8;
  float* al_l = (float*)(lds + 2 * SHM_V8 + 2 * SHM_K8) + wid * 32;
  f32x16 o[4] = {}, ol = {}; i32x8 qf[2], ones; f32x16 minit;
#pragma unroll
  for (int r = 0; r < 8; ++r) ones[r] = 0x38383838;
#pragma unroll
  for (int r = 0; r < 16; ++r) minit[r] = PSH8;
  { const unsigned char* Qw = Qb + (long)(wid * QBLK + r32) * LDQ8 + hi * 32;
#pragma unroll
    for (int s = 0; s < 2; ++s) { const i32x4 a = *reinterpret_cast<const i32x4*>(Qw + 64 * s), b = *reinterpret_cast<const i32x4*>(Qw + 64 * s + 16); qf[s] = (i32x8){a[0], a[1], a[2], a[3], b[0], b[1], b[2], b[3]}; } }
  const int kr = tid >> 3, kc = (tid & 7) * 16, vd = tid >> 2, vc = (tid & 3) * 16;
  const int kst = kr * KP8 + kc, vst = vd * VP8 + vc;
  const lcp8 kb0 = K_lds + r32 * KP8 + hi * 32, vb0 = V_lds + r32 * VP8 + hi * 32;
  struct { i32x4 k, v; } sr_[2];
#define SLOAD8(i, k0) do { sr_[i].k = *reinterpret_cast<const i32x4*>(Kh + (long)((k0) + kr) * LDK8 + kc); sr_[i].v = *reinterpret_cast<const i32x4*>(Vt + (long)(k0) * HD + tid * 16); } while (0)
#define SWRITE8(b, i) do { *reinterpret_cast<__attribute__((address_space(3))) i32x4*>(K_lds + (b) * SHM_K8 + kst) = sr_[i].k; *reinterpret_cast<__attribute__((address_space(3))) i32x4*>(V_lds + (b) * SHM_V8 + vst) = sr_[i].v; } while (0)
#define SWAIT8() asm volatile("s_waitcnt vmcnt(2)" ::: "memory")
#define RESC8(a) do { if (__any((a) < 1.f)) { if (hi == 0) al_l[r32] = (a); asm volatile("s_waitcnt lgkmcnt(0)" ::: "memory"); \
    for (int r = 0; r < 16; ++r) { const float a_ = al_l[crow(r, hi)]; o[0][r] *= a_; o[1][r] *= a_; o[2][r] *= a_; o[3][r] *= a_; ol[r] *= a_; } } } while (0)
  f32x16 pA0, pA1, pB0, pB1; float alA, alB; i32x8 pa; const int NT = seq / KVBLK;
  constexpr int SE = 0, SO = 1;
  SLOAD8(SE, 0); asm volatile("s_waitcnt vmcnt(0)" ::: "memory"); SWRITE8(0, SE); __syncthreads();
  qkt8(pA0, pA1, kb0, qf, minit);
  { const float pmax = psm_max(pA0, pA1); psm_fix8<true>(pA0, pA1, pmax, minit, alA); psm_exp8<0>(pA0); psm_exp8<8>(pA0); }
  SLOAD8(SO, KVBLK); if (2 < NT) SLOAD8(SE, 2 * KVBLK);
  SWAIT8(); SWRITE8(1, SO); __syncthreads();
  for (int j = 1; j + 1 < NT; j += 2) {
    SBAR(); qkt_fsm8(pB0, pB1, kb0 + SHM_K8, qf, minit, pA0, pA1, pa);
    SLOAD8(SO, (j + 2) * KVBLK); SBAR();
    pv_psm8(o, ol, ones, vb0, pa, pB0, pB1, minit, alB);
    __syncthreads(); SWAIT8(); SWRITE8(0, SE);
    RESC8(alB); __syncthreads();
    SBAR(); qkt_fsm8(pA0, pA1, kb0, qf, minit, pB0, pB1, pa);
    SLOAD8(SE, (j + 3 < NT ? j + 3 : NT - 1) * KVBLK); SBAR();
    pv_psm8(o, ol, ones, vb0 + SHM_V8, pa, pA0, pA1, minit, alA);
    __syncthreads(); SWAIT8(); SWRITE8(1, SO);
    RESC8(alA); __syncthreads();
  }
  SBAR(); qkt_fsm8(pB0, pB1, kb0 + SHM_K8, qf, minit, pA0, pA1, pa);
  pv_psm8(o, ol, ones, vb0, pa, pB0, pB1, minit, alB);
  __syncthreads(); RESC8(alB);
  finishSM8(pB0, pB1, pa); SBAR();
  pv8(o, ol, ones, vb0 + SHM_V8, pa);
  float rli[16];
#pragma unroll
  for (int r = 0; r < 16; ++r) rli[r] = __builtin_amdgcn_rcpf(ol[r]);
  __syncthreads();
  epi_stage_store<1>(o, rli, (__attribute__((address_space(3))) unsigned char*)(uintptr_t)(unsigned)(uintptr_t)lds + wid * EPI_BYTES, Gb + (long)(wid * QBLK) * LDQ, Ob + (long)(wid * QBLK) * LDO, lane);
  __syncthreads();
#undef SLOAD8
#undef SWRITE8
#undef SWAIT8
#undef RESC8
}
#ifdef QK_FP4
constexpr int PP_KIMG = 4096, PP_TIMG = PP_KIMG + 8192, PP_KR = 0, PP_VR = 3 * PP_KIMG, PP_AL = PP_VR + 3 * 8192;
constexpr int LDQ4 = C_H * 64;
constexpr float Q4_PRESCALE = SCALE * 1.4426950408889634f * 16.f / 1.5f, K4_PRESCALE = 1.5f;
#define MFMA4Q(A, B, Cc) __builtin_amdgcn_mfma_scale_f32_32x32x64_f8f6f4(A, B, Cc, 4, 4, 0, 0x7f7f7f7f, 0, 0x7b7b7b7b)
__device__ __forceinline__ i32x8 lds1(int a0, int off) {
  const i32x4 a = *(const __attribute__((address_space(3))) i32x4*)(uintptr_t)(unsigned)(a0 + off);
  return (i32x8){a[0], a[1], a[2], a[3], 0, 0, 0, 0};
}
#else
constexpr int PP_KIMG = 8192, PP_TIMG = 16384, PP_KR = 0, PP_VR = 3 * 8192, PP_AL = 6 * 8192;
#endif
typedef __attribute__((address_space(3))) const i32x4* lq4;
__device__ __forceinline__ i32x8 lds2(int a0, int a1, int off) {
  const i32x4 a = *(lq4)(uintptr_t)(unsigned)(a0 + off), b = *(lq4)(uintptr_t)(unsigned)(a1 + off);
  return (i32x8){a[0], a[1], a[2], a[3], b[0], b[1], b[2], b[3]};
}
#ifndef PP_PADN
#define PP_PADN 7
#endif
#define PP_STR2(x) #x
#define PP_STR(x) PP_STR2(x)
#define PP_PAD() do { SBAR(); asm volatile("s_nop " PP_STR(PP_PADN)); SBAR(); } while (0)
#ifndef PP_PADQN
#define PP_PADQN 7
#endif
#define PP_PADQ() do { SBAR(); asm volatile("s_nop " PP_STR(PP_PADQN)); SBAR(); } while (0)
template <bool QK, bool PV>
__device__ __forceinline__ void pp_mseg(f32x16* o, f32x16& ol, f32x16& n0, f32x16& n1, const i32x8 pa, const i32x8 ones, const i32x8* qf, const f32x16& minit, const i32x8 vf0, const i32x8 vf1,
                                        const int k0, const int k1, const int k2, const int k3, const int v0, const int v1) {
  i32x8 k00, k10, k01, k11, vf2, vf3;
#ifdef QK_FP4
  if (QK) { k00 = lds1(k0, 0); k10 = lds1(k0, 2048); }
#else
  if (QK) { k00 = lds2(k0, k1, 0); k10 = lds2(k0, k1, 4096); }
#endif
  if (PV) { o[0] = MFMA8(pa, vf0, o[0]); vf2 = lds2(v0, v1, 4096); PP_PAD(); }
#ifdef QK_FP4
  if (QK) { k01 = lds1(k1, 0); }
#else
  if (QK) { k01 = lds2(k2, k3, 0); }
#endif
  if (PV) { o[1] = MFMA8(pa, vf1, o[1]); vf3 = lds2(v0, v1, 6144); PP_PAD(); }
#ifdef QK_FP4
  if (QK) { k11 = lds1(k1, 2048);
            n0 = MFMA4Q(k00, qf[0], minit); PP_PADQ(); n1 = MFMA4Q(k10, qf[0], minit); PP_PADQ(); n0 = MFMA4Q(k01, qf[1], n0); PP_PADQ(); n1 = MFMA4Q(k11, qf[1], n1); PP_PADQ(); }
#else
  if (QK) { k11 = lds2(k2, k3, 4096);
            n0 = MFMA8Q(k00, qf[0], minit); PP_PAD(); n1 = MFMA8Q(k10, qf[0], minit); PP_PAD(); n0 = MFMA8Q(k01, qf[1], n0); PP_PAD(); n1 = MFMA8Q(k11, qf[1], n1); PP_PAD(); }
#endif
  if (PV) { o[2] = MFMA8(pa, vf2, o[2]); PP_PAD(); o[3] = MFMA8(pa, vf3, o[3]); PP_PAD(); ol = MFMA8(pa, ones, ol); }
}
template <bool FIRST>
__device__ __forceinline__ void pp_vseg(f32x16* o, f32x16& ol, f32x16& n0, f32x16& n1, f32x16& minit, i32x8& pa, float* al_l, const int r32, const int hi) {
  asm volatile("" : "+v"(n0), "+v"(n1));
  const float pmax = psm_max(n0, n1);
  if (FIRST || !__all(pmax <= PSH8 + THR8)) {
    const float delta = FIRST ? pmax - PSH8 : fmaxf(pmax - PSH8, 0.f);
#pragma unroll
    for (int r = 0; r < 16; ++r) { n0[r] -= delta; n1[r] -= delta; minit[r] -= delta; }
    if (!FIRST) {
      const float alpha = __builtin_amdgcn_exp2f(-delta);
      if (hi == 0) al_l[r32] = alpha;
      asm volatile("s_waitcnt lgkmcnt(0)" ::: "memory");
#pragma unroll
      for (int r = 0; r < 16; ++r) { const float a_ = al_l[crow(r, hi)]; o[0][r] *= a_; o[1][r] *= a_; o[2][r] *= a_; o[3][r] *= a_; ol[r] *= a_; }
    }
  }
#pragma unroll
  for (int r = 0; r < 16; ++r) n0[r] = __builtin_amdgcn_exp2f(n0[r]);
#pragma unroll
  for (int r = 0; r < 16; ++r) n1[r] = __builtin_amdgcn_exp2f(n1[r]);
#pragma unroll
  for (int w = 0; w < 4; ++w) { int t0_, t1_; asm volatile("" : "=v"(t0_), "=v"(t1_));
    t0_ = __builtin_amdgcn_cvt_pk_fp8_f32(n0[4 * w], n0[4 * w + 1], t0_, false); pa[w] = __builtin_amdgcn_cvt_pk_fp8_f32(n0[4 * w + 2], n0[4 * w + 3], t0_, true);
    t1_ = __builtin_amdgcn_cvt_pk_fp8_f32(n1[4 * w], n1[4 * w + 1], t1_, false); pa[4 + w] = __builtin_amdgcn_cvt_pk_fp8_f32(n1[4 * w + 2], n1[4 * w + 3], t1_, true); }
  asm volatile("" : "+v"(pa));
}
__device__ __forceinline__ void attn_f8pp_body(const unsigned char* __restrict__ Qb, const unsigned char* __restrict__ KV, const bf16* __restrict__ Gb, bf16* __restrict__ Ob, int seq, char* lds, const int wid) {
  int lane_l; asm volatile("v_mbcnt_lo_u32_b32 %0, -1, 0\n\tv_mbcnt_hi_u32_b32 %0, -1, %0" : "=v"(lane_l));
  const int lane = lane_l, r32 = lane & 31, hi = lane >> 5;
  const int ldsb = (int)(unsigned)(uintptr_t)lds;
  float* al_l = (float*)(lds + PP_AL) + wid * 32;
  int grp, w4;
  { int* sid = (int*)(lds + PP_AL + 1024);
    const int mine = (int)__builtin_amdgcn_s_getreg(2308);
    if (lane == 0) sid[wid] = mine;
    __syncthreads();
    int g[8], n0c = 0;
#pragma unroll
    for (int u = 0; u < 8; ++u) { const int su = __builtin_amdgcn_readfirstlane(sid[u]); int c = 0;
#pragma unroll
      for (int t = 0; t < 8; ++t) if (t < u) c += (__builtin_amdgcn_readfirstlane(sid[t]) == su) ? 1 : 0;
      g[u] = c; n0c += (c == 0) ? 1 : 0; }
    bool ok = (n0c == 4);
#pragma unroll
    for (int u = 0; u < 8; ++u) ok = ok && (g[u] <= 1);
    int gm = 0, rk = 0;
#pragma unroll
    for (int u = 0; u < 8; ++u) { if (u == wid) gm = g[u]; }
#pragma unroll
    for (int u = 0; u < 8; ++u) { if (u < wid && g[u] == gm) ++rk; }
    grp = ok ? gm : (wid >> 2); w4 = ok ? rk : (wid & 3);
    grp = __builtin_amdgcn_readfirstlane(grp); w4 = __builtin_amdgcn_readfirstlane(w4);
    __syncthreads(); }
  f32x16 o[4] = {}, ol = {}, minit, n0, n1; i32x8 qf[2], ones, pa, vf0, vf1;
#pragma unroll
  for (int r = 0; r < 16; ++r) minit[r] = PSH8;
  { int one4 = 0x38383838; asm volatile("" : "+v"(one4));
#pragma unroll
    for (int r = 0; r < 8; ++r) ones[r] = one4; }
#pragma unroll
  for (int r = 0; r < 8; ++r) { pa[r] = 0; vf0[r] = 0; vf1[r] = 0; }
  asm volatile("" : "+v"(ones));
#ifdef QK_FP4
  const int vg = (r32 >> 2) & 3, ka = r32 * 64 + ((hi ^ vg) << 4), ka1 = ka ^ 32, ka2 = 0, ka3 = 0, va = r32 * 64 + (((2 * hi) ^ vg) << 4), va1 = va ^ 16;
#else
  const int kf = (r32 >> 1) & 7, ka = r32 * 128 + (((2 * hi) ^ kf) << 4), vg = (r32 >> 2) & 3, va = r32 * 64 + (((2 * hi) ^ vg) << 4);
  const int ka1 = ka ^ 16, ka2 = ka ^ 64, ka3 = ka ^ 80, va1 = va ^ 16;
#endif
  const int kbase = ldsb + PP_KR, vbase = ldsb + PP_VR;
#ifdef QK_FP4
  const unsigned char* gsrc = KV + (grp ? PP_KIMG + 2 * w4 * 1024 : w4 * 1024) + lane * 16;
  const int ldst = ldsb + (grp ? PP_VR + 2 * w4 * 1024 : PP_KR + w4 * 1024);
#define PP_DMA(tile, slot) do { const unsigned char* g_ = gsrc + (long)(tile) * PP_TIMG; const int d_ = ldst + (slot) * (grp ? 8192 : PP_KIMG); \
    __builtin_amdgcn_global_load_lds((const unsigned*)g_, (__attribute__((address_space(3))) unsigned*)(uintptr_t)(unsigned)d_, 16, 0, 0); \
    if (grp) __builtin_amdgcn_global_load_lds((const unsigned*)(g_ + 1024), (__attribute__((address_space(3))) unsigned*)(uintptr_t)(unsigned)(d_ + 1024), 16, 0, 0); } while (0)
#else
  const unsigned char* gsrc = KV + (grp * 8 + 2 * w4) * 1024 + lane * 16;
  const int ldst = ldsb + (grp ? PP_VR : PP_KR) + 2 * w4 * 1024;
#define PP_DMA(tile, slot) do { const unsigned char* g_ = gsrc + (long)(tile) * PP_TIMG; const int d_ = ldst + (slot) * 8192; \
    __builtin_amdgcn_global_load_lds((const unsigned*)g_, (__attribute__((address_space(3))) unsigned*)(uintptr_t)(unsigned)d_, 16, 0, 0); \
    __builtin_amdgcn_global_load_lds((const unsigned*)(g_ + 1024), (__attribute__((address_space(3))) unsigned*)(uintptr_t)(unsigned)(d_ + 1024), 16, 0, 0); } while (0)
#endif
#define PP_BAR() do { SBAR(); __builtin_amdgcn_s_barrier(); SBAR(); } while (0)
#define PP_KOFF(s_) ((s_) / (8192 / PP_KIMG))
  const int NT = seq / KVBLK;
  PP_DMA(0, 0); PP_DMA(1, 1);
#ifdef QK_FP4
  { const unsigned char* Qw = Qb + (long)(wid * QBLK + r32) * LDQ4 + hi * 16;
#pragma unroll
    for (int s = 0; s < 2; ++s) { const i32x4 a = *reinterpret_cast<const i32x4*>(Qw + 32 * s); qf[s] = (i32x8){a[0], a[1], a[2], a[3], 0, 0, 0, 0}; } }
#else
  { const unsigned char* Qw = Qb + (long)(wid * QBLK + r32) * LDQ8 + hi * 32;
#pragma unroll
    for (int s = 0; s < 2; ++s) { const i32x4 a = *reinterpret_cast<const i32x4*>(Qw + 64 * s), b = *reinterpret_cast<const i32x4*>(Qw + 64 * s + 16); qf[s] = (i32x8){a[0], a[1], a[2], a[3], b[0], b[1], b[2], b[3]}; } }
#endif
  asm volatile("s_waitcnt vmcnt(0)" ::: "memory");
  __syncthreads();
  if (grp == 1) PP_BAR();
  int sa = 0, sb = 8192, sc = 16384;
  { const int kb_ = kbase + PP_KOFF(sa); pp_mseg<true, false>(o, ol, n0, n1, pa, ones, qf, minit, vf0, vf1, kb_ + ka, kb_ + ka1, kb_ + ka2, kb_ + ka3, 0, 0); }
  asm volatile("" : "+v"(n0), "+v"(n1)); PP_BAR();
  asm volatile("s_waitcnt vmcnt(0)" ::: "memory"); PP_DMA(2, 2);
  pp_vseg<true>(o, ol, n0, n1, minit, pa, al_l, r32, hi);
  { const int vb_ = vbase + sa; vf0 = lds2(vb_ + va, vb_ + va1, 0); vf1 = lds2(vb_ + va, vb_ + va1, 2048); }
  PP_BAR();
  { const int t = sa; sa = sb; sb = sc; sc = t; }
  const int kA = kbase + ka, kA1 = kbase + ka1, kA2 = kbase + ka2, kA3 = kbase + ka3, vA = vbase + va, vA1 = vbase + va1;
#define PP_TILE(SA_, SC_) do { \
    pp_mseg<true, true>(o, ol, n0, n1, pa, ones, qf, minit, vf0, vf1, kA + PP_KOFF(SA_), kA1 + PP_KOFF(SA_), kA2 + PP_KOFF(SA_), kA3 + PP_KOFF(SA_), vA + (SC_), vA1 + (SC_)); \
    asm volatile("" : "+v"(n0), "+v"(n1), "+v"(o[0]), "+v"(o[1]), "+v"(o[2]), "+v"(o[3]), "+v"(ol)); PP_BAR(); \
    asm volatile("s_waitcnt vmcnt(0)" ::: "memory"); \
    { const int tl = (j + 2 < NT) ? j + 2 : NT - 1; PP_DMA(tl, (SC_) >> 13); } \
    pp_vseg<false>(o, ol, n0, n1, minit, pa, al_l, r32, hi); \
    vf0 = lds2(vA + (SA_), vA1 + (SA_), 0); vf1 = lds2(vA + (SA_), vA1 + (SA_), 2048); \
    PP_BAR(); ++j; } while (0)
  int j = 1;
  while (j + 2 < NT) { PP_TILE(8192, 0); PP_TILE(16384, 8192); PP_TILE(0, 16384); }
#undef PP_TILE
  for (; j < NT; ++j) {
    { const int kb_ = kbase + PP_KOFF(sa), vb_ = vbase + sc;
      pp_mseg<true, true>(o, ol, n0, n1, pa, ones, qf, minit, vf0, vf1, kb_ + ka, kb_ + ka1, kb_ + ka2, kb_ + ka3, vb_ + va, vb_ + va1); }
    asm volatile("" : "+v"(n0), "+v"(n1), "+v"(o[0]), "+v"(o[1]), "+v"(o[2]), "+v"(o[3]), "+v"(ol)); PP_BAR();
    asm volatile("s_waitcnt vmcnt(0)" ::: "memory");
    { const int tl = (j + 2 < NT) ? j + 2 : NT - 1; PP_DMA(tl, sc >> 13); }
    pp_vseg<false>(o, ol, n0, n1, minit, pa, al_l, r32, hi);
    { const int vb_ = vbase + sa; vf0 = lds2(vb_ + va, vb_ + va1, 0); vf1 = lds2(vb_ + va, vb_ + va1, 2048); }
    PP_BAR();
    { const int t = sa; sa = sb; sb = sc; sc = t; }
  }
  { const int vb_ = vbase + sc; pp_mseg<false, true>(o, ol, n0, n1, pa, ones, qf, minit, vf0, vf1, 0, 0, 0, 0, vb_ + va, vb_ + va1); }
  if (grp == 0) PP_BAR();
  asm volatile("s_waitcnt vmcnt(0)" ::: "memory");
  float rli[16];
#pragma unroll
  for (int r = 0; r < 16; ++r) rli[r] = __builtin_amdgcn_rcpf(ol[r]);
  __syncthreads();
  epi_stage_store<1>(o, rli, (__attribute__((address_space(3))) unsigned char*)(uintptr_t)(unsigned)(uintptr_t)lds + wid * EPI_BYTES, Gb + (long)(wid * QBLK) * LDQ, Ob + (long)(wid * QBLK) * LDO, lane);
  __syncthreads();
#undef PP_DMA
#undef PP_BAR
#undef PP_KOFF
}
#undef MFMA8
#undef MFMA8Q

#undef KSWZ
#undef SBAR
}

__device__ __forceinline__ float bflo(unsigned w) { return __uint_as_float(w << 16); }
__device__ __forceinline__ float bfhi(unsigned w) { return __uint_as_float(w & 0xffff0000u); }
__device__ __forceinline__ float silu_f(float x) { return x / (1.f + __expf(-x)); }
__device__ __forceinline__ float wave_max(float v) {
#pragma unroll
    for (int o = 1; o < 64; o <<= 1) v = fmaxf(v, __shfl_xor(v, o));
    return v;
}
__device__ __forceinline__ int t5_bucket(int rel) {
    const int n = rel < 0 ? -rel : rel; const float nf = (float)(n > 1 ? n : 1);
    int large = 8 + (int)(logf(nf * 0.125f) / 4.852030263919617f * 8.0f); large = large < 15 ? large : 15;
    return (rel > 0 ? 16 : 0) + (n < 8 ? n : large);
}

struct Args { const float* in[12]; float* out; unsigned char* ws; };

__device__ __forceinline__ void p0_prologue(const Args& a, LAS unsigned char* lds, int wave, int vcu, int G) {
    const int lane = fresh_lane(), tid = wave * 64 + lane;
    const float* c = a.in[1]; const float* w_mod = a.in[2]; const float* w_in = a.in[6]; const float* w_out = a.in[7]; const float* rel_bias = a.in[11];
    float* modp = (float*)(a.ws + WS_MODP);
    float* tab = (float*)(a.ws + WS_TAB);
    bf16* Win_t = (bf16*)(a.ws + WS_WIN); bf16* Wout_t = (bf16*)(a.ws + WS_WOUT);
    const int gt = vcu * (NWAVES * 64) + tid, NGT = G * NWAVES * 64;
    for (int e = gt; e < A_H * 3 * LUTA_N; e += NGT) { const int idx = e % LUTA_N, hp = e / LUTA_N, p = hp % 3, h = hp / 3, kk = idx - 92;
        float v = -1e30f; if (kk >= -64 && kk <= 64) v = rel_bias[t5_bucket(kk * (1 << (2 * p))) * (A_H + B_H) + h] * LOG2E;
        tab[TB_LUTA + e] = v; }
    for (int e = gt; e < B_H * LUTB_N; e += NGT) { const int idx = e % LUTB_N, h = e / LUTB_N, kk = idx - 156;
        float v = -1e30f; if (kk >= -128 && kk <= 128) v = rel_bias[t5_bucket(kk) * (A_H + B_H) + A_H + h] * LOG2E;
        tab[TB_LUTB + e] = v; }
    for (int e = gt; e < (256 + 64) * 32; e += NGT) { const int j = e & 31, pp = e >> 5, pos = pp < 256 ? pp : pp - 256;
        const float freq = exp2f(-(float)j * 0.4152410118609203f);
        const float ang = (float)pos * freq;
        double rev = (double)ang * 0.15915494309189535; rev -= floor(rev);
        const float cs_ = __builtin_amdgcn_cosf((float)rev), sn_ = __builtin_amdgcn_sinf((float)rev);
        float* d = tab + (pp < 256 ? TB_ROPE_R : TB_ROPE_C) + (pos * 32 + j) * 2; d[0] = cs_; d[1] = sn_; }
    LAS float* cs = (LAS float*)lds;
    LAS float* red = (LAS float*)(lds + 16384);
    for (int k = tid; k < DM; k += NWAVES * 64) cs[k] = silu_f(c[k]);
    __syncthreads();
#ifndef REP_GEMV
#define REP_GEMV 1
#endif
    for (int rep = 0; rep < REP_GEMV; ++rep)
    for (int it = vcu; it < DEPTH * 48 * 4; it += G) {
        const int kq = it & 3, nc = (it >> 2) % 48, ly = it / 192, k0 = kq * 1024 + wave * 128;
        const float* W = w_mod + (size_t)ly * DM * NMOD + (size_t)k0 * NMOD + nc * 256 + lane * 4;
        f32x4 acc = (f32x4){0.f, 0.f, 0.f, 0.f};
#pragma unroll 8
        for (int k = 0; k < 128; ++k) { const f32x4 w = *(const GAS f32x4*)(W + (size_t)k * NMOD); acc += w * cs[k0 + k]; }
        *(LAS f32x4*)(red + wave * 256 + lane * 4) = acc;
        __syncthreads();
        if (tid < 256) { float s = 0.f;
#pragma unroll
            for (int w = 0; w < NWAVES; ++w) s += red[w * 256 + tid];
            modp[(size_t)kq * DEPTH * NMOD + ly * NMOD + nc * 256 + tid] = s; }
        __syncthreads();
    }
    LAS float* scr = (LAS float*)(lds + wave * 16384);
    const int gw = vcu * NWAVES + wave, NGW = G * NWAVES;
    constexpr int I_IN = (DM / 64) * (INW / 32), I_OUT = (DM / 64) * (DM / 32), I_L = I_IN + I_OUT;
#ifndef REP_TR
#define REP_TR 1
#endif
    gu32* ctlw = (gu32*)(a.ws + WS_CTL);
    float amx = 0.f; int aly = -1;
#define AMX_FLUSH() do { if (aly >= 0) { float m_ = amx; for (int o_ = 1; o_ < 64; o_ <<= 1) m_ = fmaxf(m_, __shfl_xor(m_, o_)); \
        if (lane == 0) (void)__hip_atomic_fetch_max((unsigned*)(ctlw + CW_AMAX + 64 * aly), __builtin_bit_cast(unsigned, m_), RLX_AGENT); } } while (0)
    for (int rep = 0; rep < REP_TR; ++rep)
    for (int it = gw; it < DEPTH * I_L; it += NGW) {
        const int ly = it / I_L, r = it - ly * I_L;
        if (ly != aly) { AMX_FLUSH(); amx = 0.f; aly = ly; }
        if (r < I_IN) { const int n0 = 32 * (r % (INW / 32));
                        const int off = proj_col_of(n0) - n0;
                        if (proj_col_of(n0) >= F8_COL0) p0_transpose_item<true>(w_in + (size_t)ly * DM * INW, DM, INW, Win_t + (size_t)ly * INW * DM, off, scr, r, lane, amx);
                        else p0_transpose_item<false>(w_in + (size_t)ly * DM * INW, DM, INW, Win_t + (size_t)ly * INW * DM, off, scr, r, lane, amx); }
        else p0_transpose_item<false>(w_out + (size_t)ly * DM * DM, DM, DM, Wout_t + (size_t)ly * DM * DM, 0, scr, r - I_IN, lane, amx);
    }
    AMX_FLUSH();
#undef AMX_FLUSH
}

__device__ __forceinline__ int w8_exp(const Args& a, int layer) {
    const unsigned b = __hip_atomic_load((unsigned*)((gu32*)(a.ws + WS_CTL) + CW_AMAX + 64 * layer), RLX_AGENT);
    int e = 7 - ((int)(b >> 23) - 127); e = e > 60 ? 60 : (e < -60 ? -60 : e);
    return __builtin_amdgcn_readfirstlane(e);
}
__device__ __forceinline__ void w8_phase(const Args& a, int wave, int vcu, int G) {
    const int lane = fresh_lane();
    const bf16* Win_t = (const bf16*)(a.ws + WS_WIN); unsigned char* W8 = (unsigned char*)(a.ws + WS_W8);
    const int gw = vcu * NWAVES + wave, NGW = G * NWAVES;
    for (int row = gw; row < DEPTH * F8_COLS; row += NGW) {
        const int ly = row / F8_COLS, n = row % F8_COLS;
        const float sc = __builtin_bit_cast(float, (unsigned)(w8_exp(a, ly) + 127) << 23);
        const bf16* src = Win_t + ((size_t)ly * INW + F8_COL0 + n) * DM + lane * 8; unsigned char* dst = W8 + ((size_t)ly * F8_COLS + n) * DM + lane * 8;
        pg8::u32x4 r_[8];
#pragma unroll
        for (int j = 0; j < 8; ++j) r_[j] = *(const pg8::u32x4*)(src + j * 512);
#pragma unroll
        for (int j = 0; j < 8; ++j) {
            int lo = __builtin_amdgcn_cvt_pk_fp8_f32(bflo(r_[j].x) * sc, bfhi(r_[j].x) * sc, 0, false); lo = __builtin_amdgcn_cvt_pk_fp8_f32(bflo(r_[j].y) * sc, bfhi(r_[j].y) * sc, lo, true);
            int hi = __builtin_amdgcn_cvt_pk_fp8_f32(bflo(r_[j].z) * sc, bfhi(r_[j].z) * sc, 0, false); hi = __builtin_amdgcn_cvt_pk_fp8_f32(bflo(r_[j].w) * sc, bfhi(r_[j].w) * sc, hi, true);
            u32x2 w; w.x = (unsigned)lo; w.y = (unsigned)hi; *(u32x2*)(dst + j * 512) = w; }
    }
}

__device__ __forceinline__ void norm_phase(const Args& a, LAS unsigned char* lds, int layer_post, int layer_pre, const float* xin, int wave, int vcu, int G, bool dummy = false) {
    const int lane = fresh_lane(), tid = wave * 64 + lane;
    LAS float* Gv = (LAS float*)lds; LAS float* Av = Gv + DM; LAS float* Bv = Av + DM;
    const float* modp = (const float*)(a.ws + WS_MODP);
#define MOD4(i) (((*(const f32x4*)(modp + (i)) + *(const f32x4*)(modp + DEPTH * NMOD + (i))) + *(const f32x4*)(modp + 2 * DEPTH * NMOD + (i))) + *(const f32x4*)(modp + 3 * DEPTH * NMOD + (i)))
    const float* b_mod = a.in[3]; const float* pre_g = a.in[4]; const float* post_g = a.in[5];
#pragma unroll
    for (int hf = 0; hf < 2; ++hf) { const int j = tid * 8 + 4 * hf;
        if (layer_post >= 0) *(LAS f32x4*)(Gv + j) = (MOD4(layer_post * NMOD + 2 * DM + j) + *(const f32x4*)(b_mod + layer_post * NMOD + 2 * DM + j)) * *(const f32x4*)(post_g + layer_post * DM + j);
        if (layer_pre >= 0) { *(LAS f32x4*)(Av + j) = *(const f32x4*)(pre_g + layer_pre * DM + j) * (1.f + MOD4(layer_pre * NMOD + DM + j) + *(const f32x4*)(b_mod + layer_pre * NMOD + DM + j));
                              *(LAS f32x4*)(Bv + j) = MOD4(layer_pre * NMOD + j) + *(const f32x4*)(b_mod + layer_pre * NMOD + j); } }
#undef MOD4
    __syncthreads();
    const bf16* Y = (const bf16*)(a.ws + WS_Y); bf16* H = (bf16*)(a.ws + (dummy ? WS_END + 256 * MiB : WS_H)); float* xout = dummy ? (float*)(a.ws + WS_END) : a.out;
    const int gw = vcu * NWAVES + wave, NGW = G * NWAVES;
    for (int row = gw; row < S; row += NGW) {
        const GAS f32x4* xr = (const GAS f32x4*)(xin + (size_t)row * DM) + lane;
        f32x4 v[16];
#pragma unroll
        for (int j = 0; j < 16; ++j) v[j] = xr[64 * j];
        if (layer_post >= 0) {
            const GAS u32x2* yr = (const GAS u32x2*)(Y + (size_t)row * DM) + lane;
            u32x2 yv[16]; float ss = 0.f;
#pragma unroll
            for (int j = 0; j < 16; ++j) { yv[j] = yr[64 * j]; const float y0 = bflo(yv[j].x), y1 = bfhi(yv[j].x), y2 = bflo(yv[j].y), y3 = bfhi(yv[j].y); ss += (y0 * y0 + y1 * y1) + (y2 * y2 + y3 * y3); }
            const float ry = rsqrtf(wave_sum_l(ss, lane) * (1.f / DM) + EPS);
            GAS f32x4* xo = (GAS f32x4*)(xout + (size_t)row * DM) + lane;
#pragma unroll
            for (int j = 0; j < 16; ++j) { const f32x4 g = *(const LAS f32x4*)(Gv + j * 256 + lane * 4);
                const f32x4 yf = (f32x4){bflo(yv[j].x), bfhi(yv[j].x), bflo(yv[j].y), bfhi(yv[j].y)};
                v[j] = v[j] + g * yf * ry; xo[64 * j] = v[j]; }
        }
        if (layer_pre >= 0) {
            float ss = 0.f;
#pragma unroll
            for (int j = 0; j < 16; ++j) ss += (v[j].x * v[j].x + v[j].y * v[j].y) + (v[j].z * v[j].z + v[j].w * v[j].w);
            const float rx = rsqrtf(wave_sum_l(ss, lane) * (1.f / DM) + EPS);
            GAS u32x2* ho = (GAS u32x2*)(H + (size_t)row * DM) + lane;
            GAS int* h8o = (GAS int*)((unsigned char*)(a.ws + (dummy ? WS_END + 320 * MiB : WS_H8)) + (size_t)row * DM) + lane;
#pragma unroll
            for (int j = 0; j < 16; ++j) { const f32x4 av = *(const LAS f32x4*)(Av + j * 256 + lane * 4), bv = *(const LAS f32x4*)(Bv + j * 256 + lane * 4);
                const f32x4 hv = v[j] * rx * av + bv; u32x2 w; w.x = pg8::cvt_pk_bf16(hv.x, hv.y); w.y = pg8::cvt_pk_bf16(hv.z, hv.w); ho[64 * j] = w;
                int w8_ = __builtin_amdgcn_cvt_pk_fp8_f32(hv.x, hv.y, 0, false); w8_ = __builtin_amdgcn_cvt_pk_fp8_f32(hv.z, hv.w, w8_, true); h8o[64 * j] = w8_; }
        }
    }
    __syncthreads();
}

__device__ __forceinline__ void prep_phase(const Args& a, LAS unsigned char* lds, int layer, int wave, int vcu, int G) {
    const int lane = fresh_lane();
    bf16* proj = (bf16*)(a.ws + WS_PROJ); const float* tab = (const float*)(a.ws + WS_TAB);
    const float* qg = a.in[8] + layer * HD; const float* kg = a.in[9] + layer * HD;
    const int l16 = lane & 15, half = l16 >> 3, jj = (l16 & 7) * 4, grp = lane >> 4;
    const f32x4 gq1 = *(const f32x4*)(qg + half * 64 + jj), gq2 = *(const f32x4*)(qg + half * 64 + 32 + jj);
    const f32x4 gk1 = *(const f32x4*)(kg + half * 64 + jj), gk2 = *(const f32x4*)(kg + half * 64 + 32 + jj);
    const int gw = vcu * NWAVES + wave, NGW = G * NWAVES;
    for (int t = gw; t < S; t += NGW) {
        const int pos = half ? (t & 63) : (t >> 6);
        const float* rt = tab + (half ? TB_ROPE_C : TB_ROPE_R) + (pos * 32 + jj) * 2;
        const f32x4 cs0 = *(const f32x4*)rt, cs1 = *(const f32x4*)(rt + 4);
        const f32x4 cv = (f32x4){cs0.x, cs0.z, cs1.x, cs1.z}, sv = (f32x4){cs0.y, cs0.w, cs1.y, cs1.w};
#pragma unroll
        for (int it = 0; it < 4; ++it) {
            const int hh = it * 4 + grp;
            bf16* p = proj + (size_t)t * PLD + PC(COL_CQ + hh * HD) + half * 64 + jj;
            const u32x2 r1 = *(const u32x2*)p, r2 = *(const u32x2*)(p + 32);
            const f32x4 x1 = (f32x4){bflo(r1.x), bfhi(r1.x), bflo(r1.y), bfhi(r1.y)}, x2 = (f32x4){bflo(r2.x), bfhi(r2.x), bflo(r2.y), bfhi(r2.y)};
            float ss = (x1.x * x1.x + x1.y * x1.y) + (x1.z * x1.z + x1.w * x1.w) + (x2.x * x2.x + x2.y * x2.y) + (x2.z * x2.z + x2.w * x2.w);
            ss += lane_xor(ss, 1, lane); ss += lane_xor(ss, 2, lane); ss += lane_xor(ss, 4, lane); ss += lane_xor(ss, 8, lane);
            const float r = rsqrtf(ss * (1.f / HD) + EPS);
            const f32x4 g1 = (it == 3) ? gk1 : gq1, g2 = (it == 3) ? gk2 : gq2;
            const f32x4 y1 = x1 * r * g1, y2 = x2 * r * g2;
            const f32x4 o1_ = y1 * cv - y2 * sv, o2_ = y2 * cv + y1 * sv;
#ifndef ATT_F8
            const f32x4 o1 = o1_, o2 = o2_;
#endif
#ifdef ATT_F8
#if defined(ATT_PP) && defined(QK_FP4)
            { unsigned char* d8; int d8b;
              if (it == 3) { unsigned char* rb = (unsigned char*)(a.ws + WS_KF8) + ((size_t)((hh - 12) * (S / 64) + (t >> 6))) * attc::PP_TIMG + (t & 63) * 64 + (jj >> 1);
                             const int c1 = half * 2, kg = ((t & 63) >> 2) & 3; d8 = rb + ((c1 ^ kg) << 4); d8b = (((c1 + 1) ^ kg) << 4) - ((c1 ^ kg) << 4); }
              else { d8 = (unsigned char*)(a.ws + WS_QF8) + (size_t)t * attc::LDQ4 + hh * 64 + half * 32 + (jj >> 1); d8b = 16; }
              const float qs = (it == 3) ? attc::K4_PRESCALE : attc::Q4_PRESCALE; const f32x4 o1 = o1_ * qs, o2 = o2_ * qs;
              const unsigned a0 = __builtin_amdgcn_cvt_scalef32_pk_fp4_f32(0u, o1.x, o1.y, 1.f, 0) & 0xffu, a1 = __builtin_amdgcn_cvt_scalef32_pk_fp4_f32(0u, o1.z, o1.w, 1.f, 0) & 0xffu;
              const unsigned b0 = __builtin_amdgcn_cvt_scalef32_pk_fp4_f32(0u, o2.x, o2.y, 1.f, 0) & 0xffu, b1 = __builtin_amdgcn_cvt_scalef32_pk_fp4_f32(0u, o2.z, o2.w, 1.f, 0) & 0xffu;
              *(unsigned short*)d8 = (unsigned short)(a0 | (a1 << 8)); *(unsigned short*)(d8 + d8b) = (unsigned short)(b0 | (b1 << 8)); }
#elif defined(ATT_PP)
            unsigned char* d8; int d8b;
            if (it == 3) { unsigned char* rb = (unsigned char*)(a.ws + WS_KF8) + ((size_t)((hh - 12) * (S / 64) + (t >> 6))) * attc::PP_TIMG + (t & 63) * 128 + (jj & 15);
                           const int c1 = half * 4 + (jj >> 4), kf = ((t & 63) >> 1) & 7; d8 = rb + ((c1 ^ kf) << 4); d8b = (((c1 + 2) ^ kf) << 4) - ((c1 ^ kf) << 4); }
            else { d8 = (unsigned char*)(a.ws + WS_QF8) + (size_t)t * (C_H * HD) + hh * HD + half * 64 + jj; d8b = 32; }
            {
#else
            { const int d8b = 32;
              unsigned char* d8 = (it == 3) ? (unsigned char*)(a.ws + WS_KF8) + (size_t)t * 512 + (hh - 12) * HD + half * 64 + jj
                                            : (unsigned char*)(a.ws + WS_QF8) + (size_t)t * (C_H * HD) + hh * HD + half * 64 + jj;
#endif
#if !(defined(ATT_PP) && defined(QK_FP4))
              const float qs = (it == 3) ? 1.f : attc::Q8_PRESCALE; const f32x4 o1 = o1_ * qs, o2 = o2_ * qs;
              int t1 = __builtin_amdgcn_cvt_pk_fp8_f32(o1.x, o1.y, 0, false); t1 = __builtin_amdgcn_cvt_pk_fp8_f32(o1.z, o1.w, t1, true);
              int t2 = __builtin_amdgcn_cvt_pk_fp8_f32(o2.x, o2.y, 0, false); t2 = __builtin_amdgcn_cvt_pk_fp8_f32(o2.z, o2.w, t2, true);
              *(int*)d8 = t1; *(int*)(d8 + d8b) = t2; }
#endif
#else
            u32x2 w1, w2; w1.x = pg8::cvt_pk_bf16(o1.x, o1.y); w1.y = pg8::cvt_pk_bf16(o1.z, o1.w); w2.x = pg8::cvt_pk_bf16(o2.x, o2.y); w2.y = pg8::cvt_pk_bf16(o2.z, o2.w);
            *(u32x2*)p = w1; *(u32x2*)(p + 32) = w2;
#endif
        }
    }
#ifdef ATT_F8
    { typedef attc::bf16x8 bx8; typedef attc::s16x4 sx4;
      unsigned char* VT8 = (unsigned char*)(a.ws + WS_VTF8);
      LAS unsigned char* img = lds + wave * 8192;
      const int lane2 = fresh_lane(), r32 = lane2 & 31, hi = lane2 >> 5, vrow = lane2 >> 4, vch = lane2 & 15;
      LAS unsigned char* vwr = img + (vch >> 2) * 512 + vrow * 64 + (vch & 3) * 16;
      const int vb = (int)(uintptr_t)img + attc::v_rd_base(lane2);
      for (int itv = gw; itv < 4 * (S / 32); itv += NGW) {
        const int kv = itv / (S / 32), t0 = (itv % (S / 32)) * 32;
        bx8 vs[8];
#pragma unroll
        for (int i = 0; i < 8; ++i) vs[i] = *reinterpret_cast<const bx8*>(proj + (size_t)(t0 + vrow + 4 * i) * PLD + PC(COL_CV + kv * HD) + vch * 8);
#pragma unroll
        for (int i = 0; i < 8; ++i) *reinterpret_cast<LAS bx8*>(vwr + (i & 1) * 2048 + ((i >> 1) & 1) * 256 + ((i >> 2) & 1) * 4096) = vs[i];
#ifdef ATT_PP
        const int vg = (r32 >> 2) & 3, c_lo = (t0 >> 5) & 1;
        unsigned char* rowp = (unsigned char*)(a.ws + WS_KF8) + ((size_t)(kv * (S / 64) + (t0 >> 6))) * attc::PP_TIMG + attc::PP_KIMG + r32 * 64 + ((c_lo ^ vg) << 4) + 4 * hi;
        const int hi_off = (((c_lo + 2) ^ vg) << 4) - ((c_lo ^ vg) << 4);
#else
        const int hi_off = 32;
        unsigned char* rowp = VT8 + (size_t)kv * HD * S + (size_t)(t0 >> 6) * 8192 + r32 * 64 + ((t0 & 32) ? 16 : 0) + 4 * hi;
#endif
#define VTR8(D0, KS) do { const sx4 l_ = attc::tr_read<attc::v_rd_off(D0, KS, 0)>(vb), h_ = attc::tr_read<attc::v_rd_off(D0, KS, 1)>(vb); asm volatile("s_waitcnt lgkmcnt(0)" ::: "memory"); __builtin_amdgcn_sched_barrier(0); \
          int lo_ = __builtin_amdgcn_cvt_pk_fp8_f32(__uint_as_float((unsigned)(unsigned short)l_[0] << 16), __uint_as_float((unsigned)(unsigned short)l_[1] << 16), 0, false); \
          lo_ = __builtin_amdgcn_cvt_pk_fp8_f32(__uint_as_float((unsigned)(unsigned short)l_[2] << 16), __uint_as_float((unsigned)(unsigned short)l_[3] << 16), lo_, true); \
          int hi_ = __builtin_amdgcn_cvt_pk_fp8_f32(__uint_as_float((unsigned)(unsigned short)h_[0] << 16), __uint_as_float((unsigned)(unsigned short)h_[1] << 16), 0, false); \
          hi_ = __builtin_amdgcn_cvt_pk_fp8_f32(__uint_as_float((unsigned)(unsigned short)h_[2] << 16), __uint_as_float((unsigned)(unsigned short)h_[3] << 16), hi_, true); \
          unsigned char* q_ = rowp + (D0 * 32) * 64 + 8 * KS; *(int*)q_ = lo_; *(int*)(q_ + hi_off) = hi_; } while (0)
        VTR8(0, 0); VTR8(0, 1); VTR8(1, 0); VTR8(1, 1); VTR8(2, 0); VTR8(2, 1); VTR8(3, 0); VTR8(3, 1);
#undef VTR8
        asm volatile("s_waitcnt lgkmcnt(0)" ::: "memory");
      } }
#endif
}

template <bool IS_B>
__device__ __forceinline__ void naive_band(const bf16* proj, bf16* o, const float* lut, float sink_l2, int t, int qcol, int kcol, int vcol, int gcol, int ocol,
                                           LAS float* sc, LAS int* jr, int lane) {
    constexpr int NS = IS_B ? 257 : 387;
    const int l16 = lane & 15, grp = lane >> 4;
    float qf[8];
    { const pg8::u32x4 qraw = *(const pg8::u32x4*)(proj + (size_t)t * INW + qcol + l16 * 8);
      qf[0] = bflo(qraw.x) * QK_C; qf[1] = bfhi(qraw.x) * QK_C; qf[2] = bflo(qraw.y) * QK_C; qf[3] = bfhi(qraw.y) * QK_C;
      qf[4] = bflo(qraw.z) * QK_C; qf[5] = bfhi(qraw.z) * QK_C; qf[6] = bflo(qraw.w) * QK_C; qf[7] = bfhi(qraw.w) * QK_C; }
    for (int s0 = 0; s0 < NS; s0 += 4) {
        const int s = s0 + grp; const bool inr = s < NS; const int ss = inr ? s : NS - 1;
        int j, li;
        if (IS_B) { j = t + ss - 128; li = ss + 28; }
        else { const int p = ss / 129, kk = ss - p * 129; j = t + (kk - 64) * (1 << (2 * p)); li = p * LUTA_N + kk + 28; }
        const bool valid = inr && j >= 0 && j < S;
        const int jc = j < 0 ? 0 : (j > S - 1 ? S - 1 : j);
        const pg8::u32x4 kr = *(const pg8::u32x4*)(proj + (size_t)jc * INW + kcol + l16 * 8);
        float d = qf[0] * bflo(kr.x) + qf[1] * bfhi(kr.x) + qf[2] * bflo(kr.y) + qf[3] * bfhi(kr.y) + qf[4] * bflo(kr.z) + qf[5] * bfhi(kr.z) + qf[6] * bflo(kr.w) + qf[7] * bfhi(kr.w);
        d += lane_xor(d, 1, lane); d += lane_xor(d, 2, lane); d += lane_xor(d, 4, lane); d += lane_xor(d, 8, lane);
        const float sv = valid ? d + lut[li] : -1e30f;
        if (l16 == 0 && inr) { sc[s] = sv; jr[s] = jc; }
    }
    float mx = -1e30f;
    for (int s = lane; s < NS; s += 64) mx = fmaxf(mx, sc[s]);
    mx = wave_max_l(mx, lane); if (IS_B) mx = fmaxf(mx, sink_l2);
    float lsum = 0.f;
    for (int s = lane; s < NS; s += 64) { const float p = exp2f(sc[s] - mx); sc[s] = p; lsum += p; }
    lsum = wave_sum_l(lsum, lane); if (IS_B) lsum += exp2f(sink_l2 - mx);
    float a0 = 0.f, a1 = 0.f;
#pragma unroll 4
    for (int s = 0; s < NS; ++s) { const float p = sc[s]; const int j = jr[s];
        const unsigned v = *(const unsigned*)(proj + (size_t)j * INW + vcol + lane * 2); a0 += p * bflo(v); a1 += p * bfhi(v); }
    const unsigned g = *(const unsigned*)(proj + (size_t)t * INW + gcol + lane * 2);
    const float inv = 1.f / lsum;
    *(unsigned*)(o + (size_t)t * DM + ocol + lane * 2) = pg8::cvt_pk_bf16(a0 * inv * silu_f(bflo(g)), a1 * inv * silu_f(bfhi(g)));
}

__device__ __forceinline__ void naive_ab_phase(const Args& a, LAS unsigned char* lds, int layer, int wave, int vcu, int G) {
    const int lane = fresh_lane();
    const bf16* proj = (const bf16*)(a.ws + WS_PROJ); bf16* o = (bf16*)(a.ws + WS_O); const float* tab = (const float*)(a.ws + WS_TAB);
    const float* sink = a.in[10] + layer * B_H;
    LAS float* sc = (LAS float*)(lds + wave * 4096); LAS int* jr = (LAS int*)(lds + wave * 4096 + 2048);
    const int gw = vcu * NWAVES + wave, NGW = G * NWAVES;
    for (int t = gw; t < S; t += NGW) {
        for (int h = 0; h < A_H; ++h)
            naive_band<false>(proj, o, tab + TB_LUTA + h * 3 * LUTA_N, 0.f, t, COL_AQ + h * HD, COL_AK + h * HD, COL_AV + h * HD, COL_AG + h * HD, OCOL_A + h * HD, sc, jr, lane);
        for (int h = 0; h < B_H; ++h)
            naive_band<true>(proj, o, tab + TB_LUTB + h * LUTB_N, sink[h] * LOG2E, t, COL_BQ + h * HD, COL_BK + (h >> 2) * HD, COL_BV + (h >> 2) * HD, COL_BG + h * HD, OCOL_B + h * HD, sc, jr, lane);
    }
}

namespace band {
using attc::bf16x8; using attc::s16x4; using attc::f32x16; using attc::u32x4; using attc::crow; using attc::cvtpk; using attc::v_rd_base; using attc::v_rd_off; using attc::tr_read;
constexpr float THR2 = 8.f;
constexpr int KPITCH = 272;
constexpr int WAVE_LDS = 8192 + 32 * KPITCH;
static_assert(WAVE_LDS >= attc::EPI_BYTES, "O stage fits the per-wave region");
enum Mode { P16 = 0, P4 = 1, P1 = 2, MB = 3 };
constexpr int A_ROW = A_H * HD;
template <int D0> __device__ __forceinline__ void pv32(f32x16& od, int vb, bf16x8 pa0, bf16x8 pa1) {
  const s16x4 l0 = tr_read<v_rd_off(D0, 0, 0)>(vb), h0 = tr_read<v_rd_off(D0, 0, 1)>(vb), l1 = tr_read<v_rd_off(D0, 1, 0)>(vb), h1 = tr_read<v_rd_off(D0, 1, 1)>(vb);
  asm volatile("s_waitcnt lgkmcnt(0)" ::: "memory"); __builtin_amdgcn_sched_barrier(0);
#define PK(L, H) (bf16x8){L[0], L[1], L[2], L[3], H[0], H[1], H[2], H[3]}
  od = __builtin_amdgcn_mfma_f32_32x32x16_bf16(pa0, PK(l0, h0), od, 0, 0, 0);
  od = __builtin_amdgcn_mfma_f32_32x32x16_bf16(pa1, PK(l1, h1), od, 0, 0, 0);
#undef PK
}
__device__ __forceinline__ void epi_stage(const f32x16 (&o)[4], const float (&rli)[16], LAS unsigned char* st, int lane) {
  asm volatile("" : "+v"(lane));
  const int r32 = lane & 31, hi = lane >> 5;
#pragma unroll
  for (int r = 0; r < 16; ++r) { const int row = crow(r, hi);
#pragma unroll
    for (int d0 = 0; d0 < 4; ++d0) *reinterpret_cast<LAS float*>(st + row * attc::EPI_PITCH + (d0 * 32 + r32) * 4) = o[d0][r] * rli[r]; }
}
template <int QS>
__device__ __forceinline__ void epi_partial_out(LAS unsigned char* st, bf16* __restrict__ dst, int lane) {
  typedef float f32x4_t __attribute__((ext_vector_type(4)));
  asm volatile("" : "+v"(lane));
  const int rr = lane >> 4, c16 = lane & 15;
#pragma unroll
  for (int i = 0; i < 8; ++i) { const int row = rr + 4 * i;
    const f32x4_t a = *reinterpret_cast<const LAS f32x4_t*>(st + row * attc::EPI_PITCH + c16 * 32);
    const f32x4_t b = *reinterpret_cast<const LAS f32x4_t*>(st + row * attc::EPI_PITCH + c16 * 32 + 16);
    u32x4 w = {cvtpk(a[0], a[1]), cvtpk(a[2], a[3]), cvtpk(b[0], b[1]), cvtpk(b[2], b[3])};
    *reinterpret_cast<u32x4*>(dst + (size_t)(QS * row) * A_ROW + c16 * 8) = w; }
}
__device__ __forceinline__ void epi_gate_out(LAS unsigned char* st, const u32x4 (&g)[8], bf16* __restrict__ obase, int lane) {
  typedef float f32x4_t __attribute__((ext_vector_type(4)));
  asm volatile("" : "+v"(lane));
  const int rr = lane >> 4, c16 = lane & 15;
#pragma unroll
  for (int i = 0; i < 8; ++i) { const int row = rr + 4 * i;
    const f32x4_t a = *reinterpret_cast<const LAS f32x4_t*>(st + row * attc::EPI_PITCH + c16 * 32);
    const f32x4_t b = *reinterpret_cast<const LAS f32x4_t*>(st + row * attc::EPI_PITCH + c16 * 32 + 16);
    float v[8] = {a[0], a[1], a[2], a[3], b[0], b[1], b[2], b[3]};
#pragma unroll
    for (int e = 0; e < 4; ++e) { const float g0 = __uint_as_float(g[i][e] << 16), g1 = __uint_as_float(g[i][e] & 0xffff0000u);
      v[2 * e] *= g0 * __builtin_amdgcn_rcpf(1.f + __expf(-g0)); v[2 * e + 1] *= g1 * __builtin_amdgcn_rcpf(1.f + __expf(-g1)); }
    u32x4 w = {cvtpk(v[0], v[1]), cvtpk(v[2], v[3]), cvtpk(v[4], v[5]), cvtpk(v[6], v[7])};
    *reinterpret_cast<u32x4*>(obase + (size_t)row * DM + c16 * 8) = w; }
}
__device__ __forceinline__ void epi_merge(LAS unsigned char* st, const LAS float* cw, const bf16* __restrict__ p4, const bf16* __restrict__ p16,
                                          const bf16* __restrict__ gbase, bf16* __restrict__ obase, int lane) {
  typedef float f32x4_t __attribute__((ext_vector_type(4)));
  asm volatile("" : "+v"(lane));
  const int rr = lane >> 4, c16 = lane & 15;
#pragma unroll
  for (int hf = 0; hf < 2; ++hf) {
    u32x4 g[4], x4[4], x16[4];
#pragma unroll
    for (int i = 0; i < 4; ++i) { const int row = rr + 4 * (4 * hf + i);
      g[i] = *reinterpret_cast<const u32x4*>(gbase + (size_t)row * PLD + c16 * 8);
      x4[i] = *reinterpret_cast<const u32x4*>(p4 + (size_t)row * A_ROW + c16 * 8); x16[i] = *reinterpret_cast<const u32x4*>(p16 + (size_t)row * A_ROW + c16 * 8); }
#pragma unroll
    for (int i = 0; i < 4; ++i) { const int row = rr + 4 * (4 * hf + i);
      const f32x4_t a = *reinterpret_cast<const LAS f32x4_t*>(st + row * attc::EPI_PITCH + c16 * 32);
      const f32x4_t b = *reinterpret_cast<const LAS f32x4_t*>(st + row * attc::EPI_PITCH + c16 * 32 + 16);
      const float w4 = cw[row], w16 = cw[32 + row];
      float v[8] = {a[0], a[1], a[2], a[3], b[0], b[1], b[2], b[3]};
#pragma unroll
      for (int e = 0; e < 4; ++e) { const float g0 = __uint_as_float(g[i][e] << 16), g1 = __uint_as_float(g[i][e] & 0xffff0000u);
        v[2 * e]     = (v[2 * e]     + w4 * __uint_as_float(x4[i][e] << 16)         + w16 * __uint_as_float(x16[i][e] << 16))         * (g0 * __builtin_amdgcn_rcpf(1.f + __expf(-g0)));
        v[2 * e + 1] = (v[2 * e + 1] + w4 * __uint_as_float(x4[i][e] & 0xffff0000u) + w16 * __uint_as_float(x16[i][e] & 0xffff0000u)) * (g1 * __builtin_amdgcn_rcpf(1.f + __expf(-g1))); }
      u32x4 w = {cvtpk(v[0], v[1]), cvtpk(v[2], v[3]), cvtpk(v[4], v[5]), cvtpk(v[6], v[7])};
      *reinterpret_cast<u32x4*>(obase + (size_t)row * DM + c16 * 8) = w; }
    asm volatile("" ::: "memory"); }
}
struct Part { bf16* p4; bf16* p16; float* s4; float* s16; };
struct Next { bool has; int q0, qcol, kcol, vcol; };
template <int MODE>
__device__ __forceinline__ void wave_tile(const bf16* __restrict__ proj, bf16* __restrict__ obuf, const Part& part, int h, int q0, int qcol, int kcol, int vcol, int gcol, int ocol,
                                          float m_init, float l_init, LAS unsigned char* vlds, LAS float* xch, LAS float* lut, const float* __restrict__ lut_g, int lane,
                                          bf16x8 (&qr)[8], bf16x8 (&ks8)[8], bf16x8 (&vs)[8], bool pre, const Next nx) {
  constexpr int KS = MODE == P16 ? 16 : (MODE == P4 ? 4 : 1), W = MODE == MB ? 128 : 64, NTT = MODE == MB ? 9 : 5;
  const int r32 = lane & 31, hi = lane >> 5, vrow = lane >> 4, vch = lane & 15;
#define BAND_QLOAD(q0_, qcol_) do { const bf16* qp = proj + (size_t)((q0_) + KS * r32) * PLD + (qcol_) + hi * 8; \
    _Pragma("unroll") for (int d0 = 0; d0 < 8; ++d0) qr[d0] = *reinterpret_cast<const bf16x8*>(qp + d0 * 16); } while (0)
  if (!pre) BAND_QLOAD(q0, qcol);
  f32x16 o[4] = {}; float m_reg = m_init, l_reg = l_init;
  const int vb = (int)(uintptr_t)vlds + v_rd_base(lane);
  LAS unsigned char* klds = vlds + 8192;
  LAS unsigned char* vwr = vlds + (vch >> 2) * 512 + vrow * 64 + (vch & 3) * 16;
  LAS unsigned char* kwr = klds + vrow * KPITCH + vch * 16;
  const LAS unsigned char* krd = klds + r32 * KPITCH + hi * 16;
#define BAND_ISSUE(kt_, kcol, vcol) do { _Pragma("unroll") for (int i = 0; i < 8; ++i) { int tv = (kt_) + KS * (vrow + 4 * i); tv = tv < 0 ? 0 : (tv > S - 1 ? S - 1 : tv); \
        const bf16* rp = proj + (size_t)tv * PLD + vch * 8; ks8[i] = *reinterpret_cast<const bf16x8*>(rp + kcol); vs[i] = *reinterpret_cast<const bf16x8*>(rp + vcol); } } while (0)
  int kt = q0 - W * KS;
  if (!pre) BAND_ISSUE(kt, kcol, vcol);
  { constexpr int LN = MODE == MB ? LUTB_N : LUTA_N, LK = (LN + 63) / 64; float lv[LK];
#pragma unroll
    for (int k = 0; k < LK; ++k) { const int e = lane + 64 * k; lv[k] = lut_g[e < LN ? e : LN - 1]; }
#pragma unroll
    for (int k = 0; k < LK; ++k) { const int e = lane + 64 * k; if (e < LN) lut[e] = lv[k]; } }
#pragma nounroll
  for (int tt = 0; tt < NTT; ++tt) {
#pragma unroll
    for (int i = 0; i < 8; ++i) { *reinterpret_cast<LAS bf16x8*>(vwr + (i & 1) * 2048 + ((i >> 1) & 1) * 256 + ((i >> 2) & 1) * 4096) = vs[i];
                                  *reinterpret_cast<LAS bf16x8*>(kwr + i * 4 * KPITCH) = ks8[i]; }
    f32x16 p0 = {};
#pragma unroll
    for (int d0 = 0; d0 < 8; ++d0) { const bf16x8 kfr = *reinterpret_cast<const LAS bf16x8*>(krd + d0 * 32);
      p0 = __builtin_amdgcn_mfma_f32_32x32x16_bf16(kfr, qr[d0], p0, 0, 0, 0); }
    const int c_kt = kt; kt += 32 * KS;
    if (tt + 1 < NTT) BAND_ISSUE(kt, kcol, vcol);
    float tv[16];
    { int dl = -W + 32 * tt + 4 * hi - r32; dl = dl < -(W + 28) ? -(W + 28) : (dl > W + 1 ? W + 1 : dl);
      const LAS float* lp = lut + (dl + (W + 28));
#pragma unroll
      for (int r = 0; r < 16; ++r) tv[r] = fmaf(p0[r], QK_C, lp[(r & 3) + 8 * (r >> 2)]); }
    if (c_kt < 0 || c_kt + 31 * KS > S - 1) {
#pragma unroll
      for (int r = 0; r < 16; ++r) { const int tok = c_kt + KS * crow(r, hi); if (tok < 0 || tok > S - 1) tv[r] = -1e30f; } }
    float pmax = tv[0];
#pragma unroll
    for (int r = 1; r < 16; ++r) pmax = fmaxf(pmax, tv[r]);
    { auto rr = __builtin_amdgcn_permlane32_swap(__float_as_uint(pmax), __float_as_uint(pmax), false, false); pmax = fmaxf(__uint_as_float(rr[0]), __uint_as_float(rr[1])); }
    float alpha = 1.f;
    if (!__all(pmax - m_reg <= THR2)) { const float mn = fmaxf(m_reg, pmax); alpha = __builtin_amdgcn_exp2f(m_reg - mn); m_reg = mn; }
    float ps = 0.f;
#pragma unroll
    for (int r = 0; r < 16; ++r) { tv[r] = __builtin_amdgcn_exp2f(tv[r] - m_reg); ps += tv[r]; }
    { auto rr = __builtin_amdgcn_permlane32_swap(__float_as_uint(ps), __float_as_uint(ps), false, false); ps = __uint_as_float(rr[0]) + __uint_as_float(rr[1]); }
    l_reg = l_reg * alpha + ps;
    bf16x8 pa0, pa1;
#define PK4(P, BASE, OUT) do { unsigned a0 = cvtpk(P[BASE + 0], P[BASE + 1]), a1 = cvtpk(P[BASE + 2], P[BASE + 3]);   \
    unsigned b0 = cvtpk(P[BASE + 4], P[BASE + 5]), b1 = cvtpk(P[BASE + 6], P[BASE + 7]);                              \
    auto r0 = __builtin_amdgcn_permlane32_swap(a0, b0, false, false); auto r1 = __builtin_amdgcn_permlane32_swap(a1, b1, false, false); \
    u32x4 w = {r0[0], r1[0], r0[1], r1[1]}; OUT = *reinterpret_cast<bf16x8*>(&w); } while (0)
    PK4(tv, 0, pa0); PK4(tv, 8, pa1);
#undef PK4
    if (__any(alpha < 1.f)) { if (hi == 0) xch[r32] = alpha; asm volatile("s_waitcnt lgkmcnt(0)" ::: "memory");
#pragma unroll
      for (int d = 0; d < 4; ++d)
#pragma unroll
        for (int r = 0; r < 16; ++r) o[d][r] *= xch[crow(r, hi)]; }
    pv32<0>(o[0], vb, pa0, pa1); pv32<1>(o[1], vb, pa0, pa1); pv32<2>(o[2], vb, pa0, pa1); pv32<3>(o[3], vb, pa0, pa1);
  }
  float f = __builtin_amdgcn_rcpf(l_reg);
  if (MODE == P16 || MODE == P4) {
    if (hi == 0) { float* sp = (MODE == P16 ? part.s16 : part.s4) + ((size_t)(q0 + KS * r32) * A_H + h) * 2; sp[0] = m_reg; sp[1] = l_reg; } }
  if (MODE == P1) {
    const size_t si = ((size_t)(q0 + r32) * A_H + h) * 2;
    const float m4 = part.s4[si], l4 = part.s4[si + 1], m16 = part.s16[si], l16 = part.s16[si + 1];
    const float M = fmaxf(m_reg, fmaxf(m4, m16));
    const float e1 = __builtin_amdgcn_exp2f(m_reg - M), e4 = l4 * __builtin_amdgcn_exp2f(m4 - M), e16 = l16 * __builtin_amdgcn_exp2f(m16 - M);
    const float rden = __builtin_amdgcn_rcpf(l_reg * e1 + e4 + e16);
    f = e1 * rden;
    if (hi == 0) { xch[64 + r32] = e4 * rden; xch[96 + r32] = e16 * rden; } }
  if (hi == 0) xch[32 + r32] = f; asm volatile("s_waitcnt lgkmcnt(0)" ::: "memory");
  float rli[16];
#pragma unroll
  for (int r = 0; r < 16; ++r) rli[r] = xch[32 + crow(r, hi)];
  u32x4 gpre[8];
  if (MODE == MB) {
    int vr2 = vrow; asm volatile("" : "+v"(vr2));
    const bf16* gb = proj + (size_t)q0 * PLD + gcol + vch * 8;
#pragma unroll
    for (int i = 0; i < 8; ++i) gpre[i] = *reinterpret_cast<const u32x4*>(gb + (size_t)(vr2 + 4 * i) * PLD); }
  epi_stage(o, rli, vlds, lane);
  if (nx.has) { BAND_QLOAD(nx.q0, nx.qcol); BAND_ISSUE(nx.q0 - W * KS, nx.kcol, nx.vcol); }
  if (MODE == P16) epi_partial_out<KS>(vlds, part.p16 + (size_t)q0 * A_ROW + h * HD, lane);
  else if (MODE == P4) epi_partial_out<KS>(vlds, part.p4 + (size_t)q0 * A_ROW + h * HD, lane);
  else if (MODE == P1) epi_merge(vlds, xch + 64, part.p4 + (size_t)q0 * A_ROW + h * HD, part.p16 + (size_t)q0 * A_ROW + h * HD, proj + (size_t)q0 * PLD + gcol, obuf + (size_t)q0 * DM + ocol, lane);
  else epi_gate_out(vlds, gpre, obuf + (size_t)q0 * DM + ocol, lane);
#undef BAND_ISSUE
#undef BAND_QLOAD
}
}

__device__ __forceinline__ void band_phase(const Args& a, LAS unsigned char* lds, int layer, int pass, int wave, int vcu, int G) {
    const int lane = fresh_lane();
    const bf16* proj = (const bf16*)(a.ws + WS_PROJ); bf16* o = (bf16*)(a.ws + WS_O); const float* tab = (const float*)(a.ws + WS_TAB);
    band::Part part; part.p4 = (bf16*)(a.ws + WS_PART4); part.p16 = (bf16*)(a.ws + WS_PART16); part.s4 = (float*)(a.ws + WS_STAT4); part.s16 = (float*)(a.ws + WS_STAT16);
    LAS unsigned char* vlds = lds + wave * band::WAVE_LDS; LAS float* xch = (LAS float*)(lds + BAND_LUT_OFF + wave * BAND_LUT_WAVE); LAS float* lut = xch + 128;
    typedef band::bf16x8 bf16x8;
    if (pass == 0) {
        { bool pre = false; bf16x8 qr[8], ks8[8], vs[8];
          for (int ua = vcu; ua < A_H * 64; ua += G) {
            const int h = ua / 64, rem = ua % 64, u = rem >> 1, r = (rem & 1) * 8 + wave;
            const int un = ua + G; band::Next nx; nx.has = un < A_H * 64; { const int h2 = un / 64, rem2 = un % 64; nx.q0 = 512 * (rem2 >> 1) + (rem2 & 1) * 8 + wave; nx.qcol = PC(COL_AQ + h2 * HD); nx.kcol = PC(COL_AK + h2 * HD); nx.vcol = PC(COL_AV + h2 * HD); }
            const float* lut_g = tab + TB_LUTA + (h * 3 + 2) * LUTA_N;
            band::wave_tile<band::P16>(proj, o, part, h, 512 * u + r, PC(COL_AQ + h * HD), PC(COL_AK + h * HD), PC(COL_AV + h * HD), PC(COL_AG + h * HD), OCOL_A + h * HD, -1e20f, 0.f, vlds, xch, lut, lut_g, lane, qr, ks8, vs, pre, nx);
            pre = nx.has; } }
        { bool pre = false; bf16x8 qr[8], ks8[8], vs[8];
          for (int ua = vcu; ua < A_H * 64; ua += G) {
            const int h = ua / 64, b = ua % 64;
            const int un = ua + G; band::Next nx; nx.has = un < A_H * 64; { const int h2 = un / 64, b2 = un % 64; nx.q0 = 256 * b2 + 128 * (wave >> 2) + (wave & 3); nx.qcol = PC(COL_AQ + h2 * HD); nx.kcol = PC(COL_AK + h2 * HD); nx.vcol = PC(COL_AV + h2 * HD); }
            const float* lut_g = tab + TB_LUTA + (h * 3 + 1) * LUTA_N;
            band::wave_tile<band::P4>(proj, o, part, h, 256 * b + 128 * (wave >> 2) + (wave & 3), PC(COL_AQ + h * HD), PC(COL_AK + h * HD), PC(COL_AV + h * HD), PC(COL_AG + h * HD), OCOL_A + h * HD, -1e20f, 0.f, vlds, xch, lut, lut_g, lane, qr, ks8, vs, pre, nx);
            pre = nx.has; } }
        const float* sink = a.in[10] + layer * B_H;
        { bool pre = false; bf16x8 qr[8], ks8[8], vs[8];
          for (int ub = vcu; ub < B_H * 64; ub += G) {
            const int kv = ub / 256, rem = ub % 256, qblk = rem >> 2, h = kv * 4 + (rem & 3);
            const int un = ub + G; band::Next nx; nx.has = un < B_H * 64; { const int kv2 = un / 256, rem2 = un % 256, h2 = kv2 * 4 + (rem2 & 3); nx.q0 = (rem2 >> 2) * 256 + wave * 32; nx.qcol = PC(COL_BQ + h2 * HD); nx.kcol = PC(COL_BK + kv2 * HD); nx.vcol = PC(COL_BV + kv2 * HD); }
            const float* lut_g = tab + TB_LUTB + h * LUTB_N;
            band::wave_tile<band::MB>(proj, o, part, h, qblk * 256 + wave * 32, PC(COL_BQ + h * HD), PC(COL_BK + kv * HD), PC(COL_BV + kv * HD), PC(COL_BG + h * HD), OCOL_B + h * HD, sink[h] * LOG2E, 1.f, vlds, xch, lut, lut_g, lane, qr, ks8, vs, pre, nx);
            pre = nx.has; } }
    } else {
        band::Next nx; nx.has = false; nx.q0 = 0; nx.qcol = 0; nx.kcol = 0; nx.vcol = 0;
        for (int ua = vcu; ua < A_H * 64; ua += G) {
            bf16x8 qr[8], ks8[8], vs[8];
            const int h = ua / 64, b = ua % 64;
            const float* lut_g = tab + TB_LUTA + (h * 3 + 0) * LUTA_N;
            band::wave_tile<band::P1>(proj, o, part, h, 256 * b + 32 * wave, PC(COL_AQ + h * HD), PC(COL_AK + h * HD), PC(COL_AV + h * HD), PC(COL_AG + h * HD), OCOL_A + h * HD, -1e20f, 0.f, vlds, xch, lut, lut_g, lane, qr, ks8, vs, false, nx);
        }
    }
}

__global__ void __launch_bounds__(NWAVES * 64, 2) fwd_kernel(Args args) {
    extern __shared__ __attribute__((aligned(16))) unsigned char lds_raw[];
    LAS unsigned char* lds = (LAS unsigned char*)lds_raw;
    volatile LAS unsigned* MISC = (volatile LAS unsigned*)(lds + MISC_OFF);
    const int wave = __builtin_amdgcn_readfirstlane((int)threadIdx.x >> 6);
    const int G = gridDim.x; const int bx = blockIdx.x; const int vcu = (G % 8 == 0) ? (bx % 8) * (G / 8) + bx / 8 : bx;
    gu32* ctl = (gu32*)(args.ws + WS_CTL);
    for (int u = threadIdx.x; u < (LDS_BYTES - LDSCTL_OFF) / 4; u += NWAVES * 64) ((LAS unsigned*)(lds + LDSCTL_OFF))[u] = 0u;
    __syncthreads();
    XcdBarrier bar = xcd_barrier_post((unsigned*)(ctl + CW_BAR), MISC + 8, (unsigned)wave);
    const bf16* Win_t = (const bf16*)(args.ws + WS_WIN); const bf16* Wout_t = (const bf16*)(args.ws + WS_WOUT);
    bf16* Hb = (bf16*)(args.ws + WS_H); bf16* PROJ = (bf16*)(args.ws + WS_PROJ); bf16* Ob = (bf16*)(args.ws + WS_O); bf16* Yb = (bf16*)(args.ws + WS_Y);

    p0_prologue(args, lds, wave, vcu, G);
    xcd_barrier(bar);
    norm_phase(args, lds, -1, 0, args.in[0], wave, vcu, G);
    w8_phase(args, wave, vcu, G);
    xcd_barrier(bar);

#pragma nounroll
    for (int layer = 0; layer < DEPTH; ++layer) {
#ifndef REP_G1
#define REP_G1 1
#endif
        for (int rep = 0; rep < REP_G1; ++rep)
        {
          pg8::Gemm g{Hb, Win_t + (size_t)layer * INW * DM, S, F8_COL0, DM}; pg8::StaticOrder so; so.init(S, F8_COL0, G, bx);
          pg8::EpiStoreT E{PROJ, (size_t)S * 256};
          const int whole = (so.nwg / G) * G, rest = so.nwg - whole; const bool halves = (2 * rest == G);
          if (halves) so.lim = whole;
          pg8::gemm_phase<pg8::EpiStoreT, pg8::StaticOrder, true, true>(lds + RING_OFF, g, so, E, wave);
          if (halves) { pg8::HalfOrder ho; ho.base = so; ho.first = whole;
              pg8::gemm_phase<pg8::EpiStoreT, pg8::HalfOrder, true, true, true>(lds + RING_OFF, g, ho, E, wave); }
          pg8::Gemm g8{(const pg8::bf16_t*)(args.ws + WS_H8), (const pg8::bf16_t*)(args.ws + WS_W8 + (size_t)layer * F8_COLS * DM), S, F8_COLS, DM / 2}; pg8::StaticOrder s8; s8.init(S, F8_COLS, G, bx);
          pg8::EpiStoreT E8{PROJ + (size_t)(F8_COL0 / 256) * S * 256, (size_t)S * 256};
          const int sclb = 127 - w8_exp(args, layer);
          const int whole8 = (s8.nwg / G) * G, rest8 = s8.nwg - whole8; const bool halves8 = (2 * rest8 == G);
          if (halves8) s8.lim = whole8;
          pg8::gemm_phase<pg8::EpiStoreT, pg8::StaticOrder, true, true, false, true>(lds + RING_OFF, g8, s8, E8, wave, sclb);
          if (halves8) { pg8::HalfOrder h8; h8.base = s8; h8.first = whole8;
              pg8::gemm_phase<pg8::EpiStoreT, pg8::HalfOrder, true, true, true, true>(lds + RING_OFF, g8, h8, E8, wave, sclb); } }
        xcd_barrier(bar);
        prep_phase(args, lds, layer, wave, vcu, G);
        __syncthreads();
        band_phase(args, lds, layer, 0, wave, vcu, G);
        xcd_barrier(bar);
#ifndef REP_C
#define REP_C 1
#endif
        for (int rep = 0; rep < REP_C; ++rep)
        for (int i = 0;; ++i) {
            const int u = i * G + vcu; if (u >= C_H * (S / 256)) break;
            const int gq = u / 256, rem = u % 256, kv = rem / 64, qb = rem % 64, head = kv * 3 + gq;
#if defined(ATT_PP)
#ifdef QK_FP4
            attc::attn_f8pp_body((const unsigned char*)(args.ws + WS_QF8) + (size_t)(qb * 256) * attc::LDQ4 + head * 64,
#else
            attc::attn_f8pp_body((const unsigned char*)(args.ws + WS_QF8) + (size_t)(qb * 256) * (C_H * HD) + head * HD,
#endif
 (const unsigned char*)(args.ws + WS_KF8) + (size_t)kv * (S / 64) * attc::PP_TIMG,
                                 PROJ + (size_t)(qb * 256) * PLD + PC(COL_CG + head * HD), Ob + (size_t)(qb * 256) * DM + OCOL_C + head * HD, S, (char*)lds_raw + RING_OFF, wave);
#elif defined(ATT_F8)
            attc::attn_f8_body((const unsigned char*)(args.ws + WS_QF8) + (size_t)(qb * 256) * (C_H * HD) + head * HD, (const unsigned char*)(args.ws + WS_KF8) + kv * HD,
                               (const unsigned char*)(args.ws + WS_VTF8) + (size_t)kv * HD * S,
                               PROJ + (size_t)(qb * 256) * PLD + PC(COL_CG + head * HD), Ob + (size_t)(qb * 256) * DM + OCOL_C + head * HD, S, (char*)lds_raw + RING_OFF, wave);
#else
            attc::attn_dense_body(PROJ + (size_t)(qb * 256) * INW + COL_CQ + head * HD, PROJ + COL_CK + kv * HD, PROJ + COL_CV + kv * HD,
                                  PROJ + (size_t)(qb * 256) * PLD + PC(COL_CG + head * HD), Ob + (size_t)(qb * 256) * DM + OCOL_C + head * HD, S, (char*)lds_raw + RING_OFF, wave);
#endif
        }
        band_phase(args, lds, layer, 1, wave, vcu, G);
        xcd_barrier(bar);
#ifndef REP_G2
#define REP_G2 1
#endif
        for (int rep = 0; rep < REP_G2; ++rep)
        { pg8::Gemm g{Ob, Wout_t + (size_t)layer * DM * DM, S, DM, DM}; pg8::StaticOrder so; so.init(S, DM, G, bx);
          pg8::EpiStore E{Yb, DM};
          pg8::gemm_phase<pg8::EpiStore, pg8::StaticOrder, true, true>(lds + RING_OFF, g, so, E, wave); }
        xcd_barrier(bar);
#ifdef REP_NORM
        norm_phase(args, lds, layer, layer + 1 < DEPTH ? layer + 1 : -1, layer == 0 ? args.in[0] : (const float*)args.out, wave, vcu, G, true);
#endif
        norm_phase(args, lds, layer, layer + 1 < DEPTH ? layer + 1 : -1, layer == 0 ? args.in[0] : (const float*)args.out, wave, vcu, G);
        if (layer + 1 < DEPTH) xcd_barrier(bar);
    }
}

extern "C" void kernel_launch(void* const* d_in, const int* in_sizes, int n_in, void* d_out, int out_size, void* d_ws, size_t ws_size, hipStream_t stream) {
    static int grid = 0;
    if (grid == 0) {
        if (n_in != 12 || in_sizes[0] != S * DM || out_size != S * DM || ws_size < WS_END) {
            fprintf(stderr, "kernel_launch: shape mismatch: n_in %d in0 %d out %d ws %zu (need >= %zu); nothing launched\n", n_in, n_in > 0 ? in_sizes[0] : -1, out_size, ws_size, (size_t)WS_END); grid = -1; return; }
        int dev = 0, cus = 0, per_cu = 0;
        if (hipGetDevice(&dev) != hipSuccess || hipDeviceGetAttribute(&cus, hipDeviceAttributeMultiprocessorCount, dev) != hipSuccess) { fprintf(stderr, "kernel_launch: device query failed\n"); grid = -1; return; }
        if (hipFuncSetAttribute((const void*)fwd_kernel, hipFuncAttributeMaxDynamicSharedMemorySize, LDS_BYTES) != hipSuccess) { fprintf(stderr, "kernel_launch: hipFuncSetAttribute failed\n"); grid = -1; return; }
        if (hipOccupancyMaxActiveBlocksPerMultiprocessor(&per_cu, (const void*)fwd_kernel, NWAVES * 64, LDS_BYTES) != hipSuccess || per_cu < 1)
            fprintf(stderr, "kernel_launch: note: occupancy query reports %d workgroups per CU\n", per_cu);
        (void)hipGetLastError();
        grid = cus;
    }
    if (grid < 0) return;
    if (hipMemsetAsync((char*)d_ws + WS_CTL, 0, CTL_ZERO_BYTES, stream) != hipSuccess) { fprintf(stderr, "kernel_launch: memset failed\n"); return; }
    Args a{};
    for (int i = 0; i < 12; ++i) a.in[i] = (const float*)d_in[i];
    a.out = (float*)d_out; a.ws = (unsigned char*)d_ws;
    hipLaunchKernelGGL(fwd_kernel, dim3(grid), dim3(NWAVES * 64), LDS_BYTES, stream, a);
    const hipError_t le = hipPeekAtLastError();
    if (le != hipSuccess) fprintf(stderr, "kernel_launch: launch failed: %s\n", hipGetErrorName(le));
}
```

```cpp
#define ATT_F8 1
#define ATT_PP 1
#define QK_FP4 1
#include <hip/hip_runtime.h>
#include <hip/hip_bf16.h>
#include <cstdio>
#include <cstdint>
#include <cmath>

namespace pg8 {
#define PG8_LAS __attribute__((address_space(3)))
typedef unsigned short bf16_t;
typedef short bf16x8 __attribute__((ext_vector_type(8)));
typedef float f32x4 __attribute__((ext_vector_type(4)));
typedef unsigned u32x4 __attribute__((ext_vector_type(4)));
constexpr int BM = 256, BK = 64, HALF = 128, HTB = HALF * BK * 2  , STAGE_BYTES = 8 * HTB, NXCD = 8, WGM = 8;

__host__ __device__ __forceinline__ int lds_byte(int r, int c) { const int st = (r >> 4) * 2 + (c >> 5), rr = r & 15, cc = c & 31, ob = rr * 64 + cc * 2; return st * 1024 + (ob ^ (((ob >> 9) & 1) << 5)); }
__host__ __device__ __forceinline__ void stage_rc(int b, int& R, int& C) { const int st = b / 1024, sb = b % 1024, swz = sb ^ (((sb >> 9) & 1) << 5); R = (st >> 1) * 16 + swz / 64; C = (st & 1) * 32 + (swz % 64) / 2; }
__host__ __device__ __forceinline__ int perm32(int rho) { const int n = rho >> 4, i = rho & 15; return 8 * (i >> 2) + 4 * n + (i & 3); }

struct Unit { int pm, pn, hm; };
struct Gemm { const bf16_t* A; const bf16_t* Bt; int M, N, K; };

struct StaticOrder {
    int nM, nN, nwg, G, c, lim;
    __host__ __device__ void init(int M, int N, int G_, int c_) { nM = M / BM; nN = N / BM; nwg = nM * nN; G = G_; c = c_; lim = nwg; }
    __host__ __device__ void map(int wgid, Unit& u) const {
        { const int q = nwg / NXCD, r = nwg % NXCD, xcd = wgid % NXCD, off = wgid / NXCD; wgid = (xcd < r ? xcd * (q + 1) : r * (q + 1) + (xcd - r) * q) + off; }
        const int nig = WGM * nN, gid = wgid / nig, fm = gid * WGM, gsz = (nM - fm) < WGM ? (nM - fm) : WGM;
        u.pm = fm + ((wgid % nig) % gsz); u.pn = (wgid % nig) / gsz; u.hm = 0;
    }
    __host__ __device__ bool next(int i, Unit& u) const {
        const long L = (long)i * G + c; if (L >= lim) return false;
        map((int)L, u); return true;
    }
    __device__ __forceinline__ void a_ready(const Unit&) const {}
    __device__ __forceinline__ void done(const Unit&) const {}
};
struct HalfOrder {
    StaticOrder base; int first;
    __host__ __device__ bool next(int i, Unit& u) const { if (i > 0) return false; base.map(first + (base.c >> 1), u); u.hm = (base.c & 1) ? 1 : 2; return true; }
    __device__ __forceinline__ void a_ready(const Unit&) const {}
    __device__ __forceinline__ void done(const Unit&) const {}
};

__device__ __forceinline__ unsigned cvt_pk_bf16(float lo, float hi) { unsigned r; asm volatile("v_cvt_pk_bf16_f32 %0, %1, %2" : "=v"(r) : "v"(lo), "v"(hi)); return r; }
struct EpiStore {
    static constexpr bool PERM = true, AFTER_DRAIN = false;
    bf16_t* O; int ldc;
    __device__ __forceinline__ void operator()(const f32x4 (&acc)[2][2][4][2], const Unit& u, int wr, int wc, int fr, int fq) const {
        const int row0 = u.pm * BM + wr * 64 + fr; const int col0 = u.pn * BM + wc * 32 + 8 * fq;
#pragma unroll
        for (int ai = 0; ai < 2; ++ai)
#pragma unroll
            for (int m = 0; m < 4; ++m) { bf16_t* rowp = O + (size_t)(row0 + ai * HALF + m * 16) * ldc + col0;
#pragma unroll
                for (int bj = 0; bj < 2; ++bj) { if (u.hm & (1 << bj)) continue; const f32x4 v0 = acc[ai][bj][m][0], v1 = acc[ai][bj][m][1];
                    u32x4 w; w.x = cvt_pk_bf16(v0[0], v0[1]); w.y = cvt_pk_bf16(v0[2], v0[3]); w.z = cvt_pk_bf16(v1[0], v1[1]); w.w = cvt_pk_bf16(v1[2], v1[3]);
                    *(u32x4*)(rowp + bj * HALF) = w; } }
    }
    __device__ __forceinline__ void fused(f32x4 (&acc)[2][2][4][2], const Unit& u, int wr, int wc, int fr, int fq, PG8_LAS unsigned char* lds, int wid, int lane) const {}
};

struct EpiStoreT {
    static constexpr bool PERM = true, AFTER_DRAIN = false;
    bf16_t* O; size_t tstride;
    __device__ __forceinline__ void operator()(const f32x4 (&acc)[2][2][4][2], const Unit& u, int wr, int wc, int fr, int fq) const {
        const int row0 = u.pm * BM + wr * 64 + fr; bf16_t* Ot = O + (size_t)u.pn * tstride + wc * 32 + 8 * fq;
#pragma unroll
        for (int ai = 0; ai < 2; ++ai)
#pragma unroll
            for (int m = 0; m < 4; ++m) { bf16_t* rowp = Ot + (size_t)(row0 + ai * HALF + m * 16) * BM;
#pragma unroll
                for (int bj = 0; bj < 2; ++bj) { if (u.hm & (1 << bj)) continue; const f32x4 v0 = acc[ai][bj][m][0], v1 = acc[ai][bj][m][1];
                    u32x4 w; w.x = cvt_pk_bf16(v0[0], v0[1]); w.y = cvt_pk_bf16(v0[2], v0[3]); w.z = cvt_pk_bf16(v1[0], v1[1]); w.w = cvt_pk_bf16(v1[2], v1[3]);
                    *(u32x4*)(rowp + bj * HALF) = w; } }
    }
    __device__ __forceinline__ void fused(f32x4 (&acc)[2][2][4][2], const Unit& u, int wr, int wc, int fr, int fq, PG8_LAS unsigned char* lds, int wid, int lane) const {}
};

template <class Epi, class Sched, bool ALIGN_EPI = false, bool SP2 = false, bool HALFU = false, bool FP8 = false>
__device__ __forceinline__ void gemm_phase(PG8_LAS unsigned char* lds, const Gemm g, const Sched& S, const Epi& E, const int wid_in, const int sclb = 127) {
    typedef int i32x4_ __attribute__((ext_vector_type(4))); typedef int i32x8_ __attribute__((ext_vector_type(8)));
    const int scl2 = 127 | (sclb << 8);
    int wid = wid_in; asm volatile("" : "+s"(wid));
    int lane_l; asm volatile("v_mbcnt_lo_u32_b32 %0, -1, 0\n\tv_mbcnt_hi_u32_b32 %0, -1, %0" : "=v"(lane_l));
    const int lane = lane_l, tid = wid * 64 + lane, wr = wid >> 2, wc = wid & 3, fr = lane & 15, fq = lane >> 4;
    const int K = g.K, nt = K / BK;
    unsigned voffA[2], voffB[2];
#pragma unroll
    for (int i = 0; i < 2; ++i) { int R, C; stage_rc(tid * 16 + i * 8192, R, C); const int Rb = Epi::PERM ? ((R & ~31) + perm32(R & 31)) : R;
        voffA[i] = (unsigned)(R * K + C) * 2u; voffB[i] = (unsigned)(Rb * K + C) * 2u; }
    const size_t kstep = (size_t)(BK * 2);
    const size_t hstep = (size_t)HALF * K * 2;
    const size_t tstep = 2 * hstep;
    const unsigned ldsw = (unsigned)wid * 1024u;
    const int aoff = lds_byte(wr * 64 + fr, fq * 8), boff = lds_byte(wc * 32 + fr, fq * 8);
#define PG8_SA(b, h) (((b) * 2 + (h)) * HTB)
#define PG8_SB(b, h) ((4 + (b) * 2 + (h)) * HTB)
#define PG8_STAGE(bufoff, gbase, voff) do { _Pragma("unroll") for (int _i = 0; _i < 2; ++_i) \
        __builtin_amdgcn_global_load_lds((const unsigned*)((const char*)(gbase) + (voff)[_i]), (PG8_LAS unsigned*)(lds + (bufoff) + ldsw + _i * 8192), 16, 0, 0); } while (0)
#define PG8_LDA(dst, b, h) do { _Pragma("unroll") for (int m = 0; m < 4; ++m) { \
        if constexpr (FP8) { const i32x4_ l_ = *(const PG8_LAS i32x4_*)(lds + PG8_SA(b, h) + aoff + m * 2048), h_ = *(const PG8_LAS i32x4_*)(lds + PG8_SA(b, h) + aoff + m * 2048 + 1024); \
                             dst##8[m] = (i32x8_){l_[0], l_[1], l_[2], l_[3], h_[0], h_[1], h_[2], h_[3]}; } \
        else { _Pragma("unroll") for (int k = 0; k < 2; ++k) dst[m][k] = *(const PG8_LAS bf16x8*)(lds + PG8_SA(b, h) + aoff + m * 2048 + k * 1024); } } } while (0)
#define PG8_LDB(dst, b, h) do { _Pragma("unroll") for (int n = 0; n < 2; ++n) { \
        if constexpr (FP8) { const i32x4_ l_ = *(const PG8_LAS i32x4_*)(lds + PG8_SB(b, h) + boff + n * 2048), h_ = *(const PG8_LAS i32x4_*)(lds + PG8_SB(b, h) + boff + n * 2048 + 1024); \
                             dst##8[n] = (i32x8_){l_[0], l_[1], l_[2], l_[3], h_[0], h_[1], h_[2], h_[3]}; } \
        else { _Pragma("unroll") for (int k = 0; k < 2; ++k) dst[n][k] = *(const PG8_LAS bf16x8*)(lds + PG8_SB(b, h) + boff + n * 2048 + k * 1024); } } } while (0)
#define PG8_MMA(ai, bj, At, Bt) do { if (HALFU && (cur.hm & (1 << (bj)))) break; __builtin_amdgcn_s_setprio(1); \
        if constexpr (FP8) { _Pragma("unroll") for (int m = 0; m < 4; ++m) _Pragma("unroll") for (int n = 0; n < 2; ++n) \
            asm volatile("v_mfma_scale_f32_16x16x128_f8f6f4 %0, %1, %2, %0, %3, %3 op_sel:[1,0,0] op_sel_hi:[0,0,0]" : "+v"(acc[ai][bj][m][n]) : "v"(Bt##8[n]), "v"(At##8[m]), "v"(scl2)); } \
        else { _Pragma("unroll") for (int m = 0; m < 4; ++m) _Pragma("unroll") for (int n = 0; n < 2; ++n) _Pragma("unroll") for (int k = 0; k < 2; ++k) \
            acc[ai][bj][m][n] = __builtin_amdgcn_mfma_f32_16x16x32_bf16(Bt[n][k], At[m][k], acc[ai][bj][m][n], 0, 0, 0); } \
        __builtin_amdgcn_s_setprio(0); } while (0)
#define PG8_WAIT_V(n) asm volatile("s_waitcnt vmcnt(" #n ")" ::: "memory")
#define PG8_WAIT_L(n) asm volatile("s_waitcnt lgkmcnt(" #n ")" ::: "memory")
#define PG8_BAR __builtin_amdgcn_s_barrier()
#define PG8_SCHED __builtin_amdgcn_sched_barrier(0)
    Unit cur, nxt; int ui = 0;
    if (!S.next(0, cur)) return;
    f32x4 acc[2][2][4][2];
#pragma unroll
    for (int a = 0; a < 2; ++a)
#pragma unroll
        for (int b = 0; b < 2; ++b)
#pragma unroll
            for (int m = 0; m < 4; ++m)
#pragma unroll
                for (int n = 0; n < 2; ++n) acc[a][b][m][n] = (f32x4){0.f, 0.f, 0.f, 0.f};
    bf16x8 At[4][2], B0[2][2], B1[2][2]; i32x8_ At8[4], B08[2], B18[2];
    const char* cA = (const char*)g.A + (size_t)cur.pm * tstep; const char* cB = (const char*)g.Bt + (size_t)cur.pn * tstep;
    S.a_ready(cur);
    if constexpr (SP2) {
        PG8_STAGE(PG8_SB(0, 0), cB, voffB); PG8_STAGE(PG8_SB(0, 1), cB + hstep, voffB); PG8_STAGE(PG8_SA(0, 0), cA, voffA); PG8_STAGE(PG8_SA(0, 1), cA + hstep, voffA);
        if (wr == 1) PG8_BAR;
        PG8_WAIT_V(2); PG8_BAR;
        PG8_STAGE(PG8_SB(1, 0), cB + kstep, voffB); PG8_STAGE(PG8_SA(1, 0), cA + kstep, voffA); PG8_STAGE(PG8_SB(1, 1), cB + hstep + kstep, voffB);
        PG8_WAIT_V(6); PG8_BAR;
    } else {
        PG8_STAGE(PG8_SB(0, 0), cB, voffB); PG8_STAGE(PG8_SA(0, 0), cA, voffA); PG8_STAGE(PG8_SB(0, 1), cB + hstep, voffB); PG8_STAGE(PG8_SA(0, 1), cA + hstep, voffA);
        if (wr == 1) PG8_BAR;
        PG8_WAIT_V(4); PG8_BAR;
        PG8_STAGE(PG8_SB(1, 0), cB + kstep, voffB); PG8_STAGE(PG8_SA(1, 0), cA + kstep, voffA); PG8_STAGE(PG8_SB(1, 1), cB + hstep + kstep, voffB);
        PG8_WAIT_V(6); PG8_BAR;
    }
    for (;;) {
        const bool has_next = S.next(ui + 1, nxt);
        const char* nA = has_next ? (const char*)g.A + (size_t)nxt.pm * tstep : cA; const char* nB = has_next ? (const char*)g.Bt + (size_t)nxt.pn * tstep : cB;
        for (int t = 0; t < nt; t += 2) {
            const bool last = (t == nt - 2);
            const char* a1 = cA + (size_t)(t + 1) * kstep;
            const char* a2 = last ? nA : cA + (size_t)(t + 2) * kstep; const char* b2 = last ? nB : cB + (size_t)(t + 2) * kstep;
            const char* a3 = a2 + kstep; const char* b3 = b2 + kstep;
            if (last && has_next) S.a_ready(nxt);
            if constexpr (SP2) {
            PG8_LDB(B0, 0, 0); PG8_LDB(B1, 0, 1); PG8_SCHED; PG8_LDA(At, 0, 0); PG8_STAGE(PG8_SA(1, 1), a1 + hstep, voffA);
            PG8_WAIT_V(8); PG8_WAIT_L(0); PG8_BAR; PG8_MMA(0, 0, At, B0); PG8_MMA(0, 1, At, B1); PG8_BAR; PG8_SCHED;
            PG8_LDA(At, 0, 1); PG8_STAGE(PG8_SB(0, 0), b2, voffB); PG8_STAGE(PG8_SB(0, 1), b2 + hstep, voffB); PG8_STAGE(PG8_SA(0, 0), a2, voffA);
            PG8_WAIT_V(8); PG8_WAIT_L(0); PG8_BAR; PG8_MMA(1, 0, At, B0); PG8_MMA(1, 1, At, B1); PG8_BAR; PG8_SCHED;
            PG8_LDB(B0, 1, 0); PG8_LDB(B1, 1, 1); PG8_SCHED; PG8_LDA(At, 1, 0); PG8_STAGE(PG8_SA(0, 1), a2 + hstep, voffA);
            PG8_WAIT_V(8); PG8_WAIT_L(0); PG8_BAR; PG8_MMA(0, 0, At, B0); PG8_MMA(0, 1, At, B1); PG8_BAR; PG8_SCHED;
            PG8_LDA(At, 1, 1); PG8_STAGE(PG8_SB(1, 0), b3, voffB); PG8_STAGE(PG8_SB(1, 1), b3 + hstep, voffB); PG8_STAGE(PG8_SA(1, 0), a3, voffA);
            PG8_WAIT_V(8); PG8_WAIT_L(0); PG8_BAR; PG8_MMA(1, 0, At, B0); PG8_MMA(1, 1, At, B1); PG8_BAR; PG8_SCHED;
            } else {
            PG8_LDB(B0, 0, 0); PG8_SCHED; PG8_LDA(At, 0, 0); PG8_STAGE(PG8_SA(1, 1), a1 + hstep, voffA);
            PG8_WAIT_L(8); PG8_BAR; PG8_WAIT_L(0); PG8_MMA(0, 0, At, B0); PG8_BAR; PG8_SCHED;
            PG8_LDB(B1, 0, 1); PG8_STAGE(PG8_SB(0, 0), b2, voffB);
            PG8_BAR; PG8_WAIT_L(0); PG8_MMA(0, 1, At, B1); PG8_BAR;
            PG8_LDA(At, 0, 1); PG8_STAGE(PG8_SA(0, 0), a2, voffA);
            PG8_BAR; PG8_WAIT_L(0); PG8_MMA(1, 0, At, B0); PG8_BAR; PG8_SCHED;
            PG8_STAGE(PG8_SB(0, 1), b2 + hstep, voffB);
            PG8_WAIT_V(6); PG8_BAR; PG8_MMA(1, 1, At, B1); PG8_BAR;
            PG8_LDB(B0, 1, 0); PG8_SCHED; PG8_LDA(At, 1, 0); PG8_STAGE(PG8_SA(0, 1), a2 + hstep, voffA);
            PG8_WAIT_L(8); PG8_BAR; PG8_WAIT_L(0); PG8_MMA(0, 0, At, B0); PG8_BAR; PG8_SCHED;
            PG8_LDB(B1, 1, 1); PG8_STAGE(PG8_SB(1, 0), b3, voffB);
            PG8_BAR; PG8_WAIT_L(0); PG8_MMA(0, 1, At, B1); PG8_BAR;
            PG8_LDA(At, 1, 1); PG8_STAGE(PG8_SA(1, 0), a3, voffA);
            PG8_BAR; PG8_WAIT_L(0); PG8_MMA(1, 0, At, B0); PG8_BAR; PG8_SCHED;
            PG8_STAGE(PG8_SB(1, 1), b3 + hstep, voffB);
            PG8_WAIT_V(6); PG8_BAR; PG8_MMA(1, 1, At, B1); PG8_BAR;
            }
        }
        if constexpr (ALIGN_EPI) { if (wr == 0) PG8_BAR; }
        if constexpr (!Epi::AFTER_DRAIN) { E(acc, cur, wr, wc, fr, fq); S.done(cur); }
        if (!has_next) break;
#pragma unroll
        for (int a = 0; a < 2; ++a)
#pragma unroll
            for (int b = 0; b < 2; ++b)
#pragma unroll
                for (int m = 0; m < 4; ++m)
#pragma unroll
                    for (int n = 0; n < 2; ++n) acc[a][b][m][n] = (f32x4){0.f, 0.f, 0.f, 0.f};
        cur = nxt; cA = nA; cB = nB; ++ui;
        if constexpr (ALIGN_EPI) { if (wr == 1) PG8_BAR; }
    }
    PG8_WAIT_V(0);
    if constexpr (!ALIGN_EPI) { if (wr == 0) PG8_BAR; }
    PG8_BAR;
    if constexpr (Epi::AFTER_DRAIN) { E.fused(acc, cur, wr, wc, fr, fq, lds, wid, lane); S.done(cur); }
#undef PG8_SA
#undef PG8_SB
#undef PG8_STAGE
#undef PG8_LDA
#undef PG8_LDB
#undef PG8_MMA
#undef PG8_WAIT_V
#undef PG8_WAIT_L
#undef PG8_BAR
#undef PG8_SCHED
}
}
typedef unsigned short bf16;
typedef pg8::bf16_t bf16_t;
typedef unsigned u32x2 __attribute__((ext_vector_type(2)));
constexpr int S = 16384, DM = 4096, DEPTH = 4, HD = 128, INW = 12800, NMOD = 3 * DM;
constexpr int A_H = 12, B_H = 8, C_H = 12;
constexpr int COL_AK = 0, COL_AV = 1536, COL_AG = 3072, COL_BQ = 4608, COL_BK = 5632, COL_BV = 5888, COL_BG = 6144, COL_CG = 7168, COL_CV = 8704,
              COL_AQ = 9216, COL_CQ = 10752, COL_CK = 12288;
__host__ __device__ constexpr int proj_col_of(int src) { return src < 1536 ? src + COL_AQ : (src < 8704 ? src - 1536 : (src < 10752 ? src + 2048 : (src < 11264 ? src - 2048 : src - 4096))); }
constexpr int PLD = 256;
__host__ __device__ constexpr int PC(int col) { return (col >> 8) * (S * 256) + (col & 255); }
constexpr int OCOL_A = 0, OCOL_B = 1536, OCOL_C = 2560;
constexpr float EPS = 1e-6f;
constexpr float SM_SCALE = 0.08838834764831845f;
constexpr float LOG2E = 1.4426950408889634f;
constexpr float QK_C = SM_SCALE * LOG2E;
constexpr int NWAVES = 8;

constexpr size_t MiB = 1u << 20;
constexpr size_t WS_CTL = 0, CTL_ZERO_BYTES = 1 * MiB;
constexpr size_t WS_TAB = 1 * MiB;
constexpr size_t WS_MODP = 1 * MiB + 256 * 1024;
constexpr size_t WS_WIN = 2 * MiB;
constexpr size_t WS_WOUT = WS_WIN + 400 * MiB;
constexpr size_t WS_H = WS_WOUT + 128 * MiB;
constexpr size_t WS_PROJ = WS_H + 128 * MiB;
constexpr size_t WS_O = WS_PROJ + 400 * MiB;
constexpr size_t WS_Y = WS_O + 128 * MiB;
constexpr size_t WS_PART4 = WS_Y + 128 * MiB;
constexpr size_t WS_PART16 = WS_PART4 + 48 * MiB;
constexpr size_t WS_STAT4 = WS_PART16 + 48 * MiB;
constexpr size_t WS_STAT16 = WS_STAT4 + 2 * MiB;
constexpr size_t WS_QF8 = WS_STAT16 + 2 * MiB;
constexpr size_t WS_KF8 = WS_QF8 + 24 * MiB;
constexpr size_t WS_VTF8 = WS_KF8 + 8 * MiB;
constexpr size_t WS_H8 = WS_VTF8 + 8 * MiB;
constexpr size_t WS_W8 = WS_H8 + 64 * MiB;
constexpr size_t WS_END = WS_W8 + 64 * MiB;
constexpr int F8_COL0 = COL_AQ, F8_COLS = 3584;
constexpr int CW_AMAX = 1024;
constexpr int CW_BAR = 4096;
constexpr int LUTA_N = 2 * (64 + 28) + 1, LUTB_N = 2 * (128 + 28) + 1;
constexpr int TB_LUTA = 0;
constexpr int TB_LUTB = 6912;
constexpr int TB_ROPE_R = 12288;
constexpr int TB_ROPE_C = 12288 + 16384;
constexpr int RING_OFF = 0, RING_BYTES = 131072;
constexpr int BAND_BYTES = 8 * (8192 + 32 * 272);
constexpr int LDSCTL_OFF = BAND_BYTES, MISC_OFF = LDSCTL_OFF + 320;
constexpr int BAND_LUT_OFF = LDSCTL_OFF + 1024;
constexpr int BAND_LUT_WAVE = 2048;
constexpr int LDS_BYTES = BAND_LUT_OFF + 8 * BAND_LUT_WAVE;
__device__ __forceinline__ int fresh_lane() { int l; asm volatile("v_mbcnt_lo_u32_b32 %0, -1, 0\n\tv_mbcnt_hi_u32_b32 %0, -1, %0" : "=v"(l)); return l; }
__device__ __forceinline__ float lane_xor(float v, int mask, int lane) { return __uint_as_float((unsigned)__builtin_amdgcn_ds_bpermute((lane ^ mask) << 2, (int)__float_as_uint(v))); }
__device__ __forceinline__ float wave_sum_l(float v, int lane) {
#pragma unroll
    for (int o = 1; o < 64; o <<= 1) v += lane_xor(v, o, lane);
    return v;
}
__device__ __forceinline__ float wave_max_l(float v, int lane) {
#pragma unroll
    for (int o = 1; o < 64; o <<= 1) v = fmaxf(v, lane_xor(v, o, lane));
    return v;
}

#define GAS __attribute__((address_space(1)))
#define LAS __attribute__((address_space(3)))
typedef unsigned short bf16;
typedef unsigned v4u __attribute__((ext_vector_type(4)));
typedef float f32x4 __attribute__((ext_vector_type(4)));
typedef short bf16x8 __attribute__((ext_vector_type(8)));
typedef GAS unsigned gu32;
typedef GAS unsigned long long gu64;
#define RLX_AGENT __ATOMIC_RELAXED, __HIP_MEMORY_SCOPE_AGENT
#define LDS_WAIT() asm volatile("s_waitcnt lgkmcnt(0)" ::: "memory")
#define VM_WAIT() asm volatile("s_waitcnt vmcnt(0)" ::: "memory")
__device__ __forceinline__ unsigned long long rt() { return __builtin_amdgcn_s_memrealtime(); }
__device__ __forceinline__ unsigned f2bf(float f) { unsigned u = __builtin_bit_cast(unsigned, f); return (u + 0x7fffu + ((u >> 16) & 1u)) >> 16; }
__device__ __forceinline__ unsigned pk2(float lo, float hi) { return f2bf(lo) | (f2bf(hi) << 16); }

#define XB_TMO      128
#define XB_XCNT(j)  (256  + 64 * (j))
#define XB_XSUB(j)  (1280 + 64 * (j))
#define XB_XGEN(j)  (2304 + 64 * (j))
#define XB_TOP      3328
#define XB_TOPGEN   3392
#define XCD_BAR_WORDS 3456
#define XB_SPIN_CAP (1u << 18)

__device__ __forceinline__ unsigned xb_ld(unsigned* p)              { return __hip_atomic_load(p, __ATOMIC_RELAXED, __HIP_MEMORY_SCOPE_AGENT); }
__device__ __forceinline__ unsigned xb_add(unsigned* p, unsigned v) { return __hip_atomic_fetch_add(p, v, __ATOMIC_RELAXED, __HIP_MEMORY_SCOPE_AGENT); }
__device__ __forceinline__ unsigned xb_xcc_id() { return (unsigned)__builtin_amdgcn_s_getreg((3 << 11) | 20) & 0xFu; }
#define XB_SPIN(cond, bar) do { unsigned _sp = 0; while (cond) { __builtin_amdgcn_s_sleep(1); \
    if ((++_sp & 255u) == 0u) { if (xb_ld(&(bar)[XB_TMO])) break; if (_sp > XB_SPIN_CAP) { atomicAdd(&(bar)[XB_TMO], 1u); break; } } } } while (0)

struct XcdBarrier {
    unsigned* bar; unsigned x; unsigned w;
    volatile LAS unsigned* st;
};

__device__ __forceinline__ XcdBarrier xcd_barrier_post(unsigned* bar, volatile LAS unsigned* st, unsigned wave) {
    XcdBarrier b; b.bar = bar; b.x = (unsigned)__builtin_amdgcn_readfirstlane((int)xb_xcc_id()); b.st = st; b.w = wave;
    if (threadIdx.x == 0) (void)xb_add(&bar[XB_XCNT(b.x)], 1u);
    return b;
}
__device__ __forceinline__ void xcd_barrier_complete(unsigned* bar, unsigned x, unsigned& nloc, unsigned& nx) {
    const unsigned G = gridDim.x * gridDim.y * gridDim.z;
    unsigned sum, cnt, mine, sp = 0u;
    for (;;) {
        sum = 0u; cnt = 0u; mine = 0u;
#pragma unroll
        for (unsigned j = 0; j < 16; ++j) { const unsigned c = xb_ld(&bar[XB_XCNT(j)]); sum += c; cnt += (c > 0u) ? 1u : 0u; mine = (j == x) ? c : mine; }
        if (sum == G) break;
        __builtin_amdgcn_s_sleep(1);
        if ((++sp & 255u) == 0u) { if (xb_ld(&bar[XB_TMO])) break; if (sp > XB_SPIN_CAP) { atomicAdd(&bar[XB_TMO], 1u); break; } }
    }
    nloc = mine > 0u ? mine : 1u; nx = cnt > 0u ? cnt : 1u;
}

__device__ __forceinline__ void xcd_barrier(const XcdBarrier& b) {
    asm volatile("s_waitcnt vmcnt(0)" ::: "memory");
    __syncthreads();
    int ln_; asm volatile("v_mbcnt_lo_u32_b32 %0, -1, 0\n\tv_mbcnt_hi_u32_b32 %0, -1, %0" : "=v"(ln_));
    if (b.w == 0u && ln_ == 0) {
        unsigned* bar = b.bar; unsigned bx_ = b.x; asm volatile("" : "+s"(bar), "+s"(bx_));
        __builtin_amdgcn_s_waitcnt(0);
        unsigned nloc = b.st[0], nx = b.st[1];
        if (nloc == 0u) { xcd_barrier_complete(bar, bx_, nloc, nx); b.st[0] = nloc; b.st[1] = nx; }
        const unsigned old = xb_add(&bar[XB_XSUB(bx_)], 1u);
        const unsigned gen = old / nloc;
        if (old + 1u == (gen + 1u) * nloc) {
            __builtin_amdgcn_fence(__ATOMIC_RELEASE, "agent");
            asm volatile("s_waitcnt vmcnt(0)" ::: "memory");
            const unsigned og = xb_add(&bar[XB_TOP], 1u);
            const unsigned tg = og / nx;
            if (og + 1u == (tg + 1u) * nx) xb_add(&bar[XB_TOPGEN], 1u);
            else XB_SPIN(xb_ld(&bar[XB_TOPGEN]) == tg, bar);
            __builtin_amdgcn_fence(__ATOMIC_ACQUIRE, "agent");
            xb_add(&bar[XB_XGEN(bx_)], 1u);
            asm volatile("s_waitcnt vmcnt(0)" ::: "memory");
        } else {
            XB_SPIN(xb_ld(&bar[XB_XGEN(bx_)]) == gen, bar);
            __builtin_amdgcn_fence(__ATOMIC_ACQUIRE, "agent");
            asm volatile("s_waitcnt vmcnt(0)" ::: "memory");
        }
    }
    __syncthreads();
}
__device__ __forceinline__ float wave_sum(float v) {
#pragma unroll
    for (int o = 1; o < 64; o <<= 1) v += __shfl_xor(v, o);
    return v;
}
template <bool TRACK>
__device__ __forceinline__ void p0_transpose_item(const float* W, int K, int N, bf16* WT, int row_off, LAS float* scr, int item, int lane, float& amx) {
    const int nblk = N / 32, kb = item / nblk, nb = item % nblk, k0 = 64 * kb, n0 = 32 * nb;
#pragma unroll 8
    for (int i = 0; i < 32; ++i) { const int kk = 2 * i + (lane >> 5); const float w_ = W[(size_t)(k0 + kk) * N + n0 + (lane & 31)]; scr[kk * 33 + (lane & 31)] = w_; if (TRACK) amx = fmaxf(amx, fabsf(w_)); }
    LDS_WAIT(); asm volatile("" ::: "memory");
    const int c = lane & 7;
#pragma unroll
    for (int j = 0; j < 4; ++j) { const int n = (lane >> 3) + 8 * j; const LAS float* s = scr + (8 * c) * 33 + n;
        v4u o; o.x = pk2(s[0 * 33], s[1 * 33]); o.y = pk2(s[2 * 33], s[3 * 33]); o.z = pk2(s[4 * 33], s[5 * 33]); o.w = pk2(s[6 * 33], s[7 * 33]);
        *(GAS v4u*)(WT + (size_t)(row_off + n0 + n) * K + k0 + 8 * c) = o; }
    LDS_WAIT(); asm volatile("" ::: "memory");
}
namespace attc {
typedef unsigned short bf16;
constexpr int   D = 128, NW = 8, QBLK = 32, KVBLK = 64;
constexpr float SCALE = SM_SCALE;
constexpr float THR = 8.f;
constexpr int SDEPTH = 2;
constexpr int LDQ = PLD, LDK = INW, LDO = DM;
constexpr size_t SHM_V = KVBLK * D * 2, SHM_K = KVBLK * D * 2, SHM_ATTN = 2 * SHM_V + 2 * SHM_K + NW * 64 * 4;
using bf16x8 = __attribute__((ext_vector_type(8))) short;
using s16x4  = __attribute__((ext_vector_type(4))) short;
using f32x16 = __attribute__((ext_vector_type(16))) float;
using u32x4  = __attribute__((ext_vector_type(4))) unsigned;
struct StageB { using T = bf16x8;
  __device__ static __forceinline__ T ld8(const bf16* p) { return *reinterpret_cast<const bf16x8*>(p); }
  __device__ static __forceinline__ bf16x8 tobf(T x) { return x; } };
#define KSWZ(row, colB) ((row) * 256 + ((colB) ^ (((row) & 7) << 4)))
#define SBAR() __builtin_amdgcn_sched_barrier(0)
__device__ __forceinline__ int crow(int r, int hi) { return (r & 3) + 8 * (r >> 2) + 4 * hi; }
__device__ __forceinline__ unsigned cvtpk(float lo, float hi) {
  unsigned r; asm volatile("v_cvt_pk_bf16_f32 %0, %1, %2" : "=v"(r) : "v"(lo), "v"(hi)); return r;
}
__device__ __forceinline__ void partialSM(f32x16& p0, f32x16& p1, float& m_reg, float& mn, float& alpha) {
  constexpr float C = SCALE * 1.4426950408889634f;
  float pmax = p0[0]; for (int r = 1; r < 16; ++r) pmax = fmaxf(pmax, p0[r]); for (int r = 0; r < 16; ++r) pmax = fmaxf(pmax, p1[r]);
  { auto rr = __builtin_amdgcn_permlane32_swap(__float_as_uint(pmax), __float_as_uint(pmax), false, false);
    pmax = fmaxf(__uint_as_float(rr[0]), __uint_as_float(rr[1])); }
  if (__builtin_expect(__all(pmax - m_reg <= THR / SCALE), 1)) { mn = m_reg; alpha = 1.f; }
  else { mn = fmaxf(m_reg, pmax); alpha = __builtin_amdgcn_exp2f((m_reg - mn) * C); m_reg = mn; }
  float mnC = -mn * C;
  for (int r = 0; r < 16; ++r) p0[r] = fmaf(p0[r], C, mnC); for (int r = 0; r < 16; ++r) p1[r] = fmaf(p1[r], C, mnC);
  for (int r = 0; r < 16; ++r) p0[r] = __builtin_amdgcn_exp2f(p0[r]);
}
__device__ __forceinline__ float psm_max(const f32x16& p0, const f32x16& p1) {
  float pmax = p0[0];
#pragma unroll
  for (int r = 1; r < 16; ++r) pmax = fmaxf(pmax, p0[r]);
#pragma unroll
  for (int r = 0; r < 16; ++r) pmax = fmaxf(pmax, p1[r]);
  auto rr = __builtin_amdgcn_permlane32_swap(__float_as_uint(pmax), __float_as_uint(pmax), false, false);
  return fmaxf(__uint_as_float(rr[0]), __uint_as_float(rr[1]));
}
__device__ __forceinline__ void psm_scale(f32x16& p0, f32x16& p1, float pmax, float& m_reg, float& mn, float& alpha) {
  constexpr float C = SCALE * 1.4426950408889634f;
  const bool keep = __all(pmax - m_reg <= THR / SCALE);
  mn = keep ? m_reg : fmaxf(m_reg, pmax); alpha = keep ? 1.f : __builtin_amdgcn_exp2f((m_reg - mn) * C); m_reg = mn;
  const float mnC = -mn * C;
#pragma unroll
  for (int r = 0; r < 16; ++r) p0[r] = fmaf(p0[r], C, mnC);
#pragma unroll
  for (int r = 0; r < 16; ++r) p1[r] = fmaf(p1[r], C, mnC);
}
template <int LO> __device__ __forceinline__ void psm_exp8(f32x16& p0) {
#pragma unroll
  for (int r = LO; r < LO + 8; ++r) p0[r] = __builtin_amdgcn_exp2f(p0[r]);
}
__device__ __forceinline__ void finishSM(f32x16& p0, f32x16& p1, float alpha, float& l_reg, bf16x8& pa0, bf16x8& pa1, bf16x8& pa2, bf16x8& pa3) {
  for (int r = 0; r < 16; ++r) p1[r] = __builtin_amdgcn_exp2f(p1[r]);
  float ps = 0; for (int r = 0; r < 16; ++r) ps += p0[r]; for (int r = 0; r < 16; ++r) ps += p1[r];
  { auto rr = __builtin_amdgcn_permlane32_swap(__float_as_uint(ps), __float_as_uint(ps), false, false);
    ps = __uint_as_float(rr[0]) + __uint_as_float(rr[1]); }
  l_reg = l_reg * alpha + ps;
#define PK4(P, BASE, OUT) do { unsigned a0 = cvtpk(P[BASE + 0], P[BASE + 1]), a1 = cvtpk(P[BASE + 2], P[BASE + 3]);   \
    unsigned b0 = cvtpk(P[BASE + 4], P[BASE + 5]), b1 = cvtpk(P[BASE + 6], P[BASE + 7]);                              \
    auto r0 = __builtin_amdgcn_permlane32_swap(a0, b0, false, false); auto r1 = __builtin_amdgcn_permlane32_swap(a1, b1, false, false); \
    u32x4 w = {r0[0], r1[0], r0[1], r1[1]}; OUT = *reinterpret_cast<bf16x8*>(&w); } while (0)
  PK4(p0, 0, pa0); PK4(p0, 8, pa1); PK4(p1, 0, pa2); PK4(p1, 8, pa3);
#undef PK4
}
__device__ __forceinline__ void qkt(f32x16& p0, f32x16& p1, const bf16* Ks, const bf16x8* qr, int r32, int hi) {
  p0 = f32x16{}; p1 = f32x16{};
  for (int d0 = 0; d0 < 8; ++d0) { int cb = (d0 * 16 + hi * 8) * 2;
    bf16x8 b0 = *reinterpret_cast<const bf16x8*>((const char*)Ks + KSWZ(r32, cb));
    bf16x8 b1 = *reinterpret_cast<const bf16x8*>((const char*)Ks + KSWZ(32 + r32, cb));
    p0 = __builtin_amdgcn_mfma_f32_32x32x16_bf16(b0, qr[d0], p0, 0, 0, 0);
    p1 = __builtin_amdgcn_mfma_f32_32x32x16_bf16(b1, qr[d0], p1, 0, 0, 0); }
}
__device__ __forceinline__ int v_st(int k, int c) { const int kk = (k & ~0xC) | ((k & 4) << 1) | ((k & 8) >> 1); return ((kk >> 3) * 4 + (c >> 5)) * 512 + ((kk & 7) * 32 + (c & 31)) * 2; }
__device__ __forceinline__ int v_rd_base(int lane) { return ((lane & 3) << 3) | (((lane >> 2) & 3) << 6) | (((lane >> 4) & 1) << 5) | (((lane >> 5) & 1) << 8); }
constexpr int v_rd_off(int d0, int ks, int half) { return d0 * 512 + ks * 4096 + half * 2048; }
template <int OFF> __device__ __forceinline__ s16x4 tr_read(int vb) {
  s16x4 r; asm volatile("ds_read_b64_tr_b16 %0, %1 offset:%2" : "=&v"(r) : "v"(vb), "i"(OFF) : "memory"); return r;
}
template <int D0> __device__ __forceinline__ void pv_one(f32x16& od, int vb, bf16x8 pa0, bf16x8 pa1, bf16x8 pa2, bf16x8 pa3) {
  const s16x4 l0 = tr_read<v_rd_off(D0, 0, 0)>(vb), h0 = tr_read<v_rd_off(D0, 0, 1)>(vb), l1 = tr_read<v_rd_off(D0, 1, 0)>(vb), h1 = tr_read<v_rd_off(D0, 1, 1)>(vb);
  const s16x4 l2 = tr_read<v_rd_off(D0, 2, 0)>(vb), h2 = tr_read<v_rd_off(D0, 2, 1)>(vb), l3 = tr_read<v_rd_off(D0, 3, 0)>(vb), h3 = tr_read<v_rd_off(D0, 3, 1)>(vb);
  asm volatile("s_waitcnt lgkmcnt(0)" ::: "memory"); SBAR();
#define PK(L, H) (bf16x8){L[0], L[1], L[2], L[3], H[0], H[1], H[2], H[3]}
  od = __builtin_amdgcn_mfma_f32_32x32x16_bf16(pa0, PK(l0, h0), od, 0, 0, 0);
  od = __builtin_amdgcn_mfma_f32_32x32x16_bf16(pa1, PK(l1, h1), od, 0, 0, 0);
  od = __builtin_amdgcn_mfma_f32_32x32x16_bf16(pa2, PK(l2, h2), od, 0, 0, 0);
  od = __builtin_amdgcn_mfma_f32_32x32x16_bf16(pa3, PK(l3, h3), od, 0, 0, 0);
#undef PK
}
__device__ __forceinline__ void pv_d0(f32x16* o, int vb, bf16x8 pa0, bf16x8 pa1, bf16x8 pa2, bf16x8 pa3) {
  pv_one<0>(o[0], vb, pa0, pa1, pa2, pa3); pv_one<1>(o[1], vb, pa0, pa1, pa2, pa3); pv_one<2>(o[2], vb, pa0, pa1, pa2, pa3); pv_one<3>(o[3], vb, pa0, pa1, pa2, pa3);
}
__device__ __forceinline__ void pv_psm(f32x16* o, int vb, bf16x8 pa0, bf16x8 pa1, bf16x8 pa2, bf16x8 pa3, f32x16& q0, f32x16& q1, float& m_reg, float& mn, float& alpha) {
  pv_one<0>(o[0], vb, pa0, pa1, pa2, pa3); float pmax = psm_max(q0, q1); asm volatile("" : "+v"(pmax));
  pv_one<1>(o[1], vb, pa0, pa1, pa2, pa3); psm_scale(q0, q1, pmax, m_reg, mn, alpha); asm volatile("" : "+v"(q0), "+v"(q1));
  pv_one<2>(o[2], vb, pa0, pa1, pa2, pa3); psm_exp8<0>(q0); asm volatile("" : "+v"(q0));
  pv_one<3>(o[3], vb, pa0, pa1, pa2, pa3); psm_exp8<8>(q0); asm volatile("" : "+v"(q0)); SBAR();
}

constexpr int EPI_PITCH = 528, EPI_BYTES = 32 * EPI_PITCH;
template <int QS>
__device__ __forceinline__ void epi_stage_store(const f32x16 (&o)[4], const float (&rli)[16], __attribute__((address_space(3))) unsigned char* st,
                                                const bf16* __restrict__ gbase, bf16* __restrict__ obase, int lane) {
  typedef float f32x4_t __attribute__((ext_vector_type(4)));
  asm volatile("" : "+v"(lane));
  const int r32 = lane & 31, hi = lane >> 5;
  const int rr = lane >> 4, c16 = lane & 15;
  u32x4 g[8];
#pragma unroll
  for (int i = 0; i < 8; ++i) g[i] = *reinterpret_cast<const u32x4*>(gbase + (size_t)(QS * (rr + 4 * i)) * LDQ + c16 * 8);
#pragma unroll
  for (int r = 0; r < 16; ++r) { const int row = crow(r, hi);
#pragma unroll
    for (int d0 = 0; d0 < 4; ++d0) *reinterpret_cast<__attribute__((address_space(3))) float*>(st + row * EPI_PITCH + (d0 * 32 + r32) * 4) = o[d0][r] * rli[r]; }
#pragma unroll
  for (int i = 0; i < 8; ++i) { const int row = rr + 4 * i;
    const f32x4_t a = *reinterpret_cast<const __attribute__((address_space(3))) f32x4_t*>(st + row * EPI_PITCH + c16 * 32);
    const f32x4_t b = *reinterpret_cast<const __attribute__((address_space(3))) f32x4_t*>(st + row * EPI_PITCH + c16 * 32 + 16);
    float v[8] = {a[0], a[1], a[2], a[3], b[0], b[1], b[2], b[3]};
#pragma unroll
    for (int e = 0; e < 4; ++e) { const float g0 = __uint_as_float(g[i][e] << 16), g1 = __uint_as_float(g[i][e] & 0xffff0000u);
      v[2 * e] *= g0 * __builtin_amdgcn_rcpf(1.f + __expf(-g0)); v[2 * e + 1] *= g1 * __builtin_amdgcn_rcpf(1.f + __expf(-g1)); }
    u32x4 w = {cvtpk(v[0], v[1]), cvtpk(v[2], v[3]), cvtpk(v[4], v[5]), cvtpk(v[6], v[7])};
    *reinterpret_cast<u32x4*>(obase + (size_t)(QS * row) * LDO + c16 * 8) = w; }
}

__device__ __forceinline__ void attn_dense_body(const bf16* __restrict__ Qb, const bf16* __restrict__ Kh, const bf16* __restrict__ Vh,
                                                const bf16* __restrict__ Gb, bf16* __restrict__ Ob, int seq, char* lds, const int wid) {
  using St = StageB;
  int lane_l; asm volatile("v_mbcnt_lo_u32_b32 %0, -1, 0\n\tv_mbcnt_hi_u32_b32 %0, -1, %0" : "=v"(lane_l));
  const int lane = lane_l, tid = wid * 64 + lane, r32 = lane & 31, hi = lane >> 5;
  bf16* V_lds = (bf16*)lds; bf16* K_lds = (bf16*)(lds + 2 * SHM_V);
  float* ws = (float*)(lds + 2 * SHM_V + 2 * SHM_K) + wid * 64; float* li_l = ws; float* al_l = ws + 32;
  float m_reg = -1e30f, l_reg = 0; f32x16 o[4] = {}; bf16x8 qr[8];
  const bf16* Qw = Qb + (long)(wid * QBLK + r32) * LDQ + hi * 8;
#pragma unroll
  for (int d0 = 0; d0 < 8; ++d0) qr[d0] = St::ld8(Qw + d0 * 16);
  const int sr = tid >> 4, sc = (tid & 15) * 8, vst0 = v_st(sr, sc), vst1 = v_st(32 + sr, sc);
  const int vb0 = (int)(uintptr_t)V_lds + v_rd_base(lane);
  struct { typename St::T vs0, vs1, ks0, ks1; } sr_[SDEPTH];
#define SLOAD(i, k0) do { sr_[i].vs0 = St::ld8(&Vh[(long)((k0) + sr) * LDK + sc]); sr_[i].vs1 = St::ld8(&Vh[(long)((k0) + 32 + sr) * LDK + sc]); \
    sr_[i].ks0 = St::ld8(&Kh[(long)((k0) + sr) * LDK + sc]); sr_[i].ks1 = St::ld8(&Kh[(long)((k0) + 32 + sr) * LDK + sc]); } while (0)
#define SWRITE(b, i) do { *(bf16x8*)((char*)V_lds + (b) * SHM_V + vst0) = St::tobf(sr_[i].vs0);          \
    *(bf16x8*)((char*)V_lds + (b) * SHM_V + vst1) = St::tobf(sr_[i].vs1); int kc = sc * 2;               \
    *(bf16x8*)((char*)K_lds + (b) * SHM_K + KSWZ(sr, kc)) = St::tobf(sr_[i].ks0);                       \
    *(bf16x8*)((char*)K_lds + (b) * SHM_K + KSWZ(32 + sr, kc)) = St::tobf(sr_[i].ks1); } while (0)
#define SWAIT() do { if constexpr (SDEPTH == 2) asm volatile("s_waitcnt vmcnt(4)" ::: "memory"); else asm volatile("s_waitcnt vmcnt(0)" ::: "memory"); } while (0)
#define RESC(a) do { if (__any((a) < 1.f)) { if (hi == 0) al_l[r32] = (a); asm volatile("s_waitcnt lgkmcnt(0)" ::: "memory"); \
    for (int d = 0; d < 4; ++d) for (int r = 0; r < 16; ++r) o[d][r] *= al_l[crow(r, hi)]; } } while (0)
  f32x16 pA0, pA1, pB0, pB1; float mnA, mnB, alA, alB; bf16x8 pa0, pa1, pa2, pa3; const int NT = seq / KVBLK;
#ifdef ATT_PRIO
  if (wid >= 4) __builtin_amdgcn_s_setprio(1);
#endif
  constexpr int SE = 0, SO = SDEPTH - 1;
  SLOAD(SE, 0); asm volatile("s_waitcnt vmcnt(0)" ::: "memory"); SWRITE(0, SE); __syncthreads();
  qkt(pA0, pA1, K_lds, qr, r32, hi); partialSM(pA0, pA1, m_reg, mnA, alA);
  SLOAD(SO, KVBLK); if constexpr (SDEPTH == 2) { if (2 < NT) SLOAD(SE, 2 * KVBLK); }
  SWAIT(); SWRITE(1, SO); __syncthreads();
  for (int j = 1; j + 1 < NT; j += 2) {
    SBAR(); qkt(pB0, pB1, (bf16*)((char*)K_lds + SHM_K), qr, r32, hi);
    finishSM(pA0, pA1, alA, l_reg, pa0, pa1, pa2, pa3); SBAR();
    SLOAD(SO, (j + SDEPTH) * KVBLK); SBAR();
    pv_psm(o, vb0, pa0, pa1, pa2, pa3, pB0, pB1, m_reg, mnB, alB);
    __syncthreads(); SWAIT(); SWRITE(0, SE);
    RESC(alB); __syncthreads();
    SBAR(); qkt(pA0, pA1, K_lds, qr, r32, hi);
    finishSM(pB0, pB1, alB, l_reg, pa0, pa1, pa2, pa3); SBAR();
    if (SDEPTH == 1 || j + 3 < NT) SLOAD(SE, (j + 1 + SDEPTH) * KVBLK); SBAR();
    pv_psm(o, vb0 + (int)SHM_V, pa0, pa1, pa2, pa3, pA0, pA1, m_reg, mnA, alA);
    __syncthreads(); SWAIT(); SWRITE(1, SO);
    RESC(alA); __syncthreads();
  }
  SBAR(); qkt(pB0, pB1, (bf16*)((char*)K_lds + SHM_K), qr, r32, hi);
  finishSM(pA0, pA1, alA, l_reg, pa0, pa1, pa2, pa3); SBAR();
  pv_psm(o, vb0, pa0, pa1, pa2, pa3, pB0, pB1, m_reg, mnB, alB);
  __syncthreads(); RESC(alB);
  finishSM(pB0, pB1, alB, l_reg, pa0, pa1, pa2, pa3); SBAR();
  pv_d0(o, vb0 + (int)SHM_V, pa0, pa1, pa2, pa3);
  if (hi == 0) li_l[r32] = l_reg; asm volatile("s_waitcnt lgkmcnt(0)" ::: "memory");
  float rli[16];
#pragma unroll
  for (int r = 0; r < 16; ++r) rli[r] = __builtin_amdgcn_rcpf(li_l[crow(r, hi)]);
#ifdef ATT_PRIO
  __builtin_amdgcn_s_setprio(0);
#endif
  __syncthreads();
  epi_stage_store<1>(o, rli, (__attribute__((address_space(3))) unsigned char*)(uintptr_t)(unsigned)(uintptr_t)lds + wid * EPI_BYTES, Gb + (long)(wid * QBLK) * LDQ, Ob + (long)(wid * QBLK) * LDO, lane);
  __syncthreads();
#undef SLOAD
#undef SWRITE
#undef SWAIT
#undef RESC
}
typedef int i32x8 __attribute__((ext_vector_type(8)));
typedef int i32x4 __attribute__((ext_vector_type(4)));
constexpr int KP8 = 144, VP8 = 80;
constexpr size_t SHM_K8 = 64 * KP8, SHM_V8 = 128 * VP8;
constexpr float THR8 = 3.72f, PSH8 = 5.f;
constexpr float Q8_PRESCALE = SCALE * 1.4426950408889634f * 8.f;
constexpr int LDQ8 = C_H * HD, LDK8 = 4 * HD;
#define MFMA8(A, B, Cc) __builtin_amdgcn_mfma_scale_f32_32x32x64_f8f6f4(A, B, Cc, 0, 0, 0, 0x7f7f7f7f, 0, 0x7f7f7f7f)
#define MFMA8Q(A, B, Cc) __builtin_amdgcn_mfma_scale_f32_32x32x64_f8f6f4(A, B, Cc, 0, 0, 0, 0x7f7f7f7f, 0, 0x7c7c7c7c)
typedef __attribute__((address_space(3))) const unsigned char* lcp8;
__device__ __forceinline__ i32x8 lds32(lcp8 p) {
  const i32x4 a = *reinterpret_cast<const __attribute__((address_space(3))) i32x4*>(p), b = *reinterpret_cast<const __attribute__((address_space(3))) i32x4*>(p + 16);
  return (i32x8){a[0], a[1], a[2], a[3], b[0], b[1], b[2], b[3]};
}
__device__ __forceinline__ void qkt8(f32x16& p0, f32x16& p1, lcp8 kb, const i32x8* qf, const f32x16& minit) {
  p0 = MFMA8Q(lds32(kb), qf[0], minit); p0 = MFMA8Q(lds32(kb + 64), qf[1], p0);
  p1 = MFMA8Q(lds32(kb + 32 * KP8), qf[0], minit); p1 = MFMA8Q(lds32(kb + 32 * KP8 + 64), qf[1], p1);
}
template <bool FIRST>
__device__ __forceinline__ void psm_fix8(f32x16& p0, f32x16& p1, float pmax, f32x16& minit, float& alpha) {
  alpha = 1.f;
  if (FIRST || !__all(pmax <= PSH8 + THR8)) {
    const float delta = FIRST ? pmax - PSH8 : fmaxf(pmax - PSH8, 0.f);
    if (!FIRST) alpha = __builtin_amdgcn_exp2f(-delta);
#pragma unroll
    for (int r = 0; r < 16; ++r) { p0[r] -= delta; p1[r] -= delta; minit[r] -= delta; }
  }
}
__device__ __forceinline__ void finishSM8(f32x16& p0, f32x16& p1, i32x8& pa) {
#pragma unroll
  for (int r = 0; r < 16; ++r) p1[r] = __builtin_amdgcn_exp2f(p1[r]);
  int und; asm volatile("" : "=v"(und));
#pragma unroll
  for (int w = 0; w < 4; ++w) { int t = __builtin_amdgcn_cvt_pk_fp8_f32(p0[4 * w], p0[4 * w + 1], und, false); pa[w] = __builtin_amdgcn_cvt_pk_fp8_f32(p0[4 * w + 2], p0[4 * w + 3], t, true);
                                int u = __builtin_amdgcn_cvt_pk_fp8_f32(p1[4 * w], p1[4 * w + 1], und, false); pa[4 + w] = __builtin_amdgcn_cvt_pk_fp8_f32(p1[4 * w + 2], p1[4 * w + 3], u, true); }
}
template <int LO> __device__ __forceinline__ void exp4(f32x16& p) {
#pragma unroll
  for (int r = LO; r < LO + 4; ++r) p[r] = __builtin_amdgcn_exp2f(p[r]);
}
template <int W> __device__ __forceinline__ void cvt8(const f32x16& p, int& d0, int& d1, int und) {
  int t = __builtin_amdgcn_cvt_pk_fp8_f32(p[8 * W], p[8 * W + 1], und, false); d0 = __builtin_amdgcn_cvt_pk_fp8_f32(p[8 * W + 2], p[8 * W + 3], t, true);
  int u = __builtin_amdgcn_cvt_pk_fp8_f32(p[8 * W + 4], p[8 * W + 5], und, false); d1 = __builtin_amdgcn_cvt_pk_fp8_f32(p[8 * W + 6], p[8 * W + 7], u, true);
}
__device__ __forceinline__ void qkt_fsm8(f32x16& n0, f32x16& n1, lcp8 kb, const i32x8* qf, const f32x16& minit, const f32x16& p0, f32x16& p1, i32x8& pa) {
  int und; asm volatile("" : "=v"(und));
  int a0, a1, a2, a3, a4, a5, a6, a7;
  const i32x8 k00 = lds32(kb), k10 = lds32(kb + 32 * KP8);
  cvt8<0>(p0, a0, a1, und); exp4<0>(p1); asm volatile("" : "+v"(p1), "+v"(a0), "+v"(a1)); SBAR();
  n0 = MFMA8Q(k00, qf[0], minit); const i32x8 k01 = lds32(kb + 64);
  cvt8<1>(p0, a2, a3, und); exp4<4>(p1); asm volatile("" : "+v"(p1), "+v"(a2), "+v"(a3)); SBAR();
  n1 = MFMA8Q(k10, qf[0], minit); const i32x8 k11 = lds32(kb + 32 * KP8 + 64);
  exp4<8>(p1); cvt8<0>(p1, a4, a5, und); asm volatile("" : "+v"(p1), "+v"(a4), "+v"(a5)); SBAR();
  n0 = MFMA8Q(k01, qf[1], n0);
  exp4<12>(p1); asm volatile("" : "+v"(p1)); SBAR();
  n1 = MFMA8Q(k11, qf[1], n1);
  cvt8<1>(p1, a6, a7, und); asm volatile("" : "+v"(a6), "+v"(a7)); SBAR();
  pa = (i32x8){a0, a1, a2, a3, a4, a5, a6, a7};
}
__device__ __forceinline__ void pv_psm8(f32x16* o, f32x16& ol, const i32x8 ones, lcp8 vb, const i32x8 pa, f32x16& q0, f32x16& q1, f32x16& minit, float& alpha) {
  o[0] = MFMA8(pa, lds32(vb), o[0]); float pmax = psm_max(q0, q1); asm volatile("" : "+v"(pmax));
  o[1] = MFMA8(pa, lds32(vb + 32 * VP8), o[1]); psm_fix8<false>(q0, q1, pmax, minit, alpha); asm volatile("" : "+v"(q0), "+v"(q1));
  o[2] = MFMA8(pa, lds32(vb + 64 * VP8), o[2]); psm_exp8<0>(q0); asm volatile("" : "+v"(q0));
  o[3] = MFMA8(pa, lds32(vb + 96 * VP8), o[3]); psm_exp8<8>(q0); asm volatile("" : "+v"(q0));
  ol = MFMA8(pa, ones, ol);
  SBAR();
}
__device__ __forceinline__ void pv8(f32x16* o, f32x16& ol, const i32x8 ones, lcp8 vb, const i32x8 pa) {
  o[0] = MFMA8(pa, lds32(vb), o[0]); o[1] = MFMA8(pa, lds32(vb + 32 * VP8), o[1]); o[2] = MFMA8(pa, lds32(vb + 64 * VP8), o[2]); o[3] = MFMA8(pa, lds32(vb + 96 * VP8), o[3]); ol = MFMA8(pa, ones, ol);
}
__device__ __forceinline__ void attn_f8_body(const unsigned char* __restrict__ Qb, const unsigned char* __restrict__ Kh, const unsigned char* __restrict__ Vt,
                                             const bf16* __restrict__ Gb, bf16* __restrict__ Ob, int seq, char* lds, const int wid) {
  int lane_l; asm volatile("v_mbcnt_lo_u32_b32 %0, -1, 0\n\tv_mbcnt_hi_u32_b32 %0, -1, %0" : "=v"(lane_l));
  const int lane = lane_l, tid = wid * 64 + lane, r32 = lane & 31, hi = lane >> 5;
  typedef __attribute__((address_space(3))) unsigned char* lp8;
  const lp8 V_lds = (lp8)(uintptr_t)(unsigned)(uintptr_t)lds; const lp8 K_lds = V_lds + 2 * SHM_V8;
  float* al_l = (float*)(lds + 2 * SHM_V8 + 2 * SHM_K8) + wid * 32;
  f32x16 o[4] = {}, ol = {}; i32x8 qf[2], ones; f32x16 minit;
#pragma unroll
  for (int r = 0; r < 8; ++r) ones[r] = 0x38383838;
#pragma unroll
  for (int r = 0; r < 16; ++r) minit[r] = PSH8;
  { const unsigned char* Qw = Qb + (long)(wid * QBLK + r32) * LDQ8 + hi * 32;
#pragma unroll
    for (int s = 0; s < 2; ++s) { const i32x4 a = *reinterpret_cast<const i32x4*>(Qw + 64 * s), b = *reinterpret_cast<const i32x4*>(Qw + 64 * s + 16); qf[s] = (i32x8){a[0], a[1], a[2], a[3], b[0], b[1], b[2], b[3]}; } }
  const int kr = tid >> 3, kc = (tid & 7) * 16, vd = tid >> 2, vc = (tid & 3) * 16;
  const int kst = kr * KP8 + kc, vst = vd * VP8 + vc;
  const lcp8 kb0 = K_lds + r32 * KP8 + hi * 32, vb0 = V_lds + r32 * VP8 + hi * 32;
  struct { i32x4 k, v; } sr_[2];
#define SLOAD8(i, k0) do { sr_[i].k = *reinterpret_cast<const i32x4*>(Kh + (long)((k0) + kr) * LDK8 + kc); sr_[i].v = *reinterpret_cast<const i32x4*>(Vt + (long)(k0) * HD + tid * 16); } while (0)
#define SWRITE8(b, i) do { *reinterpret_cast<__attribute__((address_space(3))) i32x4*>(K_lds + (b) * SHM_K8 + kst) = sr_[i].k; *reinterpret_cast<__attribute__((address_space(3))) i32x4*>(V_lds + (b) * SHM_V8 + vst) = sr_[i].v; } while (0)
#define SWAIT8() asm volatile("s_waitcnt vmcnt(2)" ::: "memory")
#define RESC8(a) do { if (__any((a) < 1.f)) { if (hi == 0) al_l[r32] = (a); asm volatile("s_waitcnt lgkmcnt(0)" ::: "memory"); \
    for (int r = 0; r < 16; ++r) { const float a_ = al_l[crow(r, hi)]; o[0][r] *= a_; o[1][r] *= a_; o[2][r] *= a_; o[3][r] *= a_; ol[r] *= a_; } } } while (0)
  f32x16 pA0, pA1, pB0, pB1; float alA, alB; i32x8 pa; const int NT = seq / KVBLK;
  constexpr int SE = 0, SO = 1;
  SLOAD8(SE, 0); asm volatile("s_waitcnt vmcnt(0)" ::: "memory"); SWRITE8(0, SE); __syncthreads();
  qkt8(pA0, pA1, kb0, qf, minit);
  { const float pmax = psm_max(pA0, pA1); psm_fix8<true>(pA0, pA1, pmax, minit, alA); psm_exp8<0>(pA0); psm_exp8<8>(pA0); }
  SLOAD8(SO, KVBLK); if (2 < NT) SLOAD8(SE, 2 * KVBLK);
  SWAIT8(); SWRITE8(1, SO); __syncthreads();
  for (int j = 1; j + 1 < NT; j += 2) {
    SBAR(); qkt_fsm8(pB0, pB1, kb0 + SHM_K8, qf, minit, pA0, pA1, pa);
    SLOAD8(SO, (j + 2) * KVBLK); SBAR();
    pv_psm8(o, ol, ones, vb0, pa, pB0, pB1, minit, alB);
    __syncthreads(); SWAIT8(); SWRITE8(0, SE);
    RESC8(alB); __syncthreads();
    SBAR(); qkt_fsm8(pA0, pA1, kb0, qf, minit, pB0, pB1, pa);
    SLOAD8(SE, (j + 3 < NT ? j + 3 : NT - 1) * KVBLK); SBAR();
    pv_psm8(o, ol, ones, vb0 + SHM_V8, pa, pA0, pA1, minit, alA);
    __syncthreads(); SWAIT8(); SWRITE8(1, SO);
    RESC8(alA); __syncthreads();
  }
  SBAR(); qkt_fsm8(pB0, pB1, kb0 + SHM_K8, qf, minit, pA0, pA1, pa);
  pv_psm8(o, ol, ones, vb0, pa, pB0, pB1, minit, alB);
  __syncthreads(); RESC8(alB);
  finishSM8(pB0, pB1, pa); SBAR();
  pv8(o, ol, ones, vb0 + SHM_V8, pa);
  float rli[16];
#pragma unroll
  for (int r = 0; r < 16; ++r) rli[r] = __builtin_amdgcn_rcpf(ol[r]);
  __syncthreads();
  epi_stage_store<1>(o, rli, (__attribute__((address_space(3))) unsigned char*)(uintptr_t)(unsigned)(uintptr_t)lds + wid * EPI_BYTES, Gb + (long)(wid * QBLK) * LDQ, Ob + (long)(wid * QBLK) * LDO, lane);
  __syncthreads();
#undef SLOAD8
#undef SWRITE8
#undef SWAIT8
#undef RESC8
}
#ifdef QK_FP4
constexpr int PP_KIMG = 4096, PP_TIMG = PP_KIMG + 8192, PP_KR = 0, PP_VR = 3 * PP_KIMG, PP_AL = PP_VR + 3 * 8192;
constexpr int LDQ4 = C_H * 64;
constexpr float Q4_PRESCALE = SCALE * 1.4426950408889634f * 16.f / 1.5f, K4_PRESCALE = 1.5f;
#define MFMA4Q(A, B, Cc) __builtin_amdgcn_mfma_scale_f32_32x32x64_f8f6f4(A, B, Cc, 4, 4, 0, 0x7f7f7f7f, 0, 0x7b7b7b7b)
__device__ __forceinline__ i32x8 lds1(int a0, int off) {
  const i32x4 a = *(const __attribute__((address_space(3))) i32x4*)(uintptr_t)(unsigned)(a0 + off);
  return (i32x8){a[0], a[1], a[2], a[3], 0, 0, 0, 0};
}
#else
constexpr int PP_KIMG = 8192, PP_TIMG = 16384, PP_KR = 0, PP_VR = 3 * 8192, PP_AL = 6 * 8192;
#endif
typedef __attribute__((address_space(3))) const i32x4* lq4;
__device__ __forceinline__ i32x8 lds2(int a0, int a1, int off) {
  const i32x4 a = *(lq4)(uintptr_t)(unsigned)(a0 + off), b = *(lq4)(uintptr_t)(unsigned)(a1 + off);
  return (i32x8){a[0], a[1], a[2], a[3], b[0], b[1], b[2], b[3]};
}
#ifndef PP_PADN
#define PP_PADN 7
#endif
#define PP_STR2(x) #x
#define PP_STR(x) PP_STR2(x)
#define PP_PAD() do { SBAR(); asm volatile("s_nop " PP_STR(PP_PADN)); SBAR(); } while (0)
#ifndef PP_PADQN
#define PP_PADQN 7
#endif
#define PP_PADQ() do { SBAR(); asm volatile("s_nop " PP_STR(PP_PADQN)); SBAR(); } while (0)
template <bool QK, bool PV>
__device__ __forceinline__ void pp_mseg(f32x16* o, f32x16& ol, f32x16& n0, f32x16& n1, const i32x8 pa, const i32x8 ones, const i32x8* qf, const f32x16& minit, const i32x8 vf0, const i32x8 vf1,
                                        const int k0, const int k1, const int k2, const int k3, const int v0, const int v1) {
  i32x8 k00, k10, k01, k11, vf2, vf3;
#ifdef QK_FP4
  if (QK) { k00 = lds1(k0, 0); k10 = lds1(k0, 2048); }
#else
  if (QK) { k00 = lds2(k0, k1, 0); k10 = lds2(k0, k1, 4096); }
#endif
  if (PV) { o[0] = MFMA8(pa, vf0, o[0]); vf2 = lds2(v0, v1, 4096); PP_PAD(); }
#ifdef QK_FP4
  if (QK) { k01 = lds1(k1, 0); }
#else
  if (QK) { k01 = lds2(k2, k3, 0); }
#endif
  if (PV) { o[1] = MFMA8(pa, vf1, o[1]); vf3 = lds2(v0, v1, 6144); PP_PAD(); }
#ifdef QK_FP4
  if (QK) { k11 = lds1(k1, 2048);
            n0 = MFMA4Q(k00, qf[0], minit); PP_PADQ(); n1 = MFMA4Q(k10, qf[0], minit); PP_PADQ(); n0 = MFMA4Q(k01, qf[1], n0); PP_PADQ(); n1 = MFMA4Q(k11, qf[1], n1); PP_PADQ(); }
#else
  if (QK) { k11 = lds2(k2, k3, 4096);
            n0 = MFMA8Q(k00, qf[0], minit); PP_PAD(); n1 = MFMA8Q(k10, qf[0], minit); PP_PAD(); n0 = MFMA8Q(k01, qf[1], n0); PP_PAD(); n1 = MFMA8Q(k11, qf[1], n1); PP_PAD(); }
#endif
  if (PV) { o[2] = MFMA8(pa, vf2, o[2]); PP_PAD(); o[3] = MFMA8(pa, vf3, o[3]); PP_PAD(); ol = MFMA8(pa, ones, ol); }
}
template <bool FIRST>
__device__ __forceinline__ void pp_vseg(f32x16* o, f32x16& ol, f32x16& n0, f32x16& n1, f32x16& minit, i32x8& pa, float* al_l, const int r32, const int hi) {
  asm volatile("" : "+v"(n0), "+v"(n1));
  const float pmax = psm_max(n0, n1);
  if (FIRST || !__all(pmax <= PSH8 + THR8)) {
    const float delta = FIRST ? pmax - PSH8 : fmaxf(pmax - PSH8, 0.f);
#pragma unroll
    for (int r = 0; r < 16; ++r) { n0[r] -= delta; n1[r] -= delta; minit[r] -= delta; }
    if (!FIRST) {
      const float alpha = __builtin_amdgcn_exp2f(-delta);
      if (hi == 0) al_l[r32] = alpha;
      asm volatile("s_waitcnt lgkmcnt(0)" ::: "memory");
#pragma unroll
      for (int r = 0; r < 16; ++r) { const float a_ = al_l[crow(r, hi)]; o[0][r] *= a_; o[1][r] *= a_; o[2][r] *= a_; o[3][r] *= a_; ol[r] *= a_; }
    }
  }
#pragma unroll
  for (int r = 0; r < 16; ++r) n0[r] = __builtin_amdgcn_exp2f(n0[r]);
#pragma unroll
  for (int r = 0; r < 16; ++r) n1[r] = __builtin_amdgcn_exp2f(n1[r]);
#pragma unroll
  for (int w = 0; w < 4; ++w) { int t0_, t1_; asm volatile("" : "=v"(t0_), "=v"(t1_));
    t0_ = __builtin_amdgcn_cvt_pk_fp8_f32(n0[4 * w], n0[4 * w + 1], t0_, false); pa[w] = __builtin_amdgcn_cvt_pk_fp8_f32(n0[4 * w + 2], n0[4 * w + 3], t0_, true);
    t1_ = __builtin_amdgcn_cvt_pk_fp8_f32(n1[4 * w], n1[4 * w + 1], t1_, false); pa[4 + w] = __builtin_amdgcn_cvt_pk_fp8_f32(n1[4 * w + 2], n1[4 * w + 3], t1_, true); }
  asm volatile("" : "+v"(pa));
}
__device__ __forceinline__ void attn_f8pp_body(const unsigned char* __restrict__ Qb, const unsigned char* __restrict__ KV, const bf16* __restrict__ Gb, bf16* __restrict__ Ob, int seq, char* lds, const int wid) {
  int lane_l; asm volatile("v_mbcnt_lo_u32_b32 %0, -1, 0\n\tv_mbcnt_hi_u32_b32 %0, -1, %0" : "=v"(lane_l));
  const int lane = lane_l, r32 = lane & 31, hi = lane >> 5;
  const int ldsb = (int)(unsigned)(uintptr_t)lds;
  float* al_l = (float*)(lds + PP_AL) + wid * 32;
  int grp, w4;
  { int* sid = (int*)(lds + PP_AL + 1024);
    const int mine = (int)__builtin_amdgcn_s_getreg(2308);
    if (lane == 0) sid[wid] = mine;
    __syncthreads();
    int g[8], n0c = 0;
#pragma unroll
    for (int u = 0; u < 8; ++u) { const int su = __builtin_amdgcn_readfirstlane(sid[u]); int c = 0;
#pragma unroll
      for (int t = 0; t < 8; ++t) if (t < u) c += (__builtin_amdgcn_readfirstlane(sid[t]) == su) ? 1 : 0;
      g[u] = c; n0c += (c == 0) ? 1 : 0; }
    bool ok = (n0c == 4);
#pragma unroll
    for (int u = 0; u < 8; ++u) ok = ok && (g[u] <= 1);
    int gm = 0, rk = 0;
#pragma unroll
    for (int u = 0; u < 8; ++u) { if (u == wid) gm = g[u]; }
#pragma unroll
    for (int u = 0; u < 8; ++u) { if (u < wid && g[u] == gm) ++rk; }
    grp = ok ? gm : (wid >> 2); w4 = ok ? rk : (wid & 3);
    grp = __builtin_amdgcn_readfirstlane(grp); w4 = __builtin_amdgcn_readfirstlane(w4);
    __syncthreads(); }
  f32x16 o[4] = {}, ol = {}, minit, n0, n1; i32x8 qf[2], ones, pa, vf0, vf1;
#pragma unroll
  for (int r = 0; r < 16; ++r) minit[r] = PSH8;
  { int one4 = 0x38383838; asm volatile("" : "+v"(one4));
#pragma unroll
    for (int r = 0; r < 8; ++r) ones[r] = one4; }
#pragma unroll
  for (int r = 0; r < 8; ++r) { pa[r] = 0; vf0[r] = 0; vf1[r] = 0; }
  asm volatile("" : "+v"(ones));
#ifdef QK_FP4
  const int vg = (r32 >> 2) & 3, ka = r32 * 64 + ((hi ^ vg) << 4), ka1 = ka ^ 32, ka2 = 0, ka3 = 0, va = r32 * 64 + (((2 * hi) ^ vg) << 4), va1 = va ^ 16;
#else
  const int kf = (r32 >> 1) & 7, ka = r32 * 128 + (((2 * hi) ^ kf) << 4), vg = (r32 >> 2) & 3, va = r32 * 64 + (((2 * hi) ^ vg) << 4);
  const int ka1 = ka ^ 16, ka2 = ka ^ 64, ka3 = ka ^ 80, va1 = va ^ 16;
#endif
  const int kbase = ldsb + PP_KR, vbase = ldsb + PP_VR;
#ifdef QK_FP4
  const unsigned char* gsrc = KV + (grp ? PP_KIMG + 2 * w4 * 1024 : w4 * 1024) + lane * 16;
  const int ldst = ldsb + (grp ? PP_VR + 2 * w4 * 1024 : PP_KR + w4 * 1024);
#define PP_DMA(tile, slot) do { const unsigned char* g_ = gsrc + (long)(tile) * PP_TIMG; const int d_ = ldst + (slot) * (grp ? 8192 : PP_KIMG); \
    __builtin_amdgcn_global_load_lds((const unsigned*)g_, (__attribute__((address_space(3))) unsigned*)(uintptr_t)(unsigned)d_, 16, 0, 0); \
    if (grp) __builtin_amdgcn_global_load_lds((const unsigned*)(g_ + 1024), (__attribute__((address_space(3))) unsigned*)(uintptr_t)(unsigned)(d_ + 1024), 16, 0, 0); } while (0)
#else
  const unsigned char* gsrc = KV + (grp * 8 + 2 * w4) * 1024 + lane * 16;
  const int ldst = ldsb + (grp ? PP_VR : PP_KR) + 2 * w4 * 1024;
#define PP_DMA(tile, slot) do { const unsigned char* g_ = gsrc + (long)(tile) * PP_TIMG; const int d_ = ldst + (slot) * 8192; \
    __builtin_amdgcn_global_load_lds((const unsigned*)g_, (__attribute__((address_space(3))) unsigned*)(uintptr_t)(unsigned)d_, 16, 0, 0); \
    __builtin_amdgcn_global_load_lds((const unsigned*)(g_ + 1024), (__attribute__((address_space(3))) unsigned*)(uintptr_t)(unsigned)(d_ + 1024), 16, 0, 0); } while (0)
#endif
#define PP_BAR() do { SBAR(); __builtin_amdgcn_s_barrier(); SBAR(); } while (0)
#define PP_KOFF(s_) ((s_) / (8192 / PP_KIMG))
  const int NT = seq / KVBLK;
  PP_DMA(0, 0); PP_DMA(1, 1);
#ifdef QK_FP4
  { const unsigned char* Qw = Qb + (long)(wid * QBLK + r32) * LDQ4 + hi * 16;
#pragma unroll
    for (int s = 0; s < 2; ++s) { const i32x4 a = *reinterpret_cast<const i32x4*>(Qw + 32 * s); qf[s] = (i32x8){a[0], a[1], a[2], a[3], 0, 0, 0, 0}; } }
#else
  { const unsigned char* Qw = Qb + (long)(wid * QBLK + r32) * LDQ8 + hi * 32;
#pragma unroll
    for (int s = 0; s < 2; ++s) { const i32x4 a = *reinterpret_cast<const i32x4*>(Qw + 64 * s), b = *reinterpret_cast<const i32x4*>(Qw + 64 * s + 16); qf[s] = (i32x8){a[0], a[1], a[2], a[3], b[0], b[1], b[2], b[3]}; } }
#endif
  asm volatile("s_waitcnt vmcnt(0)" ::: "memory");
  __syncthreads();
  if (grp == 1) PP_BAR();
  int sa = 0, sb = 8192, sc = 16384;
  { const int kb_ = kbase + PP_KOFF(sa); pp_mseg<true, false>(o, ol, n0, n1, pa, ones, qf, minit, vf0, vf1, kb_ + ka, kb_ + ka1, kb_ + ka2, kb_ + ka3, 0, 0); }
  asm volatile("" : "+v"(n0), "+v"(n1)); PP_BAR();
  asm volatile("s_waitcnt vmcnt(0)" ::: "memory"); PP_DMA(2, 2);
  pp_vseg<true>(o, ol, n0, n1, minit, pa, al_l, r32, hi);
  { const int vb_ = vbase + sa; vf0 = lds2(vb_ + va, vb_ + va1, 0); vf1 = lds2(vb_ + va, vb_ + va1, 2048); }
  PP_BAR();
  { const int t = sa; sa = sb; sb = sc; sc = t; }
  int kA = kbase + ka, kA1 = kbase + ka1, kA2 = kbase + ka2, kA3 = kbase + ka3, vA = vbase + va, vA1 = vbase + va1;
  asm volatile("" : "+v"(kA), "+v"(kA1), "+v"(vA), "+v"(vA1));
#define PP_TILE(SA_, SC_) do { \
    pp_mseg<true, true>(o, ol, n0, n1, pa, ones, qf, minit, vf0, vf1, kA + PP_KOFF(SA_), kA1 + PP_KOFF(SA_), kA2 + PP_KOFF(SA_), kA3 + PP_KOFF(SA_), vA + (SC_), vA1 + (SC_)); \
    asm volatile("" : "+v"(n0), "+v"(n1), "+v"(o[0]), "+v"(o[1]), "+v"(o[2]), "+v"(o[3]), "+v"(ol)); PP_BAR(); \
    asm volatile("s_waitcnt vmcnt(0)" ::: "memory"); \
    { const int tl = (j + 2 < NT) ? j + 2 : NT - 1; PP_DMA(tl, (SC_) >> 13); } \
    pp_vseg<false>(o, ol, n0, n1, minit, pa, al_l, r32, hi); \
    vf0 = lds2(vA + (SA_), vA1 + (SA_), 0); vf1 = lds2(vA + (SA_), vA1 + (SA_), 2048); \
    PP_BAR(); ++j; } while (0)
  int j = 1;
  while (j + 2 < NT) { PP_TILE(8192, 0); PP_TILE(16384, 8192); PP_TILE(0, 16384); }
#undef PP_TILE
  for (; j < NT; ++j) {
    { const int kb_ = kbase + PP_KOFF(sa), vb_ = vbase + sc;
      pp_mseg<true, true>(o, ol, n0, n1, pa, ones, qf, minit, vf0, vf1, kb_ + ka, kb_ + ka1, kb_ + ka2, kb_ + ka3, vb_ + va, vb_ + va1); }
    asm volatile("" : "+v"(n0), "+v"(n1), "+v"(o[0]), "+v"(o[1]), "+v"(o[2]), "+v"(o[3]), "+v"(ol)); PP_BAR();
    asm volatile("s_waitcnt vmcnt(0)" ::: "memory");
    { const int tl = (j + 2 < NT) ? j + 2 : NT - 1; PP_DMA(tl, sc >> 13); }
    pp_vseg<false>(o, ol, n0, n1, minit, pa, al_l, r32, hi);
    { const int vb_ = vbase + sa; vf0 = lds2(vb_ + va, vb_ + va1, 0); vf1 = lds2(vb_ + va, vb_ + va1, 2048); }
    PP_BAR();
    { const int t = sa; sa = sb; sb = sc; sc = t; }
  }
  { const int vb_ = vbase + sc; pp_mseg<false, true>(o, ol, n0, n1, pa, ones, qf, minit, vf0, vf1, 0, 0, 0, 0, vb_ + va, vb_ + va1); }
  if (grp == 0) PP_BAR();
  asm volatile("s_waitcnt vmcnt(0)" ::: "memory");
  float rli[16];
#pragma unroll
  for (int r = 0; r < 16; ++r) rli[r] = __builtin_amdgcn_rcpf(ol[r]);
  __syncthreads();
  epi_stage_store<1>(o, rli, (__attribute__((address_space(3))) unsigned char*)(uintptr_t)(unsigned)(uintptr_t)lds + wid * EPI_BYTES, Gb + (long)(wid * QBLK) * LDQ, Ob + (long)(wid * QBLK) * LDO, lane);
  __syncthreads();
#undef PP_DMA
#undef PP_BAR
#undef PP_KOFF
}
#undef MFMA8
#undef MFMA8Q

#undef KSWZ
#undef SBAR
}

__device__ __forceinline__ float bflo(unsigned w) { return __uint_as_float(w << 16); }
__device__ __forceinline__ float bfhi(unsigned w) { return __uint_as_float(w & 0xffff0000u); }
__device__ __forceinline__ float silu_f(float x) { return x / (1.f + __expf(-x)); }
__device__ __forceinline__ float wave_max(float v) {
#pragma unroll
    for (int o = 1; o < 64; o <<= 1) v = fmaxf(v, __shfl_xor(v, o));
    return v;
}
__device__ __forceinline__ int t5_bucket(int rel) {
    const int n = rel < 0 ? -rel : rel; const float nf = (float)(n > 1 ? n : 1);
    int large = 8 + (int)(logf(nf * 0.125f) / 4.852030263919617f * 8.0f); large = large < 15 ? large : 15;
    return (rel > 0 ? 16 : 0) + (n < 8 ? n : large);
}

struct Args { const float* in[12]; float* out; unsigned char* ws; };

__device__ __forceinline__ void p0_prologue(const Args& a, LAS unsigned char* lds, int wave, int vcu, int G) {
    const int lane = fresh_lane(), tid = wave * 64 + lane;
    const float* c = a.in[1]; const float* w_mod = a.in[2]; const float* w_in = a.in[6]; const float* w_out = a.in[7]; const float* rel_bias = a.in[11];
    float* modp = (float*)(a.ws + WS_MODP);
    float* tab = (float*)(a.ws + WS_TAB);
    bf16* Win_t = (bf16*)(a.ws + WS_WIN); bf16* Wout_t = (bf16*)(a.ws + WS_WOUT);
    const int gt = vcu * (NWAVES * 64) + tid, NGT = G * NWAVES * 64;
    for (int e = gt; e < A_H * 3 * LUTA_N; e += NGT) { const int idx = e % LUTA_N, hp = e / LUTA_N, p = hp % 3, h = hp / 3, kk = idx - 92;
        float v = -1e30f; if (kk >= -64 && kk <= 64) v = rel_bias[t5_bucket(kk * (1 << (2 * p))) * (A_H + B_H) + h] * LOG2E;
        tab[TB_LUTA + e] = v; }
    for (int e = gt; e < B_H * LUTB_N; e += NGT) { const int idx = e % LUTB_N, h = e / LUTB_N, kk = idx - 156;
        float v = -1e30f; if (kk >= -128 && kk <= 128) v = rel_bias[t5_bucket(kk) * (A_H + B_H) + A_H + h] * LOG2E;
        tab[TB_LUTB + e] = v; }
    for (int e = gt; e < (256 + 64) * 32; e += NGT) { const int j = e & 31, pp = e >> 5, pos = pp < 256 ? pp : pp - 256;
        const float freq = exp2f(-(float)j * 0.4152410118609203f);
        const float ang = (float)pos * freq;
        double rev = (double)ang * 0.15915494309189535; rev -= floor(rev);
        const float cs_ = __builtin_amdgcn_cosf((float)rev), sn_ = __builtin_amdgcn_sinf((float)rev);
        float* d = tab + (pp < 256 ? TB_ROPE_R : TB_ROPE_C) + (pos * 32 + j) * 2; d[0] = cs_; d[1] = sn_; }
    LAS float* cs = (LAS float*)lds;
    LAS float* red = (LAS float*)(lds + 16384);
    for (int k = tid; k < DM; k += NWAVES * 64) cs[k] = silu_f(c[k]);
    __syncthreads();
#ifndef REP_GEMV
#define REP_GEMV 1
#endif
    for (int rep = 0; rep < REP_GEMV; ++rep)
    for (int it = vcu; it < DEPTH * 48 * 4; it += G) {
        const int kq = it & 3, nc = (it >> 2) % 48, ly = it / 192, k0 = kq * 1024 + wave * 128;
        const float* W = w_mod + (size_t)ly * DM * NMOD + (size_t)k0 * NMOD + nc * 256 + lane * 4;
        f32x4 acc = (f32x4){0.f, 0.f, 0.f, 0.f};
#pragma unroll 8
        for (int k = 0; k < 128; ++k) { const f32x4 w = *(const GAS f32x4*)(W + (size_t)k * NMOD); acc += w * cs[k0 + k]; }
        *(LAS f32x4*)(red + wave * 256 + lane * 4) = acc;
        __syncthreads();
        if (tid < 256) { float s = 0.f;
#pragma unroll
            for (int w = 0; w < NWAVES; ++w) s += red[w * 256 + tid];
            modp[(size_t)kq * DEPTH * NMOD + ly * NMOD + nc * 256 + tid] = s; }
        __syncthreads();
    }
    LAS float* scr = (LAS float*)(lds + wave * 16384);
    const int gw = vcu * NWAVES + wave, NGW = G * NWAVES;
    constexpr int I_IN = (DM / 64) * (INW / 32), I_OUT = (DM / 64) * (DM / 32), I_L = I_IN + I_OUT;
#ifndef REP_TR
#define REP_TR 1
#endif
    gu32* ctlw = (gu32*)(a.ws + WS_CTL);
    float amx = 0.f; int aly = -1;
#define AMX_FLUSH() do { if (aly >= 0) { float m_ = amx; for (int o_ = 1; o_ < 64; o_ <<= 1) m_ = fmaxf(m_, __shfl_xor(m_, o_)); \
        if (lane == 0) (void)__hip_atomic_fetch_max((unsigned*)(ctlw + CW_AMAX + 64 * aly), __builtin_bit_cast(unsigned, m_), RLX_AGENT); } } while (0)
    for (int rep = 0; rep < REP_TR; ++rep)
    for (int it = gw; it < DEPTH * I_L; it += NGW) {
        const int ly = it / I_L, r = it - ly * I_L;
        if (ly != aly) { AMX_FLUSH(); amx = 0.f; aly = ly; }
        if (r < I_IN) { const int n0 = 32 * (r % (INW / 32));
                        const int off = proj_col_of(n0) - n0;
                        if (proj_col_of(n0) >= F8_COL0) p0_transpose_item<true>(w_in + (size_t)ly * DM * INW, DM, INW, Win_t + (size_t)ly * INW * DM, off, scr, r, lane, amx);
                        else p0_transpose_item<false>(w_in + (size_t)ly * DM * INW, DM, INW, Win_t + (size_t)ly * INW * DM, off, scr, r, lane, amx); }
        else p0_transpose_item<false>(w_out + (size_t)ly * DM * DM, DM, DM, Wout_t + (size_t)ly * DM * DM, 0, scr, r - I_IN, lane, amx);
    }
    AMX_FLUSH();
#undef AMX_FLUSH
}

__device__ __forceinline__ int w8_exp(const Args& a, int layer) {
    const unsigned b = __hip_atomic_load((unsigned*)((gu32*)(a.ws + WS_CTL) + CW_AMAX + 64 * layer), RLX_AGENT);
    int e = 7 - ((int)(b >> 23) - 127); e = e > 60 ? 60 : (e < -60 ? -60 : e);
    return __builtin_amdgcn_readfirstlane(e);
}
__device__ __forceinline__ void w8_phase(const Args& a, int wave, int vcu, int G) {
    const int lane = fresh_lane();
    const bf16* Win_t = (const bf16*)(a.ws + WS_WIN); unsigned char* W8 = (unsigned char*)(a.ws + WS_W8);
    const int gw = vcu * NWAVES + wave, NGW = G * NWAVES;
    for (int row = gw; row < DEPTH * F8_COLS; row += NGW) {
        const int ly = row / F8_COLS, n = row % F8_COLS;
        const float sc = __builtin_bit_cast(float, (unsigned)(w8_exp(a, ly) + 127) << 23);
        const bf16* src = Win_t + ((size_t)ly * INW + F8_COL0 + n) * DM + lane * 8; unsigned char* dst = W8 + ((size_t)ly * F8_COLS + n) * DM + lane * 8;
        pg8::u32x4 r_[8];
#pragma unroll
        for (int j = 0; j < 8; ++j) r_[j] = *(const pg8::u32x4*)(src + j * 512);
#pragma unroll
        for (int j = 0; j < 8; ++j) {
            int lo = __builtin_amdgcn_cvt_pk_fp8_f32(bflo(r_[j].x) * sc, bfhi(r_[j].x) * sc, 0, false); lo = __builtin_amdgcn_cvt_pk_fp8_f32(bflo(r_[j].y) * sc, bfhi(r_[j].y) * sc, lo, true);
            int hi = __builtin_amdgcn_cvt_pk_fp8_f32(bflo(r_[j].z) * sc, bfhi(r_[j].z) * sc, 0, false); hi = __builtin_amdgcn_cvt_pk_fp8_f32(bflo(r_[j].w) * sc, bfhi(r_[j].w) * sc, hi, true);
            u32x2 w; w.x = (unsigned)lo; w.y = (unsigned)hi; *(u32x2*)(dst + j * 512) = w; }
    }
}

__device__ __forceinline__ void norm_phase(const Args& a, LAS unsigned char* lds, int layer_post, int layer_pre, const float* xin, int wave, int vcu, int G, bool dummy = false) {
    const int lane = fresh_lane(), tid = wave * 64 + lane;
    LAS float* Gv = (LAS float*)lds; LAS float* Av = Gv + DM; LAS float* Bv = Av + DM;
    const float* modp = (const float*)(a.ws + WS_MODP);
#define MOD4(i) (((*(const f32x4*)(modp + (i)) + *(const f32x4*)(modp + DEPTH * NMOD + (i))) + *(const f32x4*)(modp + 2 * DEPTH * NMOD + (i))) + *(const f32x4*)(modp + 3 * DEPTH * NMOD + (i)))
    const float* b_mod = a.in[3]; const float* pre_g = a.in[4]; const float* post_g = a.in[5];
#pragma unroll
    for (int hf = 0; hf < 2; ++hf) { const int j = tid * 8 + 4 * hf;
        if (layer_post >= 0) *(LAS f32x4*)(Gv + j) = (MOD4(layer_post * NMOD + 2 * DM + j) + *(const f32x4*)(b_mod + layer_post * NMOD + 2 * DM + j)) * *(const f32x4*)(post_g + layer_post * DM + j);
        if (layer_pre >= 0) { *(LAS f32x4*)(Av + j) = *(const f32x4*)(pre_g + layer_pre * DM + j) * (1.f + MOD4(layer_pre * NMOD + DM + j) + *(const f32x4*)(b_mod + layer_pre * NMOD + DM + j));
                              *(LAS f32x4*)(Bv + j) = MOD4(layer_pre * NMOD + j) + *(const f32x4*)(b_mod + layer_pre * NMOD + j); } }
#undef MOD4
    __syncthreads();
    const bf16* Y = (const bf16*)(a.ws + WS_Y); bf16* H = (bf16*)(a.ws + (dummy ? WS_END + 256 * MiB : WS_H)); float* xout = dummy ? (float*)(a.ws + WS_END) : a.out;
    const int gw = vcu * NWAVES + wave, NGW = G * NWAVES;
    for (int row = gw; row < S; row += NGW) {
        const GAS f32x4* xr = (const GAS f32x4*)(xin + (size_t)row * DM) + lane;
        f32x4 v[16];
#pragma unroll
        for (int j = 0; j < 16; ++j) v[j] = xr[64 * j];
        if (layer_post >= 0) {
            const GAS u32x2* yr = (const GAS u32x2*)(Y + (size_t)row * DM) + lane;
            u32x2 yv[16]; float ss = 0.f;
#pragma unroll
            for (int j = 0; j < 16; ++j) { yv[j] = yr[64 * j]; const float y0 = bflo(yv[j].x), y1 = bfhi(yv[j].x), y2 = bflo(yv[j].y), y3 = bfhi(yv[j].y); ss += (y0 * y0 + y1 * y1) + (y2 * y2 + y3 * y3); }
            const float ry = rsqrtf(wave_sum_l(ss, lane) * (1.f / DM) + EPS);
            GAS f32x4* xo = (GAS f32x4*)(xout + (size_t)row * DM) + lane;
#pragma unroll
            for (int j = 0; j < 16; ++j) { const f32x4 g = *(const LAS f32x4*)(Gv + j * 256 + lane * 4);
                const f32x4 yf = (f32x4){bflo(yv[j].x), bfhi(yv[j].x), bflo(yv[j].y), bfhi(yv[j].y)};
                v[j] = v[j] + g * yf * ry; xo[64 * j] = v[j]; }
        }
        if (layer_pre >= 0) {
            float ss = 0.f;
#pragma unroll
            for (int j = 0; j < 16; ++j) ss += (v[j].x * v[j].x + v[j].y * v[j].y) + (v[j].z * v[j].z + v[j].w * v[j].w);
            const float rx = rsqrtf(wave_sum_l(ss, lane) * (1.f / DM) + EPS);
            GAS u32x2* ho = (GAS u32x2*)(H + (size_t)row * DM) + lane;
            GAS int* h8o = (GAS int*)((unsigned char*)(a.ws + (dummy ? WS_END + 320 * MiB : WS_H8)) + (size_t)row * DM) + lane;
#pragma unroll
            for (int j = 0; j < 16; ++j) { const f32x4 av = *(const LAS f32x4*)(Av + j * 256 + lane * 4), bv = *(const LAS f32x4*)(Bv + j * 256 + lane * 4);
                const f32x4 hv = v[j] * rx * av + bv; u32x2 w; w.x = pg8::cvt_pk_bf16(hv.x, hv.y); w.y = pg8::cvt_pk_bf16(hv.z, hv.w); ho[64 * j] = w;
                int w8_ = __builtin_amdgcn_cvt_pk_fp8_f32(hv.x, hv.y, 0, false); w8_ = __builtin_amdgcn_cvt_pk_fp8_f32(hv.z, hv.w, w8_, true); h8o[64 * j] = w8_; }
        }
    }
    __syncthreads();
}

__device__ __forceinline__ void prep_phase(const Args& a, LAS unsigned char* lds, int layer, int wave, int vcu, int G) {
    const int lane = fresh_lane();
    bf16* proj = (bf16*)(a.ws + WS_PROJ); const float* tab = (const float*)(a.ws + WS_TAB);
    const float* qg = a.in[8] + layer * HD; const float* kg = a.in[9] + layer * HD;
    const int l16 = lane & 15, half = l16 >> 3, jj = (l16 & 7) * 4, grp = lane >> 4;
    const f32x4 gq1 = *(const f32x4*)(qg + half * 64 + jj), gq2 = *(const f32x4*)(qg + half * 64 + 32 + jj);
    const f32x4 gk1 = *(const f32x4*)(kg + half * 64 + jj), gk2 = *(const f32x4*)(kg + half * 64 + 32 + jj);
    const int gw = vcu * NWAVES + wave, NGW = G * NWAVES;
    for (int t = gw; t < S; t += NGW) {
        const int pos = half ? (t & 63) : (t >> 6);
        const float* rt = tab + (half ? TB_ROPE_C : TB_ROPE_R) + (pos * 32 + jj) * 2;
        const f32x4 cs0 = *(const f32x4*)rt, cs1 = *(const f32x4*)(rt + 4);
        const f32x4 cv = (f32x4){cs0.x, cs0.z, cs1.x, cs1.z}, sv = (f32x4){cs0.y, cs0.w, cs1.y, cs1.w};
#pragma unroll
        for (int it = 0; it < 4; ++it) {
            const int hh = it * 4 + grp;
            bf16* p = proj + (size_t)t * PLD + PC(COL_CQ + hh * HD) + half * 64 + jj;
            const u32x2 r1 = *(const u32x2*)p, r2 = *(const u32x2*)(p + 32);
            const f32x4 x1 = (f32x4){bflo(r1.x), bfhi(r1.x), bflo(r1.y), bfhi(r1.y)}, x2 = (f32x4){bflo(r2.x), bfhi(r2.x), bflo(r2.y), bfhi(r2.y)};
            float ss = (x1.x * x1.x + x1.y * x1.y) + (x1.z * x1.z + x1.w * x1.w) + (x2.x * x2.x + x2.y * x2.y) + (x2.z * x2.z + x2.w * x2.w);
            ss += lane_xor(ss, 1, lane); ss += lane_xor(ss, 2, lane); ss += lane_xor(ss, 4, lane); ss += lane_xor(ss, 8, lane);
            const float r = rsqrtf(ss * (1.f / HD) + EPS);
            const f32x4 g1 = (it == 3) ? gk1 : gq1, g2 = (it == 3) ? gk2 : gq2;
            const f32x4 y1 = x1 * r * g1, y2 = x2 * r * g2;
            const f32x4 o1_ = y1 * cv - y2 * sv, o2_ = y2 * cv + y1 * sv;
#ifndef ATT_F8
            const f32x4 o1 = o1_, o2 = o2_;
#endif
#ifdef ATT_F8
#if defined(ATT_PP) && defined(QK_FP4)
            { unsigned char* d8; int d8b;
              if (it == 3) { unsigned char* rb = (unsigned char*)(a.ws + WS_KF8) + ((size_t)((hh - 12) * (S / 64) + (t >> 6))) * attc::PP_TIMG + (t & 63) * 64 + (jj >> 1);
                             const int c1 = half * 2, kg = ((t & 63) >> 2) & 3; d8 = rb + ((c1 ^ kg) << 4); d8b = (((c1 + 1) ^ kg) << 4) - ((c1 ^ kg) << 4); }
              else { d8 = (unsigned char*)(a.ws + WS_QF8) + (size_t)t * attc::LDQ4 + hh * 64 + half * 32 + (jj >> 1); d8b = 16; }
              const float qs = (it == 3) ? attc::K4_PRESCALE : attc::Q4_PRESCALE; const f32x4 o1 = o1_ * qs, o2 = o2_ * qs;
              const unsigned a0 = __builtin_amdgcn_cvt_scalef32_pk_fp4_f32(0u, o1.x, o1.y, 1.f, 0) & 0xffu, a1 = __builtin_amdgcn_cvt_scalef32_pk_fp4_f32(0u, o1.z, o1.w, 1.f, 0) & 0xffu;
              const unsigned b0 = __builtin_amdgcn_cvt_scalef32_pk_fp4_f32(0u, o2.x, o2.y, 1.f, 0) & 0xffu, b1 = __builtin_amdgcn_cvt_scalef32_pk_fp4_f32(0u, o2.z, o2.w, 1.f, 0) & 0xffu;
              *(unsigned short*)d8 = (unsigned short)(a0 | (a1 << 8)); *(unsigned short*)(d8 + d8b) = (unsigned short)(b0 | (b1 << 8)); }
#elif defined(ATT_PP)
            unsigned char* d8; int d8b;
            if (it == 3) { unsigned char* rb = (unsigned char*)(a.ws + WS_KF8) + ((size_t)((hh - 12) * (S / 64) + (t >> 6))) * attc::PP_TIMG + (t & 63) * 128 + (jj & 15);
                           const int c1 = half * 4 + (jj >> 4), kf = ((t & 63) >> 1) & 7; d8 = rb + ((c1 ^ kf) << 4); d8b = (((c1 + 2) ^ kf) << 4) - ((c1 ^ kf) << 4); }
            else { d8 = (unsigned char*)(a.ws + WS_QF8) + (size_t)t * (C_H * HD) + hh * HD + half * 64 + jj; d8b = 32; }
            {
#else
            { const int d8b = 32;
              unsigned char* d8 = (it == 3) ? (unsigned char*)(a.ws + WS_KF8) + (size_t)t * 512 + (hh - 12) * HD + half * 64 + jj
                                            : (unsigned char*)(a.ws + WS_QF8) + (size_t)t * (C_H * HD) + hh * HD + half * 64 + jj;
#endif
#if !(defined(ATT_PP) && defined(QK_FP4))
              const float qs = (it == 3) ? 1.f : attc::Q8_PRESCALE; const f32x4 o1 = o1_ * qs, o2 = o2_ * qs;
              int t1 = __builtin_amdgcn_cvt_pk_fp8_f32(o1.x, o1.y, 0, false); t1 = __builtin_amdgcn_cvt_pk_fp8_f32(o1.z, o1.w, t1, true);
              int t2 = __builtin_amdgcn_cvt_pk_fp8_f32(o2.x, o2.y, 0, false); t2 = __builtin_amdgcn_cvt_pk_fp8_f32(o2.z, o2.w, t2, true);
              *(int*)d8 = t1; *(int*)(d8 + d8b) = t2; }
#endif
#else
            u32x2 w1, w2; w1.x = pg8::cvt_pk_bf16(o1.x, o1.y); w1.y = pg8::cvt_pk_bf16(o1.z, o1.w); w2.x = pg8::cvt_pk_bf16(o2.x, o2.y); w2.y = pg8::cvt_pk_bf16(o2.z, o2.w);
            *(u32x2*)p = w1; *(u32x2*)(p + 32) = w2;
#endif
        }
    }
#ifdef ATT_F8
    { typedef attc::bf16x8 bx8; typedef attc::s16x4 sx4;
      unsigned char* VT8 = (unsigned char*)(a.ws + WS_VTF8);
      LAS unsigned char* img = lds + wave * 8192;
      const int lane2 = fresh_lane(), r32 = lane2 & 31, hi = lane2 >> 5, vrow = lane2 >> 4, vch = lane2 & 15;
      LAS unsigned char* vwr = img + (vch >> 2) * 512 + vrow * 64 + (vch & 3) * 16;
      const int vb = (int)(uintptr_t)img + attc::v_rd_base(lane2);
      for (int itv = gw; itv < 4 * (S / 32); itv += NGW) {
        const int kv = itv / (S / 32), t0 = (itv % (S / 32)) * 32;
        bx8 vs[8];
#pragma unroll
        for (int i = 0; i < 8; ++i) vs[i] = *reinterpret_cast<const bx8*>(proj + (size_t)(t0 + vrow + 4 * i) * PLD + PC(COL_CV + kv * HD) + vch * 8);
#pragma unroll
        for (int i = 0; i < 8; ++i) *reinterpret_cast<LAS bx8*>(vwr + (i & 1) * 2048 + ((i >> 1) & 1) * 256 + ((i >> 2) & 1) * 4096) = vs[i];
#ifdef ATT_PP
        const int vg = (r32 >> 2) & 3, c_lo = (t0 >> 5) & 1;
        unsigned char* rowp = (unsigned char*)(a.ws + WS_KF8) + ((size_t)(kv * (S / 64) + (t0 >> 6))) * attc::PP_TIMG + attc::PP_KIMG + r32 * 64 + ((c_lo ^ vg) << 4) + 4 * hi;
        const int hi_off = (((c_lo + 2) ^ vg) << 4) - ((c_lo ^ vg) << 4);
#else
        const int hi_off = 32;
        unsigned char* rowp = VT8 + (size_t)kv * HD * S + (size_t)(t0 >> 6) * 8192 + r32 * 64 + ((t0 & 32) ? 16 : 0) + 4 * hi;
#endif
#define VTR8(D0, KS) do { const sx4 l_ = attc::tr_read<attc::v_rd_off(D0, KS, 0)>(vb), h_ = attc::tr_read<attc::v_rd_off(D0, KS, 1)>(vb); asm volatile("s_waitcnt lgkmcnt(0)" ::: "memory"); __builtin_amdgcn_sched_barrier(0); \
          int lo_ = __builtin_amdgcn_cvt_pk_fp8_f32(__uint_as_float((unsigned)(unsigned short)l_[0] << 16), __uint_as_float((unsigned)(unsigned short)l_[1] << 16), 0, false); \
          lo_ = __builtin_amdgcn_cvt_pk_fp8_f32(__uint_as_float((unsigned)(unsigned short)l_[2] << 16), __uint_as_float((unsigned)(unsigned short)l_[3] << 16), lo_, true); \
          int hi_ = __builtin_amdgcn_cvt_pk_fp8_f32(__uint_as_float((unsigned)(unsigned short)h_[0] << 16), __uint_as_float((unsigned)(unsigned short)h_[1] << 16), 0, false); \
          hi_ = __builtin_amdgcn_cvt_pk_fp8_f32(__uint_as_float((unsigned)(unsigned short)h_[2] << 16), __uint_as_float((unsigned)(unsigned short)h_[3] << 16), hi_, true); \
          unsigned char* q_ = rowp + (D0 * 32) * 64 + 8 * KS; *(int*)q_ = lo_; *(int*)(q_ + hi_off) = hi_; } while (0)
        VTR8(0, 0); VTR8(0, 1); VTR8(1, 0); VTR8(1, 1); VTR8(2, 0); VTR8(2, 1); VTR8(3, 0); VTR8(3, 1);
#undef VTR8
        asm volatile("s_waitcnt lgkmcnt(0)" ::: "memory");
      } }
#endif
}

template <bool IS_B>
__device__ __forceinline__ void naive_band(const bf16* proj, bf16* o, const float* lut, float sink_l2, int t, int qcol, int kcol, int vcol, int gcol, int ocol,
                                           LAS float* sc, LAS int* jr, int lane) {
    constexpr int NS = IS_B ? 257 : 387;
    const int l16 = lane & 15, grp = lane >> 4;
    float qf[8];
    { const pg8::u32x4 qraw = *(const pg8::u32x4*)(proj + (size_t)t * INW + qcol + l16 * 8);
      qf[0] = bflo(qraw.x) * QK_C; qf[1] = bfhi(qraw.x) * QK_C; qf[2] = bflo(qraw.y) * QK_C; qf[3] = bfhi(qraw.y) * QK_C;
      qf[4] = bflo(qraw.z) * QK_C; qf[5] = bfhi(qraw.z) * QK_C; qf[6] = bflo(qraw.w) * QK_C; qf[7] = bfhi(qraw.w) * QK_C; }
    for (int s0 = 0; s0 < NS; s0 += 4) {
        const int s = s0 + grp; const bool inr = s < NS; const int ss = inr ? s : NS - 1;
        int j, li;
        if (IS_B) { j = t + ss - 128; li = ss + 28; }
        else { const int p = ss / 129, kk = ss - p * 129; j = t + (kk - 64) * (1 << (2 * p)); li = p * LUTA_N + kk + 28; }
        const bool valid = inr && j >= 0 && j < S;
        const int jc = j < 0 ? 0 : (j > S - 1 ? S - 1 : j);
        const pg8::u32x4 kr = *(const pg8::u32x4*)(proj + (size_t)jc * INW + kcol + l16 * 8);
        float d = qf[0] * bflo(kr.x) + qf[1] * bfhi(kr.x) + qf[2] * bflo(kr.y) + qf[3] * bfhi(kr.y) + qf[4] * bflo(kr.z) + qf[5] * bfhi(kr.z) + qf[6] * bflo(kr.w) + qf[7] * bfhi(kr.w);
        d += lane_xor(d, 1, lane); d += lane_xor(d, 2, lane); d += lane_xor(d, 4, lane); d += lane_xor(d, 8, lane);
        const float sv = valid ? d + lut[li] : -1e30f;
        if (l16 == 0 && inr) { sc[s] = sv; jr[s] = jc; }
    }
    float mx = -1e30f;
    for (int s = lane; s < NS; s += 64) mx = fmaxf(mx, sc[s]);
    mx = wave_max_l(mx, lane); if (IS_B) mx = fmaxf(mx, sink_l2);
    float lsum = 0.f;
    for (int s = lane; s < NS; s += 64) { const float p = exp2f(sc[s] - mx); sc[s] = p; lsum += p; }
    lsum = wave_sum_l(lsum, lane); if (IS_B) lsum += exp2f(sink_l2 - mx);
    float a0 = 0.f, a1 = 0.f;
#pragma unroll 4
    for (int s = 0; s < NS; ++s) { const float p = sc[s]; const int j = jr[s];
        const unsigned v = *(const unsigned*)(proj + (size_t)j * INW + vcol + lane * 2); a0 += p * bflo(v); a1 += p * bfhi(v); }
    const unsigned g = *(const unsigned*)(proj + (size_t)t * INW + gcol + lane * 2);
    const float inv = 1.f / lsum;
    *(unsigned*)(o + (size_t)t * DM + ocol + lane * 2) = pg8::cvt_pk_bf16(a0 * inv * silu_f(bflo(g)), a1 * inv * silu_f(bfhi(g)));
}

__device__ __forceinline__ void naive_ab_phase(const Args& a, LAS unsigned char* lds, int layer, int wave, int vcu, int G) {
    const int lane = fresh_lane();
    const bf16* proj = (const bf16*)(a.ws + WS_PROJ); bf16* o = (bf16*)(a.ws + WS_O); const float* tab = (const float*)(a.ws + WS_TAB);
    const float* sink = a.in[10] + layer * B_H;
    LAS float* sc = (LAS float*)(lds + wave * 4096); LAS int* jr = (LAS int*)(lds + wave * 4096 + 2048);
    const int gw = vcu * NWAVES + wave, NGW = G * NWAVES;
    for (int t = gw; t < S; t += NGW) {
        for (int h = 0; h < A_H; ++h)
            naive_band<false>(proj, o, tab + TB_LUTA + h * 3 * LUTA_N, 0.f, t, COL_AQ + h * HD, COL_AK + h * HD, COL_AV + h * HD, COL_AG + h * HD, OCOL_A + h * HD, sc, jr, lane);
        for (int h = 0; h < B_H; ++h)
            naive_band<true>(proj, o, tab + TB_LUTB + h * LUTB_N, sink[h] * LOG2E, t, COL_BQ + h * HD, COL_BK + (h >> 2) * HD, COL_BV + (h >> 2) * HD, COL_BG + h * HD, OCOL_B + h * HD, sc, jr, lane);
    }
}

namespace band {
using attc::bf16x8; using attc::s16x4; using attc::f32x16; using attc::u32x4; using attc::crow; using attc::cvtpk; using attc::v_rd_base; using attc::v_rd_off; using attc::tr_read;
constexpr float THR2 = 8.f;
constexpr int KPITCH = 272;
constexpr int WAVE_LDS = 8192 + 32 * KPITCH;
static_assert(WAVE_LDS >= attc::EPI_BYTES, "O stage fits the per-wave region");
enum Mode { P16 = 0, P4 = 1, P1 = 2, MB = 3 };
constexpr int A_ROW = A_H * HD;
template <int D0> __device__ __forceinline__ void pv32(f32x16& od, int vb, bf16x8 pa0, bf16x8 pa1) {
  const s16x4 l0 = tr_read<v_rd_off(D0, 0, 0)>(vb), h0 = tr_read<v_rd_off(D0, 0, 1)>(vb), l1 = tr_read<v_rd_off(D0, 1, 0)>(vb), h1 = tr_read<v_rd_off(D0, 1, 1)>(vb);
  asm volatile("s_waitcnt lgkmcnt(0)" ::: "memory"); __builtin_amdgcn_sched_barrier(0);
#define PK(L, H) (bf16x8){L[0], L[1], L[2], L[3], H[0], H[1], H[2], H[3]}
  od = __builtin_amdgcn_mfma_f32_32x32x16_bf16(pa0, PK(l0, h0), od, 0, 0, 0);
  od = __builtin_amdgcn_mfma_f32_32x32x16_bf16(pa1, PK(l1, h1), od, 0, 0, 0);
#undef PK
}
__device__ __forceinline__ void epi_stage(const f32x16 (&o)[4], const float (&rli)[16], LAS unsigned char* st, int lane) {
  asm volatile("" : "+v"(lane));
  const int r32 = lane & 31, hi = lane >> 5;
#pragma unroll
  for (int r = 0; r < 16; ++r) { const int row = crow(r, hi);
#pragma unroll
    for (int d0 = 0; d0 < 4; ++d0) *reinterpret_cast<LAS float*>(st + row * attc::EPI_PITCH + (d0 * 32 + r32) * 4) = o[d0][r] * rli[r]; }
}
template <int QS>
__device__ __forceinline__ void epi_partial_out(LAS unsigned char* st, bf16* __restrict__ dst, int lane) {
  typedef float f32x4_t __attribute__((ext_vector_type(4)));
  asm volatile("" : "+v"(lane));
  const int rr = lane >> 4, c16 = lane & 15;
#pragma unroll
  for (int i = 0; i < 8; ++i) { const int row = rr + 4 * i;
    const f32x4_t a = *reinterpret_cast<const LAS f32x4_t*>(st + row * attc::EPI_PITCH + c16 * 32);
    const f32x4_t b = *reinterpret_cast<const LAS f32x4_t*>(st + row * attc::EPI_PITCH + c16 * 32 + 16);
    u32x4 w = {cvtpk(a[0], a[1]), cvtpk(a[2], a[3]), cvtpk(b[0], b[1]), cvtpk(b[2], b[3])};
    *reinterpret_cast<u32x4*>(dst + (size_t)(QS * row) * A_ROW + c16 * 8) = w; }
}
__device__ __forceinline__ void epi_gate_out(LAS unsigned char* st, const u32x4 (&g)[8], bf16* __restrict__ obase, int lane) {
  typedef float f32x4_t __attribute__((ext_vector_type(4)));
  asm volatile("" : "+v"(lane));
  const int rr = lane >> 4, c16 = lane & 15;
#pragma unroll
  for (int i = 0; i < 8; ++i) { const int row = rr + 4 * i;
    const f32x4_t a = *reinterpret_cast<const LAS f32x4_t*>(st + row * attc::EPI_PITCH + c16 * 32);
    const f32x4_t b = *reinterpret_cast<const LAS f32x4_t*>(st + row * attc::EPI_PITCH + c16 * 32 + 16);
    float v[8] = {a[0], a[1], a[2], a[3], b[0], b[1], b[2], b[3]};
#pragma unroll
    for (int e = 0; e < 4; ++e) { const float g0 = __uint_as_float(g[i][e] << 16), g1 = __uint_as_float(g[i][e] & 0xffff0000u);
      v[2 * e] *= g0 * __builtin_amdgcn_rcpf(1.f + __expf(-g0)); v[2 * e + 1] *= g1 * __builtin_amdgcn_rcpf(1.f + __expf(-g1)); }
    u32x4 w = {cvtpk(v[0], v[1]), cvtpk(v[2], v[3]), cvtpk(v[4], v[5]), cvtpk(v[6], v[7])};
    *reinterpret_cast<u32x4*>(obase + (size_t)row * DM + c16 * 8) = w; }
}
__device__ __forceinline__ void epi_merge(LAS unsigned char* st, const LAS float* cw, const bf16* __restrict__ p4, const bf16* __restrict__ p16,
                                          const bf16* __restrict__ gbase, bf16* __restrict__ obase, int lane) {
  typedef float f32x4_t __attribute__((ext_vector_type(4)));
  asm volatile("" : "+v"(lane));
  const int rr = lane >> 4, c16 = lane & 15;
#pragma unroll
  for (int hf = 0; hf < 2; ++hf) {
    u32x4 g[4], x4[4], x16[4];
#pragma unroll
    for (int i = 0; i < 4; ++i) { const int row = rr + 4 * (4 * hf + i);
      g[i] = *reinterpret_cast<const u32x4*>(gbase + (size_t)row * PLD + c16 * 8);
      x4[i] = *reinterpret_cast<const u32x4*>(p4 + (size_t)row * A_ROW + c16 * 8); x16[i] = *reinterpret_cast<const u32x4*>(p16 + (size_t)row * A_ROW + c16 * 8); }
#pragma unroll
    for (int i = 0; i < 4; ++i) { const int row = rr + 4 * (4 * hf + i);
      const f32x4_t a = *reinterpret_cast<const LAS f32x4_t*>(st + row * attc::EPI_PITCH + c16 * 32);
      const f32x4_t b = *reinterpret_cast<const LAS f32x4_t*>(st + row * attc::EPI_PITCH + c16 * 32 + 16);
      const float w4 = cw[row], w16 = cw[32 + row];
      float v[8] = {a[0], a[1], a[2], a[3], b[0], b[1], b[2], b[3]};
#pragma unroll
      for (int e = 0; e < 4; ++e) { const float g0 = __uint_as_float(g[i][e] << 16), g1 = __uint_as_float(g[i][e] & 0xffff0000u);
        v[2 * e]     = (v[2 * e]     + w4 * __uint_as_float(x4[i][e] << 16)         + w16 * __uint_as_float(x16[i][e] << 16))         * (g0 * __builtin_amdgcn_rcpf(1.f + __expf(-g0)));
        v[2 * e + 1] = (v[2 * e + 1] + w4 * __uint_as_float(x4[i][e] & 0xffff0000u) + w16 * __uint_as_float(x16[i][e] & 0xffff0000u)) * (g1 * __builtin_amdgcn_rcpf(1.f + __expf(-g1))); }
      u32x4 w = {cvtpk(v[0], v[1]), cvtpk(v[2], v[3]), cvtpk(v[4], v[5]), cvtpk(v[6], v[7])};
      *reinterpret_cast<u32x4*>(obase + (size_t)row * DM + c16 * 8) = w; }
    asm volatile("" ::: "memory"); }
}
struct Part { bf16* p4; bf16* p16; float* s4; float* s16; };
struct Next { bool has; int q0, qcol, kcol, vcol; };
template <int MODE>
__device__ __forceinline__ void wave_tile(const bf16* __restrict__ proj, bf16* __restrict__ obuf, const Part& part, int h, int q0, int qcol, int kcol, int vcol, int gcol, int ocol,
                                          float m_init, float l_init, LAS unsigned char* vlds, LAS float* xch, LAS float* lut, const float* __restrict__ lut_g, int lane,
                                          bf16x8 (&qr)[8], bf16x8 (&ks8)[8], bf16x8 (&vs)[8], bool pre, const Next nx) {
  constexpr int KS = MODE == P16 ? 16 : (MODE == P4 ? 4 : 1), W = MODE == MB ? 128 : 64, NTT = MODE == MB ? 9 : 5;
  const int r32 = lane & 31, hi = lane >> 5, vrow = lane >> 4, vch = lane & 15;
#define BAND_QLOAD(q0_, qcol_) do { const bf16* qp = proj + (size_t)((q0_) + KS * r32) * PLD + (qcol_) + hi * 8; \
    _Pragma("unroll") for (int d0 = 0; d0 < 8; ++d0) qr[d0] = *reinterpret_cast<const bf16x8*>(qp + d0 * 16); } while (0)
  if (!pre) BAND_QLOAD(q0, qcol);
  f32x16 o[4] = {}; float m_reg = m_init, l_reg = l_init;
  const int vb = (int)(uintptr_t)vlds + v_rd_base(lane);
  LAS unsigned char* klds = vlds + 8192;
  LAS unsigned char* vwr = vlds + (vch >> 2) * 512 + vrow * 64 + (vch & 3) * 16;
  LAS unsigned char* kwr = klds + vrow * KPITCH + vch * 16;
  const LAS unsigned char* krd = klds + r32 * KPITCH + hi * 16;
#define BAND_ISSUE(kt_, kcol, vcol) do { _Pragma("unroll") for (int i = 0; i < 8; ++i) { int tv = (kt_) + KS * (vrow + 4 * i); tv = tv < 0 ? 0 : (tv > S - 1 ? S - 1 : tv); \
        const bf16* rp = proj + (size_t)tv * PLD + vch * 8; ks8[i] = *reinterpret_cast<const bf16x8*>(rp + kcol); vs[i] = *reinterpret_cast<const bf16x8*>(rp + vcol); } } while (0)
  int kt = q0 - W * KS;
  if (!pre) BAND_ISSUE(kt, kcol, vcol);
  { constexpr int LN = MODE == MB ? LUTB_N : LUTA_N, LK = (LN + 63) / 64; float lv[LK];
#pragma unroll
    for (int k = 0; k < LK; ++k) { const int e = lane + 64 * k; lv[k] = lut_g[e < LN ? e : LN - 1]; }
#pragma unroll
    for (int k = 0; k < LK; ++k) { const int e = lane + 64 * k; if (e < LN) lut[e] = lv[k]; } }
#pragma nounroll
  for (int tt = 0; tt < NTT; ++tt) {
#pragma unroll
    for (int i = 0; i < 8; ++i) { *reinterpret_cast<LAS bf16x8*>(vwr + (i & 1) * 2048 + ((i >> 1) & 1) * 256 + ((i >> 2) & 1) * 4096) = vs[i];
                                  *reinterpret_cast<LAS bf16x8*>(kwr + i * 4 * KPITCH) = ks8[i]; }
    f32x16 p0 = {};
#pragma unroll
    for (int d0 = 0; d0 < 8; ++d0) { const bf16x8 kfr = *reinterpret_cast<const LAS bf16x8*>(krd + d0 * 32);
      p0 = __builtin_amdgcn_mfma_f32_32x32x16_bf16(kfr, qr[d0], p0, 0, 0, 0); }
    const int c_kt = kt; kt += 32 * KS;
    if (tt + 1 < NTT) BAND_ISSUE(kt, kcol, vcol);
    float tv[16];
    { int dl = -W + 32 * tt + 4 * hi - r32; dl = dl < -(W + 28) ? -(W + 28) : (dl > W + 1 ? W + 1 : dl);
      const LAS float* lp = lut + (dl + (W + 28));
#pragma unroll
      for (int r = 0; r < 16; ++r) tv[r] = fmaf(p0[r], QK_C, lp[(r & 3) + 8 * (r >> 2)]); }
    if (c_kt < 0 || c_kt + 31 * KS > S - 1) {
#pragma unroll
      for (int r = 0; r < 16; ++r) { const int tok = c_kt + KS * crow(r, hi); if (tok < 0 || tok > S - 1) tv[r] = -1e30f; } }
    float pmax = tv[0];
#pragma unroll
    for (int r = 1; r < 16; ++r) pmax = fmaxf(pmax, tv[r]);
    { auto rr = __builtin_amdgcn_permlane32_swap(__float_as_uint(pmax), __float_as_uint(pmax), false, false); pmax = fmaxf(__uint_as_float(rr[0]), __uint_as_float(rr[1])); }
    float alpha = 1.f;
    if (!__all(pmax - m_reg <= THR2)) { const float mn = fmaxf(m_reg, pmax); alpha = __builtin_amdgcn_exp2f(m_reg - mn); m_reg = mn; }
    float ps = 0.f;
#pragma unroll
    for (int r = 0; r < 16; ++r) { tv[r] = __builtin_amdgcn_exp2f(tv[r] - m_reg); ps += tv[r]; }
    { auto rr = __builtin_amdgcn_permlane32_swap(__float_as_uint(ps), __float_as_uint(ps), false, false); ps = __uint_as_float(rr[0]) + __uint_as_float(rr[1]); }
    l_reg = l_reg * alpha + ps;
    bf16x8 pa0, pa1;
#define PK4(P, BASE, OUT) do { unsigned a0 = cvtpk(P[BASE + 0], P[BASE + 1]), a1 = cvtpk(P[BASE + 2], P[BASE + 3]);   \
    unsigned b0 = cvtpk(P[BASE + 4], P[BASE + 5]), b1 = cvtpk(P[BASE + 6], P[BASE + 7]);                              \
    auto r0 = __builtin_amdgcn_permlane32_swap(a0, b0, false, false); auto r1 = __builtin_amdgcn_permlane32_swap(a1, b1, false, false); \
    u32x4 w = {r0[0], r1[0], r0[1], r1[1]}; OUT = *reinterpret_cast<bf16x8*>(&w); } while (0)
    PK4(tv, 0, pa0); PK4(tv, 8, pa1);
#undef PK4
    if (__any(alpha < 1.f)) { if (hi == 0) xch[r32] = alpha; asm volatile("s_waitcnt lgkmcnt(0)" ::: "memory");
#pragma unroll
      for (int d = 0; d < 4; ++d)
#pragma unroll
        for (int r = 0; r < 16; ++r) o[d][r] *= xch[crow(r, hi)]; }
    pv32<0>(o[0], vb, pa0, pa1); pv32<1>(o[1], vb, pa0, pa1); pv32<2>(o[2], vb, pa0, pa1); pv32<3>(o[3], vb, pa0, pa1);
  }
  float f = __builtin_amdgcn_rcpf(l_reg);
  if (MODE == P16 || MODE == P4) {
    if (hi == 0) { float* sp = (MODE == P16 ? part.s16 : part.s4) + ((size_t)(q0 + KS * r32) * A_H + h) * 2; sp[0] = m_reg; sp[1] = l_reg; } }
  if (MODE == P1) {
    const size_t si = ((size_t)(q0 + r32) * A_H + h) * 2;
    const float m4 = part.s4[si], l4 = part.s4[si + 1], m16 = part.s16[si], l16 = part.s16[si + 1];
    const float M = fmaxf(m_reg, fmaxf(m4, m16));
    const float e1 = __builtin_amdgcn_exp2f(m_reg - M), e4 = l4 * __builtin_amdgcn_exp2f(m4 - M), e16 = l16 * __builtin_amdgcn_exp2f(m16 - M);
    const float rden = __builtin_amdgcn_rcpf(l_reg * e1 + e4 + e16);
    f = e1 * rden;
    if (hi == 0) { xch[64 + r32] = e4 * rden; xch[96 + r32] = e16 * rden; } }
  if (hi == 0) xch[32 + r32] = f; asm volatile("s_waitcnt lgkmcnt(0)" ::: "memory");
  float rli[16];
#pragma unroll
  for (int r = 0; r < 16; ++r) rli[r] = xch[32 + crow(r, hi)];
  u32x4 gpre[8];
  if (MODE == MB) {
    int vr2 = vrow; asm volatile("" : "+v"(vr2));
    const bf16* gb = proj + (size_t)q0 * PLD + gcol + vch * 8;
#pragma unroll
    for (int i = 0; i < 8; ++i) gpre[i] = *reinterpret_cast<const u32x4*>(gb + (size_t)(vr2 + 4 * i) * PLD); }
  epi_stage(o, rli, vlds, lane);
  if (nx.has) { BAND_QLOAD(nx.q0, nx.qcol); BAND_ISSUE(nx.q0 - W * KS, nx.kcol, nx.vcol); }
  if (MODE == P16) epi_partial_out<KS>(vlds, part.p16 + (size_t)q0 * A_ROW + h * HD, lane);
  else if (MODE == P4) epi_partial_out<KS>(vlds, part.p4 + (size_t)q0 * A_ROW + h * HD, lane);
  else if (MODE == P1) epi_merge(vlds, xch + 64, part.p4 + (size_t)q0 * A_ROW + h * HD, part.p16 + (size_t)q0 * A_ROW + h * HD, proj + (size_t)q0 * PLD + gcol, obuf + (size_t)q0 * DM + ocol, lane);
  else epi_gate_out(vlds, gpre, obuf + (size_t)q0 * DM + ocol, lane);
#undef BAND_ISSUE
#undef BAND_QLOAD
}
}

__device__ __forceinline__ void band_phase(const Args& a, LAS unsigned char* lds, int layer, int pass, int wave, int vcu, int G) {
    const int lane = fresh_lane();
    const bf16* proj = (const bf16*)(a.ws + WS_PROJ); bf16* o = (bf16*)(a.ws + WS_O); const float* tab = (const float*)(a.ws + WS_TAB);
    band::Part part; part.p4 = (bf16*)(a.ws + WS_PART4); part.p16 = (bf16*)(a.ws + WS_PART16); part.s4 = (float*)(a.ws + WS_STAT4); part.s16 = (float*)(a.ws + WS_STAT16);
    LAS unsigned char* vlds = lds + wave * band::WAVE_LDS; LAS float* xch = (LAS float*)(lds + BAND_LUT_OFF + wave * BAND_LUT_WAVE); LAS float* lut = xch + 128;
    typedef band::bf16x8 bf16x8;
    if (pass == 0) {
        { bool pre = false; bf16x8 qr[8], ks8[8], vs[8];
          for (int ua = vcu; ua < A_H * 64; ua += G) {
            const int h = ua / 64, rem = ua % 64, u = rem >> 1, r = (rem & 1) * 8 + wave;
            const int un = ua + G; band::Next nx; nx.has = un < A_H * 64; { const int h2 = un / 64, rem2 = un % 64; nx.q0 = 512 * (rem2 >> 1) + (rem2 & 1) * 8 + wave; nx.qcol = PC(COL_AQ + h2 * HD); nx.kcol = PC(COL_AK + h2 * HD); nx.vcol = PC(COL_AV + h2 * HD); }
            const float* lut_g = tab + TB_LUTA + (h * 3 + 2) * LUTA_N;
            band::wave_tile<band::P16>(proj, o, part, h, 512 * u + r, PC(COL_AQ + h * HD), PC(COL_AK + h * HD), PC(COL_AV + h * HD), PC(COL_AG + h * HD), OCOL_A + h * HD, -1e20f, 0.f, vlds, xch, lut, lut_g, lane, qr, ks8, vs, pre, nx);
            pre = nx.has; } }
        { bool pre = false; bf16x8 qr[8], ks8[8], vs[8];
          for (int ua = vcu; ua < A_H * 64; ua += G) {
            const int h = ua / 64, b = ua % 64;
            const int un = ua + G; band::Next nx; nx.has = un < A_H * 64; { const int h2 = un / 64, b2 = un % 64; nx.q0 = 256 * b2 + 128 * (wave >> 2) + (wave & 3); nx.qcol = PC(COL_AQ + h2 * HD); nx.kcol = PC(COL_AK + h2 * HD); nx.vcol = PC(COL_AV + h2 * HD); }
            const float* lut_g = tab + TB_LUTA + (h * 3 + 1) * LUTA_N;
            band::wave_tile<band::P4>(proj, o, part, h, 256 * b + 128 * (wave >> 2) + (wave & 3), PC(COL_AQ + h * HD), PC(COL_AK + h * HD), PC(COL_AV + h * HD), PC(COL_AG + h * HD), OCOL_A + h * HD, -1e20f, 0.f, vlds, xch, lut, lut_g, lane, qr, ks8, vs, pre, nx);
            pre = nx.has; } }
        const float* sink = a.in[10] + layer * B_H;
        { bool pre = false; bf16x8 qr[8], ks8[8], vs[8];
          for (int ub = vcu; ub < B_H * 64; ub += G) {
            const int kv = ub / 256, rem = ub % 256, qblk = rem >> 2, h = kv * 4 + (rem & 3);
            const int un = ub + G; band::Next nx; nx.has = un < B_H * 64; { const int kv2 = un / 256, rem2 = un % 256, h2 = kv2 * 4 + (rem2 & 3); nx.q0 = (rem2 >> 2) * 256 + wave * 32; nx.qcol = PC(COL_BQ + h2 * HD); nx.kcol = PC(COL_BK + kv2 * HD); nx.vcol = PC(COL_BV + kv2 * HD); }
            const float* lut_g = tab + TB_LUTB + h * LUTB_N;
            band::wave_tile<band::MB>(proj, o, part, h, qblk * 256 + wave * 32, PC(COL_BQ + h * HD), PC(COL_BK + kv * HD), PC(COL_BV + kv * HD), PC(COL_BG + h * HD), OCOL_B + h * HD, sink[h] * LOG2E, 1.f, vlds, xch, lut, lut_g, lane, qr, ks8, vs, pre, nx);
            pre = nx.has; } }
    } else {
        band::Next nx; nx.has = false; nx.q0 = 0; nx.qcol = 0; nx.kcol = 0; nx.vcol = 0;
        for (int ua = vcu; ua < A_H * 64; ua += G) {
            bf16x8 qr[8], ks8[8], vs[8];
            const int h = ua / 64, b = ua % 64;
            const float* lut_g = tab + TB_LUTA + (h * 3 + 0) * LUTA_N;
            band::wave_tile<band::P1>(proj, o, part, h, 256 * b + 32 * wave, PC(COL_AQ + h * HD), PC(COL_AK + h * HD), PC(COL_AV + h * HD), PC(COL_AG + h * HD), OCOL_A + h * HD, -1e20f, 0.f, vlds, xch, lut, lut_g, lane, qr, ks8, vs, false, nx);
        }
    }
}

__global__ void __launch_bounds__(NWAVES * 64, 2) fwd_kernel(Args args) {
    extern __shared__ __attribute__((aligned(16))) unsigned char lds_raw[];
    LAS unsigned char* lds = (LAS unsigned char*)lds_raw;
    volatile LAS unsigned* MISC = (volatile LAS unsigned*)(lds + MISC_OFF);
    const int wave = __builtin_amdgcn_readfirstlane((int)threadIdx.x >> 6);
    const int G = gridDim.x; const int bx = blockIdx.x; const int vcu = (G % 8 == 0) ? (bx % 8) * (G / 8) + bx / 8 : bx;
    gu32* ctl = (gu32*)(args.ws + WS_CTL);
    for (int u = threadIdx.x; u < (LDS_BYTES - LDSCTL_OFF) / 4; u += NWAVES * 64) ((LAS unsigned*)(lds + LDSCTL_OFF))[u] = 0u;
    __syncthreads();
    XcdBarrier bar = xcd_barrier_post((unsigned*)(ctl + CW_BAR), MISC + 8, (unsigned)wave);
    const bf16* Win_t = (const bf16*)(args.ws + WS_WIN); const bf16* Wout_t = (const bf16*)(args.ws + WS_WOUT);
    bf16* Hb = (bf16*)(args.ws + WS_H); bf16* PROJ = (bf16*)(args.ws + WS_PROJ); bf16* Ob = (bf16*)(args.ws + WS_O); bf16* Yb = (bf16*)(args.ws + WS_Y);

    p0_prologue(args, lds, wave, vcu, G);
    xcd_barrier(bar);
    norm_phase(args, lds, -1, 0, args.in[0], wave, vcu, G);
    w8_phase(args, wave, vcu, G);
    xcd_barrier(bar);

#pragma nounroll
    for (int layer = 0; layer < DEPTH; ++layer) {
#ifndef REP_G1
#define REP_G1 1
#endif
        for (int rep = 0; rep < REP_G1; ++rep)
        {
          pg8::Gemm g{Hb, Win_t + (size_t)layer * INW * DM, S, F8_COL0, DM}; pg8::StaticOrder so; so.init(S, F8_COL0, G, bx);
          pg8::EpiStoreT E{PROJ, (size_t)S * 256};
          const int whole = (so.nwg / G) * G, rest = so.nwg - whole; const bool halves = (2 * rest == G);
          if (halves) so.lim = whole;
          pg8::gemm_phase<pg8::EpiStoreT, pg8::StaticOrder, true, true>(lds + RING_OFF, g, so, E, wave);
          if (halves) { pg8::HalfOrder ho; ho.base = so; ho.first = whole;
              pg8::gemm_phase<pg8::EpiStoreT, pg8::HalfOrder, true, true, true>(lds + RING_OFF, g, ho, E, wave); }
          pg8::Gemm g8{(const pg8::bf16_t*)(args.ws + WS_H8), (const pg8::bf16_t*)(args.ws + WS_W8 + (size_t)layer * F8_COLS * DM), S, F8_COLS, DM / 2}; pg8::StaticOrder s8; s8.init(S, F8_COLS, G, bx);
          pg8::EpiStoreT E8{PROJ + (size_t)(F8_COL0 / 256) * S * 256, (size_t)S * 256};
          const int sclb = 127 - w8_exp(args, layer);
          const int whole8 = (s8.nwg / G) * G, rest8 = s8.nwg - whole8; const bool halves8 = (2 * rest8 == G);
          if (halves8) s8.lim = whole8;
          pg8::gemm_phase<pg8::EpiStoreT, pg8::StaticOrder, true, true, false, true>(lds + RING_OFF, g8, s8, E8, wave, sclb);
          if (halves8) { pg8::HalfOrder h8; h8.base = s8; h8.first = whole8;
              pg8::gemm_phase<pg8::EpiStoreT, pg8::HalfOrder, true, true, true, true>(lds + RING_OFF, g8, h8, E8, wave, sclb); } }
        xcd_barrier(bar);
        prep_phase(args, lds, layer, wave, vcu, G);
        __syncthreads();
        band_phase(args, lds, layer, 0, wave, vcu, G);
        xcd_barrier(bar);
#ifndef REP_C
#define REP_C 1
#endif
        for (int rep = 0; rep < REP_C; ++rep)
        for (int i = 0;; ++i) {
            const int u = i * G + vcu; if (u >= C_H * (S / 256)) break;
            const int gq = u / 256, rem = u % 256, kv = rem / 64, qb = rem % 64, head = kv * 3 + gq;
#if defined(ATT_PP)
#ifdef QK_FP4
            attc::attn_f8pp_body((const unsigned char*)(args.ws + WS_QF8) + (size_t)(qb * 256) * attc::LDQ4 + head * 64,
#else
            attc::attn_f8pp_body((const unsigned char*)(args.ws + WS_QF8) + (size_t)(qb * 256) * (C_H * HD) + head * HD,
#endif
 (const unsigned char*)(args.ws + WS_KF8) + (size_t)kv * (S / 64) * attc::PP_TIMG,
                                 PROJ + (size_t)(qb * 256) * PLD + PC(COL_CG + head * HD), Ob + (size_t)(qb * 256) * DM + OCOL_C + head * HD, S, (char*)lds_raw + RING_OFF, wave);
#elif defined(ATT_F8)
            attc::attn_f8_body((const unsigned char*)(args.ws + WS_QF8) + (size_t)(qb * 256) * (C_H * HD) + head * HD, (const unsigned char*)(args.ws + WS_KF8) + kv * HD,
                               (const unsigned char*)(args.ws + WS_VTF8) + (size_t)kv * HD * S,
                               PROJ + (size_t)(qb * 256) * PLD + PC(COL_CG + head * HD), Ob + (size_t)(qb * 256) * DM + OCOL_C + head * HD, S, (char*)lds_raw + RING_OFF, wave);
#else
            attc::attn_dense_body(PROJ + (size_t)(qb * 256) * INW + COL_CQ + head * HD, PROJ + COL_CK + kv * HD, PROJ + COL_CV + kv * HD,
                                  PROJ + (size_t)(qb * 256) * PLD + PC(COL_CG + head * HD), Ob + (size_t)(qb * 256) * DM + OCOL_C + head * HD, S, (char*)lds_raw + RING_OFF, wave);
#endif
        }
        band_phase(args, lds, layer, 1, wave, vcu, G);
        xcd_barrier(bar);
#ifndef REP_G2
#define REP_G2 1
#endif
        for (int rep = 0; rep < REP_G2; ++rep)
        { pg8::Gemm g{Ob, Wout_t + (size_t)layer * DM * DM, S, DM, DM}; pg8::StaticOrder so; so.init(S, DM, G, bx);
          pg8::EpiStore E{Yb, DM};
          pg8::gemm_phase<pg8::EpiStore, pg8::StaticOrder, true, true>(lds + RING_OFF, g, so, E, wave); }
        xcd_barrier(bar);
#ifdef REP_NORM
        norm_phase(args, lds, layer, layer + 1 < DEPTH ? layer + 1 : -1, layer == 0 ? args.in[0] : (const float*)args.out, wave, vcu, G, true);
#endif
        norm_phase(args, lds, layer, layer + 1 < DEPTH ? layer + 1 : -1, layer == 0 ? args.in[0] : (const float*)args.out, wave, vcu, G);
        if (layer + 1 < DEPTH) xcd_barrier(bar);
    }
}

extern "C" void kernel_launch(void* const* d_in, const int* in_sizes, int n_in, void* d_out, int out_size, void* d_ws, size_t ws_size, hipStream_t stream) {
    static int grid = 0;
    if (grid == 0) {
        if (n_in != 12 || in_sizes[0] != S * DM || out_size != S * DM || ws_size < WS_END) {
            fprintf(stderr, "kernel_launch: shape mismatch: n_in %d in0 %d out %d ws %zu (need >= %zu); nothing launched\n", n_in, n_in > 0 ? in_sizes[0] : -1, out_size, ws_size, (size_t)WS_END); grid = -1; return; }
        int dev = 0, cus = 0, per_cu = 0;
        if (hipGetDevice(&dev) != hipSuccess || hipDeviceGetAttribute(&cus, hipDeviceAttributeMultiprocessorCount, dev) != hipSuccess) { fprintf(stderr, "kernel_launch: device query failed\n"); grid = -1; return; }
        if (hipFuncSetAttribute((const void*)fwd_kernel, hipFuncAttributeMaxDynamicSharedMemorySize, LDS_BYTES) != hipSuccess) { fprintf(stderr, "kernel_launch: hipFuncSetAttribute failed\n"); grid = -1; return; }
        if (hipOccupancyMaxActiveBlocksPerMultiprocessor(&per_cu, (const void*)fwd_kernel, NWAVES * 64, LDS_BYTES) != hipSuccess || per_cu < 1)
            fprintf(stderr, "kernel_launch: note: occupancy query reports %d workgroups per CU\n", per_cu);
        (void)hipGetLastError();
        grid = cus;
    }
    if (grid < 0) return;
    if (hipMemsetAsync((char*)d_ws + WS_CTL, 0, CTL_ZERO_BYTES, stream) != hipSuccess) { fprintf(stderr, "kernel_launch: memset failed\n"); return; }
    Args a{};
    for (int i = 0; i < 12; ++i) a.in[i] = (const float*)d_in[i];
    a.out = (float*)d_out; a.ws = (unsigned char*)d_ws;
    hipLaunchKernelGGL(fwd_kernel, dim3(grid), dim3(NWAVES * 64), LDS_BYTES, stream, a);
    const hipError_t le = hipPeekAtLastError();
    if (le != hipSuccess) fprintf(stderr, "kernel_launch: launch failed: %s\n", hipGetErrorName(le));
}
```

```cpp
#define ATT_F8 1
#define ATT_PP 1
#define QK_FP4 1
#include <hip/hip_runtime.h>
#include <hip/hip_bf16.h>
#include <cstdio>
#include <cstdint>
#include <cmath>

namespace pg8 {
#define PG8_LAS __attribute__((address_space(3)))
typedef unsigned short bf16_t;
typedef short bf16x8 __attribute__((ext_vector_type(8)));
typedef float f32x4 __attribute__((ext_vector_type(4)));
typedef unsigned u32x4 __attribute__((ext_vector_type(4)));
constexpr int BM = 256, BK = 64, HALF = 128, HTB = HALF * BK * 2  , STAGE_BYTES = 8 * HTB, NXCD = 8, WGM = 8;

__host__ __device__ __forceinline__ int lds_byte(int r, int c) { const int st = (r >> 4) * 2 + (c >> 5), rr = r & 15, cc = c & 31, ob = rr * 64 + cc * 2; return st * 1024 + (ob ^ (((ob >> 9) & 1) << 5)); }
__host__ __device__ __forceinline__ void stage_rc(int b, int& R, int& C) { const int st = b / 1024, sb = b % 1024, swz = sb ^ (((sb >> 9) & 1) << 5); R = (st >> 1) * 16 + swz / 64; C = (st & 1) * 32 + (swz % 64) / 2; }
__host__ __device__ __forceinline__ int perm32(int rho) { const int n = rho >> 4, i = rho & 15; return 8 * (i >> 2) + 4 * n + (i & 3); }

struct Unit { int pm, pn, hm; };
struct Gemm { const bf16_t* A; const bf16_t* Bt; int M, N, K; };

struct StaticOrder {
    int nM, nN, nwg, G, c, lim;
    __host__ __device__ void init(int M, int N, int G_, int c_) { nM = M / BM; nN = N / BM; nwg = nM * nN; G = G_; c = c_; lim = nwg; }
    __host__ __device__ void map(int wgid, Unit& u) const {
        { const int q = nwg / NXCD, r = nwg % NXCD, xcd = wgid % NXCD, off = wgid / NXCD; wgid = (xcd < r ? xcd * (q + 1) : r * (q + 1) + (xcd - r) * q) + off; }
        const int nig = WGM * nN, gid = wgid / nig, fm = gid * WGM, gsz = (nM - fm) < WGM ? (nM - fm) : WGM;
        u.pm = fm + ((wgid % nig) % gsz); u.pn = (wgid % nig) / gsz; u.hm = 0;
    }
    __host__ __device__ bool next(int i, Unit& u) const {
        const long L = (long)i * G + c; if (L >= lim) return false;
        map((int)L, u); return true;
    }
    __device__ __forceinline__ void a_ready(const Unit&) const {}
    __device__ __forceinline__ void done(const Unit&) const {}
};
struct HalfOrder {
    StaticOrder base; int first;
    __host__ __device__ bool next(int i, Unit& u) const { if (i > 0) return false; base.map(first + (base.c >> 1), u); u.hm = (base.c & 1) ? 1 : 2; return true; }
    __device__ __forceinline__ void a_ready(const Unit&) const {}
    __device__ __forceinline__ void done(const Unit&) const {}
};

__device__ __forceinline__ unsigned cvt_pk_bf16(float lo, float hi) { unsigned r; asm volatile("v_cvt_pk_bf16_f32 %0, %1, %2" : "=v"(r) : "v"(lo), "v"(hi)); return r; }
struct EpiStore {
    static constexpr bool PERM = true, AFTER_DRAIN = false;
    bf16_t* O; int ldc;
    __device__ __forceinline__ void operator()(const f32x4 (&acc)[2][2][4][2], const Unit& u, int wr, int wc, int fr, int fq) const {
        const int row0 = u.pm * BM + wr * 64 + fr; const int col0 = u.pn * BM + wc * 32 + 8 * fq;
#pragma unroll
        for (int ai = 0; ai < 2; ++ai)
#pragma unroll
            for (int m = 0; m < 4; ++m) { bf16_t* rowp = O + (size_t)(row0 + ai * HALF + m * 16) * ldc + col0;
#pragma unroll
                for (int bj = 0; bj < 2; ++bj) { if (u.hm & (1 << bj)) continue; const f32x4 v0 = acc[ai][bj][m][0], v1 = acc[ai][bj][m][1];
                    u32x4 w; w.x = cvt_pk_bf16(v0[0], v0[1]); w.y = cvt_pk_bf16(v0[2], v0[3]); w.z = cvt_pk_bf16(v1[0], v1[1]); w.w = cvt_pk_bf16(v1[2], v1[3]);
                    *(u32x4*)(rowp + bj * HALF) = w; } }
    }
    __device__ __forceinline__ void fused(f32x4 (&acc)[2][2][4][2], const Unit& u, int wr, int wc, int fr, int fq, PG8_LAS unsigned char* lds, int wid, int lane) const {}
};

struct EpiStoreT {
    static constexpr bool PERM = true, AFTER_DRAIN = false;
    bf16_t* O; size_t tstride;
    __device__ __forceinline__ void operator()(const f32x4 (&acc)[2][2][4][2], const Unit& u, int wr, int wc, int fr, int fq) const {
        const int row0 = u.pm * BM + wr * 64 + fr; bf16_t* Ot = O + (size_t)u.pn * tstride + wc * 32 + 8 * fq;
#pragma unroll
        for (int ai = 0; ai < 2; ++ai)
#pragma unroll
            for (int m = 0; m < 4; ++m) { bf16_t* rowp = Ot + (size_t)(row0 + ai * HALF + m * 16) * BM;
#pragma unroll
                for (int bj = 0; bj < 2; ++bj) { if (u.hm & (1 << bj)) continue; const f32x4 v0 = acc[ai][bj][m][0], v1 = acc[ai][bj][m][1];
                    u32x4 w; w.x = cvt_pk_bf16(v0[0], v0[1]); w.y = cvt_pk_bf16(v0[2], v0[3]); w.z = cvt_pk_bf16(v1[0], v1[1]); w.w = cvt_pk_bf16(v1[2], v1[3]);
                    *(u32x4*)(rowp + bj * HALF) = w; } }
    }
    __device__ __forceinline__ void fused(f32x4 (&acc)[2][2][4][2], const Unit& u, int wr, int wc, int fr, int fq, PG8_LAS unsigned char* lds, int wid, int lane) const {}
};

template <class Epi, class Sched, bool ALIGN_EPI = false, bool SP2 = false, bool HALFU = false, bool FP8 = false>
__device__ __forceinline__ void gemm_phase(PG8_LAS unsigned char* lds, const Gemm g, const Sched& S, const Epi& E, const int wid_in, const int sclb = 127) {
    typedef int i32x4_ __attribute__((ext_vector_type(4))); typedef int i32x8_ __attribute__((ext_vector_type(8)));
    const int scl2 = 127 | (sclb << 8);
    int wid = wid_in; asm volatile("" : "+s"(wid));
    int lane_l; asm volatile("v_mbcnt_lo_u32_b32 %0, -1, 0\n\tv_mbcnt_hi_u32_b32 %0, -1, %0" : "=v"(lane_l));
    const int lane = lane_l, tid = wid * 64 + lane, wr = wid >> 2, wc = wid & 3, fr = lane & 15, fq = lane >> 4;
    const int K = g.K, nt = K / BK;
    unsigned voffA[2], voffB[2];
#pragma unroll
    for (int i = 0; i < 2; ++i) { int R, C; stage_rc(tid * 16 + i * 8192, R, C); const int Rb = Epi::PERM ? ((R & ~31) + perm32(R & 31)) : R;
        voffA[i] = (unsigned)(R * K + C) * 2u; voffB[i] = (unsigned)(Rb * K + C) * 2u; }
    const size_t kstep = (size_t)(BK * 2);
    const size_t hstep = (size_t)HALF * K * 2;
    const size_t tstep = 2 * hstep;
    const unsigned ldsw = (unsigned)wid * 1024u;
    const int aoff = lds_byte(wr * 64 + fr, fq * 8), boff = lds_byte(wc * 32 + fr, fq * 8);
#define PG8_SA(b, h) (((b) * 2 + (h)) * HTB)
#define PG8_SB(b, h) ((4 + (b) * 2 + (h)) * HTB)
#define PG8_STAGE(bufoff, gbase, voff) do { _Pragma("unroll") for (int _i = 0; _i < 2; ++_i) \
        __builtin_amdgcn_global_load_lds((const unsigned*)((const char*)(gbase) + (voff)[_i]), (PG8_LAS unsigned*)(lds + (bufoff) + ldsw + _i * 8192), 16, 0, 0); } while (0)
#define PG8_LDA(dst, b, h) do { _Pragma("unroll") for (int m = 0; m < 4; ++m) { \
        if constexpr (FP8) { const i32x4_ l_ = *(const PG8_LAS i32x4_*)(lds + PG8_SA(b, h) + aoff + m * 2048), h_ = *(const PG8_LAS i32x4_*)(lds + PG8_SA(b, h) + aoff + m * 2048 + 1024); \
                             dst##8[m] = (i32x8_){l_[0], l_[1], l_[2], l_[3], h_[0], h_[1], h_[2], h_[3]}; } \
        else { _Pragma("unroll") for (int k = 0; k < 2; ++k) dst[m][k] = *(const PG8_LAS bf16x8*)(lds + PG8_SA(b, h) + aoff + m * 2048 + k * 1024); } } } while (0)
#define PG8_LDB(dst, b, h) do { _Pragma("unroll") for (int n = 0; n < 2; ++n) { \
        if constexpr (FP8) { const i32x4_ l_ = *(const PG8_LAS i32x4_*)(lds + PG8_SB(b, h) + boff + n * 2048), h_ = *(const PG8_LAS i32x4_*)(lds + PG8_SB(b, h) + boff + n * 2048 + 1024); \
                             dst##8[n] = (i32x8_){l_[0], l_[1], l_[2], l_[3], h_[0], h_[1], h_[2], h_[3]}; } \
        else { _Pragma("unroll") for (int k = 0; k < 2; ++k) dst[n][k] = *(const PG8_LAS bf16x8*)(lds + PG8_SB(b, h) + boff + n * 2048 + k * 1024); } } } while (0)
#define PG8_MMA(ai, bj, At, Bt) do { if (HALFU && (cur.hm & (1 << (bj)))) break; __builtin_amdgcn_s_setprio(1); \
        if constexpr (FP8) { _Pragma("unroll") for (int m = 0; m < 4; ++m) _Pragma("unroll") for (int n = 0; n < 2; ++n) \
            asm volatile("v_mfma_scale_f32_16x16x128_f8f6f4 %0, %1, %2, %0, %3, %3 op_sel:[1,0,0] op_sel_hi:[0,0,0]" : "+v"(acc[ai][bj][m][n]) : "v"(Bt##8[n]), "v"(At##8[m]), "v"(scl2)); } \
        else { _Pragma("unroll") for (int m = 0; m < 4; ++m) _Pragma("unroll") for (int n = 0; n < 2; ++n) _Pragma("unroll") for (int k = 0; k < 2; ++k) \
            acc[ai][bj][m][n] = __builtin_amdgcn_mfma_f32_16x16x32_bf16(Bt[n][k], At[m][k], acc[ai][bj][m][n], 0, 0, 0); } \
        __builtin_amdgcn_s_setprio(0); } while (0)
#define PG8_WAIT_V(n) asm volatile("s_waitcnt vmcnt(" #n ")" ::: "memory")
#define PG8_WAIT_L(n) asm volatile("s_waitcnt lgkmcnt(" #n ")" ::: "memory")
#define PG8_BAR __builtin_amdgcn_s_barrier()
#define PG8_SCHED __builtin_amdgcn_sched_barrier(0)
    Unit cur, nxt; int ui = 0;
    if (!S.next(0, cur)) return;
    f32x4 acc[2][2][4][2];
#pragma unroll
    for (int a = 0; a < 2; ++a)
#pragma unroll
        for (int b = 0; b < 2; ++b)
#pragma unroll
            for (int m = 0; m < 4; ++m)
#pragma unroll
                for (int n = 0; n < 2; ++n) acc[a][b][m][n] = (f32x4){0.f, 0.f, 0.f, 0.f};
    bf16x8 At[4][2], B0[2][2], B1[2][2]; i32x8_ At8[4], B08[2], B18[2];
    const char* cA = (const char*)g.A + (size_t)cur.pm * tstep; const char* cB = (const char*)g.Bt + (size_t)cur.pn * tstep;
    S.a_ready(cur);
    if constexpr (SP2) {
        PG8_STAGE(PG8_SB(0, 0), cB, voffB); PG8_STAGE(PG8_SB(0, 1), cB + hstep, voffB); PG8_STAGE(PG8_SA(0, 0), cA, voffA); PG8_STAGE(PG8_SA(0, 1), cA + hstep, voffA);
        if (wr == 1) PG8_BAR;
        PG8_WAIT_V(2); PG8_BAR;
        PG8_STAGE(PG8_SB(1, 0), cB + kstep, voffB); PG8_STAGE(PG8_SA(1, 0), cA + kstep, voffA); PG8_STAGE(PG8_SB(1, 1), cB + hstep + kstep, voffB);
        PG8_WAIT_V(6); PG8_BAR;
    } else {
        PG8_STAGE(PG8_SB(0, 0), cB, voffB); PG8_STAGE(PG8_SA(0, 0), cA, voffA); PG8_STAGE(PG8_SB(0, 1), cB + hstep, voffB); PG8_STAGE(PG8_SA(0, 1), cA + hstep, voffA);
        if (wr == 1) PG8_BAR;
        PG8_WAIT_V(4); PG8_BAR;
        PG8_STAGE(PG8_SB(1, 0), cB + kstep, voffB); PG8_STAGE(PG8_SA(1, 0), cA + kstep, voffA); PG8_STAGE(PG8_SB(1, 1), cB + hstep + kstep, voffB);
        PG8_WAIT_V(6); PG8_BAR;
    }
    for (;;) {
        const bool has_next = S.next(ui + 1, nxt);
        const char* nA = has_next ? (const char*)g.A + (size_t)nxt.pm * tstep : cA; const char* nB = has_next ? (const char*)g.Bt + (size_t)nxt.pn * tstep : cB;
        for (int t = 0; t < nt; t += 2) {
            const bool last = (t == nt - 2);
            const char* a1 = cA + (size_t)(t + 1) * kstep;
            const char* a2 = last ? nA : cA + (size_t)(t + 2) * kstep; const char* b2 = last ? nB : cB + (size_t)(t + 2) * kstep;
            const char* a3 = a2 + kstep; const char* b3 = b2 + kstep;
            if (last && has_next) S.a_ready(nxt);
            if constexpr (SP2) {
            PG8_LDB(B0, 0, 0); PG8_LDB(B1, 0, 1); PG8_SCHED; PG8_LDA(At, 0, 0); PG8_STAGE(PG8_SA(1, 1), a1 + hstep, voffA);
            PG8_WAIT_V(8); PG8_WAIT_L(0); PG8_BAR; PG8_MMA(0, 0, At, B0); PG8_MMA(0, 1, At, B1); PG8_BAR; PG8_SCHED;
            PG8_LDA(At, 0, 1); PG8_STAGE(PG8_SB(0, 0), b2, voffB); PG8_STAGE(PG8_SB(0, 1), b2 + hstep, voffB); PG8_STAGE(PG8_SA(0, 0), a2, voffA);
            PG8_WAIT_V(8); PG8_WAIT_L(0); PG8_BAR; PG8_MMA(1, 0, At, B0); PG8_MMA(1, 1, At, B1); PG8_BAR; PG8_SCHED;
            PG8_LDB(B0, 1, 0); PG8_LDB(B1, 1, 1); PG8_SCHED; PG8_LDA(At, 1, 0); PG8_STAGE(PG8_SA(0, 1), a2 + hstep, voffA);
            PG8_WAIT_V(8); PG8_WAIT_L(0); PG8_BAR; PG8_MMA(0, 0, At, B0); PG8_MMA(0, 1, At, B1); PG8_BAR; PG8_SCHED;
            PG8_LDA(At, 1, 1); PG8_STAGE(PG8_SB(1, 0), b3, voffB); PG8_STAGE(PG8_SB(1, 1), b3 + hstep, voffB); PG8_STAGE(PG8_SA(1, 0), a3, voffA);
            PG8_WAIT_V(8); PG8_WAIT_L(0); PG8_BAR; PG8_MMA(1, 0, At, B0); PG8_MMA(1, 1, At, B1); PG8_BAR; PG8_SCHED;
            } else {
            PG8_LDB(B0, 0, 0); PG8_SCHED; PG8_LDA(At, 0, 0); PG8_STAGE(PG8_SA(1, 1), a1 + hstep, voffA);
            PG8_WAIT_L(8); PG8_BAR; PG8_WAIT_L(0); PG8_MMA(0, 0, At, B0); PG8_BAR; PG8_SCHED;
            PG8_LDB(B1, 0, 1); PG8_STAGE(PG8_SB(0, 0), b2, voffB);
            PG8_BAR; PG8_WAIT_L(0); PG8_MMA(0, 1, At, B1); PG8_BAR;
            PG8_LDA(At, 0, 1); PG8_STAGE(PG8_SA(0, 0), a2, voffA);
            PG8_BAR; PG8_WAIT_L(0); PG8_MMA(1, 0, At, B0); PG8_BAR; PG8_SCHED;
            PG8_STAGE(PG8_SB(0, 1), b2 + hstep, voffB);
            PG8_WAIT_V(6); PG8_BAR; PG8_MMA(1, 1, At, B1); PG8_BAR;
            PG8_LDB(B0, 1, 0); PG8_SCHED; PG8_LDA(At, 1, 0); PG8_STAGE(PG8_SA(0, 1), a2 + hstep, voffA);
            PG8_WAIT_L(8); PG8_BAR; PG8_WAIT_L(0); PG8_MMA(0, 0, At, B0); PG8_BAR; PG8_SCHED;
            PG8_LDB(B1, 1, 1); PG8_STAGE(PG8_SB(1, 0), b3, voffB);
            PG8_BAR; PG8_WAIT_L(0); PG8_MMA(0, 1, At, B1); PG8_BAR;
            PG8_LDA(At, 1, 1); PG8_STAGE(PG8_SA(1, 0), a3, voffA);
            PG8_BAR; PG8_WAIT_L(0); PG8_MMA(1, 0, At, B0); PG8_BAR; PG8_SCHED;
            PG8_STAGE(PG8_SB(1, 1), b3 + hstep, voffB);
            PG8_WAIT_V(6); PG8_BAR; PG8_MMA(1, 1, At, B1); PG8_BAR;
            }
        }
        if constexpr (ALIGN_EPI) { if (wr == 0) PG8_BAR; }
        if constexpr (!Epi::AFTER_DRAIN) { E(acc, cur, wr, wc, fr, fq); S.done(cur); }
        if (!has_next) break;
#pragma unroll
        for (int a = 0; a < 2; ++a)
#pragma unroll
            for (int b = 0; b < 2; ++b)
#pragma unroll
                for (int m = 0; m < 4; ++m)
#pragma unroll
                    for (int n = 0; n < 2; ++n) acc[a][b][m][n] = (f32x4){0.f, 0.f, 0.f, 0.f};
        cur = nxt; cA = nA; cB = nB; ++ui;
        if constexpr (ALIGN_EPI) { if (wr == 1) PG8_BAR; }
    }
    PG8_WAIT_V(0);
    if constexpr (!ALIGN_EPI) { if (wr == 0) PG8_BAR; }
    PG8_BAR;
    if constexpr (Epi::AFTER_DRAIN) { E.fused(acc, cur, wr, wc, fr, fq, lds, wid, lane); S.done(cur); }
#undef PG8_SA
#undef PG8_SB
#undef PG8_STAGE
#undef PG8_LDA
#undef PG8_LDB
#undef PG8_MMA
#undef PG8_WAIT_V
#undef PG8_WAIT_L
#undef PG8_BAR
#undef PG8_SCHED
}
}
typedef unsigned short bf16;
typedef pg8::bf16_t bf16_t;
typedef unsigned u32x2 __attribute__((ext_vector_type(2)));
constexpr int S = 16384, DM = 4096, DEPTH = 4, HD = 128, INW = 12800, NMOD = 3 * DM;
constexpr int A_H = 12, B_H = 8, C_H = 12;
constexpr int COL_AK = 0, COL_AV = 1536, COL_AG = 3072, COL_BQ = 4608, COL_BK = 5632, COL_BV = 5888, COL_BG = 6144, COL_CG = 7168, COL_CV = 8704,
              COL_AQ = 9216, COL_CQ = 10752, COL_CK = 12288;
__host__ __device__ constexpr int proj_col_of(int src) { return src < 1536 ? src + COL_AQ : (src < 8704 ? src - 1536 : (src < 10752 ? src + 2048 : (src < 11264 ? src - 2048 : src - 4096))); }
constexpr int PLD = 256;
__host__ __device__ constexpr int PC(int col) { return (col >> 8) * (S * 256) + (col & 255); }
constexpr int OCOL_A = 0, OCOL_B = 1536, OCOL_C = 2560;
constexpr float EPS = 1e-6f;
constexpr float SM_SCALE = 0.08838834764831845f;
constexpr float LOG2E = 1.4426950408889634f;
constexpr float QK_C = SM_SCALE * LOG2E;
constexpr int NWAVES = 8;

constexpr size_t MiB = 1u << 20;
constexpr size_t WS_CTL = 0, CTL_ZERO_BYTES = 1 * MiB;
constexpr size_t WS_TAB = 1 * MiB;
constexpr size_t WS_MODP = 1 * MiB + 256 * 1024;
constexpr size_t WS_WIN = 2 * MiB;
constexpr size_t WS_WOUT = WS_WIN + 400 * MiB;
constexpr size_t WS_H = WS_WOUT + 128 * MiB;
constexpr size_t WS_PROJ = WS_H + 128 * MiB;
constexpr size_t WS_O = WS_PROJ + 400 * MiB;
constexpr size_t WS_Y = WS_O + 128 * MiB;
constexpr size_t WS_PART4 = WS_Y + 128 * MiB;
constexpr size_t WS_PART16 = WS_PART4 + 48 * MiB;
constexpr size_t WS_STAT4 = WS_PART16 + 48 * MiB;
constexpr size_t WS_STAT16 = WS_STAT4 + 2 * MiB;
constexpr size_t WS_QF8 = WS_STAT16 + 2 * MiB;
constexpr size_t WS_KF8 = WS_QF8 + 24 * MiB;
constexpr size_t WS_VTF8 = WS_KF8 + 8 * MiB;
constexpr size_t WS_H8 = WS_VTF8 + 8 * MiB;
constexpr size_t WS_W8 = WS_H8 + 64 * MiB;
constexpr size_t WS_END = WS_W8 + 64 * MiB;
constexpr int F8_COL0 = COL_AQ, F8_COLS = 3584;
constexpr int CW_AMAX = 1024;
constexpr int CW_BAR = 4096;
constexpr int LUTA_N = 2 * (64 + 28) + 1, LUTB_N = 2 * (128 + 28) + 1;
constexpr int TB_LUTA = 0;
constexpr int TB_LUTB = 6912;
constexpr int TB_ROPE_R = 12288;
constexpr int TB_ROPE_C = 12288 + 16384;
constexpr int RING_OFF = 0, RING_BYTES = 131072;
constexpr int BAND_BYTES = 8 * (8192 + 32 * 272);
constexpr int LDSCTL_OFF = BAND_BYTES, MISC_OFF = LDSCTL_OFF + 320;
constexpr int BAND_LUT_OFF = LDSCTL_OFF + 1024;
constexpr int BAND_LUT_WAVE = 2048;
constexpr int LDS_BYTES = BAND_LUT_OFF + 8 * BAND_LUT_WAVE;
__device__ __forceinline__ int fresh_lane() { int l; asm volatile("v_mbcnt_lo_u32_b32 %0, -1, 0\n\tv_mbcnt_hi_u32_b32 %0, -1, %0" : "=v"(l)); return l; }
__device__ __forceinline__ float lane_xor(float v, int mask, int lane) { return __uint_as_float((unsigned)__builtin_amdgcn_ds_bpermute((lane ^ mask) << 2, (int)__float_as_uint(v))); }
__device__ __forceinline__ float wave_sum_l(float v, int lane) {
#pragma unroll
    for (int o = 1; o < 64; o <<= 1) v += lane_xor(v, o, lane);
    return v;
}
__device__ __forceinline__ float wave_max_l(float v, int lane) {
#pragma unroll
    for (int o = 1; o < 64; o <<= 1) v = fmaxf(v, lane_xor(v, o, lane));
    return v;
}

#define GAS __attribute__((address_space(1)))
#define LAS __attribute__((address_space(3)))
typedef unsigned short bf16;
typedef unsigned v4u __attribute__((ext_vector_type(4)));
typedef float f32x4 __attribute__((ext_vector_type(4)));
typedef short bf16x8 __attribute__((ext_vector_type(8)));
typedef GAS unsigned gu32;
typedef GAS unsigned long long gu64;
#define RLX_AGENT __ATOMIC_RELAXED, __HIP_MEMORY_SCOPE_AGENT
#define LDS_WAIT() asm volatile("s_waitcnt lgkmcnt(0)" ::: "memory")
#define VM_WAIT() asm volatile("s_waitcnt vmcnt(0)" ::: "memory")
__device__ __forceinline__ unsigned long long rt() { return __builtin_amdgcn_s_memrealtime(); }
__device__ __forceinline__ unsigned f2bf(float f) { unsigned u = __builtin_bit_cast(unsigned, f); return (u + 0x7fffu + ((u >> 16) & 1u)) >> 16; }
__device__ __forceinline__ unsigned pk2(float lo, float hi) { return f2bf(lo) | (f2bf(hi) << 16); }

#define XB_TMO      128
#define XB_XCNT(j)  (256  + 64 * (j))
#define XB_XSUB(j)  (1280 + 64 * (j))
#define XB_XGEN(j)  (2304 + 64 * (j))
#define XB_TOP      3328
#define XB_TOPGEN   3392
#define XCD_BAR_WORDS 3456
#define XB_SPIN_CAP (1u << 18)

__device__ __forceinline__ unsigned xb_ld(unsigned* p)              { return __hip_atomic_load(p, __ATOMIC_RELAXED, __HIP_MEMORY_SCOPE_AGENT); }
__device__ __forceinline__ unsigned xb_add(unsigned* p, unsigned v) { return __hip_atomic_fetch_add(p, v, __ATOMIC_RELAXED, __HIP_MEMORY_SCOPE_AGENT); }
__device__ __forceinline__ unsigned xb_xcc_id() { return (unsigned)__builtin_amdgcn_s_getreg((3 << 11) | 20) & 0xFu; }
#define XB_SPIN(cond, bar) do { unsigned _sp = 0; while (cond) { __builtin_amdgcn_s_sleep(1); \
    if ((++_sp & 255u) == 0u) { if (xb_ld(&(bar)[XB_TMO])) break; if (_sp > XB_SPIN_CAP) { atomicAdd(&(bar)[XB_TMO], 1u); break; } } } } while (0)

struct XcdBarrier {
    unsigned* bar; unsigned x; unsigned w;
    volatile LAS unsigned* st;
};

__device__ __forceinline__ XcdBarrier xcd_barrier_post(unsigned* bar, volatile LAS unsigned* st, unsigned wave) {
    XcdBarrier b; b.bar = bar; b.x = (unsigned)__builtin_amdgcn_readfirstlane((int)xb_xcc_id()); b.st = st; b.w = wave;
    if (threadIdx.x == 0) (void)xb_add(&bar[XB_XCNT(b.x)], 1u);
    return b;
}
__device__ __forceinline__ void xcd_barrier_complete(unsigned* bar, unsigned x, unsigned& nloc, unsigned& nx) {
    const unsigned G = gridDim.x * gridDim.y * gridDim.z;
    unsigned sum, cnt, mine, sp = 0u;
    for (;;) {
        sum = 0u; cnt = 0u; mine = 0u;
#pragma unroll
        for (unsigned j = 0; j < 16; ++j) { const unsigned c = xb_ld(&bar[XB_XCNT(j)]); sum += c; cnt += (c > 0u) ? 1u : 0u; mine = (j == x) ? c : mine; }
        if (sum == G) break;
        __builtin_amdgcn_s_sleep(1);
        if ((++sp & 255u) == 0u) { if (xb_ld(&bar[XB_TMO])) break; if (sp > XB_SPIN_CAP) { atomicAdd(&bar[XB_TMO], 1u); break; } }
    }
    nloc = mine > 0u ? mine : 1u; nx = cnt > 0u ? cnt : 1u;
}

__device__ __forceinline__ void xcd_barrier(const XcdBarrier& b) {
    asm volatile("s_waitcnt vmcnt(0)" ::: "memory");
    __syncthreads();
    int ln_; asm volatile("v_mbcnt_lo_u32_b32 %0, -1, 0\n\tv_mbcnt_hi_u32_b32 %0, -1, %0" : "=v"(ln_));
    if (b.w == 0u && ln_ == 0) {
        unsigned* bar = b.bar; unsigned bx_ = b.x; asm volatile("" : "+s"(bar), "+s"(bx_));
        __builtin_amdgcn_s_waitcnt(0);
        unsigned nloc = b.st[0], nx = b.st[1];
        if (nloc == 0u) { xcd_barrier_complete(bar, bx_, nloc, nx); b.st[0] = nloc; b.st[1] = nx; }
        const unsigned old = xb_add(&bar[XB_XSUB(bx_)], 1u);
        const unsigned gen = old / nloc;
        if (old + 1u == (gen + 1u) * nloc) {
            __builtin_amdgcn_fence(__ATOMIC_RELEASE, "agent");
            asm volatile("s_waitcnt vmcnt(0)" ::: "memory");
            const unsigned og = xb_add(&bar[XB_TOP], 1u);
            const unsigned tg = og / nx;
            if (og + 1u == (tg + 1u) * nx) xb_add(&bar[XB_TOPGEN], 1u);
            else XB_SPIN(xb_ld(&bar[XB_TOPGEN]) == tg, bar);
            __builtin_amdgcn_fence(__ATOMIC_ACQUIRE, "agent");
            xb_add(&bar[XB_XGEN(bx_)], 1u);
            asm volatile("s_waitcnt vmcnt(0)" ::: "memory");
        } else {
            XB_SPIN(xb_ld(&bar[XB_XGEN(bx_)]) == gen, bar);
            __builtin_amdgcn_fence(__ATOMIC_ACQUIRE, "agent");
            asm volatile("s_waitcnt vmcnt(0)" ::: "memory");
        }
    }
    __syncthreads();
}
__device__ __forceinline__ float wave_sum(float v) {
#pragma unroll
    for (int o = 1; o < 64; o <<= 1) v += __shfl_xor(v, o);
    return v;
}
template <bool TRACK>
__device__ __forceinline__ void p0_transpose_item(const float* W, int K, int N, bf16* WT, int row_off, LAS float* scr, int item, int lane, float& amx) {
    const int nblk = N / 32, kb = item / nblk, nb = item % nblk, k0 = 64 * kb, n0 = 32 * nb;
#pragma unroll 8
    for (int i = 0; i < 32; ++i) { const int kk = 2 * i + (lane >> 5); const float w_ = W[(size_t)(k0 + kk) * N + n0 + (lane & 31)]; scr[kk * 33 + (lane & 31)] = w_; if (TRACK) amx = fmaxf(amx, fabsf(w_)); }
    LDS_WAIT(); asm volatile("" ::: "memory");
    const int c = lane & 7;
#pragma unroll
    for (int j = 0; j < 4; ++j) { const int n = (lane >> 3) + 8 * j; const LAS float* s = scr + (8 * c) * 33 + n;
        v4u o; o.x = pk2(s[0 * 33], s[1 * 33]); o.y = pk2(s[2 * 33], s[3 * 33]); o.z = pk2(s[4 * 33], s[5 * 33]); o.w = pk2(s[6 * 33], s[7 * 33]);
        *(GAS v4u*)(WT + (size_t)(row_off + n0 + n) * K + k0 + 8 * c) = o; }
    LDS_WAIT(); asm volatile("" ::: "memory");
}
namespace attc {
typedef unsigned short bf16;
constexpr int   D = 128, NW = 8, QBLK = 32, KVBLK = 64;
constexpr float SCALE = SM_SCALE;
constexpr float THR = 8.f;
constexpr int SDEPTH = 2;
constexpr int LDQ = PLD, LDK = INW, LDO = DM;
constexpr size_t SHM_V = KVBLK * D * 2, SHM_K = KVBLK * D * 2, SHM_ATTN = 2 * SHM_V + 2 * SHM_K + NW * 64 * 4;
using bf16x8 = __attribute__((ext_vector_type(8))) short;
using s16x4  = __attribute__((ext_vector_type(4))) short;
using f32x16 = __attribute__((ext_vector_type(16))) float;
using u32x4  = __attribute__((ext_vector_type(4))) unsigned;
struct StageB { using T = bf16x8;
  __device__ static __forceinline__ T ld8(const bf16* p) { return *reinterpret_cast<const bf16x8*>(p); }
  __device__ static __forceinline__ bf16x8 tobf(T x) { return x; } };
#define KSWZ(row, colB) ((row) * 256 + ((colB) ^ (((row) & 7) << 4)))
#define SBAR() __builtin_amdgcn_sched_barrier(0)
__device__ __forceinline__ int crow(int r, int hi) { return (r & 3) + 8 * (r >> 2) + 4 * hi; }
__device__ __forceinline__ unsigned cvtpk(float lo, float hi) {
  unsigned r; asm volatile("v_cvt_pk_bf16_f32 %0, %1, %2" : "=v"(r) : "v"(lo), "v"(hi)); return r;
}
__device__ __forceinline__ void partialSM(f32x16& p0, f32x16& p1, float& m_reg, float& mn, float& alpha) {
  constexpr float C = SCALE * 1.4426950408889634f;
  float pmax = p0[0]; for (int r = 1; r < 16; ++r) pmax = fmaxf(pmax, p0[r]); for (int r = 0; r < 16; ++r) pmax = fmaxf(pmax, p1[r]);
  { auto rr = __builtin_amdgcn_permlane32_swap(__float_as_uint(pmax), __float_as_uint(pmax), false, false);
    pmax = fmaxf(__uint_as_float(rr[0]), __uint_as_float(rr[1])); }
  if (__builtin_expect(__all(pmax - m_reg <= THR / SCALE), 1)) { mn = m_reg; alpha = 1.f; }
  else { mn = fmaxf(m_reg, pmax); alpha = __builtin_amdgcn_exp2f((m_reg - mn) * C); m_reg = mn; }
  float mnC = -mn * C;
  for (int r = 0; r < 16; ++r) p0[r] = fmaf(p0[r], C, mnC); for (int r = 0; r < 16; ++r) p1[r] = fmaf(p1[r], C, mnC);
  for (int r = 0; r < 16; ++r) p0[r] = __builtin_amdgcn_exp2f(p0[r]);
}
__device__ __forceinline__ float psm_max(const f32x16& p0, const f32x16& p1) {
  float pmax = p0[0];
#pragma unroll
  for (int r = 1; r < 16; ++r) pmax = fmaxf(pmax, p0[r]);
#pragma unroll
  for (int r = 0; r < 16; ++r) pmax = fmaxf(pmax, p1[r]);
  auto rr = __builtin_amdgcn_permlane32_swap(__float_as_uint(pmax), __float_as_uint(pmax), false, false);
  return fmaxf(__uint_as_float(rr[0]), __uint_as_float(rr[1]));
}
__device__ __forceinline__ void psm_scale(f32x16& p0, f32x16& p1, float pmax, float& m_reg, float& mn, float& alpha) {
  constexpr float C = SCALE * 1.4426950408889634f;
  const bool keep = __all(pmax - m_reg <= THR / SCALE);
  mn = keep ? m_reg : fmaxf(m_reg, pmax); alpha = keep ? 1.f : __builtin_amdgcn_exp2f((m_reg - mn) * C); m_reg = mn;
  const float mnC = -mn * C;
#pragma unroll
  for (int r = 0; r < 16; ++r) p0[r] = fmaf(p0[r], C, mnC);
#pragma unroll
  for (int r = 0; r < 16; ++r) p1[r] = fmaf(p1[r], C, mnC);
}
template <int LO> __device__ __forceinline__ void psm_exp8(f32x16& p0) {
#pragma unroll
  for (int r = LO; r < LO + 8; ++r) p0[r] = __builtin_amdgcn_exp2f(p0[r]);
}
__device__ __forceinline__ void finishSM(f32x16& p0, f32x16& p1, float alpha, float& l_reg, bf16x8& pa0, bf16x8& pa1, bf16x8& pa2, bf16x8& pa3) {
  for (int r = 0; r < 16; ++r) p1[r] = __builtin_amdgcn_exp2f(p1[r]);
  float ps = 0; for (int r = 0; r < 16; ++r) ps += p0[r]; for (int r = 0; r < 16; ++r) ps += p1[r];
  { auto rr = __builtin_amdgcn_permlane32_swap(__float_as_uint(ps), __float_as_uint(ps), false, false);
    ps = __uint_as_float(rr[0]) + __uint_as_float(rr[1]); }
  l_reg = l_reg * alpha + ps;
#define PK4(P, BASE, OUT) do { unsigned a0 = cvtpk(P[BASE + 0], P[BASE + 1]), a1 = cvtpk(P[BASE + 2], P[BASE + 3]);   \
    unsigned b0 = cvtpk(P[BASE + 4], P[BASE + 5]), b1 = cvtpk(P[BASE + 6], P[BASE + 7]);                              \
    auto r0 = __builtin_amdgcn_permlane32_swap(a0, b0, false, false); auto r1 = __builtin_amdgcn_permlane32_swap(a1, b1, false, false); \
    u32x4 w = {r0[0], r1[0], r0[1], r1[1]}; OUT = *reinterpret_cast<bf16x8*>(&w); } while (0)
  PK4(p0, 0, pa0); PK4(p0, 8, pa1); PK4(p1, 0, pa2); PK4(p1, 8, pa3);
#undef PK4
}
__device__ __forceinline__ void qkt(f32x16& p0, f32x16& p1, const bf16* Ks, const bf16x8* qr, int r32, int hi) {
  p0 = f32x16{}; p1 = f32x16{};
  for (int d0 = 0; d0 < 8; ++d0) { int cb = (d0 * 16 + hi * 8) * 2;
    bf16x8 b0 = *reinterpret_cast<const bf16x8*>((const char*)Ks + KSWZ(r32, cb));
    bf16x8 b1 = *reinterpret_cast<const bf16x8*>((const char*)Ks + KSWZ(32 + r32, cb));
    p0 = __builtin_amdgcn_mfma_f32_32x32x16_bf16(b0, qr[d0], p0, 0, 0, 0);
    p1 = __builtin_amdgcn_mfma_f32_32x32x16_bf16(b1, qr[d0], p1, 0, 0, 0); }
}
__device__ __forceinline__ int v_st(int k, int c) { const int kk = (k & ~0xC) | ((k & 4) << 1) | ((k & 8) >> 1); return ((kk >> 3) * 4 + (c >> 5)) * 512 + ((kk & 7) * 32 + (c & 31)) * 2; }
__device__ __forceinline__ int v_rd_base(int lane) { return ((lane & 3) << 3) | (((lane >> 2) & 3) << 6) | (((lane >> 4) & 1) << 5) | (((lane >> 5) & 1) << 8); }
constexpr int v_rd_off(int d0, int ks, int half) { return d0 * 512 + ks * 4096 + half * 2048; }
template <int OFF> __device__ __forceinline__ s16x4 tr_read(int vb) {
  s16x4 r; asm volatile("ds_read_b64_tr_b16 %0, %1 offset:%2" : "=&v"(r) : "v"(vb), "i"(OFF) : "memory"); return r;
}
template <int D0> __device__ __forceinline__ void pv_one(f32x16& od, int vb, bf16x8 pa0, bf16x8 pa1, bf16x8 pa2, bf16x8 pa3) {
  const s16x4 l0 = tr_read<v_rd_off(D0, 0, 0)>(vb), h0 = tr_read<v_rd_off(D0, 0, 1)>(vb), l1 = tr_read<v_rd_off(D0, 1, 0)>(vb), h1 = tr_read<v_rd_off(D0, 1, 1)>(vb);
  const s16x4 l2 = tr_read<v_rd_off(D0, 2, 0)>(vb), h2 = tr_read<v_rd_off(D0, 2, 1)>(vb), l3 = tr_read<v_rd_off(D0, 3, 0)>(vb), h3 = tr_read<v_rd_off(D0, 3, 1)>(vb);
  asm volatile("s_waitcnt lgkmcnt(0)" ::: "memory"); SBAR();
#define PK(L, H) (bf16x8){L[0], L[1], L[2], L[3], H[0], H[1], H[2], H[3]}
  od = __builtin_amdgcn_mfma_f32_32x32x16_bf16(pa0, PK(l0, h0), od, 0, 0, 0);
  od = __builtin_amdgcn_mfma_f32_32x32x16_bf16(pa1, PK(l1, h1), od, 0, 0, 0);
  od = __builtin_amdgcn_mfma_f32_32x32x16_bf16(pa2, PK(l2, h2), od, 0, 0, 0);
  od = __builtin_amdgcn_mfma_f32_32x32x16_bf16(pa3, PK(l3, h3), od, 0, 0, 0);
#undef PK
}
__device__ __forceinline__ void pv_d0(f32x16* o, int vb, bf16x8 pa0, bf16x8 pa1, bf16x8 pa2, bf16x8 pa3) {
  pv_one<0>(o[0], vb, pa0, pa1, pa2, pa3); pv_one<1>(o[1], vb, pa0, pa1, pa2, pa3); pv_one<2>(o[2], vb, pa0, pa1, pa2, pa3); pv_one<3>(o[3], vb, pa0, pa1, pa2, pa3);
}
__device__ __forceinline__ void pv_psm(f32x16* o, int vb, bf16x8 pa0, bf16x8 pa1, bf16x8 pa2, bf16x8 pa3, f32x16& q0, f32x16& q1, float& m_reg, float& mn, float& alpha) {
  pv_one<0>(o[0], vb, pa0, pa1, pa2, pa3); float pmax = psm_max(q0, q1); asm volatile("" : "+v"(pmax));
  pv_one<1>(o[1], vb, pa0, pa1, pa2, pa3); psm_scale(q0, q1, pmax, m_reg, mn, alpha); asm volatile("" : "+v"(q0), "+v"(q1));
  pv_one<2>(o[2], vb, pa0, pa1, pa2, pa3); psm_exp8<0>(q0); asm volatile("" : "+v"(q0));
  pv_one<3>(o[3], vb, pa0, pa1, pa2, pa3); psm_exp8<8>(q0); asm volatile("" : "+v"(q0)); SBAR();
}

constexpr int EPI_PITCH = 528, EPI_BYTES = 32 * EPI_PITCH;
template <int QS>
__device__ __forceinline__ void epi_stage_store(const f32x16 (&o)[4], const float (&rli)[16], __attribute__((address_space(3))) unsigned char* st,
                                                const bf16* __restrict__ gbase, bf16* __restrict__ obase, int lane) {
  typedef float f32x4_t __attribute__((ext_vector_type(4)));
  asm volatile("" : "+v"(lane));
  const int r32 = lane & 31, hi = lane >> 5;
  const int rr = lane >> 4, c16 = lane & 15;
  u32x4 g[8];
#pragma unroll
  for (int i = 0; i < 8; ++i) g[i] = *reinterpret_cast<const u32x4*>(gbase + (size_t)(QS * (rr + 4 * i)) * LDQ + c16 * 8);
#pragma unroll
  for (int r = 0; r < 16; ++r) { const int row = crow(r, hi);
#pragma unroll
    for (int d0 = 0; d0 < 4; ++d0) *reinterpret_cast<__attribute__((address_space(3))) float*>(st + row * EPI_PITCH + (d0 * 32 + r32) * 4) = o[d0][r] * rli[r]; }
#pragma unroll
  for (int i = 0; i < 8; ++i) { const int row = rr + 4 * i;
    const f32x4_t a = *reinterpret_cast<const __attribute__((address_space(3))) f32x4_t*>(st + row * EPI_PITCH + c16 * 32);
    const f32x4_t b = *reinterpret_cast<const __attribute__((address_space(3))) f32x4_t*>(st + row * EPI_PITCH + c16 * 32 + 16);
    float v[8] = {a[0], a[1], a[2], a[3], b[0], b[1], b[2], b[3]};
#pragma unroll
    for (int e = 0; e < 4; ++e) { const float g0 = __uint_as_float(g[i][e] << 16), g1 = __uint_as_float(g[i][e] & 0xffff0000u);
      v[2 * e] *= g0 * __builtin_amdgcn_rcpf(1.f + __expf(-g0)); v[2 * e + 1] *= g1 * __builtin_amdgcn_rcpf(1.f + __expf(-g1)); }
    u32x4 w = {cvtpk(v[0], v[1]), cvtpk(v[2], v[3]), cvtpk(v[4], v[5]), cvtpk(v[6], v[7])};
    *reinterpret_cast<u32x4*>(obase + (size_t)(QS * row) * LDO + c16 * 8) = w; }
}

__device__ __forceinline__ void attn_dense_body(const bf16* __restrict__ Qb, const bf16* __restrict__ Kh, const bf16* __restrict__ Vh,
                                                const bf16* __restrict__ Gb, bf16* __restrict__ Ob, int seq, char* lds, const int wid) {
  using St = StageB;
  int lane_l; asm volatile("v_mbcnt_lo_u32_b32 %0, -1, 0\n\tv_mbcnt_hi_u32_b32 %0, -1, %0" : "=v"(lane_l));
  const int lane = lane_l, tid = wid * 64 + lane, r32 = lane & 31, hi = lane >> 5;
  bf16* V_lds = (bf16*)lds; bf16* K_lds = (bf16*)(lds + 2 * SHM_V);
  float* ws = (float*)(lds + 2 * SHM_V + 2 * SHM_K) + wid * 64; float* li_l = ws; float* al_l = ws + 32;
  float m_reg = -1e30f, l_reg = 0; f32x16 o[4] = {}; bf16x8 qr[8];
  const bf16* Qw = Qb + (long)(wid * QBLK + r32) * LDQ + hi * 8;
#pragma unroll
  for (int d0 = 0; d0 < 8; ++d0) qr[d0] = St::ld8(Qw + d0 * 16);
  const int sr = tid >> 4, sc = (tid & 15) * 8, vst0 = v_st(sr, sc), vst1 = v_st(32 + sr, sc);
  const int vb0 = (int)(uintptr_t)V_lds + v_rd_base(lane);
  struct { typename St::T vs0, vs1, ks0, ks1; } sr_[SDEPTH];
#define SLOAD(i, k0) do { sr_[i].vs0 = St::ld8(&Vh[(long)((k0) + sr) * LDK + sc]); sr_[i].vs1 = St::ld8(&Vh[(long)((k0) + 32 + sr) * LDK + sc]); \
    sr_[i].ks0 = St::ld8(&Kh[(long)((k0) + sr) * LDK + sc]); sr_[i].ks1 = St::ld8(&Kh[(long)((k0) + 32 + sr) * LDK + sc]); } while (0)
#define SWRITE(b, i) do { *(bf16x8*)((char*)V_lds + (b) * SHM_V + vst0) = St::tobf(sr_[i].vs0);          \
    *(bf16x8*)((char*)V_lds + (b) * SHM_V + vst1) = St::tobf(sr_[i].vs1); int kc = sc * 2;               \
    *(bf16x8*)((char*)K_lds + (b) * SHM_K + KSWZ(sr, kc)) = St::tobf(sr_[i].ks0);                       \
    *(bf16x8*)((char*)K_lds + (b) * SHM_K + KSWZ(32 + sr, kc)) = St::tobf(sr_[i].ks1); } while (0)
#define SWAIT() do { if constexpr (SDEPTH == 2) asm volatile("s_waitcnt vmcnt(4)" ::: "memory"); else asm volatile("s_waitcnt vmcnt(0)" ::: "memory"); } while (0)
#define RESC(a) do { if (__any((a) < 1.f)) { if (hi == 0) al_l[r32] = (a); asm volatile("s_waitcnt lgkmcnt(0)" ::: "memory"); \
    for (int d = 0; d < 4; ++d) for (int r = 0; r < 16; ++r) o[d][r] *= al_l[crow(r, hi)]; } } while (0)
  f32x16 pA0, pA1, pB0, pB1; float mnA, mnB, alA, alB; bf16x8 pa0, pa1, pa2, pa3; const int NT = seq / KVBLK;
#ifdef ATT_PRIO
  if (wid >= 4) __builtin_amdgcn_s_setprio(1);
#endif
  constexpr int SE = 0, SO = SDEPTH - 1;
  SLOAD(SE, 0); asm volatile("s_waitcnt vmcnt(0)" ::: "memory"); SWRITE(0, SE); __syncthreads();
  qkt(pA0, pA1, K_lds, qr, r32, hi); partialSM(pA0, pA1, m_reg, mnA, alA);
  SLOAD(SO, KVBLK); if constexpr (SDEPTH == 2) { if (2 < NT) SLOAD(SE, 2 * KVBLK); }
  SWAIT(); SWRITE(1, SO); __syncthreads();
  for (int j = 1; j + 1 < NT; j += 2) {
    SBAR(); qkt(pB0, pB1, (bf16*)((char*)K_lds + SHM_K), qr, r32, hi);
    finishSM(pA0, pA1, alA, l_reg, pa0, pa1, pa2, pa3); SBAR();
    SLOAD(SO, (j + SDEPTH) * KVBLK); SBAR();
    pv_psm(o, vb0, pa0, pa1, pa2, pa3, pB0, pB1, m_reg, mnB, alB);
    __syncthreads(); SWAIT(); SWRITE(0, SE);
    RESC(alB); __syncthreads();
    SBAR(); qkt(pA0, pA1, K_lds, qr, r32, hi);
    finishSM(pB0, pB1, alB, l_reg, pa0, pa1, pa2, pa3); SBAR();
    if (SDEPTH == 1 || j + 3 < NT) SLOAD(SE, (j + 1 + SDEPTH) * KVBLK); SBAR();
    pv_psm(o, vb0 + (int)SHM_V, pa0, pa1, pa2, pa3, pA0, pA1, m_reg, mnA, alA);
    __syncthreads(); SWAIT(); SWRITE(1, SO);
    RESC(alA); __syncthreads();
  }
  SBAR(); qkt(pB0, pB1, (bf16*)((char*)K_lds + SHM_K), qr, r32, hi);
  finishSM(pA0, pA1, alA, l_reg, pa0, pa1, pa2, pa3); SBAR();
  pv_psm(o, vb0, pa0, pa1, pa2, pa3, pB0, pB1, m_reg, mnB, alB);
  __syncthreads(); RESC(alB);
  finishSM(pB0, pB1, alB, l_reg, pa0, pa1, pa2, pa3); SBAR();
  pv_d0(o, vb0 + (int)SHM_V, pa0, pa1, pa2, pa3);
  if (hi == 0) li_l[r32] = l_reg; asm volatile("s_waitcnt lgkmcnt(0)" ::: "memory");
  float rli[16];
#pragma unroll
  for (int r = 0; r < 16; ++r) rli[r] = __builtin_amdgcn_rcpf(li_l[crow(r, hi)]);
#ifdef ATT_PRIO
  __builtin_amdgcn_s_setprio(0);
#endif
  __syncthreads();
  epi_stage_store<1>(o, rli, (__attribute__((address_space(3))) unsigned char*)(uintptr_t)(unsigned)(uintptr_t)lds + wid * EPI_BYTES, Gb + (long)(wid * QBLK) * LDQ, Ob + (long)(wid * QBLK) * LDO, lane);
  __syncthreads();
#undef SLOAD
#undef SWRITE
#undef SWAIT
#undef RESC
}
typedef int i32x8 __attribute__((ext_vector_type(8)));
typedef int i32x4 __attribute__((ext_vector_type(4)));
constexpr int KP8 = 144, VP8 = 80;
constexpr size_t SHM_K8 = 64 * KP8, SHM_V8 = 128 * VP8;
constexpr float THR8 = 3.72f, PSH8 = 5.f;
constexpr float Q8_PRESCALE = SCALE * 1.4426950408889634f * 8.f;
constexpr int LDQ8 = C_H * HD, LDK8 = 4 * HD;
#define MFMA8(A, B, Cc) __builtin_amdgcn_mfma_scale_f32_32x32x64_f8f6f4(A, B, Cc, 0, 0, 0, 0x7f7f7f7f, 0, 0x7f7f7f7f)
#define MFMA8Q(A, B, Cc) __builtin_amdgcn_mfma_scale_f32_32x32x64_f8f6f4(A, B, Cc, 0, 0, 0, 0x7f7f7f7f, 0, 0x7c7c7c7c)
typedef __attribute__((address_space(3))) const unsigned char* lcp8;
__device__ __forceinline__ i32x8 lds32(lcp8 p) {
  const i32x4 a = *reinterpret_cast<const __attribute__((address_space(3))) i32x4*>(p), b = *reinterpret_cast<const __attribute__((address_space(3))) i32x4*>(p + 16);
  return (i32x8){a[0], a[1], a[2], a[3], b[0], b[1], b[2], b[3]};
}
__device__ __forceinline__ void qkt8(f32x16& p0, f32x16& p1, lcp8 kb, const i32x8* qf, const f32x16& minit) {
  p0 = MFMA8Q(lds32(kb), qf[0], minit); p0 = MFMA8Q(lds32(kb + 64), qf[1], p0);
  p1 = MFMA8Q(lds32(kb + 32 * KP8), qf[0], minit); p1 = MFMA8Q(lds32(kb + 32 * KP8 + 64), qf[1], p1);
}
template <bool FIRST>
__device__ __forceinline__ void psm_fix8(f32x16& p0, f32x16& p1, float pmax, f32x16& minit, float& alpha) {
  alpha = 1.f;
  if (FIRST || !__all(pmax <= PSH8 + THR8)) {
    const float delta = FIRST ? pmax - PSH8 : fmaxf(pmax - PSH8, 0.f);
    if (!FIRST) alpha = __builtin_amdgcn_exp2f(-delta);
#pragma unroll
    for (int r = 0; r < 16; ++r) { p0[r] -= delta; p1[r] -= delta; minit[r] -= delta; }
  }
}
__device__ __forceinline__ void finishSM8(f32x16& p0, f32x16& p1, i32x8& pa) {
#pragma unroll
  for (int r = 0; r < 16; ++r) p1[r] = __builtin_amdgcn_exp2f(p1[r]);
  int und; asm volatile("" : "=v"(und));
#pragma unroll
  for (int w = 0; w < 4; ++w) { int t = __builtin_amdgcn_cvt_pk_fp8_f32(p0[4 * w], p0[4 * w + 1], und, false); pa[w] = __builtin_amdgcn_cvt_pk_fp8_f32(p0[4 * w + 2], p0[4 * w + 3], t, true);
                                int u = __builtin_amdgcn_cvt_pk_fp8_f32(p1[4 * w], p1[4 * w + 1], und, false); pa[4 + w] = __builtin_amdgcn_cvt_pk_fp8_f32(p1[4 * w + 2], p1[4 * w + 3], u, true); }
}
template <int LO> __device__ __forceinline__ void exp4(f32x16& p) {
#pragma unroll
  for (int r = LO; r < LO + 4; ++r) p[r] = __builtin_amdgcn_exp2f(p[r]);
}
template <int W> __device__ __forceinline__ void cvt8(const f32x16& p, int& d0, int& d1, int und) {
  int t = __builtin_amdgcn_cvt_pk_fp8_f32(p[8 * W], p[8 * W + 1], und, false); d0 = __builtin_amdgcn_cvt_pk_fp8_f32(p[8 * W + 2], p[8 * W + 3], t, true);
  int u = __builtin_amdgcn_cvt_pk_fp8_f32(p[8 * W + 4], p[8 * W + 5], und, false); d1 = __builtin_amdgcn_cvt_pk_fp8_f32(p[8 * W + 6], p[8 * W + 7], u, true);
}
__device__ __forceinline__ void qkt_fsm8(f32x16& n0, f32x16& n1, lcp8 kb, const i32x8* qf, const f32x16& minit, const f32x16& p0, f32x16& p1, i32x8& pa) {
  int und; asm volatile("" : "=v"(und));
  int a0, a1, a2, a3, a4, a5, a6, a7;
  const i32x8 k00 = lds32(kb), k10 = lds32(kb + 32 * KP8);
  cvt8<0>(p0, a0, a1, und); exp4<0>(p1); asm volatile("" : "+v"(p1), "+v"(a0), "+v"(a1)); SBAR();
  n0 = MFMA8Q(k00, qf[0], minit); const i32x8 k01 = lds32(kb + 64);
  cvt8<1>(p0, a2, a3, und); exp4<4>(p1); asm volatile("" : "+v"(p1), "+v"(a2), "+v"(a3)); SBAR();
  n1 = MFMA8Q(k10, qf[0], minit); const i32x8 k11 = lds32(kb + 32 * KP8 + 64);
  exp4<8>(p1); cvt8<0>(p1, a4, a5, und); asm volatile("" : "+v"(p1), "+v"(a4), "+v"(a5)); SBAR();
  n0 = MFMA8Q(k01, qf[1], n0);
  exp4<12>(p1); asm volatile("" : "+v"(p1)); SBAR();
  n1 = MFMA8Q(k11, qf[1], n1);
  cvt8<1>(p1, a6, a7, und); asm volatile("" : "+v"(a6), "+v"(a7)); SBAR();
  pa = (i32x8){a0, a1, a2, a3, a4, a5, a6, a7};
}
__device__ __forceinline__ void pv_psm8(f32x16* o, f32x16& ol, const i32x8 ones, lcp8 vb, const i32x8 pa, f32x16& q0, f32x16& q1, f32x16& minit, float& alpha) {
  o[0] = MFMA8(pa, lds32(vb), o[0]); float pmax = psm_max(q0, q1); asm volatile("" : "+v"(pmax));
  o[1] = MFMA8(pa, lds32(vb + 32 * VP8), o[1]); psm_fix8<false>(q0, q1, pmax, minit, alpha); asm volatile("" : "+v"(q0), "+v"(q1));
  o[2] = MFMA8(pa, lds32(vb + 64 * VP8), o[2]); psm_exp8<0>(q0); asm volatile("" : "+v"(q0));
  o[3] = MFMA8(pa, lds32(vb + 96 * VP8), o[3]); psm_exp8<8>(q0); asm volatile("" : "+v"(q0));
  ol = MFMA8(pa, ones, ol);
  SBAR();
}
__device__ __forceinline__ void pv8(f32x16* o, f32x16& ol, const i32x8 ones, lcp8 vb, const i32x8 pa) {
  o[0] = MFMA8(pa, lds32(vb), o[0]); o[1] = MFMA8(pa, lds32(vb + 32 * VP8), o[1]); o[2] = MFMA8(pa, lds32(vb + 64 * VP8), o[2]); o[3] = MFMA8(pa, lds32(vb + 96 * VP8), o[3]); ol = MFMA8(pa, ones, ol);
}
__device__ __forceinline__ void attn_f8_body(const unsigned char* __restrict__ Qb, const unsigned char* __restrict__ Kh, const unsigned char* __restrict__ Vt,
                                             const bf16* __restrict__ Gb, bf16* __restrict__ Ob, int seq, char* lds, const int wid) {
  int lane_l; asm volatile("v_mbcnt_lo_u32_b32 %0, -1, 0\n\tv_mbcnt_hi_u32_b32 %0, -1, %0" : "=v"(lane_l));
  const int lane = lane_l, tid = wid * 64 + lane, r32 = lane & 31, hi = lane >> 5;
  typedef __attribute__((address_space(3))) unsigned char* lp8;
  const lp8 V_lds = (lp8)(uintptr_t)(unsigned)(uintptr_t)lds; const lp8 K_lds = V_lds + 2 * SHM_V8;
  float* al_l = (float*)(lds + 2 * SHM_V8 + 2 * SHM_K8) + wid * 32;
  f32x16 o[4] = {}, ol = {}; i32x8 qf[2], ones; f32x16 minit;
#pragma unroll
  for (int r = 0; r < 8; ++r) ones[r] = 0x38383838;
#pragma unroll
  for (int r = 0; r < 16; ++r) minit[r] = PSH8;
  { const unsigned char* Qw = Qb + (long)(wid * QBLK + r32) * LDQ8 + hi * 32;
#pragma unroll
    for (int s = 0; s < 2; ++s) { const i32x4 a = *reinterpret_cast<const i32x4*>(Qw + 64 * s), b = *reinterpret_cast<const i32x4*>(Qw + 64 * s + 16); qf[s] = (i32x8){a[0], a[1], a[2], a[3], b[0], b[1], b[2], b[3]}; } }
  const int kr = tid >> 3, kc = (tid & 7) * 16, vd = tid >> 2, vc = (tid & 3) * 16;
  const int kst = kr * KP8 + kc, vst = vd * VP8 + vc;
  const lcp8 kb0 = K_lds + r32 * KP8 + hi * 32, vb0 = V_lds + r32 * VP8 + hi * 32;
  struct { i32x4 k, v; } sr_[2];
#define SLOAD8(i, k0) do { sr_[i].k = *reinterpret_cast<const i32x4*>(Kh + (long)((k0) + kr) * LDK8 + kc); sr_[i].v = *reinterpret_cast<const i32x4*>(Vt + (long)(k0) * HD + tid * 16); } while (0)
#define SWRITE8(b, i) do { *reinterpret_cast<__attribute__((address_space(3))) i32x4*>(K_lds + (b) * SHM_K8 + kst) = sr_[i].k; *reinterpret_cast<__attribute__((address_space(3))) i32x4*>(V_lds + (b) * SHM_V8 + vst) = sr_[i].v; } while (0)
#define SWAIT8() asm volatile("s_waitcnt vmcnt(2)" ::: "memory")
#define RESC8(a) do { if (__any((a) < 1.f)) { if (hi == 0) al_l[r32] = (a); asm volatile("s_waitcnt lgkmcnt(0)" ::: "memory"); \
    for (int r = 0; r < 16; ++r) { const float a_ = al_l[crow(r, hi)]; o[0][r] *= a_; o[1][r] *= a_; o[2][r] *= a_; o[3][r] *= a_; ol[r] *= a_; } } } while (0)
  f32x16 pA0, pA1, pB0, pB1; float alA, alB; i32x8 pa; const int NT = seq / KVBLK;
  constexpr int SE = 0, SO = 1;
  SLOAD8(SE, 0); asm volatile("s_waitcnt vmcnt(0)" ::: "memory"); SWRITE8(0, SE); __syncthreads();
  qkt8(pA0, pA1, kb0, qf, minit);
  { const float pmax = psm_max(pA0, pA1); psm_fix8<true>(pA0, pA1, pmax, minit, alA); psm_exp8<0>(pA0); psm_exp8<8>(pA0); }
  SLOAD8(SO, KVBLK); if (2 < NT) SLOAD8(SE, 2 * KVBLK);
  SWAIT8(); SWRITE8(1, SO); __syncthreads();
  for (int j = 1; j + 1 < NT; j += 2) {
    SBAR(); qkt_fsm8(pB0, pB1, kb0 + SHM_K8, qf, minit, pA0, pA1, pa);
    SLOAD8(SO, (j + 2) * KVBLK); SBAR();
    pv_psm8(o, ol, ones, vb0, pa, pB0, pB1, minit, alB);
    __syncthreads(); SWAIT8(); SWRITE8(0, SE);
    RESC8(alB); __syncthreads();
    SBAR(); qkt_fsm8(pA0, pA1, kb0, qf, minit, pB0, pB1, pa);
    SLOAD8(SE, (j + 3 < NT ? j + 3 : NT - 1) * KVBLK); SBAR();
    pv_psm8(o, ol, ones, vb0 + SHM_V8, pa, pA0, pA1, minit, alA);
    __syncthreads(); SWAIT8(); SWRITE8(1, SO);
    RESC8(alA); __syncthreads();
  }
  SBAR(); qkt_fsm8(pB0, pB1, kb0 + SHM_K8, qf, minit, pA0, pA1, pa);
  pv_psm8(o, ol, ones, vb0, pa, pB0, pB1, minit, alB);
  __syncthreads(); RESC8(alB);
  finishSM8(pB0, pB1, pa); SBAR();
  pv8(o, ol, ones, vb0 + SHM_V8, pa);
  float rli[16];
#pragma unroll
  for (int r = 0; r < 16; ++r) rli[r] = __builtin_amdgcn_rcpf(ol[r]);
  __syncthreads();
  epi_stage_store<1>(o, rli, (__attribute__((address_space(3))) unsigned char*)(uintptr_t)(unsigned)(uintptr_t)lds + wid * EPI_BYTES, Gb + (long)(wid * QBLK) * LDQ, Ob + (long)(wid * QBLK) * LDO, lane);
  __syncthreads();
#undef SLOAD8
#undef SWRITE8
#undef SWAIT8
#undef RESC8
}
#ifdef QK_FP4
constexpr int PP_KIMG = 4096, PP_TIMG = PP_KIMG + 8192, PP_KR = 0, PP_VR = 3 * PP_KIMG, PP_AL = PP_VR + 3 * 8192;
constexpr int LDQ4 = C_H * 64;
constexpr float Q4_PRESCALE = SCALE * 1.4426950408889634f * 16.f / 1.5f, K4_PRESCALE = 1.5f;
#define MFMA4Q(A, B, Cc) __builtin_amdgcn_mfma_scale_f32_32x32x64_f8f6f4(A, B, Cc, 4, 4, 0, 0x7f7f7f7f, 0, 0x7b7b7b7b)
__device__ __forceinline__ i32x8 lds1(int a0, int off) {
  const i32x4 a = *(const __attribute__((address_space(3))) i32x4*)(uintptr_t)(unsigned)(a0 + off);
  return (i32x8){a[0], a[1], a[2], a[3], 0, 0, 0, 0};
}
#else
constexpr int PP_KIMG = 8192, PP_TIMG = 16384, PP_KR = 0, PP_VR = 3 * 8192, PP_AL = 6 * 8192;
#endif
typedef __attribute__((address_space(3))) const i32x4* lq4;
__device__ __forceinline__ i32x8 lds2(int a0, int a1, int off) {
  const i32x4 a = *(lq4)(uintptr_t)(unsigned)(a0 + off), b = *(lq4)(uintptr_t)(unsigned)(a1 + off);
  return (i32x8){a[0], a[1], a[2], a[3], b[0], b[1], b[2], b[3]};
}
#ifndef PP_PADN
#define PP_PADN 7
#endif
#define PP_STR2(x) #x
#define PP_STR(x) PP_STR2(x)
#define PP_PAD() do { SBAR(); asm volatile("s_nop " PP_STR(PP_PADN)); SBAR(); } while (0)
#ifndef PP_PADQN
#define PP_PADQN 7
#endif
#define PP_PADQ() do { SBAR(); asm volatile("s_nop " PP_STR(PP_PADQN)); SBAR(); } while (0)
template <bool QK, bool PV>
__device__ __forceinline__ void pp_mseg(f32x16* o, f32x16& ol, f32x16& n0, f32x16& n1, const i32x8 pa, const i32x8 ones, const i32x8* qf, const f32x16& minit, const i32x8 vf0, const i32x8 vf1,
                                        const int k0, const int k1, const int k2, const int k3, const int v0, const int v1) {
  i32x8 k00, k10, k01, k11, vf2, vf3;
#ifdef QK_FP4
  if (QK) { k00 = lds1(k0, 0); k10 = lds1(k0, 2048); }
#else
  if (QK) { k00 = lds2(k0, k1, 0); k10 = lds2(k0, k1, 4096); }
#endif
  if (PV) { o[0] = MFMA8(pa, vf0, o[0]); vf2 = lds2(v0, v1, 4096); PP_PAD(); }
#ifdef QK_FP4
  if (QK) { k01 = lds1(k1, 0); }
#else
  if (QK) { k01 = lds2(k2, k3, 0); }
#endif
  if (PV) { o[1] = MFMA8(pa, vf1, o[1]); vf3 = lds2(v0, v1, 6144); PP_PAD(); }
#ifdef QK_FP4
  if (QK) { k11 = lds1(k1, 2048);
            n0 = MFMA4Q(k00, qf[0], minit); PP_PADQ(); n1 = MFMA4Q(k10, qf[0], minit); PP_PADQ(); n0 = MFMA4Q(k01, qf[1], n0); PP_PADQ(); n1 = MFMA4Q(k11, qf[1], n1); PP_PADQ(); }
#else
  if (QK) { k11 = lds2(k2, k3, 4096);
            n0 = MFMA8Q(k00, qf[0], minit); PP_PAD(); n1 = MFMA8Q(k10, qf[0], minit); PP_PAD(); n0 = MFMA8Q(k01, qf[1], n0); PP_PAD(); n1 = MFMA8Q(k11, qf[1], n1); PP_PAD(); }
#endif
  if (PV) { o[2] = MFMA8(pa, vf2, o[2]); PP_PAD(); o[3] = MFMA8(pa, vf3, o[3]); PP_PAD(); ol = MFMA8(pa, ones, ol); }
}
template <bool FIRST>
__device__ __forceinline__ void pp_vseg(f32x16* o, f32x16& ol, f32x16& n0, f32x16& n1, f32x16& minit, i32x8& pa, float* al_l, const int r32, const int hi) {
  asm volatile("" : "+v"(n0), "+v"(n1));
  float pmax;
  if (FIRST) pmax = psm_max(n0, n1);
  else {
    int im = __float_as_int(n0[0]);
#pragma unroll
    for (int r = 1; r < 16; ++r) { const int v_ = __float_as_int(n0[r]); im = im > v_ ? im : v_; }
#pragma unroll
    for (int r = 0; r < 16; ++r) { const int v_ = __float_as_int(n1[r]); im = im > v_ ? im : v_; }
    auto rr = __builtin_amdgcn_permlane32_swap((unsigned)im, (unsigned)im, false, false);
    const int a_ = (int)rr[0], b_ = (int)rr[1];
    pmax = __int_as_float(a_ > b_ ? a_ : b_);
  }
  if (FIRST || !__all(pmax <= PSH8 + THR8)) {
    const float delta = FIRST ? pmax - PSH8 : fmaxf(pmax - PSH8, 0.f);
#pragma unroll
    for (int r = 0; r < 16; ++r) { n0[r] -= delta; n1[r] -= delta; minit[r] -= delta; }
    if (!FIRST) {
      const float alpha = __builtin_amdgcn_exp2f(-delta);
      if (hi == 0) al_l[r32] = alpha;
      asm volatile("s_waitcnt lgkmcnt(0)" ::: "memory");
#pragma unroll
      for (int r = 0; r < 16; ++r) { const float a_ = al_l[crow(r, hi)]; o[0][r] *= a_; o[1][r] *= a_; o[2][r] *= a_; o[3][r] *= a_; ol[r] *= a_; }
    }
  }
#pragma unroll
  for (int r = 0; r < 16; ++r) n0[r] = __builtin_amdgcn_exp2f(n0[r]);
#pragma unroll
  for (int r = 0; r < 16; ++r) n1[r] = __builtin_amdgcn_exp2f(n1[r]);
#pragma unroll
  for (int w = 0; w < 4; ++w) { int t0_, t1_; asm volatile("" : "=v"(t0_), "=v"(t1_));
    t0_ = __builtin_amdgcn_cvt_pk_fp8_f32(n0[4 * w], n0[4 * w + 1], t0_, false); pa[w] = __builtin_amdgcn_cvt_pk_fp8_f32(n0[4 * w + 2], n0[4 * w + 3], t0_, true);
    t1_ = __builtin_amdgcn_cvt_pk_fp8_f32(n1[4 * w], n1[4 * w + 1], t1_, false); pa[4 + w] = __builtin_amdgcn_cvt_pk_fp8_f32(n1[4 * w + 2], n1[4 * w + 3], t1_, true); }
  asm volatile("" : "+v"(pa));
}
__device__ __forceinline__ void attn_f8pp_body(const unsigned char* __restrict__ Qb, const unsigned char* __restrict__ KV, const bf16* __restrict__ Gb, bf16* __restrict__ Ob, int seq, char* lds, const int wid) {
  int lane_l; asm volatile("v_mbcnt_lo_u32_b32 %0, -1, 0\n\tv_mbcnt_hi_u32_b32 %0, -1, %0" : "=v"(lane_l));
  const int lane = lane_l, r32 = lane & 31, hi = lane >> 5;
  const int ldsb = (int)(unsigned)(uintptr_t)lds;
  float* al_l = (float*)(lds + PP_AL) + wid * 32;
  int grp, w4;
  { int* sid = (int*)(lds + PP_AL + 1024);
    const int mine = (int)__builtin_amdgcn_s_getreg(2308);
    if (lane == 0) sid[wid] = mine;
    __syncthreads();
    int g[8], n0c = 0;
#pragma unroll
    for (int u = 0; u < 8; ++u) { const int su = __builtin_amdgcn_readfirstlane(sid[u]); int c = 0;
#pragma unroll
      for (int t = 0; t < 8; ++t) if (t < u) c += (__builtin_amdgcn_readfirstlane(sid[t]) == su) ? 1 : 0;
      g[u] = c; n0c += (c == 0) ? 1 : 0; }
    bool ok = (n0c == 4);
#pragma unroll
    for (int u = 0; u < 8; ++u) ok = ok && (g[u] <= 1);
    int gm = 0, rk = 0;
#pragma unroll
    for (int u = 0; u < 8; ++u) { if (u == wid) gm = g[u]; }
#pragma unroll
    for (int u = 0; u < 8; ++u) { if (u < wid && g[u] == gm) ++rk; }
    grp = ok ? gm : (wid >> 2); w4 = ok ? rk : (wid & 3);
    grp = __builtin_amdgcn_readfirstlane(grp); w4 = __builtin_amdgcn_readfirstlane(w4);
    __syncthreads(); }
  f32x16 o[4] = {}, ol = {}, minit, n0, n1; i32x8 qf[2], ones, pa, vf0, vf1;
#pragma unroll
  for (int r = 0; r < 16; ++r) minit[r] = PSH8;
  { int one4 = 0x38383838; asm volatile("" : "+v"(one4));
#pragma unroll
    for (int r = 0; r < 8; ++r) ones[r] = one4; }
#pragma unroll
  for (int r = 0; r < 8; ++r) { pa[r] = 0; vf0[r] = 0; vf1[r] = 0; }
  asm volatile("" : "+v"(ones));
#ifdef QK_FP4
  const int vg = (r32 >> 2) & 3, ka = r32 * 64 + ((hi ^ vg) << 4), ka1 = ka ^ 32, ka2 = 0, ka3 = 0, va = r32 * 64 + (((2 * hi) ^ vg) << 4), va1 = va ^ 16;
#else
  const int kf = (r32 >> 1) & 7, ka = r32 * 128 + (((2 * hi) ^ kf) << 4), vg = (r32 >> 2) & 3, va = r32 * 64 + (((2 * hi) ^ vg) << 4);
  const int ka1 = ka ^ 16, ka2 = ka ^ 64, ka3 = ka ^ 80, va1 = va ^ 16;
#endif
  const int kbase = ldsb + PP_KR, vbase = ldsb + PP_VR;
#ifdef QK_FP4
  const unsigned char* gsrc = KV + (grp ? PP_KIMG + 2 * w4 * 1024 : w4 * 1024) + lane * 16;
  const int ldst = ldsb + (grp ? PP_VR + 2 * w4 * 1024 : PP_KR + w4 * 1024);
#define PP_DMA(tile, slot) do { const unsigned char* g_ = gsrc + (long)(tile) * PP_TIMG; const int d_ = ldst + (slot) * (grp ? 8192 : PP_KIMG); \
    __builtin_amdgcn_global_load_lds((const unsigned*)g_, (__attribute__((address_space(3))) unsigned*)(uintptr_t)(unsigned)d_, 16, 0, 0); \
    if (grp) __builtin_amdgcn_global_load_lds((const unsigned*)(g_ + 1024), (__attribute__((address_space(3))) unsigned*)(uintptr_t)(unsigned)(d_ + 1024), 16, 0, 0); } while (0)
#else
  const unsigned char* gsrc = KV + (grp * 8 + 2 * w4) * 1024 + lane * 16;
  const int ldst = ldsb + (grp ? PP_VR : PP_KR) + 2 * w4 * 1024;
#define PP_DMA(tile, slot) do { const unsigned char* g_ = gsrc + (long)(tile) * PP_TIMG; const int d_ = ldst + (slot) * 8192; \
    __builtin_amdgcn_global_load_lds((const unsigned*)g_, (__attribute__((address_space(3))) unsigned*)(uintptr_t)(unsigned)d_, 16, 0, 0); \
    __builtin_amdgcn_global_load_lds((const unsigned*)(g_ + 1024), (__attribute__((address_space(3))) unsigned*)(uintptr_t)(unsigned)(d_ + 1024), 16, 0, 0); } while (0)
#endif
#define PP_BAR() do { SBAR(); __builtin_amdgcn_s_barrier(); SBAR(); } while (0)
#define PP_KOFF(s_) ((s_) / (8192 / PP_KIMG))
  const int NT = seq / KVBLK;
  PP_DMA(0, 0); PP_DMA(1, 1);
#ifdef QK_FP4
  { const unsigned char* Qw = Qb + (long)(wid * QBLK + r32) * LDQ4 + hi * 16;
#pragma unroll
    for (int s = 0; s < 2; ++s) { const i32x4 a = *reinterpret_cast<const i32x4*>(Qw + 32 * s); qf[s] = (i32x8){a[0], a[1], a[2], a[3], 0, 0, 0, 0}; } }
#else
  { const unsigned char* Qw = Qb + (long)(wid * QBLK + r32) * LDQ8 + hi * 32;
#pragma unroll
    for (int s = 0; s < 2; ++s) { const i32x4 a = *reinterpret_cast<const i32x4*>(Qw + 64 * s), b = *reinterpret_cast<const i32x4*>(Qw + 64 * s + 16); qf[s] = (i32x8){a[0], a[1], a[2], a[3], b[0], b[1], b[2], b[3]}; } }
#endif
  asm volatile("s_waitcnt vmcnt(0)" ::: "memory");
  __syncthreads();
  if (grp == 1) PP_BAR();
  int sa = 0, sb = 8192, sc = 16384;
  { const int kb_ = kbase + PP_KOFF(sa); pp_mseg<true, false>(o, ol, n0, n1, pa, ones, qf, minit, vf0, vf1, kb_ + ka, kb_ + ka1, kb_ + ka2, kb_ + ka3, 0, 0); }
  asm volatile("" : "+v"(n0), "+v"(n1)); PP_BAR();
  asm volatile("s_waitcnt vmcnt(0)" ::: "memory"); PP_DMA(2, 2);
  pp_vseg<true>(o, ol, n0, n1, minit, pa, al_l, r32, hi);
  { const int vb_ = vbase + sa; vf0 = lds2(vb_ + va, vb_ + va1, 0); vf1 = lds2(vb_ + va, vb_ + va1, 2048); }
  PP_BAR();
  { const int t = sa; sa = sb; sb = sc; sc = t; }
  int kA = kbase + ka, kA1 = kbase + ka1, kA2 = kbase + ka2, kA3 = kbase + ka3, vA = vbase + va, vA1 = vbase + va1;
  asm volatile("" : "+v"(kA), "+v"(kA1), "+v"(vA), "+v"(vA1));
#define PP_TILE(SA_, SC_) do { \
    pp_mseg<true, true>(o, ol, n0, n1, pa, ones, qf, minit, vf0, vf1, kA + PP_KOFF(SA_), kA1 + PP_KOFF(SA_), kA2 + PP_KOFF(SA_), kA3 + PP_KOFF(SA_), vA + (SC_), vA1 + (SC_)); \
    asm volatile("" : "+v"(n0), "+v"(n1), "+v"(o[0]), "+v"(o[1]), "+v"(o[2]), "+v"(o[3]), "+v"(ol)); PP_BAR(); \
    asm volatile("s_waitcnt vmcnt(0)" ::: "memory"); \
    { const int tl = (j + 2 < NT) ? j + 2 : NT - 1; PP_DMA(tl, (SC_) >> 13); } \
    pp_vseg<false>(o, ol, n0, n1, minit, pa, al_l, r32, hi); \
    vf0 = lds2(vA + (SA_), vA1 + (SA_), 0); vf1 = lds2(vA + (SA_), vA1 + (SA_), 2048); \
    PP_BAR(); ++j; } while (0)
  int j = 1;
  while (j + 2 < NT) { PP_TILE(8192, 0); PP_TILE(16384, 8192); PP_TILE(0, 16384); }
#undef PP_TILE
  for (; j < NT; ++j) {
    { const int kb_ = kbase + PP_KOFF(sa), vb_ = vbase + sc;
      pp_mseg<true, true>(o, ol, n0, n1, pa, ones, qf, minit, vf0, vf1, kb_ + ka, kb_ + ka1, kb_ + ka2, kb_ + ka3, vb_ + va, vb_ + va1); }
    asm volatile("" : "+v"(n0), "+v"(n1), "+v"(o[0]), "+v"(o[1]), "+v"(o[2]), "+v"(o[3]), "+v"(ol)); PP_BAR();
    asm volatile("s_waitcnt vmcnt(0)" ::: "memory");
    { const int tl = (j + 2 < NT) ? j + 2 : NT - 1; PP_DMA(tl, sc >> 13); }
    pp_vseg<false>(o, ol, n0, n1, minit, pa, al_l, r32, hi);
    { const int vb_ = vbase + sa; vf0 = lds2(vb_ + va, vb_ + va1, 0); vf1 = lds2(vb_ + va, vb_ + va1, 2048); }
    PP_BAR();
    { const int t = sa; sa = sb; sb = sc; sc = t; }
  }
  { const int vb_ = vbase + sc; pp_mseg<false, true>(o, ol, n0, n1, pa, ones, qf, minit, vf0, vf1, 0, 0, 0, 0, vb_ + va, vb_ + va1); }
  if (grp == 0) PP_BAR();
  asm volatile("s_waitcnt vmcnt(0)" ::: "memory");
  float rli[16];
#pragma unroll
  for (int r = 0; r < 16; ++r) rli[r] = __builtin_amdgcn_rcpf(ol[r]);
  __syncthreads();
  epi_stage_store<1>(o, rli, (__attribute__((address_space(3))) unsigned char*)(uintptr_t)(unsigned)(uintptr_t)lds + wid * EPI_BYTES, Gb + (long)(wid * QBLK) * LDQ, Ob + (long)(wid * QBLK) * LDO, lane);
  __syncthreads();
#undef PP_DMA
#undef PP_BAR
#undef PP_KOFF
}
#undef MFMA8
#undef MFMA8Q

#undef KSWZ
#undef SBAR
}

__device__ __forceinline__ float bflo(unsigned w) { return __uint_as_float(w << 16); }
__device__ __forceinline__ float bfhi(unsigned w) { return __uint_as_float(w & 0xffff0000u); }
__device__ __forceinline__ float silu_f(float x) { return x / (1.f + __expf(-x)); }
__device__ __forceinline__ float wave_max(float v) {
#pragma unroll
    for (int o = 1; o < 64; o <<= 1) v = fmaxf(v, __shfl_xor(v, o));
    return v;
}
__device__ __forceinline__ int t5_bucket(int rel) {
    const int n = rel < 0 ? -rel : rel; const float nf = (float)(n > 1 ? n : 1);
    int large = 8 + (int)(logf(nf * 0.125f) / 4.852030263919617f * 8.0f); large = large < 15 ? large : 15;
    return (rel > 0 ? 16 : 0) + (n < 8 ? n : large);
}

struct Args { const float* in[12]; float* out; unsigned char* ws; };

__device__ __forceinline__ void p0_prologue(const Args& a, LAS unsigned char* lds, int wave, int vcu, int G) {
    const int lane = fresh_lane(), tid = wave * 64 + lane;
    const float* c = a.in[1]; const float* w_mod = a.in[2]; const float* w_in = a.in[6]; const float* w_out = a.in[7]; const float* rel_bias = a.in[11];
    float* modp = (float*)(a.ws + WS_MODP);
    float* tab = (float*)(a.ws + WS_TAB);
    bf16* Win_t = (bf16*)(a.ws + WS_WIN); bf16* Wout_t = (bf16*)(a.ws + WS_WOUT);
    const int gt = vcu * (NWAVES * 64) + tid, NGT = G * NWAVES * 64;
    for (int e = gt; e < A_H * 3 * LUTA_N; e += NGT) { const int idx = e % LUTA_N, hp = e / LUTA_N, p = hp % 3, h = hp / 3, kk = idx - 92;
        float v = -1e30f; if (kk >= -64 && kk <= 64) v = rel_bias[t5_bucket(kk * (1 << (2 * p))) * (A_H + B_H) + h] * LOG2E;
        tab[TB_LUTA + e] = v; }
    for (int e = gt; e < B_H * LUTB_N; e += NGT) { const int idx = e % LUTB_N, h = e / LUTB_N, kk = idx - 156;
        float v = -1e30f; if (kk >= -128 && kk <= 128) v = rel_bias[t5_bucket(kk) * (A_H + B_H) + A_H + h] * LOG2E;
        tab[TB_LUTB + e] = v; }
    for (int e = gt; e < (256 + 64) * 32; e += NGT) { const int j = e & 31, pp = e >> 5, pos = pp < 256 ? pp : pp - 256;
        const float freq = exp2f(-(float)j * 0.4152410118609203f);
        const float ang = (float)pos * freq;
        double rev = (double)ang * 0.15915494309189535; rev -= floor(rev);
        const float cs_ = __builtin_amdgcn_cosf((float)rev), sn_ = __builtin_amdgcn_sinf((float)rev);
        float* d = tab + (pp < 256 ? TB_ROPE_R : TB_ROPE_C) + (pos * 32 + j) * 2; d[0] = cs_; d[1] = sn_; }
    LAS float* cs = (LAS float*)lds;
    LAS float* red = (LAS float*)(lds + 16384);
    for (int k = tid; k < DM; k += NWAVES * 64) cs[k] = silu_f(c[k]);
    __syncthreads();
#ifndef REP_GEMV
#define REP_GEMV 1
#endif
    for (int rep = 0; rep < REP_GEMV; ++rep)
    for (int it = vcu; it < DEPTH * 48 * 4; it += G) {
        const int kq = it & 3, nc = (it >> 2) % 48, ly = it / 192, k0 = kq * 1024 + wave * 128;
        const float* W = w_mod + (size_t)ly * DM * NMOD + (size_t)k0 * NMOD + nc * 256 + lane * 4;
        f32x4 acc = (f32x4){0.f, 0.f, 0.f, 0.f};
#pragma unroll 8
        for (int k = 0; k < 128; ++k) { const f32x4 w = *(const GAS f32x4*)(W + (size_t)k * NMOD); acc += w * cs[k0 + k]; }
        *(LAS f32x4*)(red + wave * 256 + lane * 4) = acc;
        __syncthreads();
        if (tid < 256) { float s = 0.f;
#pragma unroll
            for (int w = 0; w < NWAVES; ++w) s += red[w * 256 + tid];
            modp[(size_t)kq * DEPTH * NMOD + ly * NMOD + nc * 256 + tid] = s; }
        __syncthreads();
    }
    LAS float* scr = (LAS float*)(lds + wave * 16384);
    const int gw = vcu * NWAVES + wave, NGW = G * NWAVES;
    constexpr int I_IN = (DM / 64) * (INW / 32), I_OUT = (DM / 64) * (DM / 32), I_L = I_IN + I_OUT;
#ifndef REP_TR
#define REP_TR 1
#endif
    gu32* ctlw = (gu32*)(a.ws + WS_CTL);
    float amx = 0.f; int aly = -1;
#define AMX_FLUSH() do { if (aly >= 0) { float m_ = amx; for (int o_ = 1; o_ < 64; o_ <<= 1) m_ = fmaxf(m_, __shfl_xor(m_, o_)); \
        if (lane == 0) (void)__hip_atomic_fetch_max((unsigned*)(ctlw + CW_AMAX + 64 * aly), __builtin_bit_cast(unsigned, m_), RLX_AGENT); } } while (0)
    for (int rep = 0; rep < REP_TR; ++rep)
    for (int it = gw; it < DEPTH * I_L; it += NGW) {
        const int ly = it / I_L, r = it - ly * I_L;
        if (ly != aly) { AMX_FLUSH(); amx = 0.f; aly = ly; }
        if (r < I_IN) { const int n0 = 32 * (r % (INW / 32));
                        const int off = proj_col_of(n0) - n0;
                        if (proj_col_of(n0) >= F8_COL0) p0_transpose_item<true>(w_in + (size_t)ly * DM * INW, DM, INW, Win_t + (size_t)ly * INW * DM, off, scr, r, lane, amx);
                        else p0_transpose_item<false>(w_in + (size_t)ly * DM * INW, DM, INW, Win_t + (size_t)ly * INW * DM, off, scr, r, lane, amx); }
        else p0_transpose_item<false>(w_out + (size_t)ly * DM * DM, DM, DM, Wout_t + (size_t)ly * DM * DM, 0, scr, r - I_IN, lane, amx);
    }
    AMX_FLUSH();
#undef AMX_FLUSH
}

__device__ __forceinline__ int w8_exp(const Args& a, int layer) {
    const unsigned b = __hip_atomic_load((unsigned*)((gu32*)(a.ws + WS_CTL) + CW_AMAX + 64 * layer), RLX_AGENT);
    int e = 7 - ((int)(b >> 23) - 127); e = e > 60 ? 60 : (e < -60 ? -60 : e);
    return __builtin_amdgcn_readfirstlane(e);
}
__device__ __forceinline__ void w8_phase(const Args& a, int wave, int vcu, int G) {
    const int lane = fresh_lane();
    const bf16* Win_t = (const bf16*)(a.ws + WS_WIN); unsigned char* W8 = (unsigned char*)(a.ws + WS_W8);
    const int gw = vcu * NWAVES + wave, NGW = G * NWAVES;
    for (int row = gw; row < DEPTH * F8_COLS; row += NGW) {
        const int ly = row / F8_COLS, n = row % F8_COLS;
        const float sc = __builtin_bit_cast(float, (unsigned)(w8_exp(a, ly) + 127) << 23);
        const bf16* src = Win_t + ((size_t)ly * INW + F8_COL0 + n) * DM + lane * 8; unsigned char* dst = W8 + ((size_t)ly * F8_COLS + n) * DM + lane * 8;
        pg8::u32x4 r_[8];
#pragma unroll
        for (int j = 0; j < 8; ++j) r_[j] = *(const pg8::u32x4*)(src + j * 512);
#pragma unroll
        for (int j = 0; j < 8; ++j) {
            int lo = __builtin_amdgcn_cvt_pk_fp8_f32(bflo(r_[j].x) * sc, bfhi(r_[j].x) * sc, 0, false); lo = __builtin_amdgcn_cvt_pk_fp8_f32(bflo(r_[j].y) * sc, bfhi(r_[j].y) * sc, lo, true);
            int hi = __builtin_amdgcn_cvt_pk_fp8_f32(bflo(r_[j].z) * sc, bfhi(r_[j].z) * sc, 0, false); hi = __builtin_amdgcn_cvt_pk_fp8_f32(bflo(r_[j].w) * sc, bfhi(r_[j].w) * sc, hi, true);
            u32x2 w; w.x = (unsigned)lo; w.y = (unsigned)hi; *(u32x2*)(dst + j * 512) = w; }
    }
}

__device__ __forceinline__ void norm_phase(const Args& a, LAS unsigned char* lds, int layer_post, int layer_pre, const float* xin, int wave, int vcu, int G, bool dummy = false) {
    const int lane = fresh_lane(), tid = wave * 64 + lane;
    LAS float* Gv = (LAS float*)lds; LAS float* Av = Gv + DM; LAS float* Bv = Av + DM;
    const float* modp = (const float*)(a.ws + WS_MODP);
#define MOD4(i) (((*(const f32x4*)(modp + (i)) + *(const f32x4*)(modp + DEPTH * NMOD + (i))) + *(const f32x4*)(modp + 2 * DEPTH * NMOD + (i))) + *(const f32x4*)(modp + 3 * DEPTH * NMOD + (i)))
    const float* b_mod = a.in[3]; const float* pre_g = a.in[4]; const float* post_g = a.in[5];
#pragma unroll
    for (int hf = 0; hf < 2; ++hf) { const int j = tid * 8 + 4 * hf;
        if (layer_post >= 0) *(LAS f32x4*)(Gv + j) = (MOD4(layer_post * NMOD + 2 * DM + j) + *(const f32x4*)(b_mod + layer_post * NMOD + 2 * DM + j)) * *(const f32x4*)(post_g + layer_post * DM + j);
        if (layer_pre >= 0) { *(LAS f32x4*)(Av + j) = *(const f32x4*)(pre_g + layer_pre * DM + j) * (1.f + MOD4(layer_pre * NMOD + DM + j) + *(const f32x4*)(b_mod + layer_pre * NMOD + DM + j));
                              *(LAS f32x4*)(Bv + j) = MOD4(layer_pre * NMOD + j) + *(const f32x4*)(b_mod + layer_pre * NMOD + j); } }
#undef MOD4
    __syncthreads();
    const bf16* Y = (const bf16*)(a.ws + WS_Y); bf16* H = (bf16*)(a.ws + (dummy ? WS_END + 256 * MiB : WS_H)); float* xout = dummy ? (float*)(a.ws + WS_END) : a.out;
    const int gw = vcu * NWAVES + wave, NGW = G * NWAVES;
    for (int row = gw; row < S; row += NGW) {
        const GAS f32x4* xr = (const GAS f32x4*)(xin + (size_t)row * DM) + lane;
        f32x4 v[16];
#pragma unroll
        for (int j = 0; j < 16; ++j) v[j] = xr[64 * j];
        if (layer_post >= 0) {
            const GAS u32x2* yr = (const GAS u32x2*)(Y + (size_t)row * DM) + lane;
            u32x2 yv[16]; float ss = 0.f;
#pragma unroll
            for (int j = 0; j < 16; ++j) { yv[j] = yr[64 * j]; const float y0 = bflo(yv[j].x), y1 = bfhi(yv[j].x), y2 = bflo(yv[j].y), y3 = bfhi(yv[j].y); ss += (y0 * y0 + y1 * y1) + (y2 * y2 + y3 * y3); }
            const float ry = rsqrtf(wave_sum_l(ss, lane) * (1.f / DM) + EPS);
            GAS f32x4* xo = (GAS f32x4*)(xout + (size_t)row * DM) + lane;
#pragma unroll
            for (int j = 0; j < 16; ++j) { const f32x4 g = *(const LAS f32x4*)(Gv + j * 256 + lane * 4);
                const f32x4 yf = (f32x4){bflo(yv[j].x), bfhi(yv[j].x), bflo(yv[j].y), bfhi(yv[j].y)};
                v[j] = v[j] + g * yf * ry; xo[64 * j] = v[j]; }
        }
        if (layer_pre >= 0) {
            float ss = 0.f;
#pragma unroll
            for (int j = 0; j < 16; ++j) ss += (v[j].x * v[j].x + v[j].y * v[j].y) + (v[j].z * v[j].z + v[j].w * v[j].w);
            const float rx = rsqrtf(wave_sum_l(ss, lane) * (1.f / DM) + EPS);
            GAS u32x2* ho = (GAS u32x2*)(H + (size_t)row * DM) + lane;
            GAS int* h8o = (GAS int*)((unsigned char*)(a.ws + (dummy ? WS_END + 320 * MiB : WS_H8)) + (size_t)row * DM) + lane;
#pragma unroll
            for (int j = 0; j < 16; ++j) { const f32x4 av = *(const LAS f32x4*)(Av + j * 256 + lane * 4), bv = *(const LAS f32x4*)(Bv + j * 256 + lane * 4);
                const f32x4 hv = v[j] * rx * av + bv; u32x2 w; w.x = pg8::cvt_pk_bf16(hv.x, hv.y); w.y = pg8::cvt_pk_bf16(hv.z, hv.w); ho[64 * j] = w;
                int w8_ = __builtin_amdgcn_cvt_pk_fp8_f32(hv.x, hv.y, 0, false); w8_ = __builtin_amdgcn_cvt_pk_fp8_f32(hv.z, hv.w, w8_, true); h8o[64 * j] = w8_; }
        }
    }
    __syncthreads();
}

__device__ __forceinline__ void prep_phase(const Args& a, LAS unsigned char* lds, int layer, int wave, int vcu, int G) {
    const int lane = fresh_lane();
    bf16* proj = (bf16*)(a.ws + WS_PROJ); const float* tab = (const float*)(a.ws + WS_TAB);
    const float* qg = a.in[8] + layer * HD; const float* kg = a.in[9] + layer * HD;
    const int l16 = lane & 15, half = l16 >> 3, jj = (l16 & 7) * 4, grp = lane >> 4;
    const f32x4 gq1 = *(const f32x4*)(qg + half * 64 + jj), gq2 = *(const f32x4*)(qg + half * 64 + 32 + jj);
    const f32x4 gk1 = *(const f32x4*)(kg + half * 64 + jj), gk2 = *(const f32x4*)(kg + half * 64 + 32 + jj);
    const int gw = vcu * NWAVES + wave, NGW = G * NWAVES;
    for (int t = gw; t < S; t += NGW) {
        const int pos = half ? (t & 63) : (t >> 6);
        const float* rt = tab + (half ? TB_ROPE_C : TB_ROPE_R) + (pos * 32 + jj) * 2;
        const f32x4 cs0 = *(const f32x4*)rt, cs1 = *(const f32x4*)(rt + 4);
        const f32x4 cv = (f32x4){cs0.x, cs0.z, cs1.x, cs1.z}, sv = (f32x4){cs0.y, cs0.w, cs1.y, cs1.w};
#pragma unroll
        for (int it = 0; it < 4; ++it) {
            const int hh = it * 4 + grp;
            bf16* p = proj + (size_t)t * PLD + PC(COL_CQ + hh * HD) + half * 64 + jj;
            const u32x2 r1 = *(const u32x2*)p, r2 = *(const u32x2*)(p + 32);
            const f32x4 x1 = (f32x4){bflo(r1.x), bfhi(r1.x), bflo(r1.y), bfhi(r1.y)}, x2 = (f32x4){bflo(r2.x), bfhi(r2.x), bflo(r2.y), bfhi(r2.y)};
            float ss = (x1.x * x1.x + x1.y * x1.y) + (x1.z * x1.z + x1.w * x1.w) + (x2.x * x2.x + x2.y * x2.y) + (x2.z * x2.z + x2.w * x2.w);
            ss += lane_xor(ss, 1, lane); ss += lane_xor(ss, 2, lane); ss += lane_xor(ss, 4, lane); ss += lane_xor(ss, 8, lane);
            const float r = rsqrtf(ss * (1.f / HD) + EPS);
            const f32x4 g1 = (it == 3) ? gk1 : gq1, g2 = (it == 3) ? gk2 : gq2;
            const f32x4 y1 = x1 * r * g1, y2 = x2 * r * g2;
            const f32x4 o1_ = y1 * cv - y2 * sv, o2_ = y2 * cv + y1 * sv;
#ifndef ATT_F8
            const f32x4 o1 = o1_, o2 = o2_;
#endif
#ifdef ATT_F8
#if defined(ATT_PP) && defined(QK_FP4)
            { unsigned char* d8; int d8b;
              if (it == 3) { unsigned char* rb = (unsigned char*)(a.ws + WS_KF8) + ((size_t)((hh - 12) * (S / 64) + (t >> 6))) * attc::PP_TIMG + (t & 63) * 64 + (jj >> 1);
                             const int c1 = half * 2, kg = ((t & 63) >> 2) & 3; d8 = rb + ((c1 ^ kg) << 4); d8b = (((c1 + 1) ^ kg) << 4) - ((c1 ^ kg) << 4); }
              else { d8 = (unsigned char*)(a.ws + WS_QF8) + (size_t)t * attc::LDQ4 + hh * 64 + half * 32 + (jj >> 1); d8b = 16; }
              const float qs = (it == 3) ? attc::K4_PRESCALE : attc::Q4_PRESCALE; const f32x4 o1 = o1_ * qs, o2 = o2_ * qs;
              const unsigned a0 = __builtin_amdgcn_cvt_scalef32_pk_fp4_f32(0u, o1.x, o1.y, 1.f, 0) & 0xffu, a1 = __builtin_amdgcn_cvt_scalef32_pk_fp4_f32(0u, o1.z, o1.w, 1.f, 0) & 0xffu;
              const unsigned b0 = __builtin_amdgcn_cvt_scalef32_pk_fp4_f32(0u, o2.x, o2.y, 1.f, 0) & 0xffu, b1 = __builtin_amdgcn_cvt_scalef32_pk_fp4_f32(0u, o2.z, o2.w, 1.f, 0) & 0xffu;
              *(unsigned short*)d8 = (unsigned short)(a0 | (a1 << 8)); *(unsigned short*)(d8 + d8b) = (unsigned short)(b0 | (b1 << 8)); }
#elif defined(ATT_PP)
            unsigned char* d8; int d8b;
            if (it == 3) { unsigned char* rb = (unsigned char*)(a.ws + WS_KF8) + ((size_t)((hh - 12) * (S / 64) + (t >> 6))) * attc::PP_TIMG + (t & 63) * 128 + (jj & 15);
                           const int c1 = half * 4 + (jj >> 4), kf = ((t & 63) >> 1) & 7; d8 = rb + ((c1 ^ kf) << 4); d8b = (((c1 + 2) ^ kf) << 4) - ((c1 ^ kf) << 4); }
            else { d8 = (unsigned char*)(a.ws + WS_QF8) + (size_t)t * (C_H * HD) + hh * HD + half * 64 + jj; d8b = 32; }
            {
#else
            { const int d8b = 32;
              unsigned char* d8 = (it == 3) ? (unsigned char*)(a.ws + WS_KF8) + (size_t)t * 512 + (hh - 12) * HD + half * 64 + jj
                                            : (unsigned char*)(a.ws + WS_QF8) + (size_t)t * (C_H * HD) + hh * HD + half * 64 + jj;
#endif
#if !(defined(ATT_PP) && defined(QK_FP4))
              const float qs = (it == 3) ? 1.f : attc::Q8_PRESCALE; const f32x4 o1 = o1_ * qs, o2 = o2_ * qs;
              int t1 = __builtin_amdgcn_cvt_pk_fp8_f32(o1.x, o1.y, 0, false); t1 = __builtin_amdgcn_cvt_pk_fp8_f32(o1.z, o1.w, t1, true);
              int t2 = __builtin_amdgcn_cvt_pk_fp8_f32(o2.x, o2.y, 0, false); t2 = __builtin_amdgcn_cvt_pk_fp8_f32(o2.z, o2.w, t2, true);
              *(int*)d8 = t1; *(int*)(d8 + d8b) = t2; }
#endif
#else
            u32x2 w1, w2; w1.x = pg8::cvt_pk_bf16(o1.x, o1.y); w1.y = pg8::cvt_pk_bf16(o1.z, o1.w); w2.x = pg8::cvt_pk_bf16(o2.x, o2.y); w2.y = pg8::cvt_pk_bf16(o2.z, o2.w);
            *(u32x2*)p = w1; *(u32x2*)(p + 32) = w2;
#endif
        }
    }
#ifdef ATT_F8
    { typedef attc::bf16x8 bx8; typedef attc::s16x4 sx4;
      unsigned char* VT8 = (unsigned char*)(a.ws + WS_VTF8);
      LAS unsigned char* img = lds + wave * 8192;
      const int lane2 = fresh_lane(), r32 = lane2 & 31, hi = lane2 >> 5, vrow = lane2 >> 4, vch = lane2 & 15;
      LAS unsigned char* vwr = img + (vch >> 2) * 512 + vrow * 64 + (vch & 3) * 16;
      const int vb = (int)(uintptr_t)img + attc::v_rd_base(lane2);
      for (int itv = gw; itv < 4 * (S / 32); itv += NGW) {
        const int kv = itv / (S / 32), t0 = (itv % (S / 32)) * 32;
        bx8 vs[8];
#pragma unroll
        for (int i = 0; i < 8; ++i) vs[i] = *reinterpret_cast<const bx8*>(proj + (size_t)(t0 + vrow + 4 * i) * PLD + PC(COL_CV + kv * HD) + vch * 8);
#pragma unroll
        for (int i = 0; i < 8; ++i) *reinterpret_cast<LAS bx8*>(vwr + (i & 1) * 2048 + ((i >> 1) & 1) * 256 + ((i >> 2) & 1) * 4096) = vs[i];
#ifdef ATT_PP
        const int vg = (r32 >> 2) & 3, c_lo = (t0 >> 5) & 1;
        unsigned char* rowp = (unsigned char*)(a.ws + WS_KF8) + ((size_t)(kv * (S / 64) + (t0 >> 6))) * attc::PP_TIMG + attc::PP_KIMG + r32 * 64 + ((c_lo ^ vg) << 4) + 4 * hi;
        const int hi_off = (((c_lo + 2) ^ vg) << 4) - ((c_lo ^ vg) << 4);
#else
        const int hi_off = 32;
        unsigned char* rowp = VT8 + (size_t)kv * HD * S + (size_t)(t0 >> 6) * 8192 + r32 * 64 + ((t0 & 32) ? 16 : 0) + 4 * hi;
#endif
#define VTR8(D0, KS) do { const sx4 l_ = attc::tr_read<attc::v_rd_off(D0, KS, 0)>(vb), h_ = attc::tr_read<attc::v_rd_off(D0, KS, 1)>(vb); asm volatile("s_waitcnt lgkmcnt(0)" ::: "memory"); __builtin_amdgcn_sched_barrier(0); \
          int lo_ = __builtin_amdgcn_cvt_pk_fp8_f32(__uint_as_float((unsigned)(unsigned short)l_[0] << 16), __uint_as_float((unsigned)(unsigned short)l_[1] << 16), 0, false); \
          lo_ = __builtin_amdgcn_cvt_pk_fp8_f32(__uint_as_float((unsigned)(unsigned short)l_[2] << 16), __uint_as_float((unsigned)(unsigned short)l_[3] << 16), lo_, true); \
          int hi_ = __builtin_amdgcn_cvt_pk_fp8_f32(__uint_as_float((unsigned)(unsigned short)h_[0] << 16), __uint_as_float((unsigned)(unsigned short)h_[1] << 16), 0, false); \
          hi_ = __builtin_amdgcn_cvt_pk_fp8_f32(__uint_as_float((unsigned)(unsigned short)h_[2] << 16), __uint_as_float((unsigned)(unsigned short)h_[3] << 16), hi_, true); \
          unsigned char* q_ = rowp + (D0 * 32) * 64 + 8 * KS; *(int*)q_ = lo_; *(int*)(q_ + hi_off) = hi_; } while (0)
        VTR8(0, 0); VTR8(0, 1); VTR8(1, 0); VTR8(1, 1); VTR8(2, 0); VTR8(2, 1); VTR8(3, 0); VTR8(3, 1);
#undef VTR8
        asm volatile("s_waitcnt lgkmcnt(0)" ::: "memory");
      } }
#endif
}

template <bool IS_B>
__device__ __forceinline__ void naive_band(const bf16* proj, bf16* o, const float* lut, float sink_l2, int t, int qcol, int kcol, int vcol, int gcol, int ocol,
                                           LAS float* sc, LAS int* jr, int lane) {
    constexpr int NS = IS_B ? 257 : 387;
    const int l16 = lane & 15, grp = lane >> 4;
    float qf[8];
    { const pg8::u32x4 qraw = *(const pg8::u32x4*)(proj + (size_t)t * INW + qcol + l16 * 8);
      qf[0] = bflo(qraw.x) * QK_C; qf[1] = bfhi(qraw.x) * QK_C; qf[2] = bflo(qraw.y) * QK_C; qf[3] = bfhi(qraw.y) * QK_C;
      qf[4] = bflo(qraw.z) * QK_C; qf[5] = bfhi(qraw.z) * QK_C; qf[6] = bflo(qraw.w) * QK_C; qf[7] = bfhi(qraw.w) * QK_C; }
    for (int s0 = 0; s0 < NS; s0 += 4) {
        const int s = s0 + grp; const bool inr = s < NS; const int ss = inr ? s : NS - 1;
        int j, li;
        if (IS_B) { j = t + ss - 128; li = ss + 28; }
        else { const int p = ss / 129, kk = ss - p * 129; j = t + (kk - 64) * (1 << (2 * p)); li = p * LUTA_N + kk + 28; }
        const bool valid = inr && j >= 0 && j < S;
        const int jc = j < 0 ? 0 : (j > S - 1 ? S - 1 : j);
        const pg8::u32x4 kr = *(const pg8::u32x4*)(proj + (size_t)jc * INW + kcol + l16 * 8);
        float d = qf[0] * bflo(kr.x) + qf[1] * bfhi(kr.x) + qf[2] * bflo(kr.y) + qf[3] * bfhi(kr.y) + qf[4] * bflo(kr.z) + qf[5] * bfhi(kr.z) + qf[6] * bflo(kr.w) + qf[7] * bfhi(kr.w);
        d += lane_xor(d, 1, lane); d += lane_xor(d, 2, lane); d += lane_xor(d, 4, lane); d += lane_xor(d, 8, lane);
        const float sv = valid ? d + lut[li] : -1e30f;
        if (l16 == 0 && inr) { sc[s] = sv; jr[s] = jc; }
    }
    float mx = -1e30f;
    for (int s = lane; s < NS; s += 64) mx = fmaxf(mx, sc[s]);
    mx = wave_max_l(mx, lane); if (IS_B) mx = fmaxf(mx, sink_l2);
    float lsum = 0.f;
    for (int s = lane; s < NS; s += 64) { const float p = exp2f(sc[s] - mx); sc[s] = p; lsum += p; }
    lsum = wave_sum_l(lsum, lane); if (IS_B) lsum += exp2f(sink_l2 - mx);
    float a0 = 0.f, a1 = 0.f;
#pragma unroll 4
    for (int s = 0; s < NS; ++s) { const float p = sc[s]; const int j = jr[s];
        const unsigned v = *(const unsigned*)(proj + (size_t)j * INW + vcol + lane * 2); a0 += p * bflo(v); a1 += p * bfhi(v); }
    const unsigned g = *(const unsigned*)(proj + (size_t)t * INW + gcol + lane * 2);
    const float inv = 1.f / lsum;
    *(unsigned*)(o + (size_t)t * DM + ocol + lane * 2) = pg8::cvt_pk_bf16(a0 * inv * silu_f(bflo(g)), a1 * inv * silu_f(bfhi(g)));
}

__device__ __forceinline__ void naive_ab_phase(const Args& a, LAS unsigned char* lds, int layer, int wave, int vcu, int G) {
    const int lane = fresh_lane();
    const bf16* proj = (const bf16*)(a.ws + WS_PROJ); bf16* o = (bf16*)(a.ws + WS_O); const float* tab = (const float*)(a.ws + WS_TAB);
    const float* sink = a.in[10] + layer * B_H;
    LAS float* sc = (LAS float*)(lds + wave * 4096); LAS int* jr = (LAS int*)(lds + wave * 4096 + 2048);
    const int gw = vcu * NWAVES + wave, NGW = G * NWAVES;
    for (int t = gw; t < S; t += NGW) {
        for (int h = 0; h < A_H; ++h)
            naive_band<false>(proj, o, tab + TB_LUTA + h * 3 * LUTA_N, 0.f, t, COL_AQ + h * HD, COL_AK + h * HD, COL_AV + h * HD, COL_AG + h * HD, OCOL_A + h * HD, sc, jr, lane);
        for (int h = 0; h < B_H; ++h)
            naive_band<true>(proj, o, tab + TB_LUTB + h * LUTB_N, sink[h] * LOG2E, t, COL_BQ + h * HD, COL_BK + (h >> 2) * HD, COL_BV + (h >> 2) * HD, COL_BG + h * HD, OCOL_B + h * HD, sc, jr, lane);
    }
}

namespace band {
using attc::bf16x8; using attc::s16x4; using attc::f32x16; using attc::u32x4; using attc::crow; using attc::cvtpk; using attc::v_rd_base; using attc::v_rd_off; using attc::tr_read;
constexpr float THR2 = 8.f;
constexpr int KPITCH = 272;
constexpr int WAVE_LDS = 8192 + 32 * KPITCH;
static_assert(WAVE_LDS >= attc::EPI_BYTES, "O stage fits the per-wave region");
enum Mode { P16 = 0, P4 = 1, P1 = 2, MB = 3 };
constexpr int A_ROW = A_H * HD;
template <int D0> __device__ __forceinline__ void pv32(f32x16& od, int vb, bf16x8 pa0, bf16x8 pa1) {
  const s16x4 l0 = tr_read<v_rd_off(D0, 0, 0)>(vb), h0 = tr_read<v_rd_off(D0, 0, 1)>(vb), l1 = tr_read<v_rd_off(D0, 1, 0)>(vb), h1 = tr_read<v_rd_off(D0, 1, 1)>(vb);
  asm volatile("s_waitcnt lgkmcnt(0)" ::: "memory"); __builtin_amdgcn_sched_barrier(0);
#define PK(L, H) (bf16x8){L[0], L[1], L[2], L[3], H[0], H[1], H[2], H[3]}
  od = __builtin_amdgcn_mfma_f32_32x32x16_bf16(pa0, PK(l0, h0), od, 0, 0, 0);
  od = __builtin_amdgcn_mfma_f32_32x32x16_bf16(pa1, PK(l1, h1), od, 0, 0, 0);
#undef PK
}
__device__ __forceinline__ void epi_stage(const f32x16 (&o)[4], const float (&rli)[16], LAS unsigned char* st, int lane) {
  asm volatile("" : "+v"(lane));
  const int r32 = lane & 31, hi = lane >> 5;
#pragma unroll
  for (int r = 0; r < 16; ++r) { const int row = crow(r, hi);
#pragma unroll
    for (int d0 = 0; d0 < 4; ++d0) *reinterpret_cast<LAS float*>(st + row * attc::EPI_PITCH + (d0 * 32 + r32) * 4) = o[d0][r] * rli[r]; }
}
template <int QS>
__device__ __forceinline__ void epi_partial_out(LAS unsigned char* st, bf16* __restrict__ dst, int lane) {
  typedef float f32x4_t __attribute__((ext_vector_type(4)));
  asm volatile("" : "+v"(lane));
  const int rr = lane >> 4, c16 = lane & 15;
#pragma unroll
  for (int i = 0; i < 8; ++i) { const int row = rr + 4 * i;
    const f32x4_t a = *reinterpret_cast<const LAS f32x4_t*>(st + row * attc::EPI_PITCH + c16 * 32);
    const f32x4_t b = *reinterpret_cast<const LAS f32x4_t*>(st + row * attc::EPI_PITCH + c16 * 32 + 16);
    u32x4 w = {cvtpk(a[0], a[1]), cvtpk(a[2], a[3]), cvtpk(b[0], b[1]), cvtpk(b[2], b[3])};
    *reinterpret_cast<u32x4*>(dst + (size_t)(QS * row) * A_ROW + c16 * 8) = w; }
}
__device__ __forceinline__ void epi_gate_out(LAS unsigned char* st, const u32x4 (&g)[8], bf16* __restrict__ obase, int lane) {
  typedef float f32x4_t __attribute__((ext_vector_type(4)));
  asm volatile("" : "+v"(lane));
  const int rr = lane >> 4, c16 = lane & 15;
#pragma unroll
  for (int i = 0; i < 8; ++i) { const int row = rr + 4 * i;
    const f32x4_t a = *reinterpret_cast<const LAS f32x4_t*>(st + row * attc::EPI_PITCH + c16 * 32);
    const f32x4_t b = *reinterpret_cast<const LAS f32x4_t*>(st + row * attc::EPI_PITCH + c16 * 32 + 16);
    float v[8] = {a[0], a[1], a[2], a[3], b[0], b[1], b[2], b[3]};
#pragma unroll
    for (int e = 0; e < 4; ++e) { const float g0 = __uint_as_float(g[i][e] << 16), g1 = __uint_as_float(g[i][e] & 0xffff0000u);
      v[2 * e] *= g0 * __builtin_amdgcn_rcpf(1.f + __expf(-g0)); v[2 * e + 1] *= g1 * __builtin_amdgcn_rcpf(1.f + __expf(-g1)); }
    u32x4 w = {cvtpk(v[0], v[1]), cvtpk(v[2], v[3]), cvtpk(v[4], v[5]), cvtpk(v[6], v[7])};
    *reinterpret_cast<u32x4*>(obase + (size_t)row * DM + c16 * 8) = w; }
}
__device__ __forceinline__ void epi_merge(LAS unsigned char* st, const LAS float* cw, const bf16* __restrict__ p4, const bf16* __restrict__ p16,
                                          const bf16* __restrict__ gbase, bf16* __restrict__ obase, int lane) {
  typedef float f32x4_t __attribute__((ext_vector_type(4)));
  asm volatile("" : "+v"(lane));
  const int rr = lane >> 4, c16 = lane & 15;
#pragma unroll
  for (int hf = 0; hf < 2; ++hf) {
    u32x4 g[4], x4[4], x16[4];
#pragma unroll
    for (int i = 0; i < 4; ++i) { const int row = rr + 4 * (4 * hf + i);
      g[i] = *reinterpret_cast<const u32x4*>(gbase + (size_t)row * PLD + c16 * 8);
      x4[i] = *reinterpret_cast<const u32x4*>(p4 + (size_t)row * A_ROW + c16 * 8); x16[i] = *reinterpret_cast<const u32x4*>(p16 + (size_t)row * A_ROW + c16 * 8); }
#pragma unroll
    for (int i = 0; i < 4; ++i) { const int row = rr + 4 * (4 * hf + i);
      const f32x4_t a = *reinterpret_cast<const LAS f32x4_t*>(st + row * attc::EPI_PITCH + c16 * 32);
      const f32x4_t b = *reinterpret_cast<const LAS f32x4_t*>(st + row * attc::EPI_PITCH + c16 * 32 + 16);
      const float w4 = cw[row], w16 = cw[32 + row];
      float v[8] = {a[0], a[1], a[2], a[3], b[0], b[1], b[2], b[3]};
#pragma unroll
      for (int e = 0; e < 4; ++e) { const float g0 = __uint_as_float(g[i][e] << 16), g1 = __uint_as_float(g[i][e] & 0xffff0000u);
        v[2 * e]     = (v[2 * e]     + w4 * __uint_as_float(x4[i][e] << 16)         + w16 * __uint_as_float(x16[i][e] << 16))         * (g0 * __builtin_amdgcn_rcpf(1.f + __expf(-g0)));
        v[2 * e + 1] = (v[2 * e + 1] + w4 * __uint_as_float(x4[i][e] & 0xffff0000u) + w16 * __uint_as_float(x16[i][e] & 0xffff0000u)) * (g1 * __builtin_amdgcn_rcpf(1.f + __expf(-g1))); }
      u32x4 w = {cvtpk(v[0], v[1]), cvtpk(v[2], v[3]), cvtpk(v[4], v[5]), cvtpk(v[6], v[7])};
      *reinterpret_cast<u32x4*>(obase + (size_t)row * DM + c16 * 8) = w; }
    asm volatile("" ::: "memory"); }
}
struct Part { bf16* p4; bf16* p16; float* s4; float* s16; };
struct Next { bool has; int q0, qcol, kcol, vcol; };
template <int MODE>
__device__ __forceinline__ void wave_tile(const bf16* __restrict__ proj, bf16* __restrict__ obuf, const Part& part, int h, int q0, int qcol, int kcol, int vcol, int gcol, int ocol,
                                          float m_init, float l_init, LAS unsigned char* vlds, LAS float* xch, LAS float* lut, const float* __restrict__ lut_g, int lane,
                                          bf16x8 (&qr)[8], bf16x8 (&ks8)[8], bf16x8 (&vs)[8], bool pre, const Next nx) {
  constexpr int KS = MODE == P16 ? 16 : (MODE == P4 ? 4 : 1), W = MODE == MB ? 128 : 64, NTT = MODE == MB ? 9 : 5;
  const int r32 = lane & 31, hi = lane >> 5, vrow = lane >> 4, vch = lane & 15;
#define BAND_QLOAD(q0_, qcol_) do { const bf16* qp = proj + (size_t)((q0_) + KS * r32) * PLD + (qcol_) + hi * 8; \
    _Pragma("unroll") for (int d0 = 0; d0 < 8; ++d0) qr[d0] = *reinterpret_cast<const bf16x8*>(qp + d0 * 16); } while (0)
  if (!pre) BAND_QLOAD(q0, qcol);
  f32x16 o[4] = {}; float m_reg = m_init, l_reg = l_init;
  const int vb = (int)(uintptr_t)vlds + v_rd_base(lane);
  LAS unsigned char* klds = vlds + 8192;
  LAS unsigned char* vwr = vlds + (vch >> 2) * 512 + vrow * 64 + (vch & 3) * 16;
  LAS unsigned char* kwr = klds + vrow * KPITCH + vch * 16;
  const LAS unsigned char* krd = klds + r32 * KPITCH + hi * 16;
#define BAND_ISSUE(kt_, kcol, vcol) do { _Pragma("unroll") for (int i = 0; i < 8; ++i) { int tv = (kt_) + KS * (vrow + 4 * i); tv = tv < 0 ? 0 : (tv > S - 1 ? S - 1 : tv); \
        const bf16* rp = proj + (size_t)tv * PLD + vch * 8; ks8[i] = *reinterpret_cast<const bf16x8*>(rp + kcol); vs[i] = *reinterpret_cast<const bf16x8*>(rp + vcol); } } while (0)
  int kt = q0 - W * KS;
  if (!pre) BAND_ISSUE(kt, kcol, vcol);
  { constexpr int LN = MODE == MB ? LUTB_N : LUTA_N, LK = (LN + 63) / 64; float lv[LK];
#pragma unroll
    for (int k = 0; k < LK; ++k) { const int e = lane + 64 * k; lv[k] = lut_g[e < LN ? e : LN - 1]; }
#pragma unroll
    for (int k = 0; k < LK; ++k) { const int e = lane + 64 * k; if (e < LN) lut[e] = lv[k]; } }
#pragma nounroll
  for (int tt = 0; tt < NTT; ++tt) {
#pragma unroll
    for (int i = 0; i < 8; ++i) { *reinterpret_cast<LAS bf16x8*>(vwr + (i & 1) * 2048 + ((i >> 1) & 1) * 256 + ((i >> 2) & 1) * 4096) = vs[i];
                                  *reinterpret_cast<LAS bf16x8*>(kwr + i * 4 * KPITCH) = ks8[i]; }
    f32x16 p0 = {};
#pragma unroll
    for (int d0 = 0; d0 < 8; ++d0) { const bf16x8 kfr = *reinterpret_cast<const LAS bf16x8*>(krd + d0 * 32);
      p0 = __builtin_amdgcn_mfma_f32_32x32x16_bf16(kfr, qr[d0], p0, 0, 0, 0); }
    const int c_kt = kt; kt += 32 * KS;
    if (tt + 1 < NTT) BAND_ISSUE(kt, kcol, vcol);
    float tv[16];
    { int dl = -W + 32 * tt + 4 * hi - r32; dl = dl < -(W + 28) ? -(W + 28) : (dl > W + 1 ? W + 1 : dl);
      const LAS float* lp = lut + (dl + (W + 28));
#pragma unroll
      for (int r = 0; r < 16; ++r) tv[r] = fmaf(p0[r], QK_C, lp[(r & 3) + 8 * (r >> 2)]); }
    if (c_kt < 0 || c_kt + 31 * KS > S - 1) {
#pragma unroll
      for (int r = 0; r < 16; ++r) { const int tok = c_kt + KS * crow(r, hi); if (tok < 0 || tok > S - 1) tv[r] = -1e30f; } }
    float pmax = tv[0];
#pragma unroll
    for (int r = 1; r < 16; ++r) pmax = fmaxf(pmax, tv[r]);
    { auto rr = __builtin_amdgcn_permlane32_swap(__float_as_uint(pmax), __float_as_uint(pmax), false, false); pmax = fmaxf(__uint_as_float(rr[0]), __uint_as_float(rr[1])); }
    float alpha = 1.f;
    if (!__all(pmax - m_reg <= THR2)) { const float mn = fmaxf(m_reg, pmax); alpha = __builtin_amdgcn_exp2f(m_reg - mn); m_reg = mn; }
    float ps = 0.f;
#pragma unroll
    for (int r = 0; r < 16; ++r) { tv[r] = __builtin_amdgcn_exp2f(tv[r] - m_reg); ps += tv[r]; }
    { auto rr = __builtin_amdgcn_permlane32_swap(__float_as_uint(ps), __float_as_uint(ps), false, false); ps = __uint_as_float(rr[0]) + __uint_as_float(rr[1]); }
    l_reg = l_reg * alpha + ps;
    bf16x8 pa0, pa1;
#define PK4(P, BASE, OUT) do { unsigned a0 = cvtpk(P[BASE + 0], P[BASE + 1]), a1 = cvtpk(P[BASE + 2], P[BASE + 3]);   \
    unsigned b0 = cvtpk(P[BASE + 4], P[BASE + 5]), b1 = cvtpk(P[BASE + 6], P[BASE + 7]);                              \
    auto r0 = __builtin_amdgcn_permlane32_swap(a0, b0, false, false); auto r1 = __builtin_amdgcn_permlane32_swap(a1, b1, false, false); \
    u32x4 w = {r0[0], r1[0], r0[1], r1[1]}; OUT = *reinterpret_cast<bf16x8*>(&w); } while (0)
    PK4(tv, 0, pa0); PK4(tv, 8, pa1);
#undef PK4
    if (__any(alpha < 1.f)) { if (hi == 0) xch[r32] = alpha; asm volatile("s_waitcnt lgkmcnt(0)" ::: "memory");
#pragma unroll
      for (int d = 0; d < 4; ++d)
#pragma unroll
        for (int r = 0; r < 16; ++r) o[d][r] *= xch[crow(r, hi)]; }
    pv32<0>(o[0], vb, pa0, pa1); pv32<1>(o[1], vb, pa0, pa1); pv32<2>(o[2], vb, pa0, pa1); pv32<3>(o[3], vb, pa0, pa1);
  }
  float f = __builtin_amdgcn_rcpf(l_reg);
  if (MODE == P16 || MODE == P4) {
    if (hi == 0) { float* sp = (MODE == P16 ? part.s16 : part.s4) + ((size_t)(q0 + KS * r32) * A_H + h) * 2; sp[0] = m_reg; sp[1] = l_reg; } }
  if (MODE == P1) {
    const size_t si = ((size_t)(q0 + r32) * A_H + h) * 2;
    const float m4 = part.s4[si], l4 = part.s4[si + 1], m16 = part.s16[si], l16 = part.s16[si + 1];
    const float M = fmaxf(m_reg, fmaxf(m4, m16));
    const float e1 = __builtin_amdgcn_exp2f(m_reg - M), e4 = l4 * __builtin_amdgcn_exp2f(m4 - M), e16 = l16 * __builtin_amdgcn_exp2f(m16 - M);
    const float rden = __builtin_amdgcn_rcpf(l_reg * e1 + e4 + e16);
    f = e1 * rden;
    if (hi == 0) { xch[64 + r32] = e4 * rden; xch[96 + r32] = e16 * rden; } }
  if (hi == 0) xch[32 + r32] = f; asm volatile("s_waitcnt lgkmcnt(0)" ::: "memory");
  float rli[16];
#pragma unroll
  for (int r = 0; r < 16; ++r) rli[r] = xch[32 + crow(r, hi)];
  u32x4 gpre[8];
  if (MODE == MB) {
    int vr2 = vrow; asm volatile("" : "+v"(vr2));
    const bf16* gb = proj + (size_t)q0 * PLD + gcol + vch * 8;
#pragma unroll
    for (int i = 0; i < 8; ++i) gpre[i] = *reinterpret_cast<const u32x4*>(gb + (size_t)(vr2 + 4 * i) * PLD); }
  epi_stage(o, rli, vlds, lane);
  if (nx.has) { BAND_QLOAD(nx.q0, nx.qcol); BAND_ISSUE(nx.q0 - W * KS, nx.kcol, nx.vcol); }
  if (MODE == P16) epi_partial_out<KS>(vlds, part.p16 + (size_t)q0 * A_ROW + h * HD, lane);
  else if (MODE == P4) epi_partial_out<KS>(vlds, part.p4 + (size_t)q0 * A_ROW + h * HD, lane);
  else if (MODE == P1) epi_merge(vlds, xch + 64, part.p4 + (size_t)q0 * A_ROW + h * HD, part.p16 + (size_t)q0 * A_ROW + h * HD, proj + (size_t)q0 * PLD + gcol, obuf + (size_t)q0 * DM + ocol, lane);
  else epi_gate_out(vlds, gpre, obuf + (size_t)q0 * DM + ocol, lane);
#undef BAND_ISSUE
#undef BAND_QLOAD
}
}

__device__ __forceinline__ void band_phase(const Args& a, LAS unsigned char* lds, int layer, int pass, int wave, int vcu, int G) {
    const int lane = fresh_lane();
    const bf16* proj = (const bf16*)(a.ws + WS_PROJ); bf16* o = (bf16*)(a.ws + WS_O); const float* tab = (const float*)(a.ws + WS_TAB);
    band::Part part; part.p4 = (bf16*)(a.ws + WS_PART4); part.p16 = (bf16*)(a.ws + WS_PART16); part.s4 = (float*)(a.ws + WS_STAT4); part.s16 = (float*)(a.ws + WS_STAT16);
    LAS unsigned char* vlds = lds + wave * band::WAVE_LDS; LAS float* xch = (LAS float*)(lds + BAND_LUT_OFF + wave * BAND_LUT_WAVE); LAS float* lut = xch + 128;
    typedef band::bf16x8 bf16x8;
    if (pass == 0) {
        { bool pre = false; bf16x8 qr[8], ks8[8], vs[8];
          for (int ua = vcu; ua < A_H * 64; ua += G) {
            const int h = ua / 64, rem = ua % 64, u = rem >> 1, r = (rem & 1) * 8 + wave;
            const int un = ua + G; band::Next nx; nx.has = un < A_H * 64; { const int h2 = un / 64, rem2 = un % 64; nx.q0 = 512 * (rem2 >> 1) + (rem2 & 1) * 8 + wave; nx.qcol = PC(COL_AQ + h2 * HD); nx.kcol = PC(COL_AK + h2 * HD); nx.vcol = PC(COL_AV + h2 * HD); }
            const float* lut_g = tab + TB_LUTA + (h * 3 + 2) * LUTA_N;
            band::wave_tile<band::P16>(proj, o, part, h, 512 * u + r, PC(COL_AQ + h * HD), PC(COL_AK + h * HD), PC(COL_AV + h * HD), PC(COL_AG + h * HD), OCOL_A + h * HD, -1e20f, 0.f, vlds, xch, lut, lut_g, lane, qr, ks8, vs, pre, nx);
            pre = nx.has; } }
        { bool pre = false; bf16x8 qr[8], ks8[8], vs[8];
          for (int ua = vcu; ua < A_H * 64; ua += G) {
            const int h = ua / 64, b = ua % 64;
            const int un = ua + G; band::Next nx; nx.has = un < A_H * 64; { const int h2 = un / 64, b2 = un % 64; nx.q0 = 256 * b2 + 128 * (wave >> 2) + (wave & 3); nx.qcol = PC(COL_AQ + h2 * HD); nx.kcol = PC(COL_AK + h2 * HD); nx.vcol = PC(COL_AV + h2 * HD); }
            const float* lut_g = tab + TB_LUTA + (h * 3 + 1) * LUTA_N;
            band::wave_tile<band::P4>(proj, o, part, h, 256 * b + 128 * (wave >> 2) + (wave & 3), PC(COL_AQ + h * HD), PC(COL_AK + h * HD), PC(COL_AV + h * HD), PC(COL_AG + h * HD), OCOL_A + h * HD, -1e20f, 0.f, vlds, xch, lut, lut_g, lane, qr, ks8, vs, pre, nx);
            pre = nx.has; } }
        const float* sink = a.in[10] + layer * B_H;
        { bool pre = false; bf16x8 qr[8], ks8[8], vs[8];
          for (int ub = vcu; ub < B_H * 64; ub += G) {
            const int kv = ub / 256, rem = ub % 256, qblk = rem >> 2, h = kv * 4 + (rem & 3);
            const int un = ub + G; band::Next nx; nx.has = un < B_H * 64; { const int kv2 = un / 256, rem2 = un % 256, h2 = kv2 * 4 + (rem2 & 3); nx.q0 = (rem2 >> 2) * 256 + wave * 32; nx.qcol = PC(COL_BQ + h2 * HD); nx.kcol = PC(COL_BK + kv2 * HD); nx.vcol = PC(COL_BV + kv2 * HD); }
            const float* lut_g = tab + TB_LUTB + h * LUTB_N;
            band::wave_tile<band::MB>(proj, o, part, h, qblk * 256 + wave * 32, PC(COL_BQ + h * HD), PC(COL_BK + kv * HD), PC(COL_BV + kv * HD), PC(COL_BG + h * HD), OCOL_B + h * HD, sink[h] * LOG2E, 1.f, vlds, xch, lut, lut_g, lane, qr, ks8, vs, pre, nx);
            pre = nx.has; } }
    } else {
        band::Next nx; nx.has = false; nx.q0 = 0; nx.qcol = 0; nx.kcol = 0; nx.vcol = 0;
        for (int ua = vcu; ua < A_H * 64; ua += G) {
            bf16x8 qr[8], ks8[8], vs[8];
            const int h = ua / 64, b = ua % 64;
            const float* lut_g = tab + TB_LUTA + (h * 3 + 0) * LUTA_N;
            band::wave_tile<band::P1>(proj, o, part, h, 256 * b + 32 * wave, PC(COL_AQ + h * HD), PC(COL_AK + h * HD), PC(COL_AV + h * HD), PC(COL_AG + h * HD), OCOL_A + h * HD, -1e20f, 0.f, vlds, xch, lut, lut_g, lane, qr, ks8, vs, false, nx);
        }
    }
}

__global__ void __launch_bounds__(NWAVES * 64, 2) fwd_kernel(Args args) {
    extern __shared__ __attribute__((aligned(16))) unsigned char lds_raw[];
    LAS unsigned char* lds = (LAS unsigned char*)lds_raw;
    volatile LAS unsigned* MISC = (volatile LAS unsigned*)(lds + MISC_OFF);
    const int wave = __builtin_amdgcn_readfirstlane((int)threadIdx.x >> 6);
    const int G = gridDim.x; const int bx = blockIdx.x; const int vcu = (G % 8 == 0) ? (bx % 8) * (G / 8) + bx / 8 : bx;
    gu32* ctl = (gu32*)(args.ws + WS_CTL);
    for (int u = threadIdx.x; u < (LDS_BYTES - LDSCTL_OFF) / 4; u += NWAVES * 64) ((LAS unsigned*)(lds + LDSCTL_OFF))[u] = 0u;
    __syncthreads();
    XcdBarrier bar = xcd_barrier_post((unsigned*)(ctl + CW_BAR), MISC + 8, (unsigned)wave);
    const bf16* Win_t = (const bf16*)(args.ws + WS_WIN); const bf16* Wout_t = (const bf16*)(args.ws + WS_WOUT);
    bf16* Hb = (bf16*)(args.ws + WS_H); bf16* PROJ = (bf16*)(args.ws + WS_PROJ); bf16* Ob = (bf16*)(args.ws + WS_O); bf16* Yb = (bf16*)(args.ws + WS_Y);

    p0_prologue(args, lds, wave, vcu, G);
    xcd_barrier(bar);
    norm_phase(args, lds, -1, 0, args.in[0], wave, vcu, G);
    w8_phase(args, wave, vcu, G);
    xcd_barrier(bar);

#pragma nounroll
    for (int layer = 0; layer < DEPTH; ++layer) {
#ifndef REP_G1
#define REP_G1 1
#endif
        for (int rep = 0; rep < REP_G1; ++rep)
        {
          pg8::Gemm g{Hb, Win_t + (size_t)layer * INW * DM, S, F8_COL0, DM}; pg8::StaticOrder so; so.init(S, F8_COL0, G, bx);
          pg8::EpiStoreT E{PROJ, (size_t)S * 256};
          const int whole = (so.nwg / G) * G, rest = so.nwg - whole; const bool halves = (2 * rest == G);
          if (halves) so.lim = whole;
          pg8::gemm_phase<pg8::EpiStoreT, pg8::StaticOrder, true, true>(lds + RING_OFF, g, so, E, wave);
          if (halves) { pg8::HalfOrder ho; ho.base = so; ho.first = whole;
              pg8::gemm_phase<pg8::EpiStoreT, pg8::HalfOrder, true, true, true>(lds + RING_OFF, g, ho, E, wave); }
          pg8::Gemm g8{(const pg8::bf16_t*)(args.ws + WS_H8), (const pg8::bf16_t*)(args.ws + WS_W8 + (size_t)layer * F8_COLS * DM), S, F8_COLS, DM / 2}; pg8::StaticOrder s8; s8.init(S, F8_COLS, G, bx);
          pg8::EpiStoreT E8{PROJ + (size_t)(F8_COL0 / 256) * S * 256, (size_t)S * 256};
          const int sclb = 127 - w8_exp(args, layer);
          const int whole8 = (s8.nwg / G) * G, rest8 = s8.nwg - whole8; const bool halves8 = (2 * rest8 == G);
          if (halves8) s8.lim = whole8;
          pg8::gemm_phase<pg8::EpiStoreT, pg8::StaticOrder, true, true, false, true>(lds + RING_OFF, g8, s8, E8, wave, sclb);
          if (halves8) { pg8::HalfOrder h8; h8.base = s8; h8.first = whole8;
              pg8::gemm_phase<pg8::EpiStoreT, pg8::HalfOrder, true, true, true, true>(lds + RING_OFF, g8, h8, E8, wave, sclb); } }
        xcd_barrier(bar);
        prep_phase(args, lds, layer, wave, vcu, G);
        __syncthreads();
        band_phase(args, lds, layer, 0, wave, vcu, G);
        xcd_barrier(bar);
#ifndef REP_C
#define REP_C 1
#endif
        for (int rep = 0; rep < REP_C; ++rep)
        for (int i = 0;; ++i) {
            const int u = i * G + vcu; if (u >= C_H * (S / 256)) break;
            const int gq = u / 256, rem = u % 256, kv = rem / 64, qb = rem % 64, head = kv * 3 + gq;
#if defined(ATT_PP)
#ifdef QK_FP4
            attc::attn_f8pp_body((const unsigned char*)(args.ws + WS_QF8) + (size_t)(qb * 256) * attc::LDQ4 + head * 64,
#else
            attc::attn_f8pp_body((const unsigned char*)(args.ws + WS_QF8) + (size_t)(qb * 256) * (C_H * HD) + head * HD,
#endif
 (const unsigned char*)(args.ws + WS_KF8) + (size_t)kv * (S / 64) * attc::PP_TIMG,
                                 PROJ + (size_t)(qb * 256) * PLD + PC(COL_CG + head * HD), Ob + (size_t)(qb * 256) * DM + OCOL_C + head * HD, S, (char*)lds_raw + RING_OFF, wave);
#elif defined(ATT_F8)
            attc::attn_f8_body((const unsigned char*)(args.ws + WS_QF8) + (size_t)(qb * 256) * (C_H * HD) + head * HD, (const unsigned char*)(args.ws + WS_KF8) + kv * HD,
                               (const unsigned char*)(args.ws + WS_VTF8) + (size_t)kv * HD * S,
                               PROJ + (size_t)(qb * 256) * PLD + PC(COL_CG + head * HD), Ob + (size_t)(qb * 256) * DM + OCOL_C + head * HD, S, (char*)lds_raw + RING_OFF, wave);
#else
            attc::attn_dense_body(PROJ + (size_t)(qb * 256) * INW + COL_CQ + head * HD, PROJ + COL_CK + kv * HD, PROJ + COL_CV + kv * HD,
                                  PROJ + (size_t)(qb * 256) * PLD + PC(COL_CG + head * HD), Ob + (size_t)(qb * 256) * DM + OCOL_C + head * HD, S, (char*)lds_raw + RING_OFF, wave);
#endif
        }
        band_phase(args, lds, layer, 1, wave, vcu, G);
        xcd_barrier(bar);
#ifndef REP_G2
#define REP_G2 1
#endif
        for (int rep = 0; rep < REP_G2; ++rep)
        { pg8::Gemm g{Ob, Wout_t + (size_t)layer * DM * DM, S, DM, DM}; pg8::StaticOrder so; so.init(S, DM, G, bx);
          pg8::EpiStore E{Yb, DM};
          pg8::gemm_phase<pg8::EpiStore, pg8::StaticOrder, true, true>(lds + RING_OFF, g, so, E, wave); }
        xcd_barrier(bar);
#ifdef REP_NORM
        norm_phase(args, lds, layer, layer + 1 < DEPTH ? layer + 1 : -1, layer == 0 ? args.in[0] : (const float*)args.out, wave, vcu, G, true);
#endif
        norm_phase(args, lds, layer, layer + 1 < DEPTH ? layer + 1 : -1, layer == 0 ? args.in[0] : (const float*)args.out, wave, vcu, G);
        if (layer + 1 < DEPTH) xcd_barrier(bar);
    }
}

extern "C" void kernel_launch(void* const* d_in, const int* in_sizes, int n_in, void* d_out, int out_size, void* d_ws, size_t ws_size, hipStream_t stream) {
    static int grid = 0;
    if (grid == 0) {
        if (n_in != 12 || in_sizes[0] != S * DM || out_size != S * DM || ws_size < WS_END) {
            fprintf(stderr, "kernel_launch: shape mismatch: n_in %d in0 %d out %d ws %zu (need >= %zu); nothing launched\n", n_in, n_in > 0 ? in_sizes[0] : -1, out_size, ws_size, (size_t)WS_END); grid = -1; return; }
        int dev = 0, cus = 0, per_cu = 0;
        if (hipGetDevice(&dev) != hipSuccess || hipDeviceGetAttribute(&cus, hipDeviceAttributeMultiprocessorCount, dev) != hipSuccess) { fprintf(stderr, "kernel_launch: device query failed\n"); grid = -1; return; }
        if (hipFuncSetAttribute((const void*)fwd_kernel, hipFuncAttributeMaxDynamicSharedMemorySize, LDS_BYTES) != hipSuccess) { fprintf(stderr, "kernel_launch: hipFuncSetAttribute failed\n"); grid = -1; return; }
        if (hipOccupancyMaxActiveBlocksPerMultiprocessor(&per_cu, (const void*)fwd_kernel, NWAVES * 64, LDS_BYTES) != hipSuccess || per_cu < 1)
            fprintf(stderr, "kernel_launch: note: occupancy query reports %d workgroups per CU\n", per_cu);
        (void)hipGetLastError();
        grid = cus;
    }
    if (grid < 0) return;
    if (hipMemsetAsync((char*)d_ws + WS_CTL, 0, CTL_ZERO_BYTES, stream) != hipSuccess) { fprintf(stderr, "kernel_launch: memset failed\n"); return; }
    Args a{};
    for (int i = 0; i < 12; ++i) a.in[i] = (const float*)d_in[i];
    a.out = (float*)d_out; a.ws = (unsigned char*)d_ws;
    hipLaunchKernelGGL(fwd_kernel, dim3(grid), dim3(NWAVES * 64), LDS_BYTES, stream, a);
    const hipError_t le = hipPeekAtLastError();
    if (le != hipSuccess) fprintf(stderr, "kernel_launch: launch failed: %s\n", hipGetErrorName(le));
}
```
